# Optimizing an MI355X kernel written in HIP

```python
import jax
import jax.numpy as jnp
from jax import lax
import numpy as np

D_MODEL = 1024
BATCH = 4
SEQ = 8192
DEPTH = 4

GRID_W = 64
CTX_LEN = 256
N_MIXERS = 2
N_MOD = 6
EPS = 1e-6
FNET_GROUPS = 4
FNET_GROUP_DIM = D_MODEL // FNET_GROUPS
HEAD_DIM = 64
N_HEADS = D_MODEL // HEAD_DIM
N_KV_HEADS = 4
GROUP = N_HEADS // N_KV_HEADS
QKV_DIM = (N_HEADS + 2 * N_KV_HEADS) * HEAD_DIM
WINDOW = 128
BLOCK = 128
ROPE_THETA = 10000.0
ROT_FREQS = HEAD_DIM // 4
D_FF = D_MODEL * 7 // 2
N_EXPERTS = 8
TOP_K = 2
MOE_BLOCK = 256

kernel_name = "hybrid_fnet_swa_moe_dit"


def rms_norm(x, g):
    xf = x.astype(jnp.float32)
    return (xf * lax.rsqrt(jnp.mean(xf * xf, axis=-1, keepdims=True) + EPS)).astype(x.dtype) * g


def modulate(h, shift, scale):
    return h * (1 + scale) + shift


def swiglu(h, w_gate, w_up, w_down):
    return (jax.nn.silu(h @ w_gate) * (h @ w_up)) @ w_down


def moe_swiglu(h, w_router, w_gate, w_up, w_down):
    T, D = h.shape
    logits = (h @ w_router).astype(jnp.float32)
    top_logit, top_idx = lax.top_k(logits, TOP_K)
    gates = jax.nn.softmax(top_logit, axis=-1)
    flat_e = top_idx.reshape(-1)
    flat_g = gates.reshape(-1)
    n_pairs = T * TOP_K
    order = jnp.argsort(flat_e)
    sorted_e = flat_e[order]
    sorted_tok = (order // TOP_K).astype(jnp.int32)
    counts = jnp.bincount(flat_e, length=N_EXPERTS)
    padded = (counts + MOE_BLOCK - 1) // MOE_BLOCK * MOE_BLOCK
    pad_end = jnp.cumsum(padded)
    pad_start = pad_end - padded
    start = jnp.cumsum(counts) - counts
    dest = pad_start[sorted_e] + jnp.arange(n_pairs) - start[sorted_e]
    n_blocks = -(-n_pairs // MOE_BLOCK) + N_EXPERTS
    cap = n_blocks * MOE_BLOCK
    slot_tok = jnp.zeros((cap,), jnp.int32).at[dest].set(sorted_tok)
    slot_w = jnp.zeros((cap,), jnp.float32).at[dest].set(flat_g[order])
    block_expert = jnp.minimum(
        jnp.searchsorted(pad_end, jnp.arange(n_blocks) * MOE_BLOCK, side='right'), N_EXPERTS - 1)
    xs = h[slot_tok].reshape(n_blocks, MOE_BLOCK, D)

    def expert_group(args):
        xb, e = args
        return swiglu(xb, w_gate[e], w_up[e], w_down[e])

    ys = lax.map(expert_group, (xs, block_expert)).reshape(cap, D)
    return jnp.zeros_like(h).at[slot_tok].add(ys * slot_w[:, None].astype(h.dtype))


def fourier_mix(h, w_out):
    B, N, _ = h.shape
    hg = h.astype(jnp.float32).reshape(B, N, FNET_GROUPS, FNET_GROUP_DIM)
    mixed = jnp.fft.fft2(hg, axes=(1, 3), norm='ortho').real
    return mixed.reshape(B, N, D_MODEL).astype(h.dtype) @ w_out


def axial_rope_tables(n_rows):
    row = jnp.repeat(jnp.arange(n_rows, dtype=jnp.float32), GRID_W)
    col = jnp.tile(jnp.arange(GRID_W, dtype=jnp.float32), n_rows)
    inv_freq = ROPE_THETA ** (-jnp.arange(ROT_FREQS, dtype=jnp.float32) / ROT_FREQS)
    ang = jnp.stack([row[:, None] * inv_freq, col[:, None] * inv_freq], axis=1)
    return jnp.cos(ang), jnp.sin(ang)


def apply_rope(x, cos, sin):
    xr = x.reshape(x.shape[:3] + (2, 2, ROT_FREQS))
    x1 = xr[..., 0, :]
    x2 = xr[..., 1, :]
    c = cos[None, :, None].astype(x.dtype)
    s = sin[None, :, None].astype(x.dtype)
    return jnp.stack([x1 * c - x2 * s, x2 * c + x1 * s], axis=-2).reshape(x.shape)


def window_gqa_attention(h_lat, h_ctx, w_qkv, w_o, sinks, cos, sin, ctx_out):
    B, S, _ = h_lat.shape
    L = h_ctx.shape[1]
    nb = S // BLOCK
    scale = HEAD_DIM ** -0.5

    def project(h):
        n = h.shape[1]
        q, k, v = jnp.split(h @ w_qkv, [N_HEADS * HEAD_DIM, (N_HEADS + N_KV_HEADS) * HEAD_DIM], axis=-1)
        return (q.reshape(B, n, N_HEADS, HEAD_DIM), k.reshape(B, n, N_KV_HEADS, HEAD_DIM),
                v.reshape(B, n, N_KV_HEADS, HEAD_DIM))

    q_l, k_l, v_l = project(h_lat)
    q_l = apply_rope(q_l, cos, sin).reshape(B, S, N_KV_HEADS, GROUP, HEAD_DIM)
    k_l = apply_rope(k_l, cos, sin)
    q_c, k_c, v_c = project(h_ctx)
    sink = sinks.astype(jnp.float32).reshape(N_KV_HEADS, GROUP)[None, :, :, None, None]

    def sink_softmax(logits):
        b, kv, g, nq, _ = logits.shape
        sink_col = jnp.broadcast_to(sink, (b, kv, g, nq, 1))
        return jax.nn.softmax(jnp.concatenate([logits, sink_col], axis=-1), axis=-1)[..., :-1]

    def band(t):
        tp = jnp.pad(t, ((0, 0), (BLOCK, BLOCK), (0, 0), (0, 0))).reshape(B, nb + 2, BLOCK, N_KV_HEADS, HEAD_DIM)
        w = jnp.concatenate([tp[:, :-2], tp[:, 1:-1], tp[:, 2:]], axis=2)
        return w.transpose(1, 0, 2, 3, 4)

    q_idx = jnp.arange(BLOCK)[:, None]
    k_idx = jnp.arange(3 * BLOCK)[None, :]
    in_window = jnp.abs(k_idx - BLOCK - q_idx) <= WINDOW
    key_pos = jnp.arange(nb)[:, None] * BLOCK - BLOCK + jnp.arange(3 * BLOCK)[None, :]
    in_range = (key_pos >= 0) & (key_pos < S)
    mask = jnp.concatenate([in_window[None] & in_range[:, None, :],
                            jnp.ones((nb, BLOCK, L), dtype=bool)], axis=-1)

    def latent_block(args):
        qb, kb, vb, mb = args
        k_all = jnp.concatenate([kb, k_c], axis=1)
        v_all = jnp.concatenate([vb, v_c], axis=1)
        logits = jnp.einsum('bqkgd,bjkd->bkgqj', qb, k_all).astype(jnp.float32) * scale
        logits = jnp.where(mb, logits, -jnp.inf)
        p = sink_softmax(logits).astype(vb.dtype)
        return jnp.einsum('bkgqj,bjkd->bqkgd', p, v_all)

    q_blocks = q_l.reshape(B, nb, BLOCK, N_KV_HEADS, GROUP, HEAD_DIM).transpose(1, 0, 2, 3, 4, 5)
    o_l = lax.map(latent_block, (q_blocks, band(k_l), band(v_l), mask))
    o_l = o_l.transpose(1, 0, 2, 3, 4, 5).reshape(B, S, N_HEADS * HEAD_DIM) @ w_o
    if not ctx_out:
        return o_l, None
    q_c = q_c.reshape(B, L, N_KV_HEADS, GROUP, HEAD_DIM)
    logits_c = jnp.einsum('bqkgd,bjkd->bkgqj', q_c, k_c).astype(jnp.float32) * scale
    p_c = sink_softmax(logits_c).astype(v_c.dtype)
    o_c = jnp.einsum('bkgqj,bjkd->bqkgd', p_c, v_c).reshape(B, L, N_HEADS * HEAD_DIM) @ w_o
    return o_l, o_c


def setup_inputs(seed: int = 0) -> dict:
    key = jax.random.key(seed)
    ks = jax.random.split(key, 20)
    n_even = (DEPTH + 1) // 2
    n_odd = DEPTH // 2
    f32 = jnp.float32

    def normal(k, shape):
        return jax.random.normal(k, shape, f32)

    def dense(k, shape, fan_in):
        return normal(k, shape) * fan_in ** -0.5

    return {
        'x': normal(ks[0], (BATCH, SEQ, D_MODEL)),
        'c': normal(ks[1], (BATCH, D_MODEL)),
        'ctx': normal(ks[2], (BATCH, CTX_LEN, D_MODEL)),
        'c_ctx': normal(ks[3], (D_MODEL,)),
        'ada_w': dense(ks[4], (DEPTH, D_MODEL, N_MOD * D_MODEL), D_MODEL) * 0.5,
        'ada_b': 0.02 * normal(ks[5], (DEPTH, N_MOD * D_MODEL)),
        'norm_mix_g': 1.0 + 0.05 * normal(ks[6], (DEPTH, D_MODEL)),
        'norm_ffn_g': 1.0 + 0.05 * normal(ks[7], (DEPTH, D_MODEL)),
        'fnet_w_out': dense(ks[8], (n_even, D_MODEL, D_MODEL), D_MODEL),
        'attn_w_qkv': dense(ks[9], (n_odd, D_MODEL, QKV_DIM), D_MODEL),
        'attn_w_o': dense(ks[10], (n_odd, N_HEADS * HEAD_DIM, D_MODEL), N_HEADS * HEAD_DIM),
        'attn_sinks': normal(ks[11], (n_odd, N_HEADS)),
        'ffn_w_gate': dense(ks[12], (n_even, D_MODEL, D_FF), D_MODEL),
        'ffn_w_up': dense(ks[13], (n_even, D_MODEL, D_FF), D_MODEL),
        'ffn_w_down': dense(ks[14], (n_even, D_FF, D_MODEL), D_FF),
        'moe_w_router': dense(ks[15], (n_odd, D_MODEL, N_EXPERTS), D_MODEL),
        'moe_w_gate': dense(ks[16], (n_odd, N_EXPERTS, D_MODEL, D_FF), D_MODEL),
        'moe_w_up': dense(ks[17], (n_odd, N_EXPERTS, D_MODEL, D_FF), D_MODEL),
        'moe_w_down': dense(ks[18], (n_odd, N_EXPERTS, D_FF, D_MODEL), D_FF),
        'final_norm_g': 1.0 + 0.05 * normal(ks[19], (D_MODEL,)),
    }


def reference(x, c, ctx, c_ctx, ada_w, ada_b, norm_mix_g, norm_ffn_g, fnet_w_out, attn_w_qkv, attn_w_o,
              attn_sinks, ffn_w_gate, ffn_w_up, ffn_w_down, moe_w_router, moe_w_gate, moe_w_up, moe_w_down,
              final_norm_g):
    B, S, D = x.shape
    L = ctx.shape[1]
    rows = S // GRID_W
    cos, sin = axial_rope_tables(rows)
    silu_c = jax.nn.silu(c)
    silu_cc = jax.nn.silu(c_ctx)
    x_lat, x_ctx = x, ctx
    for i in range(DEPTH):
        j = i // 2
        last = i == DEPTH - 1
        is_attn = i % N_MIXERS == 1
        sh_l, sc_l, g_l, shf_l, scf_l, gf_l = jnp.split(silu_c @ ada_w[i] + ada_b[i], N_MOD, axis=-1)
        sh_c, sc_c, g_c, shf_c, scf_c, gf_c = jnp.split(silu_cc @ ada_w[i] + ada_b[i], N_MOD, axis=-1)
        h_lat = modulate(rms_norm(x_lat, norm_mix_g[i]), sh_l[:, None], sc_l[:, None])
        if is_attn:
            h_ctx = modulate(rms_norm(x_ctx, norm_mix_g[i]), sh_c, sc_c)
            y_lat, y_ctx = window_gqa_attention(h_lat, h_ctx, attn_w_qkv[j], attn_w_o[j], attn_sinks[j],
                                                cos, sin, not last)
        else:
            y_lat = fourier_mix(h_lat, fnet_w_out[j])
            if not last:
                y_ctx = fourier_mix(modulate(rms_norm(x_ctx, norm_mix_g[i]), sh_c, sc_c), fnet_w_out[j])
        x_lat = x_lat + g_l[:, None] * y_lat
        if not last:
            x_ctx = x_ctx + g_c * y_ctx
        tokens = modulate(rms_norm(x_lat, norm_ffn_g[i]), shf_l[:, None], scf_l[:, None]).reshape(B * S, D)
        if not last:
            hf_ctx = modulate(rms_norm(x_ctx, norm_ffn_g[i]), shf_c, scf_c).reshape(B * L, D)
            tokens = jnp.concatenate([tokens, hf_ctx], axis=0)
        if i % 2 == 0:
            y = swiglu(tokens, ffn_w_gate[j], ffn_w_up[j], ffn_w_down[j])
        else:
            y = moe_swiglu(tokens, moe_w_router[j], moe_w_gate[j], moe_w_up[j], moe_w_down[j])
        x_lat = x_lat + gf_l[:, None] * y[:B * S].reshape(B, S, D)
        if not last:
            x_ctx = x_ctx + gf_c * y[B * S:].reshape(B, L, D)
    return rms_norm(x_lat, final_norm_g)
```

```cpp
#include <hip/hip_runtime.h>
#include <cstdio>
#include <cstdint>
#include <cmath>

constexpr int DM = 1024, NB = 4, SEQ = 8192, DEPTH = 4, CTXL = 256;
constexpr int TL = NB * SEQ;
constexpr int TC = NB * CTXL;
constexpr int TT = TL + TC;
constexpr int NMOD = 6, DFF = 3584, NEXP = 8, QKVD = 1536, NH = 16, NKV = 4, HD = 64;
constexpr int FN1 = 128, FN2 = 64;
constexpr float EPS = 1e-6f;

constexpr size_t MiB = 1ull << 20;
constexpr size_t WS_CTL = 0;
constexpr size_t WS_MOD = 1 * MiB;
constexpr size_t WS_ROPE = 2 * MiB;
constexpr size_t WS_XC = 3 * MiB;
constexpr size_t WS_ROUTE = 8 * MiB;
constexpr size_t WS_S = 416 * MiB;

struct Prm {
    const float *x, *c, *ctx, *c_ctx, *ada_w, *ada_b, *nmg, *nfg, *fw, *wqkv, *wo, *sinks, *fg, *fu, *fd, *mr, *mg, *mu, *md, *fng;
    float* out; unsigned char* ws;
};

__device__ __forceinline__ float silu_f(float v) { return v / (1.f + expf(-v)); }
__device__ __forceinline__ int row_b5(int r) { return r < TL ? r / SEQ : 4; }
__device__ __forceinline__ float* xrow(const Prm& p, int r) { return r < TL ? p.out + (size_t)r * DM : (float*)(p.ws + WS_XC) + (size_t)(r - TL) * DM; }

__global__ void nk_adaln(Prm p) {
    const int idx = blockIdx.x * blockDim.x + threadIdx.x;
    if (idx >= DEPTH * 5 * NMOD * DM) return;
    const int n = idx % (NMOD * DM), r = (idx / (NMOD * DM)) % 5, l = idx / (5 * NMOD * DM);
    const float* cv = r < 4 ? p.c + r * DM : p.c_ctx;
    const float* w = p.ada_w + (size_t)l * DM * NMOD * DM;
    float acc = 0.f;
    for (int k = 0; k < DM; ++k) acc += silu_f(cv[k]) * w[(size_t)k * NMOD * DM + n];
    ((float*)(p.ws + WS_MOD))[idx] = acc + p.ada_b[l * NMOD * DM + n];
}
__global__ void nk_rope(Prm p) {
    const int idx = blockIdx.x * blockDim.x + threadIdx.x;
    if (idx >= 128 * 16) return;
    const int pos = idx / 16, f = idx % 16;
    const float inv = powf(10000.f, -(float)f / 16.f);
    const float ang = (float)pos * inv;
    ((float2*)(p.ws + WS_ROPE))[idx] = make_float2((float)cos((double)ang), (float)sin((double)ang));
}
__global__ void nk_norm_mod(Prm p, const float* g, int layer, int which  , float* H, int nrows) {
    const int r = blockIdx.x; if (r >= nrows) return;
    const float* xr = xrow(p, r);
    __shared__ float red[256];
    float s = 0.f;
    for (int c = threadIdx.x; c < DM; c += 256) { const float v = xr[c]; s += v * v; }
    red[threadIdx.x] = s; __syncthreads();
    for (int o = 128; o > 0; o >>= 1) { if (threadIdx.x < o) red[threadIdx.x] += red[threadIdx.x + o]; __syncthreads(); }
    const float rstd = rsqrtf(red[0] / DM + EPS);
    const float* mod = (const float*)(p.ws + WS_MOD) + ((size_t)layer * 5 + row_b5(r)) * NMOD * DM;
    for (int c = threadIdx.x; c < DM; c += 256) H[(size_t)r * DM + c] = xr[c] * rstd * g[c] * (1.f + mod[(which + 1) * DM + c]) + mod[which * DM + c];
}
__global__ void nk_final_norm(Prm p) {
    const int r = blockIdx.x;
    float* xr = p.out + (size_t)r * DM;
    __shared__ float red[256];
    float s = 0.f;
    for (int c = threadIdx.x; c < DM; c += 256) { const float v = xr[c]; s += v * v; }
    red[threadIdx.x] = s; __syncthreads();
    for (int o = 128; o > 0; o >>= 1) { if (threadIdx.x < o) red[threadIdx.x] += red[threadIdx.x + o]; __syncthreads(); }
    const float rstd = rsqrtf(red[0] / DM + EPS);
    for (int c = threadIdx.x; c < DM; c += 256) xr[c] = xr[c] * rstd * p.fng[c];
}
template <class FA, class FB, class FE>
__global__ void __launch_bounds__(256) nk_gemm(int M, int N, int K, FA fa, FB fb, FE fe) {
    __shared__ float As[16][68], Bs[16][68];
    const int m0 = blockIdx.y * 64, n0 = blockIdx.x * 64;
    if (m0 >= fa.rows()) return;
    const int t = threadIdx.x, tx = t % 16, ty = t / 16;
    float acc[4][4] = {};
    for (int k0 = 0; k0 < K; k0 += 16) {
        { const int m = t / 4, kq = (t % 4) * 4;
#pragma unroll
          for (int i = 0; i < 4; ++i) As[kq + i][m] = fa(m0 + m, k0 + kq + i); }
        { const int k = t / 16, nq = (t % 16) * 4;
#pragma unroll
          for (int i = 0; i < 4; ++i) Bs[k][nq + i] = fb(k0 + k, n0 + nq + i); }
        __syncthreads();
#pragma unroll
        for (int kk = 0; kk < 16; ++kk) {
            float a[4], b[4];
#pragma unroll
            for (int i = 0; i < 4; ++i) { a[i] = As[kk][ty * 4 + i]; b[i] = Bs[kk][tx * 4 + i]; }
#pragma unroll
            for (int i = 0; i < 4; ++i)
#pragma unroll
                for (int j = 0; j < 4; ++j) acc[i][j] += a[i] * b[j];
        }
        __syncthreads();
    }
#pragma unroll
    for (int i = 0; i < 4; ++i)
#pragma unroll
        for (int j = 0; j < 4; ++j) fe(m0 + ty * 4 + i, n0 + tx * 4 + j, acc[i][j]);
}
struct ADense { const float* A; int lda, M; __device__ int rows() const { return M; } __device__ float operator()(int m, int k) const { return m < M ? A[(size_t)m * lda + k] : 0.f; } };
struct BDense { const float* B; int ldb, pad; __device__ float operator()(int k, int n) const { return B[(size_t)k * ldb + n]; } };
struct EStore { float* C; int ldc, M; __device__ void operator()(int m, int n, float v) const { if (m < M) C[(size_t)m * ldc + n] = v; } };
struct ESilu { float* C; int ldc, M; __device__ void operator()(int m, int n, float v) const { if (m < M) C[(size_t)m * ldc + n] = silu_f(v); } };
struct EMulInto { float* C; int ldc, M; __device__ void operator()(int m, int n, float v) const { if (m < M) C[(size_t)m * ldc + n] *= v; } };
struct EResid { Prm p; int layer, which  , row0, M;
    __device__ void operator()(int m, int n, float v) const { if (m < M) { const int r = row0 + m; const float* mod = (const float*)(p.ws + WS_MOD) + ((size_t)layer * 5 + row_b5(r)) * NMOD * DM; xrow(p, r)[n] += mod[which * DM + n] * v; } } };
struct AGather { const float* H; const int* tok; const int* cnt; int r0, rmax; __device__ int rows() const { int c = *cnt - r0; return c < rmax ? c : rmax; }
    __device__ float operator()(int m, int k) const { return m < rows() ? H[(size_t)tok[r0 + m] * DM + k] : 0.f; } };
struct ADenseCnt { const float* A; const int* cnt; int lda, r0, rmax, pad; __device__ int rows() const { int c = *cnt - r0; return c < rmax ? c : rmax; }
    __device__ float operator()(int m, int k) const { return m < rows() ? A[(size_t)m * lda + k] : 0.f; } };
struct ESiluCnt { float* C; const int* cnt; int ldc, r0, rmax, pad; __device__ void operator()(int m, int n, float v) const { int c = *cnt - r0; c = c < rmax ? c : rmax; if (m < c) C[(size_t)m * ldc + n] = silu_f(v); } };
struct EMulCnt { float* C; const int* cnt; int ldc, r0, rmax, pad; __device__ void operator()(int m, int n, float v) const { int c = *cnt - r0; c = c < rmax ? c : rmax; if (m < c) C[(size_t)m * ldc + n] *= v; } };
struct EScatterY { float* Y0; float* Y1; const int* tok; const float* w; const int* kk; const int* cnt; int r0, rmax;
    __device__ void operator()(int m, int n, float v) const { int c = *cnt - r0; c = c < rmax ? c : rmax; if (m < c) { const int i = r0 + m; (kk[i] ? Y1 : Y0)[(size_t)tok[i] * DM + n] = w[i] * v; } } };

__global__ void nk_fft_s1(const float* H, int b, float2* Y1) {
    const size_t idx = (size_t)blockIdx.x * blockDim.x + threadIdx.x;
    const int ch = idx % DM, n2 = (idx / DM) % FN2, k1 = idx / ((size_t)DM * FN2);
    float re = 0.f, im = 0.f;
    for (int n1 = 0; n1 < FN1; ++n1) {
        const float v = H[((size_t)b * SEQ + n1 * FN2 + n2) * DM + ch];
        const int ph = (n1 * k1) % FN1; double s, c; sincospi(-2.0 * ph / FN1, &s, &c);
        re += v * (float)c; im += v * (float)s;
    }
    double s, c; sincospi(-2.0 * (double)(n2 * k1) / (FN1 * FN2), &s, &c);
    Y1[idx] = make_float2(re * (float)c - im * (float)s, re * (float)s + im * (float)c);
}
__global__ void nk_fft_s2(const float2* Y1, int b, float2* Z) {
    const size_t idx = (size_t)blockIdx.x * blockDim.x + threadIdx.x;
    const int ch = idx % DM, k1 = (idx / DM) % FN1, k2 = idx / ((size_t)DM * FN1);
    float re = 0.f, im = 0.f;
    for (int n2 = 0; n2 < FN2; ++n2) {
        const float2 v = Y1[((size_t)k1 * FN2 + n2) * DM + ch];
        const int ph = (n2 * k2) % FN2; double s, c; sincospi(-2.0 * ph / FN2, &s, &c);
        re += v.x * (float)c - v.y * (float)s; im += v.x * (float)s + v.y * (float)c;
    }
    Z[((size_t)b * SEQ + k1 + FN1 * k2) * DM + ch] = make_float2(re, im);
}
__global__ void nk_dft_ctx(const float* H, float2* Z) {
    const size_t idx = (size_t)blockIdx.x * blockDim.x + threadIdx.x;
    const int ch = idx % DM, k = (idx / DM) % CTXL, b = idx / ((size_t)DM * CTXL);
    float re = 0.f, im = 0.f;
    for (int n = 0; n < CTXL; ++n) {
        const float v = H[((size_t)TL + b * CTXL + n) * DM + ch];
        const int ph = (n * k) % CTXL; double s, c; sincospi(-2.0 * ph / CTXL, &s, &c);
        re += v * (float)c; im += v * (float)s;
    }
    Z[((size_t)TL + b * CTXL + k) * DM + ch] = make_float2(re, im);
}
__global__ void nk_chan_dft(const float2* Z, float* R) {
    const size_t idx = (size_t)blockIdx.x * blockDim.x + threadIdx.x;
    const int col = idx % DM, row = idx / DM, g = col / 256, q = col % 256;
    float acc = 0.f;
    for (int pp = 0; pp < 256; ++pp) {
        const float2 v = Z[(size_t)row * DM + g * 256 + pp];
        const int ph = (pp * q) % 256; double s, c; sincospi(2.0 * ph / 256, &s, &c);
        acc += v.x * (float)c + v.y * (float)s;
    }
    const float scale = row < TL ? 1.f / sqrtf((float)SEQ * 256.f) : 1.f / sqrtf((float)CTXL * 256.f);
    R[idx] = acc * scale;
}
__global__ void nk_rope_apply(Prm p, float* QKV) {
    const size_t idx = (size_t)blockIdx.x * blockDim.x + threadIdx.x;
    const int f = idx % 16, a = (idx / 16) % 2, hh = (idx / 32) % 20; const size_t row = idx / 640;
    if (row >= TL) return;
    const int t = row % SEQ, pos = a ? (t % 64) : (t / 64);
    const float2 cs = ((const float2*)(p.ws + WS_ROPE))[pos * 16 + f];
    float* base = QKV + row * QKVD + hh * 64 + a * 32;
    const float x1 = base[f], x2 = base[16 + f];
    base[f] = x1 * cs.x - x2 * cs.y; base[16 + f] = x2 * cs.x + x1 * cs.y;
}
__global__ void __launch_bounds__(64) nk_attn(Prm p, const float* QKV, const float* sinks, float* O, int nrows) {
    const size_t idx = (size_t)blockIdx.x * blockDim.x + threadIdx.x;
    const int h = idx % NH; const size_t row = idx / NH;
    if (row >= (size_t)nrows) return;
    const int kv = h / 4;
    float q[64], o[64];
#pragma unroll
    for (int d = 0; d < 64; ++d) { q[d] = QKV[row * QKVD + h * 64 + d] * 0.125f; o[d] = 0.f; }
    float m = sinks[h], l = 1.f;
    const bool lat = row < TL; const int b = lat ? row / SEQ : (row - TL) / CTXL; const int t = lat ? row % SEQ : 0;
    const int j0 = lat ? (t - 128 < 0 ? 0 : t - 128) : 0, j1 = lat ? (t + 128 > SEQ - 1 ? SEQ - 1 : t + 128) : -1;
    const int nlat = j1 - j0 + 1;
    for (int jj = 0; jj < nlat + CTXL; ++jj) {
        const size_t krow = jj < nlat ? (size_t)b * SEQ + j0 + jj : (size_t)TL + b * CTXL + (jj - nlat);
        const float* kp = QKV + krow * QKVD + 1024 + kv * 64; const float* vp = kp + 256;
        float s = 0.f;
#pragma unroll
        for (int d = 0; d < 64; ++d) s += q[d] * kp[d];
        if (s > m) { const float f = expf(m - s); l *= f;
#pragma unroll
            for (int d = 0; d < 64; ++d) o[d] *= f;
            m = s; }
        const float pe = expf(s - m); l += pe;
#pragma unroll
        for (int d = 0; d < 64; ++d) o[d] += pe * vp[d];
    }
    const float il = 1.f / l;
#pragma unroll
    for (int d = 0; d < 64; ++d) O[row * DM + h * 64 + d] = o[d] * il;
}
__global__ void nk_router(Prm p, const float* H, const float* wr, int nrows, int* cnt, int* ltok, float* lw, int* lk) {
    const int r = blockIdx.x * blockDim.x + threadIdx.x; if (r >= nrows) return;
    float lg[NEXP] = {};
    for (int k = 0; k < DM; ++k) { const float hv = H[(size_t)r * DM + k];
#pragma unroll
        for (int e = 0; e < NEXP; ++e) lg[e] += hv * wr[k * NEXP + e]; }
    int e0 = 0; float v0 = lg[0];
#pragma unroll
    for (int e = 1; e < NEXP; ++e) if (lg[e] > v0) { v0 = lg[e]; e0 = e; }
    int e1 = -1; float v1 = -INFINITY;
#pragma unroll
    for (int e = 0; e < NEXP; ++e) if (e != e0 && lg[e] > v1) { v1 = lg[e]; e1 = e; }
    const float g1 = 1.f / (1.f + expf(v0 - v1)), g0 = 1.f - g1;
    int i0 = atomicAdd(&cnt[e0], 1); ltok[e0 * TT + i0] = r; lw[e0 * TT + i0] = g0; lk[e0 * TT + i0] = 0;
    int i1 = atomicAdd(&cnt[e1], 1); ltok[e1 * TT + i1] = r; lw[e1 * TT + i1] = g1; lk[e1 * TT + i1] = 1;
}
__global__ void nk_moe_combine(Prm p, const float* Y0, const float* Y1, int layer, int nrows) {
    const size_t idx = (size_t)blockIdx.x * blockDim.x + threadIdx.x; const int n = idx % DM; const size_t r = idx / DM;
    if (r >= (size_t)nrows) return;
    const float* mod = (const float*)(p.ws + WS_MOD) + ((size_t)layer * 5 + row_b5((int)r)) * NMOD * DM;
    xrow(p, (int)r)[n] += mod[5 * DM + n] * (Y0[idx] + Y1[idx]);
}


#define GAS __attribute__((address_space(1)))
#define LAS __attribute__((address_space(3)))
typedef unsigned short bf16_t;
typedef short bf16x8 __attribute__((ext_vector_type(8)));
typedef short s16x4 __attribute__((ext_vector_type(4)));
typedef float f32x4 __attribute__((ext_vector_type(4)));
typedef float f32x16 __attribute__((ext_vector_type(16)));
typedef unsigned u32x4 __attribute__((ext_vector_type(4)));
typedef unsigned u32x2 __attribute__((ext_vector_type(2)));
typedef float f32x2 __attribute__((ext_vector_type(2)));

constexpr size_t WS_TAB = 13 * MiB;
constexpr size_t TAB_F1 = 0, TAB_F2 = 65536, TAB_TW = 131072, TAB_TWC = 196608;
constexpr size_t WS_W = 16 * MiB;
constexpr size_t WE_STRIDE = 25 * MiB, WE_F = 0, WE_GU = 4 * MiB, WE_D = 18 * MiB;
constexpr size_t WO_BASE = 50 * MiB, WO_STRIDE = 173 * MiB, WO_QKV = 0, WO_O = 3 * MiB, WO_EXP = 5 * MiB, WX_STRIDE = 21 * MiB, WX_GU = 0, WX_D = 14 * MiB;
constexpr size_t WS_MS = 416 * MiB;
constexpr size_t MS_HB = 0;
constexpr size_t MS_BIG = 66 * MiB;
constexpr size_t BIG_ACT = 0;
constexpr size_t BIG_Y1 = 0, BIG_Y1C = 128 * MiB, BIG_PQ = 136 * MiB;
constexpr size_t BIG_Q = 0, BIG_K = 66 * MiB, BIG_V = 83 * MiB, BIG_O = 100 * MiB;
constexpr size_t WS_MEGA_END = WS_MS + MS_BIG + 490 * MiB;
constexpr int MAXBLK = 280;
constexpr int CW_BAR = 4096;
constexpr int CW_CNT = 1024;
constexpr int CW_CNTW = 65536;
constexpr int CW_SKF = 32768;
constexpr int CW_MCNT = 2048;
constexpr int LDS_BYTES = 147456;
constexpr int LDS_MISC = 146944;
constexpr float LOG2E = 1.4426950408889634f;

struct Args { Prm p; int ph_lo, ph_hi; };

__device__ __forceinline__ unsigned f2bf(float f) { unsigned u = __builtin_bit_cast(unsigned, f); return (u + 0x7fffu + ((u >> 16) & 1u)) >> 16; }
__device__ __forceinline__ unsigned pk2(float lo, float hi) { typedef float f2 __attribute__((ext_vector_type(2))); typedef __bf16 b2 __attribute__((ext_vector_type(2))); f2 v = {lo, hi}; b2 b = __builtin_convertvector(v, b2); return __builtin_bit_cast(unsigned, b); }
#define SWZ_XOR(v, m) __builtin_bit_cast(float, __builtin_amdgcn_ds_swizzle(__builtin_bit_cast(int, (v)), ((m) << 10) | 0x1f))
__device__ __forceinline__ float xor32(float v, bool lower) { unsigned a = __builtin_bit_cast(unsigned, v), b = a; asm volatile("" : "+v"(b));
    auto rr = __builtin_amdgcn_permlane32_swap(a, b, false, false); return __builtin_bit_cast(float, lower ? rr[1] : rr[0]); }
__device__ __forceinline__ float wave_sum(float v) {
    v += SWZ_XOR(v, 1); v += SWZ_XOR(v, 2); v += SWZ_XOR(v, 4); v += SWZ_XOR(v, 8); v += SWZ_XOR(v, 16);
    return __builtin_bit_cast(float, __builtin_amdgcn_readlane(__builtin_bit_cast(int, v), 0)) + __builtin_bit_cast(float, __builtin_amdgcn_readlane(__builtin_bit_cast(int, v), 32));
}
__device__ __forceinline__ float fast_silu(float v) { return v * __builtin_amdgcn_rcpf(1.f + __builtin_amdgcn_exp2f(-v * LOG2E)); }

#define XB_TMO      128
#define XB_XCNT(j)  (256  + 64 * (j))
#define XB_XSUB(j)  (1280 + 64 * (j))
#define XB_XGEN(j)  (2304 + 64 * (j))
#define XB_TOP      3328
#define XB_TOPGEN   3392
#define XCD_BAR_WORDS 3456
#define XB_SPIN_CAP (1u << 18)
__device__ __forceinline__ unsigned xb_ld(unsigned* p)              { return __hip_atomic_load(p, __ATOMIC_RELAXED, __HIP_MEMORY_SCOPE_AGENT); }
__device__ __forceinline__ unsigned xb_add(unsigned* p, unsigned v) { return __hip_atomic_fetch_add(p, v, __ATOMIC_RELAXED, __HIP_MEMORY_SCOPE_AGENT); }
__device__ __forceinline__ unsigned xb_xcc_id() { return (unsigned)__builtin_amdgcn_s_getreg((3 << 11) | 20) & 0xFu; }
#define XB_SPIN(cond, bar) do { unsigned _sp = 0; while (cond) { __builtin_amdgcn_s_sleep(1); \
    if ((++_sp & 255u) == 0u) { if (xb_ld(&(bar)[XB_TMO])) break; if (_sp > XB_SPIN_CAP) { atomicAdd(&(bar)[XB_TMO], 1u); break; } } } } while (0)
struct XcdBarrier { unsigned* bar; unsigned x; volatile LAS unsigned* st; };
__device__ __forceinline__ XcdBarrier xcd_barrier_post(unsigned* bar, volatile LAS unsigned* st) {
    XcdBarrier b; b.bar = bar; b.x = xb_xcc_id(); b.st = st;
    if (threadIdx.x == 0) (void)xb_add(&bar[XB_XCNT(b.x)], 1u);
    return b;
}
__device__ __forceinline__ void xcd_barrier_complete(unsigned* bar, unsigned x, unsigned& nloc, unsigned& nx) {
    const unsigned G = gridDim.x * gridDim.y * gridDim.z;
    unsigned sum, cnt, mine, sp = 0u;
    for (;;) {
        sum = 0u; cnt = 0u; mine = 0u;
#pragma unroll
        for (unsigned j = 0; j < 16; ++j) { const unsigned c = xb_ld(&bar[XB_XCNT(j)]); sum += c; cnt += (c > 0u) ? 1u : 0u; mine = (j == x) ? c : mine; }
        if (sum == G) break;
        __builtin_amdgcn_s_sleep(1);
        if ((++sp & 255u) == 0u) { if (xb_ld(&bar[XB_TMO])) break; if (sp > XB_SPIN_CAP) { atomicAdd(&bar[XB_TMO], 1u); break; } }
    }
    nloc = mine > 0u ? mine : 1u; nx = cnt > 0u ? cnt : 1u;
}
__device__ __forceinline__ void xcd_barrier(const XcdBarrier& b) {
    asm volatile("s_waitcnt vmcnt(0)" ::: "memory");
    __syncthreads();
    if (threadIdx.x == 0) {
        unsigned* bar = b.bar;
        __builtin_amdgcn_s_waitcnt(0);
        unsigned nloc = b.st[0], nx = b.st[1];
        if (nloc == 0u) { xcd_barrier_complete(bar, b.x, nloc, nx); b.st[0] = nloc; b.st[1] = nx; }
        const unsigned old = xb_add(&bar[XB_XSUB(b.x)], 1u);
        const unsigned gen = old / nloc;
        if (old + 1u == (gen + 1u) * nloc) {
            __builtin_amdgcn_fence(__ATOMIC_RELEASE, "agent");
            asm volatile("s_waitcnt vmcnt(0)" ::: "memory");
            const unsigned og = xb_add(&bar[XB_TOP], 1u);
            const unsigned tg = og / nx;
            if (og + 1u == (tg + 1u) * nx) xb_add(&bar[XB_TOPGEN], 1u);
            else XB_SPIN(xb_ld(&bar[XB_TOPGEN]) == tg, bar);
            __builtin_amdgcn_fence(__ATOMIC_ACQUIRE, "agent");
            xb_add(&bar[XB_XGEN(b.x)], 1u);
            asm volatile("s_waitcnt vmcnt(0)" ::: "memory");
        } else {
            XB_SPIN(xb_ld(&bar[XB_XGEN(b.x)]) == gen, bar);
            __builtin_amdgcn_fence(__ATOMIC_ACQUIRE, "agent");
            asm volatile("s_waitcnt vmcnt(0)" ::: "memory");
        }
    }
    __syncthreads();
}

namespace pg8 {
constexpr int BM = 256, BK = 64, HALF = 128, HTB = HALF * BK * 2, STAGE_BYTES = 8 * HTB, NXCD = 8, WGM = 4;
__device__ __forceinline__ int lds_byte(int r, int c) { const int st = (r >> 4) * 2 + (c >> 5), rr = r & 15, cc = c & 31, ob = rr * 64 + cc * 2; return st * 1024 + (ob ^ (((ob >> 9) & 1) << 5)); }
__device__ __forceinline__ void stage_rc(int b, int& R, int& C) { const int st = b / 1024, sb = b % 1024, swz = sb ^ (((sb >> 9) & 1) << 5); R = (st >> 1) * 16 + swz / 64; C = (st & 1) * 32 + (swz % 64) / 2; }
__device__ __forceinline__ int perm32(int rho) { const int n = rho >> 4, i = rho & 15; return 8 * (i >> 2) + 4 * n + (i & 3); }
struct Unit { int pm, pn, g, first, cnt, kofs, nt, flags, np, part, qmask; };
__device__ __forceinline__ bool static_next(int nM, int nN, int G, int c, int i, Unit& u) {
    const int nwg = nM * nN; const long L = (long)i * G + c; const bool ok = L < nwg;
    int wgid = ok ? (int)L : nwg - 1; { const int q = nwg / NXCD, r = nwg % NXCD, xcd = wgid % NXCD, off = wgid / NXCD; wgid = (xcd < r ? xcd * (q + 1) : r * (q + 1) + (xcd - r) * q) + off; }
    const int nig = WGM * nN, gid = wgid / nig, fm = gid * WGM, gsz = (nM - fm) < WGM ? (nM - fm) : WGM;
    u.pm = fm + ((wgid % nig) % gsz); u.pn = (wgid % nig) / gsz; return ok;
}
__device__ __forceinline__ bool sk_next(int nM, int nN, int nt2, int G, int c, int i, int pmax, Unit& u) {
    const int nwg = nM * nN, nfull = nwg / G, R = nwg - nfull * G;
    int P = 1; if (R > 0) { if (R * 8 <= G && pmax >= 8) P = 8; else if (R * 4 <= G && pmax >= 4) P = 4; else if (R * 2 <= G && pmax >= 2) P = 2; }
    const bool tail = (i >= nfull);
    const int x = c % NXCD, rho = c / NXCD, jj = rho / P, p = rho % P, j = jj * NXCD + x;
    const long L = tail ? (long)nfull * G + (j < R ? j : 0) : (long)i * G + c;
    int wgid = (int)(L < nwg ? L : nwg - 1); { const int q = nwg / NXCD, r = nwg % NXCD, xcd = wgid % NXCD, off = wgid / NXCD; wgid = (xcd < r ? xcd * (q + 1) : r * (q + 1) + (xcd - r) * q) + off; }
    const int nig = WGM * nN, gid = wgid / nig, fm = gid * WGM, gsz = (nM - fm) < WGM ? (nM - fm) : WGM;
    u.pm = fm + ((wgid % nig) % gsz); u.pn = (wgid % nig) / gsz;
    const int lo = tail ? p * nt2 / P : 0, hi = tail ? (p + 1) * nt2 / P : nt2;
    u.kofs = lo * 2 * BK * 2; u.nt = (hi - lo) * 2; u.flags = (tail && P > 1) ? 1 : 0; u.np = P; u.part = p;
    u.qmask = (tail && P > 1) ? (P == 4 ? (1 << p) : P == 2 ? (5 << p) : 0xF) : 0xF;
    return tail ? (i == nfull && j < R) : true;
}
struct SkCtl { f32x4* slots; unsigned* flag; unsigned* tmo; unsigned epoch; int c, G; };
template <class Epi, class Sched, bool GATHER>
__device__ __forceinline__ void gemm_phase(LAS unsigned char* lds, const int tid_in, const bf16_t* Aptr, const int K, const Sched& S, const Epi& E, const SkCtl sk = SkCtl{}) {
    int tid = tid_in; asm volatile("" : "+v"(tid));
    const int wid = __builtin_amdgcn_readfirstlane(tid >> 6), lane = tid & 63, wr = wid >> 2, wc = wid & 3, fr = lane & 15, fq = lane >> 4;
    int RA[2], CA[2]; unsigned voffA[2], voffB[2];
#pragma unroll
    for (int i = 0; i < 2; ++i) { int R, C; stage_rc(tid * 16 + i * 8192, R, C); const int Rb = Epi::PERM ? ((R & ~31) + perm32(R & 31)) : R; RA[i] = R; CA[i] = C; voffA[i] = (unsigned)(R * K + C) * 2u; voffB[i] = (unsigned)(Rb * K + C) * 2u; }
    const size_t kstep = (size_t)(BK * 2);
    const size_t hstep = (size_t)HALF * K * 2;
    const unsigned ldsw = (unsigned)wid * 1024u;
    const int aoff = lds_byte(wr * 64 + fr, fq * 8), boff = lds_byte(wc * 32 + fr, fq * 8);
    const char* const cAb = (const char*)Aptr;
#define PG8_SA(b, h) (((b) * 2 + (h)) * HTB)
#define PG8_SB(b, h) ((4 + (b) * 2 + (h)) * HTB)
#define PG8_STAGE(bufoff, gbase, voff) do { _Pragma("unroll") for (int _i = 0; _i < 2; ++_i) \
        __builtin_amdgcn_global_load_lds((const unsigned*)((const char*)(gbase) + (voff)[_i]), (LAS unsigned*)(lds + (bufoff) + ldsw + _i * 8192), 16, 0, 0); } while (0)
#define PG8_STAGEA(bufoff, vo, h, kb) do { _Pragma("unroll") for (int _i = 0; _i < 2; ++_i) { \
        if constexpr (GATHER) __builtin_amdgcn_global_load_lds((const unsigned*)(cAb + (size_t)(vo)[h][_i] + (size_t)(kb)), (LAS unsigned*)(lds + (bufoff) + ldsw + _i * 8192), 16, 0, 0); \
        else __builtin_amdgcn_global_load_lds((const unsigned*)(cAb + s##vo + (size_t)(h) * hstep + (size_t)(kb) + voffA[_i]), (LAS unsigned*)(lds + (bufoff) + ldsw + _i * 8192), 16, 0, 0); } } while (0)
#define PG8_LDA(dst, b, h) do { _Pragma("unroll") for (int m = 0; m < 4; ++m) _Pragma("unroll") for (int k = 0; k < 2; ++k) dst[m][k] = *(const LAS bf16x8*)(lds + PG8_SA(b, h) + aoff + m * 2048 + k * 1024); } while (0)
#define PG8_LDB(dst, b, h) do { _Pragma("unroll") for (int n = 0; n < 2; ++n) _Pragma("unroll") for (int k = 0; k < 2; ++k) dst[n][k] = *(const LAS bf16x8*)(lds + PG8_SB(b, h) + boff + n * 2048 + k * 1024); } while (0)
#define PG8_MMA(ai, bj, At, Bt) do { __builtin_amdgcn_s_setprio(1); _Pragma("unroll") for (int m = 0; m < 4; ++m) _Pragma("unroll") for (int n = 0; n < 2; ++n) _Pragma("unroll") for (int k = 0; k < 2; ++k) \
        acc[ai][bj][m][n] = __builtin_amdgcn_mfma_f32_16x16x32_bf16(Bt[n][k], At[m][k], acc[ai][bj][m][n], 0, 0, 0); __builtin_amdgcn_s_setprio(0); } while (0)
#define PG8_WAIT_V(n) asm volatile("s_waitcnt vmcnt(" #n ")" ::: "memory")
#define PG8_WAIT_L(n) asm volatile("s_waitcnt lgkmcnt(" #n ")" ::: "memory")
#define PG8_BAR __builtin_amdgcn_s_barrier()
#define PG8_SCHED __builtin_amdgcn_sched_barrier(0)
#define PG8_AOFFS(vo, u) do { if constexpr (GATHER) { _Pragma("unroll") for (int _h = 0; _h < 2; ++_h) _Pragma("unroll") for (int _i = 0; _i < 2; ++_i) \
        (vo)[_h][_i] = (unsigned)(((size_t)S.a_row(u, _h * HALF + RA[_i]) * (size_t)K + (size_t)CA[_i]) * 2u) + (unsigned)(u).kofs; } else { s##vo = (size_t)S.a_row(u, 0) * (size_t)K * 2u + (size_t)(u).kofs; } } while (0)
    Unit cur, nxt; int ui = 0;
    if (!S.next(0, cur)) return;
    f32x4 acc[2][2][4][2];
#pragma unroll
    for (int a = 0; a < 2; ++a)
#pragma unroll
        for (int b = 0; b < 2; ++b)
#pragma unroll
            for (int m = 0; m < 4; ++m)
#pragma unroll
                for (int n = 0; n < 2; ++n) acc[a][b][m][n] = (f32x4){0.f, 0.f, 0.f, 0.f};
    bf16x8 At[4][2], B0[2][2], B1[2][2];
    unsigned vA[2][2], vN[2][2];
    size_t svA = 0, svN = 0;
    PG8_AOFFS(vA, cur);
    const char* cB = S.b_ptr(cur) + cur.kofs;
    PG8_STAGE(PG8_SB(0, 0), cB, voffB); PG8_STAGE(PG8_SB(0, 1), cB + hstep, voffB); PG8_STAGEA(PG8_SA(0, 0), vA, 0, 0); PG8_STAGEA(PG8_SA(0, 1), vA, 1, 0);
    if (wr == 1) PG8_BAR;
    PG8_WAIT_V(2); PG8_BAR;
    PG8_STAGE(PG8_SB(1, 0), cB + kstep, voffB); PG8_STAGEA(PG8_SA(1, 0), vA, 0, kstep); PG8_STAGE(PG8_SB(1, 1), cB + hstep + kstep, voffB);
    PG8_WAIT_V(6); PG8_BAR;
    for (;;) {
        const bool has_next = S.next(ui + 1, nxt);
        const char* nB = has_next ? S.b_ptr(nxt) + nxt.kofs : cB;
        const int nt = cur.nt;
        if (has_next) { PG8_AOFFS(vN, nxt); } else { svN = svA;
#pragma unroll
            for (int _h = 0; _h < 2; ++_h)
#pragma unroll
                for (int _i = 0; _i < 2; ++_i) vN[_h][_i] = vA[_h][_i]; }
        if constexpr (GATHER) { *(LAS u32x4*)(lds + STAGE_BYTES + tid * 16) = (u32x4){vN[0][0], vN[0][1], vN[1][0], vN[1][1]}; }
        for (int t = 0; t < nt; t += 2) {
            const bool last = (t == nt - 2);
            const size_t k1 = (size_t)(t + 1) * kstep;
            const size_t k2 = last ? 0 : (size_t)(t + 2) * kstep, k3 = k2 + kstep;
            const char* b2 = last ? nB : cB + (size_t)(t + 2) * kstep; const char* b3 = b2 + kstep;
            unsigned v2[2][2]; const size_t sv2 = last ? svN : svA;
            if constexpr (GATHER) {
#pragma unroll
                for (int _h = 0; _h < 2; ++_h)
#pragma unroll
                    for (int _i = 0; _i < 2; ++_i) v2[_h][_i] = vA[_h][_i];
                if (last) { const u32x4 q = *(const LAS u32x4*)(lds + STAGE_BYTES + tid * 16); v2[0][0] = q.x; v2[0][1] = q.y; v2[1][0] = q.z; v2[1][1] = q.w; } }
            PG8_LDB(B0, 0, 0); PG8_LDB(B1, 0, 1); PG8_SCHED; PG8_LDA(At, 0, 0); PG8_STAGEA(PG8_SA(1, 1), vA, 1, k1);
            PG8_WAIT_V(8); PG8_WAIT_L(0); PG8_BAR; PG8_MMA(0, 0, At, B0); PG8_MMA(0, 1, At, B1); PG8_BAR; PG8_SCHED;
            PG8_LDA(At, 0, 1); PG8_STAGE(PG8_SB(0, 0), b2, voffB); PG8_STAGE(PG8_SB(0, 1), b2 + hstep, voffB); PG8_STAGEA(PG8_SA(0, 0), v2, 0, k2);
            PG8_WAIT_V(8); PG8_WAIT_L(0); PG8_BAR; PG8_MMA(1, 0, At, B0); PG8_MMA(1, 1, At, B1); PG8_BAR; PG8_SCHED;
            PG8_LDB(B0, 1, 0); PG8_LDB(B1, 1, 1); PG8_SCHED; PG8_LDA(At, 1, 0); PG8_STAGEA(PG8_SA(0, 1), v2, 1, k2);
            PG8_WAIT_V(8); PG8_WAIT_L(0); PG8_BAR; PG8_MMA(0, 0, At, B0); PG8_MMA(0, 1, At, B1); PG8_BAR; PG8_SCHED;
            PG8_LDA(At, 1, 1); PG8_STAGE(PG8_SB(1, 0), b3, voffB); PG8_STAGE(PG8_SB(1, 1), b3 + hstep, voffB); PG8_STAGEA(PG8_SA(1, 0), v2, 0, k3);
            PG8_WAIT_V(8); PG8_WAIT_L(0); PG8_BAR; PG8_MMA(1, 0, At, B0); PG8_MMA(1, 1, At, B1); PG8_BAR; PG8_SCHED;
        }
        if (wr == 0) PG8_BAR;
        if (cur.flags & 1) {
            const int P = cur.np, p = cur.part, c0 = sk.c - NXCD * p;
            int tl; asm volatile("v_mbcnt_lo_u32_b32 %0, -1, 0\n\tv_mbcnt_hi_u32_b32 %0, -1, %0" : "=v"(tl));
            const int tid = wid * 64 + tl;
            const __amdgpu_buffer_rsrc_t rs = __builtin_amdgcn_make_buffer_rsrc((void*)sk.slots, 0, (int)(sk.G * 32 * 512 * 16), 0x00020000);
            const unsigned so = (unsigned)((sk.c * (32 * 512) + tid) * 16);
#pragma unroll
            for (int a = 0; a < 2; ++a)
#pragma unroll
                for (int b = 0; b < 2; ++b) if (!((cur.qmask >> (a * 2 + b)) & 1)) {
#pragma unroll
                    for (int m = 0; m < 4; ++m)
#pragma unroll
                        for (int n = 0; n < 2; ++n) __builtin_amdgcn_raw_buffer_store_b128(__builtin_bit_cast(u32x4, acc[a][b][m][n]), rs, so + (unsigned)((((a * 2 + b) * 4 + m) * 2 + n) * 512 * 16), 0, 16); }
            PG8_WAIT_V(0); PG8_BAR; asm volatile("" ::: "memory");
            if (tid == 0) __hip_atomic_store(sk.flag + 64 * sk.c, sk.epoch, __ATOMIC_RELAXED, __HIP_MEMORY_SCOPE_AGENT);
            if (tid < 64) {
                for (int q = 0; q < P; ++q) if (q != p) { const int pc = c0 + NXCD * q; unsigned sp = 0;
                    while ((unsigned)__builtin_amdgcn_readfirstlane(__hip_atomic_load(sk.flag + 64 * pc, __ATOMIC_RELAXED, __HIP_MEMORY_SCOPE_AGENT)) != sk.epoch) { __builtin_amdgcn_s_sleep(1);
                        if ((++sp & 255u) == 0u) { if (__hip_atomic_load(sk.tmo, __ATOMIC_RELAXED, __HIP_MEMORY_SCOPE_AGENT)) break; if (sp > (1u << 20)) { if (tid == 0) atomicAdd(sk.tmo, 1u); break; } } } }
                __builtin_amdgcn_fence(__ATOMIC_ACQUIRE, "agent"); PG8_WAIT_V(0); }
            asm volatile("" ::: "memory"); PG8_BAR; asm volatile("" ::: "memory");
#pragma unroll
            for (int a = 0; a < 2; ++a)
#pragma unroll
                for (int b = 0; b < 2; ++b) if ((cur.qmask >> (a * 2 + b)) & 1) {
                    for (int q = 0; q < P; ++q) if (q != p) {
                        const GAS f32x4* sl = (const GAS f32x4*)sk.slots + (size_t)(c0 + NXCD * q) * (32 * 512) + (size_t)((a * 2 + b) * 8) * 512 + tid;
#pragma unroll
                        for (int h4 = 0; h4 < 2; ++h4) { f32x4 pv[4];
#pragma unroll
                            for (int v4 = 0; v4 < 4; ++v4) pv[v4] = sl[(h4 * 4 + v4) * 512];
#pragma unroll
                            for (int v4 = 0; v4 < 4; ++v4) acc[a][b][h4 * 2 + (v4 >> 1)][v4 & 1] += pv[v4]; } } }
        }
        { int fr_ = fr, fq_ = fq; asm volatile("" : "+v"(fr_), "+v"(fq_));
          E(acc, cur, wr, wc, fr_, fq_); }
        if (!has_next) break;
#pragma unroll
        for (int a = 0; a < 2; ++a)
#pragma unroll
            for (int b = 0; b < 2; ++b)
#pragma unroll
                for (int m = 0; m < 4; ++m)
#pragma unroll
                    for (int n = 0; n < 2; ++n) acc[a][b][m][n] = (f32x4){0.f, 0.f, 0.f, 0.f};
        cur = nxt; cB = nB; ++ui; svA = svN;
        if constexpr (GATHER) { const u32x4 q = *(const LAS u32x4*)(lds + STAGE_BYTES + tid * 16); vA[0][0] = q.x; vA[0][1] = q.y; vA[1][0] = q.z; vA[1][1] = q.w; }
        if (wr == 1) PG8_BAR;
    }
    PG8_WAIT_V(0);
    PG8_BAR;
#undef PG8_SA
#undef PG8_SB
#undef PG8_STAGE
#undef PG8_STAGEA
#undef PG8_LDA
#undef PG8_LDB
#undef PG8_MMA
#undef PG8_WAIT_V
#undef PG8_WAIT_L
#undef PG8_BAR
#undef PG8_SCHED
#undef PG8_AOFFS
}
}


template <bool SK>
struct SchedDense {
    const bf16_t* Bt; int nM, nN, G, c, K;
    __device__ __forceinline__ bool next(int i, pg8::Unit& u) const { u.g = 0; u.first = 0; u.cnt = 0;
        if constexpr (SK) return pg8::sk_next(nM, nN, K / 128, G, c, i, 4, u);
        else { u.kofs = 0; u.nt = K / 64; u.flags = 0; u.np = 1; u.part = 0; u.qmask = 0xF; return pg8::static_next(nM, nN, G, c, i, u); } }
    __device__ __forceinline__ const char* b_ptr(const pg8::Unit& u) const { return (const char*)Bt + (size_t)u.pn * 256 * K * 2; }
    __device__ __forceinline__ int a_row(const pg8::Unit& u, int r) const { return u.pm * 256 + r; }
};
struct MoeTab { volatile LAS unsigned* T;
    __device__ __forceinline__ int group_of(int blk) const { int g = 0;
#pragma unroll
        for (int j = 1; j < 16; ++j) g += (blk >= (int)T[16 + j]) ? 1 : 0; return g; }
};
template <bool GATHER, bool SK>
struct SchedMoe {
    const bf16_t* Wbase; size_t wx_stride; int nN, G, c, K, blk0, nblk; MoeTab tab; const int* ltok;
    __device__ __forceinline__ bool next(int i, pg8::Unit& u) const { bool ok;
        if constexpr (SK) ok = pg8::sk_next(nblk, nN, K / 128, G, c, i, 4, u); else { u.kofs = 0; u.nt = K / 64; u.flags = 0; u.np = 1; u.part = 0; u.qmask = 0xF; ok = pg8::static_next(nblk, nN, G, c, i, u); }
        u.pm += blk0;
        const int g = __builtin_amdgcn_readfirstlane(tab.group_of(u.pm)); u.g = g; u.first = __builtin_amdgcn_readfirstlane((int)tab.T[16 + g]); u.cnt = __builtin_amdgcn_readfirstlane((int)tab.T[32 + g]); return ok; }
    __device__ __forceinline__ const char* b_ptr(const pg8::Unit& u) const { return (const char*)Wbase + (size_t)(u.g & 7) * wx_stride + (size_t)u.pn * 256 * K * 2; }
    __device__ __forceinline__ int a_row(const pg8::Unit& u, int r) const {
        if (!GATHER) return u.pm * 256 + r;
        const int local = (u.pm - u.first) * 256 + r;
        return ltok[(size_t)u.g * TT + (local < u.cnt ? local : u.cnt - 1)]; }
};

struct EpiResid {
    static constexpr bool PERM = false;
    const float* xin_l; const float* xin_c; float* xout_l; float* xout_c; const float* mod; int which; float rs;
    __device__ __forceinline__ void operator()(const f32x4 (&acc)[2][2][4][2], const pg8::Unit& u, int wr, int wc, int fr, int fq) const {
        const bool lat = u.pm < TL / 256; const int b5 = lat ? u.pm / 32 : 4;
        const size_t rbase = (size_t)(lat ? u.pm : u.pm - TL / 256) * 256 + wr * 64 + fr;
        const float* xi = (lat ? xin_l : xin_c); float* xo = (lat ? xout_l : xout_c);
        const int col0 = u.pn * 256 + wc * 32 + 4 * fq;
        const float* gp = mod + (size_t)b5 * NMOD * DM + which * DM + col0;
        f32x4 gv[2][2];
#pragma unroll
        for (int bj = 0; bj < 2; ++bj)
#pragma unroll
            for (int n = 0; n < 2; ++n) gv[bj][n] = *(const f32x4*)(gp + bj * 128 + n * 16) * rs;
#pragma unroll
        for (int ai = 0; ai < 2; ++ai)
#pragma unroll
            for (int m = 0; m < 4; ++m) { const size_t off = (rbase + ai * 128 + m * 16) * DM + col0;
#pragma unroll
                for (int bj = 0; bj < 2; ++bj)
#pragma unroll
                    for (int n = 0; n < 2; ++n) if ((u.qmask >> (ai * 2 + bj)) & 1) *(f32x4*)(xo + off + bj * 128 + n * 16) = *(const f32x4*)(xi + off + bj * 128 + n * 16) + gv[bj][n] * acc[ai][bj][m][n];
                if (m & 1) asm volatile("" ::: "memory"); }
    }
};
struct EpiSwiglu {
    static constexpr bool PERM = true;
    bf16_t* act;
    __device__ __forceinline__ void operator()(const f32x4 (&acc)[2][2][4][2], const pg8::Unit& u, int wr, int wc, int fr, int fq) const {
        const size_t row0 = (size_t)u.pm * 256 + wr * 64 + fr; const int col0 = u.pn * 128 + wc * 32 + 8 * fq;
#pragma unroll
        for (int ai = 0; ai < 2; ++ai)
#pragma unroll
            for (int m = 0; m < 4; ++m) {
                const f32x4 g0 = acc[ai][0][m][0], g1 = acc[ai][0][m][1], u0 = acc[ai][1][m][0], u1 = acc[ai][1][m][1];
                u32x4 w;
                w.x = pk2(fast_silu(g0[0]) * u0[0], fast_silu(g0[1]) * u0[1]); w.y = pk2(fast_silu(g0[2]) * u0[2], fast_silu(g0[3]) * u0[3]);
                w.z = pk2(fast_silu(g1[0]) * u1[0], fast_silu(g1[1]) * u1[1]); w.w = pk2(fast_silu(g1[2]) * u1[2], fast_silu(g1[3]) * u1[3]);
                *(u32x4*)(act + (row0 + ai * 128 + m * 16) * DFF + col0) = w; }
    }
};
struct EpiQKV {
    static constexpr bool PERM = true;
    bf16_t *QB, *KB, *VB; const float2* rope;
    __device__ __forceinline__ void operator()(const f32x4 (&acc)[2][2][4][2], const pg8::Unit& u, int wr, int wc, int fr, int fq) const {
        const bool lat = u.pm < TL / 256; const int row0 = u.pm * 256 + wr * 64 + fr;
        const bool dorope = lat && u.pn < 5; const float qs = u.pn < 4 ? 0.125f * LOG2E : 1.f;
        const size_t doff = u.pn < 4 ? (size_t)0 : (u.pn == 4 ? (size_t)((BIG_K - BIG_Q) / 2) : (size_t)((BIG_V - BIG_Q) / 2));
        bf16_t* dst = QB + doff; const int ld = u.pn < 4 ? DM : 256, colt = u.pn < 4 ? u.pn * 256 : 0;
        const int a = wc & 1, f0 = 8 * (fq & 1); const float sg = (fq < 2) ? -1.f : 1.f;
#pragma unroll
        for (int ai = 0; ai < 2; ++ai)
#pragma unroll
            for (int m = 0; m < 4; ++m) { const int r = row0 + ai * 128 + m * 16; const int t = r & (SEQ - 1); const int pos = a ? (t & 63) : (t >> 6);
                const f32x4* csp = (const f32x4*)(rope + pos * 16 + f0);
#pragma unroll
                for (int bj = 0; bj < 2; ++bj) if ((u.qmask >> (ai * 2 + bj)) & 1) { f32x4 v[2];
#pragma unroll
                    for (int n = 0; n < 2; ++n) { v[n] = acc[ai][bj][m][n];
                        if (dorope) { const f32x4 c01 = csp[2 * n], c23 = csp[2 * n + 1];
#pragma unroll
                            for (int j = 0; j < 4; ++j) { const float pr = xor32(v[n][j], fq < 2); const float c = (j < 2 ? c01 : c23)[2 * (j & 1)], sn = (j < 2 ? c01 : c23)[2 * (j & 1) + 1]; v[n][j] = v[n][j] * c + sg * pr * sn; } }
                        v[n] = v[n] * qs; }
                    u32x4 w; w.x = pk2(v[0][0], v[0][1]); w.y = pk2(v[0][2], v[0][3]); w.z = pk2(v[1][0], v[1][1]); w.w = pk2(v[1][2], v[1][3]);
                    *(u32x4*)(dst + (size_t)r * ld + colt + bj * 128 + wc * 32 + 8 * fq) = w; }
                asm volatile("" ::: "memory"); }
    }
};
struct EpiMoeDown {
    static constexpr bool PERM = false;
    float* xl; float* xc; const float* mod; const int* ltok; const float* lw; float rs;
    __device__ __forceinline__ void operator()(const f32x4 (&acc)[2][2][4][2], const pg8::Unit& u, int wr, int wc, int fr, int fq) const {
        const int g = u.g; const int lbase = (u.pm - u.first) * 256 + wr * 64 + fr; const int cnt = u.cnt;
        const int col0 = u.pn * 256 + wc * 32 + 4 * fq;
        int tokv[2][4]; float wv[2][4];
#pragma unroll
        for (int ai = 0; ai < 2; ++ai)
#pragma unroll
            for (int m = 0; m < 4; ++m) { const int local = lbase + ai * 128 + m * 16, li = local < cnt ? local : cnt - 1; tokv[ai][m] = ltok[(size_t)g * TT + li]; wv[ai][m] = lw[(size_t)g * TT + li] * rs; }
#pragma unroll
        for (int ai = 0; ai < 2; ++ai)
#pragma unroll
            for (int m = 0; m < 4; ++m) { const int local = lbase + ai * 128 + m * 16;
                if (local < cnt) { const int tok = tokv[ai][m]; const float w = wv[ai][m];
                    const bool lat = tok < TL; const int b5 = lat ? tok / SEQ : 4; float* xr = (lat ? xl + (size_t)tok * DM : xc + (size_t)(tok - TL) * DM) + col0;
                    const float* gp = mod + (size_t)b5 * NMOD * DM + 5 * DM + col0;
#pragma unroll
                    for (int bj = 0; bj < 2; ++bj)
#pragma unroll
                        for (int n = 0; n < 2; ++n) if ((u.qmask >> (ai * 2 + bj)) & 1) { const f32x4 gv = *(const f32x4*)(gp + bj * 128 + n * 16); *(f32x4*)(xr + bj * 128 + n * 16) = *(const f32x4*)(xr + bj * 128 + n * 16) + gv * (w * acc[ai][bj][m][n]); } } }
    }
};
struct Frame { LAS unsigned char* lds; volatile LAS unsigned* MISC; int tid, lane, wave, vcu, G; };

__device__ __forceinline__ void p0_transpose_item(const float* W, int K, int N, bf16_t* WT, int k0, int n0, int drow0, LAS float* scr, int lane) {
    f32x4 v[16];
#pragma unroll
    for (int i = 0; i < 16; ++i) v[i] = __builtin_nontemporal_load((const f32x4*)(W + (size_t)(k0 + 4 * i + (lane >> 4)) * N + n0 + 4 * (lane & 15)));
#pragma unroll
    for (int i = 0; i < 16; ++i) { LAS float* d = scr + (4 * i + (lane >> 4)) * 65 + 4 * (lane & 15); d[0] = v[i][0]; d[1] = v[i][1]; d[2] = v[i][2]; d[3] = v[i][3]; }
    asm volatile("s_waitcnt lgkmcnt(0)" ::: "memory");
    const int c = lane & 7;
#pragma unroll
    for (int j = 0; j < 8; ++j) { const int n = (lane >> 3) + 8 * j; const LAS float* sp = scr + (8 * c) * 65 + n;
        u32x4 o; o.x = pk2(sp[0 * 65], sp[1 * 65]); o.y = pk2(sp[2 * 65], sp[3 * 65]); o.z = pk2(sp[4 * 65], sp[5 * 65]); o.w = pk2(sp[6 * 65], sp[7 * 65]);
        *(u32x4*)(WT + (size_t)(drow0 + n) * K + k0 + 8 * c) = o; }
    asm volatile("s_waitcnt lgkmcnt(0)" ::: "memory");
}
__device__ __forceinline__ void p0_ffn_matrix(const Prm& p, int m, int r, LAS float* scr, int lane) {
    unsigned char* ws = p.ws; const float* src; bf16_t* dst; int t;
    if (m < 6) { const int j = m / 3; t = m % 3; src = (t == 0 ? p.fg : t == 1 ? p.fu : p.fd) + (size_t)j * DM * DFF; dst = (bf16_t*)(ws + WS_W + j * WE_STRIDE + (t == 2 ? WE_D : WE_GU)); }
    else { const int q = m - 6, j = q / 24, e = (q % 24) / 3; t = q % 3; src = (t == 0 ? p.mg : t == 1 ? p.mu : p.md) + ((size_t)j * NEXP + e) * DM * DFF; dst = (bf16_t*)(ws + WS_W + WO_BASE + j * WO_STRIDE + WO_EXP + e * WX_STRIDE + (t == 2 ? WX_D : WX_GU)); }
    if (t == 2) { const int nblk = DM / 64, q8 = r >> 3, w8 = r & 7, ngx = nblk / 2, kb = 4 * (q8 / ngx) + (w8 >> 1), nb = 2 * (q8 % ngx) + (w8 & 1); p0_transpose_item(src, DFF, DM, dst, 64 * kb, 64 * nb, 64 * nb, scr, lane); }
    else { const int nblk = DFF / 64, q8 = r >> 3, w8 = r & 7, ngx = nblk / 2, kb = 4 * (q8 / ngx) + (w8 >> 1), nb = 2 * (q8 % ngx) + (w8 & 1), n0 = 64 * nb; p0_transpose_item(src, DM, DFF, dst, 64 * kb, n0, (n0 / 128) * 256 + (n0 % 128) + (t == 1 ? 128 : 0), scr, lane); }
}
__device__ __forceinline__ void p0_prologue(const Prm& p, Frame& F) {
    unsigned char* ws = p.ws;
    { const int gt = F.vcu * 512 + F.tid, NT = F.G * 512;
      bf16_t* F1 = (bf16_t*)(ws + WS_TAB + TAB_F1); bf16_t* F2 = (bf16_t*)(ws + WS_TAB + TAB_F2); float2* TW = (float2*)(ws + WS_TAB + TAB_TW); float2* TWC = (float2*)(ws + WS_TAB + TAB_TWC);
      for (int i = gt; i < 256 * 128; i += NT) { const int row = i / 128, n1 = i % 128, k1 = row >> 1, c = row & 1; float sn, cs; sincospif(2.f * (float)((n1 * k1) & 127) / 128.f, &sn, &cs);
          F1[i] = (bf16_t)f2bf((c ? -sn : cs) * 0.08838834764831845f); }
      for (int i = gt; i < 128 * 128; i += NT) { const int row = i / 128, col = i % 128, k2 = row >> 1, cp = row & 1, n2 = col >> 1, c = col & 1; float sn, cs; sincospif(2.f * (float)((n2 * k2) & 63) / 64.f, &sn, &cs);
          const float v = cp == 0 ? (c == 0 ? cs : sn) : (c == 0 ? -sn : cs); F2[i] = (bf16_t)f2bf(v * 0.125f); }
      for (int i = gt; i < 64 * 128; i += NT) { const int n2 = i / 128, k1 = i % 128; float sn, cs; sincospif(2.f * (float)(n2 * k1) / 8192.f, &sn, &cs); TW[i] = make_float2(cs, -sn); }
      for (int i = gt; i < 2 * 128; i += NT) { const int n2 = i / 128, k1 = i % 128; float sn, cs; sincospif(2.f * (float)(n2 * k1) / 256.f, &sn, &cs); TWC[i] = make_float2(cs, -sn); }
      for (int i = gt; i < 128 * 16; i += NT) { const int pos = i / 16, f = i % 16; const float inv = powf(10000.f, -(float)f / 16.f); const float ang = (float)pos * inv;
          ((float2*)(ws + WS_ROPE))[i] = make_float2((float)cos((double)ang), (float)sin((double)ang)); }
    }
    { LAS float* sc = (LAS float*)(F.lds);
      LAS float* part = (LAS float*)(F.lds + 32768);
      for (int i = F.tid; i < 5 * DM; i += 512) { const int r = i / DM, k = i % DM; const float v = r < 4 ? p.c[r * DM + k] : p.c_ctx[k]; sc[i] = v / (1.f + expf(-v)); }
      __syncthreads();
      for (int it = F.vcu; it < DEPTH * 96; it += F.G) { const int l = it / 96, n = (it % 96) * 64 + F.lane;
          const float* w = p.ada_w + (size_t)l * DM * NMOD * DM + n; float a[5] = {0.f, 0.f, 0.f, 0.f, 0.f};
          for (int kb = 0; kb < 128; kb += 32) { float wv[32];
#pragma unroll
              for (int kk = 0; kk < 32; ++kk) wv[kk] = w[(size_t)(F.wave * 128 + kb + kk) * NMOD * DM];
#pragma unroll
              for (int kk = 0; kk < 32; ++kk) { const int k = F.wave * 128 + kb + kk;
#pragma unroll
                  for (int r = 0; r < 5; ++r) a[r] += sc[r * DM + k] * wv[kk]; } }
#pragma unroll
          for (int r = 0; r < 5; ++r) part[(F.wave * 5 + r) * 64 + F.lane] = a[r];
          __syncthreads();
          if (F.tid < 320) { const int r = F.tid / 64, ln = F.tid % 64; float sum = 0.f;
#pragma unroll
              for (int wv = 0; wv < 8; ++wv) sum += part[(wv * 5 + r) * 64 + ln];
              ((float*)(ws + WS_MOD))[((size_t)l * 5 + r) * NMOD * DM + (it % 96) * 64 + ln] = sum + p.ada_b[l * NMOD * DM + (it % 96) * 64 + ln]; }
          __syncthreads(); }
    }
    { LAS f32x2* cs256 = (LAS f32x2*)(F.lds);
      __syncthreads();
      for (int i = F.tid; i < 256; i += 512) { float sn, cs; sincospif(2.f * (float)i / 256.f, &sn, &cs); cs256[i] = (f32x2){cs * 0.0625f, sn * 0.0625f}; }
      __syncthreads();
      const int gw = F.vcu * 8 + F.wave, NGW = F.G * 8;
      for (int it = gw; it < 2 * 64 * 16; it += NGW) { const int j = it / 1024, kk0 = ((it / 16) % 64) * 32, n = (it % 16) * 64 + F.lane;
          const int type = kk0 / 1024, g = (kk0 % 1024) / 256, p0 = kk0 % 256;
          const float* w = p.fw + (size_t)j * DM * DM + (size_t)(g * 256) * DM + n; float a[32] = {};
          for (int qb = 0; qb < 256; qb += 16) { float wv[16];
#pragma unroll
              for (int qq = 0; qq < 16; ++qq) wv[qq] = w[(size_t)(qb + qq) * DM];
#pragma unroll
              for (int qq = 0; qq < 16; ++qq) { const int q = qb + qq; int idx = p0 * q;
#pragma unroll
                  for (int i = 0; i < 32; ++i) { const f32x2 t = cs256[idx & 255]; a[i] += (type ? t.y : t.x) * wv[qq]; idx += q; } } }
#pragma unroll
          for (int i8 = 0; i8 < 4; ++i8) { u32x4 o; o.x = pk2(a[8 * i8], a[8 * i8 + 1]); o.y = pk2(a[8 * i8 + 2], a[8 * i8 + 3]); o.z = pk2(a[8 * i8 + 4], a[8 * i8 + 5]); o.w = pk2(a[8 * i8 + 6], a[8 * i8 + 7]);
              *(u32x4*)((bf16_t*)(ws + WS_W + j * WE_STRIDE + WE_F) + (size_t)n * 2048 + kk0 + 8 * i8) = o; } }
      __syncthreads();
    }
    { LAS float* scr = (LAS float*)(F.lds + F.wave * 16640);
      const int gw = F.vcu * 8 + F.wave, NGW = F.G * 8;
      constexpr int I_FFN = 54 * 896, I_QKV = 2 * 384, I_O = 2 * 256;
      for (int it = gw; it < I_FFN + I_QKV + I_O; it += NGW) {
          if (it < I_FFN) { p0_ffn_matrix(p, it / 896, it % 896, scr, F.lane); continue; }
          int r = it - I_FFN;
          if (r < I_QKV) { const int j = r / 384, q = r % 384, nblk = QKVD / 64, kb = q / nblk, nb = q % nblk;
              p0_transpose_item(p.wqkv + (size_t)j * DM * QKVD, DM, QKVD, (bf16_t*)(ws + WS_W + WO_BASE + j * WO_STRIDE + WO_QKV), 64 * kb, 64 * nb, 64 * nb, scr, F.lane); continue; }
          r -= I_QKV;
          { const int j = r / 256, q = r % 256, nblk = DM / 64, kb = q / nblk, nb = q % nblk;
              p0_transpose_item(p.wo + (size_t)j * DM * DM, DM, DM, (bf16_t*)(ws + WS_W + WO_BASE + j * WO_STRIDE + WO_O), 64 * kb, 64 * nb, 64 * nb, scr, F.lane); }
      }
    }
}

template <bool ROUTER>
__device__ __forceinline__ void norm_phase(const Prm& p, Frame& F, const float* xl, const float* xc, const float* g, const float* mod  , int which, bf16_t* HB, int nrows,
                                            const float* wr, unsigned* mcnt, int* ltok, float* lw) {
    const int lane = F.lane;
    f32x4 gv[4];
#pragma unroll
    for (int j = 0; j < 4; ++j) gv[j] = *(const f32x4*)(g + 4 * (lane + 64 * j));
    float wreg[ROUTER ? 128 : 1];
    if (ROUTER) {
#pragma unroll
        for (int j = 0; j < 4; ++j)
#pragma unroll
            for (int i = 0; i < 4; ++i) { const int c = 4 * (lane + 64 * j) + i; const f32x4 w0 = *(const f32x4*)(wr + c * 8), w1 = *(const f32x4*)(wr + c * 8 + 4);
#pragma unroll
                for (int e = 0; e < 4; ++e) { wreg[(j * 4 + i) * 8 + e] = w0[e]; wreg[(j * 4 + i) * 8 + 4 + e] = w1[e]; } }
    }
    const int rpb = (nrows + F.G - 1) / F.G;
    const int r0 = ROUTER ? F.vcu * rpb : F.vcu * 8 + F.wave, r1 = ROUTER ? (r0 + rpb < nrows ? r0 + rpb : nrows) : nrows, rstep = ROUTER ? 8 : F.G * 8;
    LAS unsigned* ech = (LAS unsigned*)F.lds; LAS float* gch = (LAS float*)(F.lds + 4096);
    if (ROUTER) __syncthreads();
    for (int rr = ROUTER ? r0 + F.wave : r0; rr < r1; rr += 2 * rstep) {
        f32x4 v[2][4]; float ss[2];
#pragma unroll
        for (int q = 0; q < 2; ++q) { const int r = rr + q * rstep; ss[q] = 0.f;
            if (r < r1) { const float* xr = (r < TL) ? xl + (size_t)r * DM : xc + (size_t)(r - TL) * DM;
#pragma unroll
                for (int j = 0; j < 4; ++j) v[q][j] = *(const f32x4*)(xr + 4 * (lane + 64 * j)); } }
#pragma unroll
        for (int q = 0; q < 2; ++q) { const int r = rr + q * rstep;
            if (r < r1) {
#pragma unroll
                for (int j = 0; j < 4; ++j) ss[q] += (v[q][j][0] * v[q][j][0] + v[q][j][1] * v[q][j][1]) + (v[q][j][2] * v[q][j][2] + v[q][j][3] * v[q][j][3]); } }
#pragma unroll
        for (int q = 0; q < 2; ++q) { const int r = rr + q * rstep;
          if (r < r1) {
            const int b5 = (r < TL) ? r / SEQ : 4; const float* mp = mod + (size_t)b5 * NMOD * DM + which * DM;
            const float rstd = rsqrtf(wave_sum(ss[q]) * (1.f / DM) + EPS);
            float lg[8] = {};
#pragma unroll
            for (int j = 0; j < 4; ++j) { const f32x4 sh = *(const f32x4*)(mp + 4 * (lane + 64 * j)), sc = *(const f32x4*)(mp + DM + 4 * (lane + 64 * j));
                f32x4 h = v[q][j] * rstd * gv[j] * (sc + 1.f) + sh;
                u32x2 o; o.x = pk2(h[0], h[1]); o.y = pk2(h[2], h[3]); *(u32x2*)(HB + (size_t)r * DM + 4 * (lane + 64 * j)) = o;
                if (ROUTER) {
#pragma unroll
                    for (int i = 0; i < 4; ++i)
#pragma unroll
                        for (int e = 0; e < 8; ++e) lg[e] += h[i] * wreg[(j * 4 + i) * 8 + e]; } }
            if (ROUTER) {
                float a4[4], b2[2], c1;
#pragma unroll
                for (int t = 0; t < 4; ++t) { const float snd = (lane & 1) ? lg[t] : lg[t + 4], kp = (lane & 1) ? lg[t + 4] : lg[t]; a4[t] = kp + SWZ_XOR(snd, 1); }
#pragma unroll
                for (int t = 0; t < 2; ++t) { const float snd = (lane & 2) ? a4[t] : a4[t + 2], kp = (lane & 2) ? a4[t + 2] : a4[t]; b2[t] = kp + SWZ_XOR(snd, 2); }
                { const float snd = (lane & 4) ? b2[0] : b2[1], kp = (lane & 4) ? b2[1] : b2[0]; c1 = kp + SWZ_XOR(snd, 4); }
                c1 += SWZ_XOR(c1, 8); c1 += SWZ_XOR(c1, 16);
                const int cb = __builtin_bit_cast(int, c1);
#pragma unroll
                for (int e = 0; e < 8; ++e) { const int l = ((e >> 2) & 1) | (((e >> 1) & 1) << 1) | ((e & 1) << 2);
                    lg[e] = __builtin_bit_cast(float, __builtin_amdgcn_readlane(cb, l)) + __builtin_bit_cast(float, __builtin_amdgcn_readlane(cb, l + 32)); }
                int e0 = 0; float v0 = lg[0];
#pragma unroll
                for (int e = 1; e < 8; ++e) if (lg[e] > v0) { v0 = lg[e]; e0 = e; }
                int e1 = -1; float v1 = -INFINITY;
#pragma unroll
                for (int e = 0; e < 8; ++e) if (e != e0 && lg[e] > v1) { v1 = lg[e]; e1 = e; }
                const float g1 = 1.f / (1.f + expf(v0 - v1)), g0 = 1.f - g1;
                if (lane == 0) { ech[r - r0] = (unsigned)e0 | ((unsigned)e1 << 8); gch[2 * (r - r0)] = g0; gch[2 * (r - r0) + 1] = g1; }
            }
          } }
    }
    if (ROUTER) {
        __syncthreads();
        if (F.tid < 16) { const int grp = F.tid, k = grp >> 3, e = grp & 7, n = r1 - r0; int cnt = 0;
            for (int i = 0; i < n; ++i) cnt += (int)(((ech[i] >> (8 * k)) & 0xffu) == (unsigned)e);
            mcnt[(size_t)F.vcu * 16 + grp] = (unsigned)cnt; }
    }
}
__device__ __forceinline__ void moe_lists(Frame& F, const unsigned* cntw, unsigned* mcnt, int* ltok, float* lw, int nrows) {
    const int rpb = (nrows + F.G - 1) / F.G; const int r0 = F.vcu * rpb, r1 = (r0 + rpb < nrows ? r0 + rpb : nrows);
    LAS unsigned* ech = (LAS unsigned*)F.lds; LAS float* gch = (LAS float*)(F.lds + 4096);
    if (F.tid < 16) { const int grp = F.tid, k = grp >> 3, e = grp & 7, n = r1 - r0; unsigned pos = 0u, tot = 0u;
        for (int w = 0; w < F.G; ++w) { const unsigned c = cntw[(size_t)w * 16 + grp]; tot += c; pos += (w < F.vcu) ? c : 0u; }
        if (F.vcu == 0) mcnt[grp] = tot;
        for (int i = 0; i < n; ++i) if (((ech[i] >> (8 * k)) & 0xffu) == (unsigned)e) { ltok[(size_t)grp * TT + pos] = r0 + i; lw[(size_t)grp * TT + pos] = gch[2 * i + k]; ++pos; } }
}
__device__ __forceinline__ void final_norm_phase(const Prm& p, Frame& F) {
    const int gw = F.vcu * 8 + F.wave, NGW = F.G * 8, lane = F.lane;
    f32x4 gv[4];
#pragma unroll
    for (int j = 0; j < 4; ++j) gv[j] = *(const f32x4*)(p.fng + 4 * (lane + 64 * j));
    for (int rr = gw; rr < TL; rr += 2 * NGW) { f32x4 v[2][4];
#pragma unroll
        for (int q = 0; q < 2; ++q) { const int r = rr + q * NGW; if (r < TL) {
#pragma unroll
            for (int j = 0; j < 4; ++j) v[q][j] = *(const f32x4*)(p.out + (size_t)r * DM + 4 * (lane + 64 * j)); } }
#pragma unroll
        for (int q = 0; q < 2; ++q) { const int r = rr + q * NGW; if (r < TL) { float s = 0.f;
#pragma unroll
            for (int j = 0; j < 4; ++j) s += (v[q][j][0] * v[q][j][0] + v[q][j][1] * v[q][j][1]) + (v[q][j][2] * v[q][j][2] + v[q][j][3] * v[q][j][3]);
            const float rstd = rsqrtf(wave_sum(s) * (1.f / DM) + EPS);
#pragma unroll
            for (int j = 0; j < 4; ++j) *(f32x4*)(p.out + (size_t)r * DM + 4 * (lane + 64 * j)) = v[q][j] * rstd * gv[j]; } } }
}
__device__ __forceinline__ void moe_tables(Frame& F, const unsigned* mcnt) {
    __syncthreads();
    if (F.tid == 0) { unsigned first = 0u, nb0 = 0u;
        for (int g = 0; g < 16; ++g) { const unsigned c = __hip_atomic_load(mcnt + g, __ATOMIC_RELAXED, __HIP_MEMORY_SCOPE_AGENT); F.MISC[16 + g] = first; F.MISC[32 + g] = c; first += (c + 255u) / 256u; if (g == 7) nb0 = first; }
        F.MISC[48] = nb0; F.MISC[49] = first; }
    __syncthreads();
}


__device__ __forceinline__ int fresh_tid(int wave) { int tl; asm volatile("v_mbcnt_lo_u32_b32 %0, -1, 0\n\tv_mbcnt_hi_u32_b32 %0, -1, %0" : "=v"(tl)); return wave * 64 + tl; }
typedef short v4i16_t __attribute__((ext_vector_type(4)));
__device__ __forceinline__ unsigned off_b(unsigned row, unsigned ch) { return 256u * row + 16u * (ch ^ (((row & 3u) << 2) | ((row >> 2) & 3u))); }
__device__ __forceinline__ int crow(int r, int hi) { return (r & 3) + 8 * (r >> 2) + 4 * hi; }
__device__ __forceinline__ s16x4 trrd(const LAS unsigned char* p) { return __builtin_bit_cast(s16x4, __builtin_amdgcn_ds_read_tr16_b64_v4i16((LAS v4i16_t*)p)); }
template <int MB>
__device__ __forceinline__ void dft_mma(const LAS unsigned char* Aimg, const LAS unsigned char* Bimg, int wave, int lane, f32x16 (&acc)[MB]) {
    const int r32 = lane & 31, hi = lane >> 5;
    const unsigned X = ((r32 & 3) << 2) | ((r32 >> 2) & 3);
    const LAS unsigned char* bbase = Bimg + (wave >> 2) * 32768;
    const unsigned blk = (lane >> 4) & 1, q = (lane & 15) >> 2, pp = lane & 3, c = wave & 3;
    unsigned tra[2];
#pragma unroll
    for (int t = 0; t < 2; ++t) tra[t] = off_b(8 * hi + 4 * t + q, 4 * c + 2 * blk + (pp >> 1)) + 8 * (pp & 1);
#pragma unroll
    for (int ks = 0; ks < 8; ++ks) {
        const s16x4 lo = trrd(bbase + tra[0] + ks * 4096), hh = trrd(bbase + tra[1] + ks * 4096);
        const bf16x8 bf = (bf16x8){lo[0], lo[1], lo[2], lo[3], hh[0], hh[1], hh[2], hh[3]};
        const unsigned achunk = ((2 * ks + hi) ^ X) * 16;
#pragma unroll
        for (int mb = 0; mb < MB; ++mb) { const bf16x8 af = *(const LAS bf16x8*)(Aimg + 256 * (32 * mb + r32) + achunk);
            acc[mb] = __builtin_amdgcn_mfma_f32_32x32x16_bf16(af, bf, acc[mb], 0, 0, 0); }
    }
}
__device__ __forceinline__ void s1_phase(const Prm& p, Frame& F, const float* xl, const float* xc, const float* g, const float* mod, bf16_t* Y1, bf16_t* Y1C) {
    LAS unsigned char* Aimg = F.lds; LAS unsigned char* Bimg = F.lds + 65536;
    LAS float* rstd = (LAS float*)(F.lds + 131072); LAS f32x2* tw = (LAS f32x2*)(F.lds + 131584); LAS float* gm = (LAS float*)(F.lds + 132608); LAS float* shv = (LAS float*)(F.lds + 136704);
    const bf16_t* F1 = (const bf16_t*)(p.ws + WS_TAB + TAB_F1); const float2* TW = (const float2*)(p.ws + WS_TAB + TAB_TW); const float2* TWC = (const float2*)(p.ws + WS_TAB + TAB_TWC);
    const int tid = F.tid, lane = F.lane, wave = F.wave, r32 = lane & 31, hi = lane >> 5;
    __syncthreads();
    for (int qq = tid; qq < 256 * 16; qq += 512) { const int row = qq >> 4, ch = qq & 15; *(LAS u32x4*)(Aimg + off_b(row, ch)) = *(const u32x4*)(F1 + row * 128 + ch * 8); }
    for (int w = F.vcu; w < 288; w += F.G) {
        const int u = w < 256 ? w : 256 + ((w - 256) >> 2), c_lo = w < 256 ? 0 : (w - 256) & 3, c_hi = w < 256 ? 4 : c_lo + 1;
        const bool lat = u < 256; const int b = lat ? u >> 6 : (u - 256) >> 1, n2 = lat ? u & 63 : (u - 256) & 1;
        const float* xs = lat ? xl + ((size_t)b * SEQ + n2) * DM : xc + ((size_t)b * CTXL + n2) * DM; const size_t rstride = (size_t)(lat ? 64 : 2) * DM;
        const float* mp = mod + (size_t)(lat ? b : 4) * NMOD * DM;
        __syncthreads();
        for (int c = tid; c < DM; c += 512) { gm[c] = g[c] * (1.f + mp[DM + c]); shv[c] = mp[c]; }
        if (tid < 128) { const float2 t = lat ? TW[n2 * 128 + tid] : TWC[n2 * 128 + tid]; tw[tid] = (f32x2){t.x, t.y}; }
#pragma unroll 4
        for (int i = 0; i < 16; ++i) { const int n1 = 16 * wave + i; const float* xr = xs + n1 * rstride; float sq = 0.f;
#pragma unroll
            for (int j = 0; j < 4; ++j) { const f32x4 v = *(const f32x4*)(xr + 4 * (lane + 64 * j)); sq += (v[0] * v[0] + v[1] * v[1]) + (v[2] * v[2] + v[3] * v[3]); }
            sq = wave_sum(sq); if (lane == 0) rstd[n1] = rsqrtf(sq * (1.f / DM) + EPS); }
        __syncthreads();
        for (int cc = c_lo; cc < c_hi; ++cc) {
            { const int tt = fresh_tid(wave); const int cols4 = tt & 63, rb = tt >> 6, c0 = 256 * cc + 4 * cols4;
              f32x4 xv[16];
#pragma unroll
              for (int i = 0; i < 16; ++i) xv[i] = *(const f32x4*)(xs + (size_t)(rb + 8 * i) * rstride + c0);
              const f32x4 gv = *(const LAS f32x4*)(gm + c0), sv = *(const LAS f32x4*)(shv + c0);
              LAS unsigned char* bw = Bimg + (cols4 >> 5) * 32768 + 8 * (cols4 & 1);
#pragma unroll
              for (int i = 0; i < 16; ++i) { const int n1 = rb + 8 * i; const f32x4 h = xv[i] * rstd[n1] * gv + sv; u32x2 o; o.x = pk2(h[0], h[1]); o.y = pk2(h[2], h[3]);
                  *(LAS u32x2*)(bw + off_b(n1, (cols4 & 31) >> 1)) = o; } }
            __syncthreads();
            f32x16 acc[8];
#pragma unroll
            for (int mb = 0; mb < 8; ++mb) acc[mb] = (f32x16){};
            dft_mma<8>(Aimg, Bimg, wave, lane, acc);
            __syncthreads();
            bf16_t* Y = lat ? Y1 : Y1C; const size_t k1stride = (size_t)(lat ? 128 : 4) * DM;
            const size_t ybase = (lat ? ((size_t)b * 128 * 64 + n2) * 2 : ((size_t)b * 128 * 2 + n2) * 2) * DM + 256 * cc;
            LAS bf16_t* ost = (LAS bf16_t*)Bimg + (4 * hi) * 256 + 32 * wave + r32;
#pragma unroll
            for (int hf = 0; hf < 2; ++hf) {
#pragma unroll
                for (int mb = 0; mb < 4; ++mb)
#pragma unroll
                    for (int r = 0; r < 16; r += 2) { const int k1 = (32 * (4 * hf + mb) + crow(r, hi)) >> 1; const f32x2 t = tw[k1]; const float re = acc[4 * hf + mb][r], im = acc[4 * hf + mb][r + 1];
                        ost[(32 * mb + (r & 3) + 8 * (r >> 2)) * 256] = (bf16_t)f2bf(re * t.x - im * t.y); ost[(32 * mb + (r & 3) + 8 * (r >> 2) + 1) * 256] = (bf16_t)f2bf(re * t.y + im * t.x);
                        if ((r & 7) == 6) asm volatile("" ::: "memory"); }
                __syncthreads();
                const int t2 = fresh_tid(wave);
#pragma unroll
                for (int i = 0; i < 8; ++i) { const int qq = t2 + 512 * i, row = qq >> 5, ch = qq & 31;
                    const u32x4 v = *(const LAS u32x4*)((const LAS unsigned char*)Bimg + row * 512 + ch * 16);
                    const int k1 = 64 * hf + (row >> 1);
                    *(u32x4*)(Y + ybase + (size_t)k1 * k1stride + (size_t)(row & 1) * DM + ch * 8) = v; }
                __syncthreads();
            }
        }
    }
}
__device__ __forceinline__ void s2_phase(const Prm& p, Frame& F, const bf16_t* Y1, const bf16_t* Y1C, bf16_t* PQ) {
    LAS unsigned char* Aimg = F.lds; LAS unsigned char* Bimg = F.lds + 65536;
    const bf16_t* F2 = (const bf16_t*)(p.ws + WS_TAB + TAB_F2);
    const int tid = F.tid, lane = F.lane, wave = F.wave, r32 = lane & 31, hi = lane >> 5;
    __syncthreads();
    for (int qq = tid; qq < 128 * 16; qq += 512) { const int row = qq >> 4, ch = qq & 15; *(LAS u32x4*)(Aimg + off_b(row, ch)) = *(const u32x4*)(F2 + row * 128 + ch * 8); }
    u32x4 v[8];
    { const int u = F.vcu; if (u < 2048) { const int cc = u & 3, k1 = (u >> 2) & 127, b = u >> 9; const bf16_t* src = Y1 + ((size_t)b * 128 + k1) * 128 * DM + 256 * cc;
#pragma unroll
        for (int i = 0; i < 8; ++i) { const int qq = tid + 512 * i; v[i] = *(const u32x4*)(src + (size_t)(qq >> 5) * DM + (qq & 31) * 8); } } }
    for (int u = F.vcu; u < 2048; u += F.G) {
        const int cc = u & 3, k1 = (u >> 2) & 127, b = u >> 9;
        __syncthreads();
#pragma unroll
        for (int i = 0; i < 8; ++i) { const int qq = tid + 512 * i, row = qq >> 5, ch32 = qq & 31; *(LAS u32x4*)(Bimg + (ch32 >> 4) * 32768 + off_b(row, ch32 & 15)) = v[i]; }
        __syncthreads();
        { const int un = u + F.G; if (un < 2048) { const int ccn = un & 3, k1n = (un >> 2) & 127, bn = un >> 9; const bf16_t* src = Y1 + ((size_t)bn * 128 + k1n) * 128 * DM + 256 * ccn;
#pragma unroll
            for (int i = 0; i < 8; ++i) { const int qq = tid + 512 * i; v[i] = *(const u32x4*)(src + (size_t)(qq >> 5) * DM + (qq & 31) * 8); } } }
        f32x16 acc[4];
#pragma unroll
        for (int mb = 0; mb < 4; ++mb) acc[mb] = (f32x16){};
        dft_mma<4>(Aimg, Bimg, wave, lane, acc);
        __syncthreads();
        { LAS bf16_t* ost = (LAS bf16_t*)Bimg + (4 * hi) * 256 + 32 * wave + r32;
#pragma unroll
          for (int mb = 0; mb < 4; ++mb)
#pragma unroll
              for (int r = 0; r < 16; ++r) ost[(32 * mb + (r & 3) + 8 * (r >> 2)) * 256] = (bf16_t)f2bf(acc[mb][r]); }
        __syncthreads();
        { const int t2 = fresh_tid(wave);
#pragma unroll
          for (int i = 0; i < 8; ++i) { const int qq = t2 + 512 * i, row = qq >> 5, ch = qq & 31, k2 = row >> 1, cp = row & 1;
              const u32x4 o = *(const LAS u32x4*)((const LAS unsigned char*)Bimg + row * 512 + ch * 16);
              *(u32x4*)(PQ + ((size_t)b * SEQ + k1 + 128 * k2) * 2048 + cp * DM + 256 * cc + ch * 8) = o; } }
    }
    { const int gt = F.vcu * 512 + fresh_tid(wave), NT = F.G * 512; const float sc = 0.70710678118654752f;
      for (int i = gt; i < NB * 128 * DM; i += NT) { const int ch = i & (DM - 1), k1 = (i >> 10) & 127, b = i >> 17;
          const bf16_t* y = Y1C + ((size_t)b * 128 + k1) * 4 * DM + ch;
          const float y0r = __uint_as_float((unsigned)y[0] << 16), y0i = __uint_as_float((unsigned)y[DM] << 16), y1r = __uint_as_float((unsigned)y[2 * DM] << 16), y1i = __uint_as_float((unsigned)y[3 * DM] << 16);
          bf16_t* o0 = PQ + ((size_t)TL + b * CTXL + k1) * 2048 + ch; bf16_t* o1 = o0 + (size_t)128 * 2048;
          o0[0] = (bf16_t)f2bf((y0r + y1r) * sc); o0[DM] = (bf16_t)f2bf((y0i + y1i) * sc); o1[0] = (bf16_t)f2bf((y0r - y1r) * sc); o1[DM] = (bf16_t)f2bf((y0i - y1i) * sc); } }
}

__device__ __forceinline__ void attn_phase(const Prm& p, Frame& F, const bf16_t* QB, const bf16_t* KB, const bf16_t* VB, bf16_t* OB, const float* sinks, int nunits) {
    LAS unsigned char* Ks = F.lds; LAS unsigned char* Vs = F.lds + 8192; LAS float* wsf = (LAS float*)(F.lds + 32768) + F.wave * 64; LAS bf16_t* stg = (LAS bf16_t*)(F.lds + 34816 + F.wave * 4096);
    const int lane = F.lane, wave = F.wave, r32 = lane & 31, hi = lane >> 5;
    for (int u = F.vcu; u < nunits; u += F.G) {
        const bool isctx = u >= 2048; const int uu = isctx ? u - 2048 : u;
        const int pb = isctx ? (uu & 3) : (uu & 127), kv = isctx ? ((uu >> 2) & 3) : ((uu >> 7) & 3), b = isctx ? (uu >> 4) : (uu >> 9);
        const int h = kv * 4 + (wave >> 1); const int qq = 32 * (wave & 1) + r32;
        const size_t qrow0 = (size_t)(isctx ? TL + b * CTXL : b * SEQ) + 64 * pb + 32 * (wave & 1);
        bf16x8 qr[4];
#pragma unroll
        for (int d0 = 0; d0 < 4; ++d0) qr[d0] = *(const bf16x8*)(QB + (qrow0 + r32) * DM + h * 64 + d0 * 16 + hi * 8);
        float m = sinks[h] * LOG2E, l = hi ? 0.f : 1.f; f32x16 o[2]; o[0] = (f32x16){}; o[1] = (f32x16){};
        const int ntl = isctx ? 0 : 5;
        const int t_first = isctx ? 0 : (pb < 2 ? 2 - pb : 0), t_lastl = isctx ? -1 : (pb > 125 ? 129 - pb : 4);
        const bf16_t* kbase = KB + (size_t)lane * 256 + kv * 64 + wave * 8;
        const bf16_t* vbase = VB + (size_t)(16 * (wave & 3) + (lane >> 2)) * 256 + kv * 64 + (wave >> 2) * 32 + (lane & 3) * 8;
        auto tile_row0 = [&](int ti) -> size_t { return ti < ntl ? (size_t)b * SEQ + 64 * (pb - 2 + ti) : (size_t)TL + b * CTXL + 64 * (ti - ntl); };
        int ti = isctx ? 0 : t_first; int slot = 0;
        u32x4 kreg = *(const u32x4*)(kbase + tile_row0(ti) * 256), vreg = *(const u32x4*)(vbase + tile_row0(ti) * 256);
        __syncthreads();
        *(LAS u32x4*)(Ks + wave * 1024 + lane * 16) = kreg; *(LAS u32x4*)(Vs + wave * 1024 + lane * 16) = vreg;
        { int tn0 = ti + 1; if (tn0 > t_lastl && tn0 < ntl) tn0 = ntl; kreg = *(const u32x4*)(kbase + tile_row0(tn0) * 256); vreg = *(const u32x4*)(vbase + tile_row0(tn0) * 256); }
        __syncthreads();
        while (ti < ntl + 4) {
            const int mode = (ti < ntl) ? ((ti == 0) ? 1 : (ti == 4) ? 2 : 0) : 0;
            int tn = ti + 1; if (tn > t_lastl && tn < ntl) tn = ntl;
            int tnn = tn + 1; if (tnn > t_lastl && tnn < ntl) tnn = ntl;
            const LAS unsigned char* kb = Ks + slot * 16384 + hi * 1024 + r32 * 16;
            const LAS unsigned char* vp = Vs + slot * 16384 + ((lane >> 4) & 1) * 32 + (lane & 3) * 8 + (4 * hi + ((lane & 15) >> 2)) * 64;
            f32x16 p0 = (f32x16){}, p1 = (f32x16){};
#pragma unroll
            for (int d0 = 0; d0 < 4; ++d0) { const bf16x8 b0 = *(const LAS bf16x8*)(kb + d0 * 2048), b1 = *(const LAS bf16x8*)(kb + d0 * 2048 + 512);
                p0 = __builtin_amdgcn_mfma_f32_32x32x16_bf16(b0, qr[d0], p0, 0, 0, 0); p1 = __builtin_amdgcn_mfma_f32_32x32x16_bf16(b1, qr[d0], p1, 0, 0, 0); }
            if (mode) {
#pragma unroll
                for (int r = 0; r < 16; ++r) { const int kk = crow(r, hi); const bool m0 = (mode == 1) ? (kk < qq) : (kk > qq), m1 = (mode == 1) ? (kk + 32 < qq) : (kk + 32 > qq);
                    if (m0) p0[r] = -INFINITY; if (m1) p1[r] = -INFINITY; } }
            float rm = fmaxf(p0[0], p1[0]);
#pragma unroll
            for (int r = 1; r < 16; ++r) rm = fmaxf(rm, fmaxf(p0[r], p1[r]));
            { auto rr = __builtin_amdgcn_permlane32_swap(__float_as_uint(rm), __float_as_uint(rm), false, false); rm = fmaxf(__uint_as_float(rr[0]), __uint_as_float(rr[1])); }
            const float mnew = fmaxf(m, rm), alpha = __builtin_amdgcn_exp2f(m - mnew); m = mnew;
            float ps = 0.f;
#pragma unroll
            for (int r = 0; r < 16; ++r) { p0[r] = __builtin_amdgcn_exp2f(p0[r] - m); p1[r] = __builtin_amdgcn_exp2f(p1[r] - m); ps += p0[r] + p1[r]; }
            l = l * alpha + ps;
            if (hi == 0) wsf[r32] = alpha;
#pragma unroll
            for (int r = 0; r < 16; ++r) { const float a = wsf[crow(r, hi)]; o[0][r] *= a; o[1][r] *= a; }
            u32x4 pw[4];
            pw[0] = (u32x4){pk2(p0[0], p0[1]), pk2(p0[2], p0[3]), pk2(p0[4], p0[5]), pk2(p0[6], p0[7])};
            pw[1] = (u32x4){pk2(p0[8], p0[9]), pk2(p0[10], p0[11]), pk2(p0[12], p0[13]), pk2(p0[14], p0[15])};
            pw[2] = (u32x4){pk2(p1[0], p1[1]), pk2(p1[2], p1[3]), pk2(p1[4], p1[5]), pk2(p1[6], p1[7])};
            pw[3] = (u32x4){pk2(p1[8], p1[9]), pk2(p1[10], p1[11]), pk2(p1[12], p1[13]), pk2(p1[14], p1[15])};
#pragma unroll
            for (int d0 = 0; d0 < 2; ++d0)
#pragma unroll
                for (int ks = 0; ks < 4; ++ks) { const s16x4 lo = trrd(vp + d0 * 4096 + ks * 1024), hh = trrd(vp + d0 * 4096 + ks * 1024 + 512);
                    const bf16x8 vf = (bf16x8){lo[0], lo[1], lo[2], lo[3], hh[0], hh[1], hh[2], hh[3]};
                    o[d0] = __builtin_amdgcn_mfma_f32_32x32x16_bf16(__builtin_bit_cast(bf16x8, pw[ks]), vf, o[d0], 0, 0, 0); }
            if (tn < ntl + 4) {
                *(LAS u32x4*)(Ks + (slot ^ 1) * 16384 + wave * 1024 + lane * 16) = kreg; *(LAS u32x4*)(Vs + (slot ^ 1) * 16384 + wave * 1024 + lane * 16) = vreg;
                if (tnn < ntl + 4) { kreg = *(const u32x4*)(kbase + tile_row0(tnn) * 256); vreg = *(const u32x4*)(vbase + tile_row0(tnn) * 256); }
                __syncthreads(); }
            ti = tn; slot ^= 1;
        }
        { auto rr = __builtin_amdgcn_permlane32_swap(__float_as_uint(l), __float_as_uint(l), false, false); l = __uint_as_float(rr[0]) + __uint_as_float(rr[1]); }
        if (hi == 0) wsf[32 + r32] = l;
#pragma unroll
        for (int r = 0; r < 16; ++r) { const int orow = crow(r, hi); const float rl = __builtin_amdgcn_rcpf(wsf[32 + orow]);
            stg[orow * 64 + r32] = (bf16_t)f2bf(o[0][r] * rl); stg[orow * 64 + 32 + r32] = (bf16_t)f2bf(o[1][r] * rl); }
#pragma unroll
        for (int i = 0; i < 4; ++i) { const int row = i * 8 + (lane >> 3), ch = lane & 7; const u32x4 v = *(const LAS u32x4*)(stg + row * 64 + ch * 8);
            *(u32x4*)(OB + (qrow0 + row) * DM + h * 64 + ch * 8) = v; }
    }
}


__device__ __forceinline__ int next_real(int ph) { int q = ph + 1; if (q >= 1 && q <= 32) { const int i = (q - 1) >> 3, o = (q - 1) & 7; if ((i & 1) == 0 && o >= 6) q = 1 + 8 * (i + 1); } return q; }
__global__ void __launch_bounds__(512, 2) mk_fwd(Args a) {
    extern __shared__ __attribute__((aligned(16))) unsigned char lds_raw[];
    Frame F; F.lds = (LAS unsigned char*)lds_raw; F.MISC = (volatile LAS unsigned*)(F.lds + LDS_MISC);
    F.tid = threadIdx.x; F.lane = F.tid & 63; F.wave = __builtin_amdgcn_readfirstlane(F.tid >> 6);
    F.G = gridDim.x; { const int bx = blockIdx.x; F.vcu = (F.G % 8 == 0) ? (bx % 8) * (F.G / 8) + bx / 8 : bx; }
    const Prm& p = a.p; GAS unsigned char* ws = (GAS unsigned char*)a.p.ws;
    for (int u = F.tid; u < 128; u += 512) F.MISC[u] = 0u;
    __syncthreads();
    unsigned* ctl = (unsigned*)(ws + WS_CTL);
    XcdBarrier bar = xcd_barrier_post(ctl + CW_BAR, F.MISC + 8);
    const int lo = a.ph_lo, hi = a.ph_hi;
    const int wave0 = __builtin_amdgcn_readfirstlane((int)threadIdx.x >> 6);
#ifndef ONLY
#define ONLY -1
#endif
#ifndef PROBE_KIND
#define PROBE_KIND -1
#endif
#ifndef PROBE_GEMMS
#define PROBE_GEMMS 0
#endif
#define NREP(k) (((k) == PROBE_KIND) || (PROBE_GEMMS && ((k) == 3 || (k) == 5 || (k) == 6 || (k) == 7 || (k) == 9 || (k) == 11 || (k) == 12)) ? 2 : 1)
#define EN(k) (ONLY == -1 || ONLY == (k))
#define RUN(ph) (lo <= (ph) && (ph) < hi)
#define SEAM(ph) do { if (next_real(ph) < hi) xcd_barrier(bar); } while (0)
#define FRESH() do { const int t_ = fresh_tid(wave0);     F.tid = t_; F.lane = t_ & 63; F.wave = __builtin_amdgcn_readfirstlane(t_ >> 6); asm volatile("" : "+s"(ws)); } while (0)
    const int cblk = (int)blockIdx.x;
#define WSP(T, off) ((T*)(GAS T*)(ws + (off)))
#define SKCTL(slots_off, ph) pg8::SkCtl{WSP(f32x4, slots_off), WSP(unsigned, WS_CTL) + CW_SKF, WSP(unsigned, WS_CTL) + CW_BAR + XB_TMO, (unsigned)((ph) * 4 + rep + 1), cblk, F.G}
    for (int rep = 0; rep < NREP(0); ++rep) if (EN(0) && RUN(0)) { FRESH(); p0_prologue(p, F); SEAM(0); }

    for (int lp = 0; lp < 2; ++lp) {
        const int ie = 2 * lp, io = 2 * lp + 1, j = lp;
        { const int base = 1 + 8 * ie;
          for (int rep = 0; rep < NREP(1); ++rep) if (EN(1) && RUN(base + 0)) { FRESH(); s1_phase(p, F, ie == 0 ? p.x : p.out, ie == 0 ? p.ctx : WSP(const float, WS_XC), p.nmg + ie * DM, WSP(const float, WS_MOD) + (size_t)ie * 5 * NMOD * DM,
                                                  WSP(bf16_t, WS_MS + MS_BIG + BIG_Y1), WSP(bf16_t, WS_MS + MS_BIG + BIG_Y1C)); SEAM(base + 0); }
          for (int rep = 0; rep < NREP(2); ++rep) if (EN(2) && RUN(base + 1)) { FRESH(); s2_phase(p, F, WSP(const bf16_t, WS_MS + MS_BIG + BIG_Y1), WSP(const bf16_t, WS_MS + MS_BIG + BIG_Y1C), WSP(bf16_t, WS_MS + MS_BIG + BIG_PQ)); SEAM(base + 1); }
          for (int rep = 0; rep < NREP(3); ++rep) if (EN(3) && RUN(base + 2)) { FRESH(); SchedDense<true> S{WSP(const bf16_t, WS_W + j * WE_STRIDE + WE_F), TT / 256, DM / 256, F.G, cblk, 2048};
              EpiResid E{ie == 0 ? p.x : p.out, ie == 0 ? p.ctx : WSP(const float, WS_XC), p.out, WSP(float, WS_XC), WSP(const float, WS_MOD) + (size_t)ie * 5 * NMOD * DM, 2, rep ? 0.f : 1.f};
              pg8::gemm_phase<EpiResid, SchedDense<true>, false>(F.lds, F.tid, WSP(const bf16_t, WS_MS + MS_BIG + BIG_PQ), 2048, S, E, SKCTL(WS_MS + MS_HB, base + 2)); SEAM(base + 2); }
          for (int rep = 0; rep < NREP(4); ++rep) if (EN(4) && RUN(base + 3)) { FRESH(); norm_phase<false>(p, F, p.out, WSP(const float, WS_XC), p.nfg + ie * DM, WSP(const float, WS_MOD) + (size_t)ie * 5 * NMOD * DM, 3, WSP(bf16_t, WS_MS + MS_HB), TT, nullptr, nullptr, nullptr, nullptr); SEAM(base + 3); }
          for (int rep = 0; rep < NREP(5); ++rep) if (EN(5) && RUN(base + 4)) { FRESH(); SchedDense<false> S{WSP(const bf16_t, WS_W + j * WE_STRIDE + WE_GU), TT / 256, 2 * DFF / 256, F.G, cblk, DM}; EpiSwiglu E{WSP(bf16_t, WS_MS + MS_BIG + BIG_ACT)};
              pg8::gemm_phase<EpiSwiglu, SchedDense<false>, false>(F.lds, F.tid, WSP(const bf16_t, WS_MS + MS_HB), DM, S, E); SEAM(base + 4); }
          for (int rep = 0; rep < NREP(6); ++rep) if (EN(6) && RUN(base + 5)) { FRESH(); SchedDense<true> S{WSP(const bf16_t, WS_W + j * WE_STRIDE + WE_D), TT / 256, DM / 256, F.G, cblk, DFF};
              EpiResid E{p.out, WSP(const float, WS_XC), p.out, WSP(float, WS_XC), WSP(const float, WS_MOD) + (size_t)ie * 5 * NMOD * DM, 5, rep ? 0.f : 1.f};
              pg8::gemm_phase<EpiResid, SchedDense<true>, false>(F.lds, F.tid, WSP(const bf16_t, WS_MS + MS_BIG + BIG_ACT), DFF, S, E, SKCTL(WS_MS + MS_HB, base + 5)); SEAM(base + 5); }
        }
        { const int base = 1 + 8 * io; const bool last = (io == DEPTH - 1); const int nrows = last ? TL : TT;
          const size_t wo = WS_W + WO_BASE + j * WO_STRIDE;
          for (int rep = 0; rep < NREP(4); ++rep) if (EN(4) && RUN(base + 0)) { FRESH(); norm_phase<false>(p, F, p.out, WSP(const float, WS_XC), p.nmg + io * DM, WSP(const float, WS_MOD) + (size_t)io * 5 * NMOD * DM, 0, WSP(bf16_t, WS_MS + MS_HB), TT, nullptr, nullptr, nullptr, nullptr); SEAM(base + 0); }
          for (int rep = 0; rep < NREP(7); ++rep) if (EN(7) && RUN(base + 1)) { FRESH(); SchedDense<true> S{WSP(const bf16_t, wo + WO_QKV), TT / 256, QKVD / 256, F.G, cblk, DM};
              EpiQKV E{WSP(bf16_t, WS_MS + MS_BIG + BIG_Q), WSP(bf16_t, WS_MS + MS_BIG + BIG_K), WSP(bf16_t, WS_MS + MS_BIG + BIG_V), WSP(const float2, WS_ROPE)};
              pg8::gemm_phase<EpiQKV, SchedDense<true>, false>(F.lds, F.tid, WSP(const bf16_t, WS_MS + MS_HB), DM, S, E, SKCTL(WS_MS + MS_BIG + 300 * MiB, base + 1)); SEAM(base + 1); }
          for (int rep = 0; rep < NREP(8); ++rep) if (EN(8) && RUN(base + 2)) { FRESH(); attn_phase(p, F, WSP(const bf16_t, WS_MS + MS_BIG + BIG_Q), WSP(const bf16_t, WS_MS + MS_BIG + BIG_K), WSP(const bf16_t, WS_MS + MS_BIG + BIG_V), WSP(bf16_t, WS_MS + MS_BIG + BIG_O), p.sinks + j * NH, last ? 2048 : 2048 + 64); SEAM(base + 2); }
          for (int rep = 0; rep < NREP(9); ++rep) if (EN(9) && RUN(base + 3)) { FRESH(); SchedDense<true> S{WSP(const bf16_t, wo + WO_O), nrows / 256, DM / 256, F.G, cblk, DM};
              EpiResid E{p.out, WSP(const float, WS_XC), p.out, WSP(float, WS_XC), WSP(const float, WS_MOD) + (size_t)io * 5 * NMOD * DM, 2, rep ? 0.f : 1.f};
              pg8::gemm_phase<EpiResid, SchedDense<true>, false>(F.lds, F.tid, WSP(const bf16_t, WS_MS + MS_BIG + BIG_O), DM, S, E, SKCTL(WS_MS + MS_HB, base + 3)); SEAM(base + 3); }
          for (int rep = 0; rep < NREP(10); ++rep) if (EN(10) && RUN(base + 4)) { FRESH(); norm_phase<true>(p, F, p.out, WSP(const float, WS_XC), p.nfg + io * DM, WSP(const float, WS_MOD) + (size_t)io * 5 * NMOD * DM, 3, WSP(bf16_t, WS_MS + MS_HB), nrows,
                                                       p.mr + (size_t)j * DM * NEXP, WSP(unsigned, WS_CTL) + CW_CNTW + 4096 * j, WSP(int, WS_ROUTE), WSP(float, WS_ROUTE) + 16 * TT); SEAM(base + 4); }
          for (int rep = 0; rep < NREP(11); ++rep) if (EN(11) && RUN(base + 5)) { FRESH(); if (rep == 0) { moe_lists(F, WSP(const unsigned, WS_CTL) + CW_CNTW + 4096 * j, WSP(unsigned, WS_CTL) + CW_MCNT + 64 * j, WSP(int, WS_ROUTE), WSP(float, WS_ROUTE) + 16 * TT, nrows); xcd_barrier(bar); }
              FRESH(); moe_tables(F, WSP(unsigned, WS_CTL) + CW_MCNT + 64 * j); MoeTab tab{F.MISC};
              SchedMoe<true, false> S{WSP(const bf16_t, wo + WO_EXP + WX_GU), WX_STRIDE, 2 * DFF / 256, F.G, cblk, DM, 0, (int)F.MISC[49], tab, WSP(const int, WS_ROUTE)}; EpiSwiglu E{WSP(bf16_t, WS_MS + MS_BIG + BIG_ACT)};
              pg8::gemm_phase<EpiSwiglu, SchedMoe<true, false>, true>(F.lds, F.tid, WSP(const bf16_t, WS_MS + MS_HB), DM, S, E); SEAM(base + 5); }
#pragma unroll
          for (int k = 0; k < 2; ++k)
          for (int rep = 0; rep < NREP(12); ++rep) if (EN(12) && RUN(base + 6 + k)) { FRESH(); moe_tables(F, WSP(unsigned, WS_CTL) + CW_MCNT + 64 * j); MoeTab tab{F.MISC};
              const int nb0 = (int)F.MISC[48], nba = (int)F.MISC[49];
              SchedMoe<false, true> S{WSP(const bf16_t, wo + WO_EXP + WX_D), WX_STRIDE, DM / 256, F.G, cblk, DFF, k ? nb0 : 0, k ? nba - nb0 : nb0, tab, WSP(const int, WS_ROUTE)};
              EpiMoeDown E{p.out, WSP(float, WS_XC), WSP(const float, WS_MOD) + (size_t)io * 5 * NMOD * DM, WSP(const int, WS_ROUTE), WSP(const float, WS_ROUTE) + 16 * TT, rep ? 0.f : 1.f};
              pg8::gemm_phase<EpiMoeDown, SchedMoe<false, true>, false>(F.lds, F.tid, WSP(const bf16_t, WS_MS + MS_BIG + BIG_ACT), DFF, S, E, SKCTL(WS_MS + MS_HB, base + 6 + k)); SEAM(base + 6 + k); }
        }
    }
    if (EN(13) && RUN(33)) { FRESH(); final_norm_phase(p, F); }
#undef WSP
#undef RUN
#undef SEAM
}

static int g_grid = 0;
static void mega_launch(const Prm& p, int lo, int hi, hipStream_t st) {
    if (g_grid == 0) {
        int dev = 0, cus = 0; hipGetDevice(&dev); hipDeviceGetAttribute(&cus, hipDeviceAttributeMultiprocessorCount, dev);
        if (hipFuncSetAttribute((const void*)mk_fwd, hipFuncAttributeMaxDynamicSharedMemorySize, LDS_BYTES) != hipSuccess) { fprintf(stderr, "hipFuncSetAttribute failed\n"); g_grid = -1; return; }
        int per_cu = 0; if (hipOccupancyMaxActiveBlocksPerMultiprocessor(&per_cu, (const void*)mk_fwd, 512, LDS_BYTES) != hipSuccess || per_cu < 1) fprintf(stderr, "occupancy query: %d\n", per_cu);
        (void)hipGetLastError();
        g_grid = cus & ~7;
    }
    if (g_grid < 0) return;
    hipMemsetAsync(p.ws + WS_CTL + CW_BAR * 4, 0, XCD_BAR_WORDS * 4, st);
    Args a{}; a.p = p; a.ph_lo = lo; a.ph_hi = hi;
    hipLaunchKernelGGL(mk_fwd, dim3(g_grid), dim3(512), LDS_BYTES, st, a);
}

template <class FA, class FB, class FE> static void ngemm(hipStream_t st, int Mmax, int N, int K, FA fa, FB fb, FE fe) {
    hipLaunchKernelGGL((nk_gemm<FA, FB, FE>), dim3(N / 64, (Mmax + 63) / 64), dim3(256), 0, st, Mmax, N, K, fa, fb, fe);
}

#ifndef MEGA_MASK
#define MEGA_MASK 0xFF
#endif
static void naive_forward(const Prm& p, hipStream_t st) {
    unsigned char* ws = p.ws;
    hipMemsetAsync(ws + WS_CTL, 0, 1 * MiB, st);
    if (MEGA_MASK) mega_launch(p, 0, 1, st);
    if (!(MEGA_MASK & 0x20)) {
    hipLaunchKernelGGL(nk_adaln, dim3((DEPTH * 5 * NMOD * DM + 255) / 256), dim3(256), 0, st, p);
    hipLaunchKernelGGL(nk_rope, dim3(8), dim3(256), 0, st, p); }
    hipMemcpyAsync(p.out, p.x, (size_t)TL * DM * 4, hipMemcpyDeviceToDevice, st);
    hipMemcpyAsync(ws + WS_XC, p.ctx, (size_t)TC * DM * 4, hipMemcpyDeviceToDevice, st);
    float* H = (float*)(ws + WS_S);
    unsigned char* S2 = ws + WS_S + 136 * MiB;
    for (int i = 0; i < DEPTH; ++i) {
        const int j = i / 2; const bool last = (i == DEPTH - 1);
        const int nrows = last ? TL : TT;
        const int pbase = 1 + 8 * i;
        if ((i % 2 == 0) && (MEGA_MASK & 0x08)) mega_launch(p, pbase + 0, pbase + 3, st);
        else if ((i % 2 == 1) && (MEGA_MASK & 0x04)) mega_launch(p, pbase + 0, pbase + 4, st);
        else {
        hipLaunchKernelGGL(nk_norm_mod, dim3(TT), dim3(256), 0, st, p, p.nmg + i * DM, i, 0, H, TT);
        if (i % 2 == 0) {
            float2* Y1 = (float2*)S2;
            float2* Z = (float2*)(S2 + 64 * MiB);
            for (int b = 0; b < NB; ++b) {
                hipLaunchKernelGGL(nk_fft_s1, dim3(SEQ * DM / 256), dim3(256), 0, st, H, b, Y1);
                hipLaunchKernelGGL(nk_fft_s2, dim3(SEQ * DM / 256), dim3(256), 0, st, Y1, b, Z);
            }
            hipLaunchKernelGGL(nk_dft_ctx, dim3(TC * DM / 256), dim3(256), 0, st, H, Z);
            hipLaunchKernelGGL(nk_chan_dft, dim3(TT * (DM / 256)), dim3(256), 0, st, Z, H);
            ngemm(st, nrows, DM, DM, ADense{H, DM, nrows}, BDense{p.fw + (size_t)j * DM * DM, DM, 0}, EResid{p, i, 2, 0, nrows});
        } else {
            float* QKV = (float*)S2;
            ngemm(st, TT, QKVD, DM, ADense{H, DM, TT}, BDense{p.wqkv + (size_t)j * DM * QKVD, QKVD, 0}, EStore{QKV, QKVD, TT});
            hipLaunchKernelGGL(nk_rope_apply, dim3((unsigned)(((size_t)TL * 640 + 255) / 256)), dim3(256), 0, st, p, QKV);
            hipLaunchKernelGGL(nk_attn, dim3((unsigned)(((size_t)nrows * NH + 63) / 64)), dim3(64), 0, st, p, QKV, p.sinks + j * NH, H, nrows);
            ngemm(st, nrows, DM, DM, ADense{H, DM, nrows}, BDense{p.wo + (size_t)j * DM * DM, DM, 0}, EResid{p, i, 2, 0, nrows});
        } }
        if ((i % 2 == 0) && (MEGA_MASK & 0x01)) { mega_launch(p, pbase + 3, pbase + 6, st); continue; }
        if ((i % 2 == 1) && (MEGA_MASK & 0x02)) { mega_launch(p, pbase + 4, pbase + 8, st); continue; }
        hipLaunchKernelGGL(nk_norm_mod, dim3(nrows), dim3(256), 0, st, p, p.nfg + i * DM, i, 3, H, nrows);
        constexpr int CH = 8448;
        float* ACT = (float*)S2;
        if (i % 2 == 0) {
            for (int r0 = 0; r0 < nrows; r0 += CH) {
                const int m = nrows - r0 < CH ? nrows - r0 : CH;
                ngemm(st, m, DFF, DM, ADense{H + (size_t)r0 * DM, DM, m}, BDense{p.fg + (size_t)j * DM * DFF, DFF, 0}, ESilu{ACT, DFF, m});
                ngemm(st, m, DFF, DM, ADense{H + (size_t)r0 * DM, DM, m}, BDense{p.fu + (size_t)j * DM * DFF, DFF, 0}, EMulInto{ACT, DFF, m});
                ngemm(st, m, DM, DFF, ADense{ACT, DFF, m}, BDense{p.fd + (size_t)j * DFF * DM, DM, 0}, EResid{p, i, 5, r0, m});
            }
        } else {
            int* cnt = (int*)(ws + WS_CTL) + 1024 + 64 * i;
            int* ltok = (int*)(ws + WS_ROUTE); float* lw = (float*)(ltok + NEXP * TT); int* lk = (int*)(lw + NEXP * TT);
            float* Y0 = (float*)(S2 + 120 * MiB); float* Y1 = Y0 + (size_t)TT * DM;
            hipLaunchKernelGGL(nk_router, dim3((nrows + 255) / 256), dim3(256), 0, st, p, H, p.mr + (size_t)j * DM * NEXP, nrows, cnt, ltok, lw, lk);
            for (int e = 0; e < NEXP; ++e) {
                const size_t we = ((size_t)j * NEXP + e) * DM * DFF;
                for (int r0 = 0; r0 < nrows; r0 += CH) {
                    ngemm(st, CH, DFF, DM, AGather{H, ltok + e * TT, cnt + e, r0, CH}, BDense{p.mg + we, DFF, 0}, ESiluCnt{ACT, cnt + e, DFF, r0, CH, 0});
                    ngemm(st, CH, DFF, DM, AGather{H, ltok + e * TT, cnt + e, r0, CH}, BDense{p.mu + we, DFF, 0}, EMulCnt{ACT, cnt + e, DFF, r0, CH, 0});
                    ngemm(st, CH, DM, DFF, ADenseCnt{ACT, cnt + e, DFF, r0, CH, 0}, BDense{p.md + we, DM, 0}, EScatterY{Y0, Y1, ltok + e * TT, lw + e * TT, lk + e * TT, cnt + e, r0, CH});
                }
            }
            hipLaunchKernelGGL(nk_moe_combine, dim3((unsigned)(((size_t)nrows * DM + 255) / 256)), dim3(256), 0, st, p, Y0, Y1, i, nrows);
        }
    }
    if (MEGA_MASK & 0x10) mega_launch(p, 33, 34, st); else hipLaunchKernelGGL(nk_final_norm, dim3(TL), dim3(256), 0, st, p);
}

extern "C" void kernel_launch(void* const* d_in, const int* in_sizes, int n_in, void* d_out, int out_size, void* d_ws, size_t ws_size, hipStream_t stream) {
    if (n_in != 20 || out_size != TL * DM || ws_size < WS_MEGA_END) { fprintf(stderr, "kernel_launch: unexpected shapes n_in %d out %d ws %zu\n", n_in, out_size, ws_size); return; }
    Prm p{};
    const float** f = (const float**)&p;
    for (int i = 0; i < 20; ++i) f[i] = (const float*)d_in[i];
    p.out = (float*)d_out; p.ws = (unsigned char*)d_ws;
    if (MEGA_MASK == 0xFF) {
        hipMemsetAsync(p.ws + WS_CTL, 0, 1 * MiB, stream);
        mega_launch(p, 0, 34, stream);
    } else naive_forward(p, stream);
}
```

```cpp
#include <hip/hip_runtime.h>
#include <cstdio>
#include <cstdint>
#include <cmath>

constexpr int DM = 1024, NB = 4, SEQ = 8192, DEPTH = 4, CTXL = 256;
constexpr int TL = NB * SEQ;
constexpr int TC = NB * CTXL;
constexpr int TT = TL + TC;
constexpr int NMOD = 6, DFF = 3584, NEXP = 8, QKVD = 1536, NH = 16, NKV = 4, HD = 64;
constexpr int FN1 = 128, FN2 = 64;
constexpr float EPS = 1e-6f;

constexpr size_t MiB = 1ull << 20;
constexpr size_t WS_CTL = 0;
constexpr size_t WS_MOD = 1 * MiB;
constexpr size_t WS_ROPE = 2 * MiB;
constexpr size_t WS_XC = 3 * MiB;
constexpr size_t WS_ROUTE = 8 * MiB;
constexpr size_t WS_S = 416 * MiB;

struct Prm {
    const float *x, *c, *ctx, *c_ctx, *ada_w, *ada_b, *nmg, *nfg, *fw, *wqkv, *wo, *sinks, *fg, *fu, *fd, *mr, *mg, *mu, *md, *fng;
    float* out; unsigned char* ws;
};

__device__ __forceinline__ float silu_f(float v) { return v / (1.f + expf(-v)); }
__device__ __forceinline__ int row_b5(int r) { return r < TL ? r / SEQ : 4; }
__device__ __forceinline__ float* xrow(const Prm& p, int r) { return r < TL ? p.out + (size_t)r * DM : (float*)(p.ws + WS_XC) + (size_t)(r - TL) * DM; }

__global__ void nk_adaln(Prm p) {
    const int idx = blockIdx.x * blockDim.x + threadIdx.x;
    if (idx >= DEPTH * 5 * NMOD * DM) return;
    const int n = idx % (NMOD * DM), r = (idx / (NMOD * DM)) % 5, l = idx / (5 * NMOD * DM);
    const float* cv = r < 4 ? p.c + r * DM : p.c_ctx;
    const float* w = p.ada_w + (size_t)l * DM * NMOD * DM;
    float acc = 0.f;
    for (int k = 0; k < DM; ++k) acc += silu_f(cv[k]) * w[(size_t)k * NMOD * DM + n];
    ((float*)(p.ws + WS_MOD))[idx] = acc + p.ada_b[l * NMOD * DM + n];
}
__global__ void nk_rope(Prm p) {
    const int idx = blockIdx.x * blockDim.x + threadIdx.x;
    if (idx >= 128 * 16) return;
    const int pos = idx / 16, f = idx % 16;
    const float inv = powf(10000.f, -(float)f / 16.f);
    const float ang = (float)pos * inv;
    ((float2*)(p.ws + WS_ROPE))[idx] = make_float2((float)cos((double)ang), (float)sin((double)ang));
}
__global__ void nk_norm_mod(Prm p, const float* g, int layer, int which  , float* H, int nrows) {
    const int r = blockIdx.x; if (r >= nrows) return;
    const float* xr = xrow(p, r);
    __shared__ float red[256];
    float s = 0.f;
    for (int c = threadIdx.x; c < DM; c += 256) { const float v = xr[c]; s += v * v; }
    red[threadIdx.x] = s; __syncthreads();
    for (int o = 128; o > 0; o >>= 1) { if (threadIdx.x < o) red[threadIdx.x] += red[threadIdx.x + o]; __syncthreads(); }
    const float rstd = rsqrtf(red[0] / DM + EPS);
    const float* mod = (const float*)(p.ws + WS_MOD) + ((size_t)layer * 5 + row_b5(r)) * NMOD * DM;
    for (int c = threadIdx.x; c < DM; c += 256) H[(size_t)r * DM + c] = xr[c] * rstd * g[c] * (1.f + mod[(which + 1) * DM + c]) + mod[which * DM + c];
}
__global__ void nk_final_norm(Prm p) {
    const int r = blockIdx.x;
    float* xr = p.out + (size_t)r * DM;
    __shared__ float red[256];
    float s = 0.f;
    for (int c = threadIdx.x; c < DM; c += 256) { const float v = xr[c]; s += v * v; }
    red[threadIdx.x] = s; __syncthreads();
    for (int o = 128; o > 0; o >>= 1) { if (threadIdx.x < o) red[threadIdx.x] += red[threadIdx.x + o]; __syncthreads(); }
    const float rstd = rsqrtf(red[0] / DM + EPS);
    for (int c = threadIdx.x; c < DM; c += 256) xr[c] = xr[c] * rstd * p.fng[c];
}
template <class FA, class FB, class FE>
__global__ void __launch_bounds__(256) nk_gemm(int M, int N, int K, FA fa, FB fb, FE fe) {
    __shared__ float As[16][68], Bs[16][68];
    const int m0 = blockIdx.y * 64, n0 = blockIdx.x * 64;
    if (m0 >= fa.rows()) return;
    const int t = threadIdx.x, tx = t % 16, ty = t / 16;
    float acc[4][4] = {};
    for (int k0 = 0; k0 < K; k0 += 16) {
        { const int m = t / 4, kq = (t % 4) * 4;
#pragma unroll
          for (int i = 0; i < 4; ++i) As[kq + i][m] = fa(m0 + m, k0 + kq + i); }
        { const int k = t / 16, nq = (t % 16) * 4;
#pragma unroll
          for (int i = 0; i < 4; ++i) Bs[k][nq + i] = fb(k0 + k, n0 + nq + i); }
        __syncthreads();
#pragma unroll
        for (int kk = 0; kk < 16; ++kk) {
            float a[4], b[4];
#pragma unroll
            for (int i = 0; i < 4; ++i) { a[i] = As[kk][ty * 4 + i]; b[i] = Bs[kk][tx * 4 + i]; }
#pragma unroll
            for (int i = 0; i < 4; ++i)
#pragma unroll
                for (int j = 0; j < 4; ++j) acc[i][j] += a[i] * b[j];
        }
        __syncthreads();
    }
#pragma unroll
    for (int i = 0; i < 4; ++i)
#pragma unroll
        for (int j = 0; j < 4; ++j) fe(m0 + ty * 4 + i, n0 + tx * 4 + j, acc[i][j]);
}
struct ADense { const float* A; int lda, M; __device__ int rows() const { return M; } __device__ float operator()(int m, int k) const { return m < M ? A[(size_t)m * lda + k] : 0.f; } };
struct BDense { const float* B; int ldb, pad; __device__ float operator()(int k, int n) const { return B[(size_t)k * ldb + n]; } };
struct EStore { float* C; int ldc, M; __device__ void operator()(int m, int n, float v) const { if (m < M) C[(size_t)m * ldc + n] = v; } };
struct ESilu { float* C; int ldc, M; __device__ void operator()(int m, int n, float v) const { if (m < M) C[(size_t)m * ldc + n] = silu_f(v); } };
struct EMulInto { float* C; int ldc, M; __device__ void operator()(int m, int n, float v) const { if (m < M) C[(size_t)m * ldc + n] *= v; } };
struct EResid { Prm p; int layer, which  , row0, M;
    __device__ void operator()(int m, int n, float v) const { if (m < M) { const int r = row0 + m; const float* mod = (const float*)(p.ws + WS_MOD) + ((size_t)layer * 5 + row_b5(r)) * NMOD * DM; xrow(p, r)[n] += mod[which * DM + n] * v; } } };
struct AGather { const float* H; const int* tok; const int* cnt; int r0, rmax; __device__ int rows() const { int c = *cnt - r0; return c < rmax ? c : rmax; }
    __device__ float operator()(int m, int k) const { return m < rows() ? H[(size_t)tok[r0 + m] * DM + k] : 0.f; } };
struct ADenseCnt { const float* A; const int* cnt; int lda, r0, rmax, pad; __device__ int rows() const { int c = *cnt - r0; return c < rmax ? c : rmax; }
    __device__ float operator()(int m, int k) const { return m < rows() ? A[(size_t)m * lda + k] : 0.f; } };
struct ESiluCnt { float* C; const int* cnt; int ldc, r0, rmax, pad; __device__ void operator()(int m, int n, float v) const { int c = *cnt - r0; c = c < rmax ? c : rmax; if (m < c) C[(size_t)m * ldc + n] = silu_f(v); } };
struct EMulCnt { float* C; const int* cnt; int ldc, r0, rmax, pad; __device__ void operator()(int m, int n, float v) const { int c = *cnt - r0; c = c < rmax ? c : rmax; if (m < c) C[(size_t)m * ldc + n] *= v; } };
struct EScatterY { float* Y0; float* Y1; const int* tok; const float* w; const int* kk; const int* cnt; int r0, rmax;
    __device__ void operator()(int m, int n, float v) const { int c = *cnt - r0; c = c < rmax ? c : rmax; if (m < c) { const int i = r0 + m; (kk[i] ? Y1 : Y0)[(size_t)tok[i] * DM + n] = w[i] * v; } } };

__global__ void nk_fft_s1(const float* H, int b, float2* Y1) {
    const size_t idx = (size_t)blockIdx.x * blockDim.x + threadIdx.x;
    const int ch = idx % DM, n2 = (idx / DM) % FN2, k1 = idx / ((size_t)DM * FN2);
    float re = 0.f, im = 0.f;
    for (int n1 = 0; n1 < FN1; ++n1) {
        const float v = H[((size_t)b * SEQ + n1 * FN2 + n2) * DM + ch];
        const int ph = (n1 * k1) % FN1; double s, c; sincospi(-2.0 * ph / FN1, &s, &c);
        re += v * (float)c; im += v * (float)s;
    }
    double s, c; sincospi(-2.0 * (double)(n2 * k1) / (FN1 * FN2), &s, &c);
    Y1[idx] = make_float2(re * (float)c - im * (float)s, re * (float)s + im * (float)c);
}
__global__ void nk_fft_s2(const float2* Y1, int b, float2* Z) {
    const size_t idx = (size_t)blockIdx.x * blockDim.x + threadIdx.x;
    const int ch = idx % DM, k1 = (idx / DM) % FN1, k2 = idx / ((size_t)DM * FN1);
    float re = 0.f, im = 0.f;
    for (int n2 = 0; n2 < FN2; ++n2) {
        const float2 v = Y1[((size_t)k1 * FN2 + n2) * DM + ch];
        const int ph = (n2 * k2) % FN2; double s, c; sincospi(-2.0 * ph / FN2, &s, &c);
        re += v.x * (float)c - v.y * (float)s; im += v.x * (float)s + v.y * (float)c;
    }
    Z[((size_t)b * SEQ + k1 + FN1 * k2) * DM + ch] = make_float2(re, im);
}
__global__ void nk_dft_ctx(const float* H, float2* Z) {
    const size_t idx = (size_t)blockIdx.x * blockDim.x + threadIdx.x;
    const int ch = idx % DM, k = (idx / DM) % CTXL, b = idx / ((size_t)DM * CTXL);
    float re = 0.f, im = 0.f;
    for (int n = 0; n < CTXL; ++n) {
        const float v = H[((size_t)TL + b * CTXL + n) * DM + ch];
        const int ph = (n * k) % CTXL; double s, c; sincospi(-2.0 * ph / CTXL, &s, &c);
        re += v * (float)c; im += v * (float)s;
    }
    Z[((size_t)TL + b * CTXL + k) * DM + ch] = make_float2(re, im);
}
__global__ void nk_chan_dft(const float2* Z, float* R) {
    const size_t idx = (size_t)blockIdx.x * blockDim.x + threadIdx.x;
    const int col = idx % DM, row = idx / DM, g = col / 256, q = col % 256;
    float acc = 0.f;
    for (int pp = 0; pp < 256; ++pp) {
        const float2 v = Z[(size_t)row * DM + g * 256 + pp];
        const int ph = (pp * q) % 256; double s, c; sincospi(2.0 * ph / 256, &s, &c);
        acc += v.x * (float)c + v.y * (float)s;
    }
    const float scale = row < TL ? 1.f / sqrtf((float)SEQ * 256.f) : 1.f / sqrtf((float)CTXL * 256.f);
    R[idx] = acc * scale;
}
__global__ void nk_rope_apply(Prm p, float* QKV) {
    const size_t idx = (size_t)blockIdx.x * blockDim.x + threadIdx.x;
    const int f = idx % 16, a = (idx / 16) % 2, hh = (idx / 32) % 20; const size_t row = idx / 640;
    if (row >= TL) return;
    const int t = row % SEQ, pos = a ? (t % 64) : (t / 64);
    const float2 cs = ((const float2*)(p.ws + WS_ROPE))[pos * 16 + f];
    float* base = QKV + row * QKVD + hh * 64 + a * 32;
    const float x1 = base[f], x2 = base[16 + f];
    base[f] = x1 * cs.x - x2 * cs.y; base[16 + f] = x2 * cs.x + x1 * cs.y;
}
__global__ void __launch_bounds__(64) nk_attn(Prm p, const float* QKV, const float* sinks, float* O, int nrows) {
    const size_t idx = (size_t)blockIdx.x * blockDim.x + threadIdx.x;
    const int h = idx % NH; const size_t row = idx / NH;
    if (row >= (size_t)nrows) return;
    const int kv = h / 4;
    float q[64], o[64];
#pragma unroll
    for (int d = 0; d < 64; ++d) { q[d] = QKV[row * QKVD + h * 64 + d] * 0.125f; o[d] = 0.f; }
    float m = sinks[h], l = 1.f;
    const bool lat = row < TL; const int b = lat ? row / SEQ : (row - TL) / CTXL; const int t = lat ? row % SEQ : 0;
    const int j0 = lat ? (t - 128 < 0 ? 0 : t - 128) : 0, j1 = lat ? (t + 128 > SEQ - 1 ? SEQ - 1 : t + 128) : -1;
    const int nlat = j1 - j0 + 1;
    for (int jj = 0; jj < nlat + CTXL; ++jj) {
        const size_t krow = jj < nlat ? (size_t)b * SEQ + j0 + jj : (size_t)TL + b * CTXL + (jj - nlat);
        const float* kp = QKV + krow * QKVD + 1024 + kv * 64; const float* vp = kp + 256;
        float s = 0.f;
#pragma unroll
        for (int d = 0; d < 64; ++d) s += q[d] * kp[d];
        if (s > m) { const float f = expf(m - s); l *= f;
#pragma unroll
            for (int d = 0; d < 64; ++d) o[d] *= f;
            m = s; }
        const float pe = expf(s - m); l += pe;
#pragma unroll
        for (int d = 0; d < 64; ++d) o[d] += pe * vp[d];
    }
    const float il = 1.f / l;
#pragma unroll
    for (int d = 0; d < 64; ++d) O[row * DM + h * 64 + d] = o[d] * il;
}
__global__ void nk_router(Prm p, const float* H, const float* wr, int nrows, int* cnt, int* ltok, float* lw, int* lk) {
    const int r = blockIdx.x * blockDim.x + threadIdx.x; if (r >= nrows) return;
    float lg[NEXP] = {};
    for (int k = 0; k < DM; ++k) { const float hv = H[(size_t)r * DM + k];
#pragma unroll
        for (int e = 0; e < NEXP; ++e) lg[e] += hv * wr[k * NEXP + e]; }
    int e0 = 0; float v0 = lg[0];
#pragma unroll
    for (int e = 1; e < NEXP; ++e) if (lg[e] > v0) { v0 = lg[e]; e0 = e; }
    int e1 = -1; float v1 = -INFINITY;
#pragma unroll
    for (int e = 0; e < NEXP; ++e) if (e != e0 && lg[e] > v1) { v1 = lg[e]; e1 = e; }
    const float g1 = 1.f / (1.f + expf(v0 - v1)), g0 = 1.f - g1;
    int i0 = atomicAdd(&cnt[e0], 1); ltok[e0 * TT + i0] = r; lw[e0 * TT + i0] = g0; lk[e0 * TT + i0] = 0;
    int i1 = atomicAdd(&cnt[e1], 1); ltok[e1 * TT + i1] = r; lw[e1 * TT + i1] = g1; lk[e1 * TT + i1] = 1;
}
__global__ void nk_moe_combine(Prm p, const float* Y0, const float* Y1, int layer, int nrows) {
    const size_t idx = (size_t)blockIdx.x * blockDim.x + threadIdx.x; const int n = idx % DM; const size_t r = idx / DM;
    if (r >= (size_t)nrows) return;
    const float* mod = (const float*)(p.ws + WS_MOD) + ((size_t)layer * 5 + row_b5((int)r)) * NMOD * DM;
    xrow(p, (int)r)[n] += mod[5 * DM + n] * (Y0[idx] + Y1[idx]);
}


#define GAS __attribute__((address_space(1)))
#define LAS __attribute__((address_space(3)))
typedef unsigned short bf16_t;
typedef short bf16x8 __attribute__((ext_vector_type(8)));
typedef short s16x4 __attribute__((ext_vector_type(4)));
typedef float f32x4 __attribute__((ext_vector_type(4)));
typedef float f32x16 __attribute__((ext_vector_type(16)));
typedef unsigned u32x4 __attribute__((ext_vector_type(4)));
typedef unsigned u32x2 __attribute__((ext_vector_type(2)));
typedef float f32x2 __attribute__((ext_vector_type(2)));

constexpr size_t WS_TAB = 13 * MiB;
constexpr size_t TAB_F1 = 0, TAB_F2 = 65536, TAB_TW = 131072, TAB_TWC = 196608;
constexpr size_t WS_W = 16 * MiB;
constexpr size_t WE_STRIDE = 25 * MiB, WE_F = 0, WE_GU = 4 * MiB, WE_D = 18 * MiB;
constexpr size_t WO_BASE = 50 * MiB, WO_STRIDE = 173 * MiB, WO_QKV = 0, WO_O = 3 * MiB, WO_EXP = 5 * MiB, WX_STRIDE = 21 * MiB, WX_GU = 0, WX_D = 14 * MiB;
constexpr size_t WS_MS = 416 * MiB;
constexpr size_t MS_HB = 0;
constexpr size_t MS_BIG = 66 * MiB;
constexpr size_t BIG_ACT = 0;
constexpr size_t BIG_Y1 = 0, BIG_Y1C = 128 * MiB, BIG_PQ = 136 * MiB;
constexpr size_t BIG_Q = 0, BIG_K = 66 * MiB, BIG_V = 83 * MiB, BIG_O = 100 * MiB;
constexpr size_t WS_MEGA_END = WS_MS + MS_BIG + 490 * MiB;
constexpr size_t WS_YS = WS_W + WO_BASE;
constexpr size_t WS_TOKSLOT = WS_ROUTE + 4352 * 1024;
constexpr int MAXBLK = 280;
constexpr int CW_BAR = 4096;
constexpr int CW_CNT = 1024;
constexpr int CW_CNTW = 65536;
constexpr int CW_SKF = 32768;
constexpr int CW_MCNT = 2048;
constexpr int LDS_BYTES = 147456;
constexpr int LDS_MISC = 146944;
constexpr float LOG2E = 1.4426950408889634f;

struct Args { Prm p; int ph_lo, ph_hi; };

__device__ __forceinline__ unsigned f2bf(float f) { unsigned u = __builtin_bit_cast(unsigned, f); return (u + 0x7fffu + ((u >> 16) & 1u)) >> 16; }
__device__ __forceinline__ unsigned pk2(float lo, float hi) { typedef float f2 __attribute__((ext_vector_type(2))); typedef __bf16 b2 __attribute__((ext_vector_type(2))); f2 v = {lo, hi}; b2 b = __builtin_convertvector(v, b2); return __builtin_bit_cast(unsigned, b); }
#define SWZ_XOR(v, m) __builtin_bit_cast(float, __builtin_amdgcn_ds_swizzle(__builtin_bit_cast(int, (v)), ((m) << 10) | 0x1f))
__device__ __forceinline__ float xor32(float v, bool lower) { unsigned a = __builtin_bit_cast(unsigned, v), b = a; asm volatile("" : "+v"(b));
    auto rr = __builtin_amdgcn_permlane32_swap(a, b, false, false); return __builtin_bit_cast(float, lower ? rr[1] : rr[0]); }
__device__ __forceinline__ float wave_sum(float v) {
    v += SWZ_XOR(v, 1); v += SWZ_XOR(v, 2); v += SWZ_XOR(v, 4); v += SWZ_XOR(v, 8); v += SWZ_XOR(v, 16);
    return __builtin_bit_cast(float, __builtin_amdgcn_readlane(__builtin_bit_cast(int, v), 0)) + __builtin_bit_cast(float, __builtin_amdgcn_readlane(__builtin_bit_cast(int, v), 32));
}
__device__ __forceinline__ float fast_silu(float v) { return v * __builtin_amdgcn_rcpf(1.f + __builtin_amdgcn_exp2f(-v * LOG2E)); }

#define XB_TMO      128
#define XB_XCNT(j)  (256  + 64 * (j))
#define XB_XSUB(j)  (1280 + 64 * (j))
#define XB_XGEN(j)  (2304 + 64 * (j))
#define XB_TOP      3328
#define XB_TOPGEN   3392
#define XCD_BAR_WORDS 3456
#define XB_SPIN_CAP (1u << 18)
__device__ __forceinline__ unsigned xb_ld(unsigned* p)              { return __hip_atomic_load(p, __ATOMIC_RELAXED, __HIP_MEMORY_SCOPE_AGENT); }
__device__ __forceinline__ unsigned xb_add(unsigned* p, unsigned v) { return __hip_atomic_fetch_add(p, v, __ATOMIC_RELAXED, __HIP_MEMORY_SCOPE_AGENT); }
__device__ __forceinline__ unsigned xb_xcc_id() { return (unsigned)__builtin_amdgcn_s_getreg((3 << 11) | 20) & 0xFu; }
#define XB_SPIN(cond, bar) do { unsigned _sp = 0; while (cond) { __builtin_amdgcn_s_sleep(1); \
    if ((++_sp & 255u) == 0u) { if (xb_ld(&(bar)[XB_TMO])) break; if (_sp > XB_SPIN_CAP) { atomicAdd(&(bar)[XB_TMO], 1u); break; } } } } while (0)
struct XcdBarrier { unsigned* bar; unsigned x; volatile LAS unsigned* st; };
__device__ __forceinline__ XcdBarrier xcd_barrier_post(unsigned* bar, volatile LAS unsigned* st) {
    XcdBarrier b; b.bar = bar; b.x = xb_xcc_id(); b.st = st;
    if (threadIdx.x == 0) (void)xb_add(&bar[XB_XCNT(b.x)], 1u);
    return b;
}
__device__ __forceinline__ void xcd_barrier_complete(unsigned* bar, unsigned x, unsigned& nloc, unsigned& nx) {
    const unsigned G = gridDim.x * gridDim.y * gridDim.z;
    unsigned sum, cnt, mine, sp = 0u;
    for (;;) {
        sum = 0u; cnt = 0u; mine = 0u;
#pragma unroll
        for (unsigned j = 0; j < 16; ++j) { const unsigned c = xb_ld(&bar[XB_XCNT(j)]); sum += c; cnt += (c > 0u) ? 1u : 0u; mine = (j == x) ? c : mine; }
        if (sum == G) break;
        __builtin_amdgcn_s_sleep(1);
        if ((++sp & 255u) == 0u) { if (xb_ld(&bar[XB_TMO])) break; if (sp > XB_SPIN_CAP) { atomicAdd(&bar[XB_TMO], 1u); break; } }
    }
    nloc = mine > 0u ? mine : 1u; nx = cnt > 0u ? cnt : 1u;
}
__device__ __forceinline__ void xcd_barrier(const XcdBarrier& b) {
    asm volatile("s_waitcnt vmcnt(0)" ::: "memory");
    __syncthreads();
    if (threadIdx.x == 0) {
        unsigned* bar = b.bar;
        __builtin_amdgcn_s_waitcnt(0);
        unsigned nloc = b.st[0], nx = b.st[1];
        if (nloc == 0u) { xcd_barrier_complete(bar, b.x, nloc, nx); b.st[0] = nloc; b.st[1] = nx; }
        const unsigned old = xb_add(&bar[XB_XSUB(b.x)], 1u);
        const unsigned gen = old / nloc;
        if (old + 1u == (gen + 1u) * nloc) {
            __builtin_amdgcn_fence(__ATOMIC_RELEASE, "agent");
            asm volatile("s_waitcnt vmcnt(0)" ::: "memory");
            const unsigned og = xb_add(&bar[XB_TOP], 1u);
            const unsigned tg = og / nx;
            if (og + 1u == (tg + 1u) * nx) xb_add(&bar[XB_TOPGEN], 1u);
            else XB_SPIN(xb_ld(&bar[XB_TOPGEN]) == tg, bar);
            __builtin_amdgcn_fence(__ATOMIC_ACQUIRE, "agent");
            xb_add(&bar[XB_XGEN(b.x)], 1u);
            asm volatile("s_waitcnt vmcnt(0)" ::: "memory");
        } else {
            XB_SPIN(xb_ld(&bar[XB_XGEN(b.x)]) == gen, bar);
            __builtin_amdgcn_fence(__ATOMIC_ACQUIRE, "agent");
            asm volatile("s_waitcnt vmcnt(0)" ::: "memory");
        }
    }
    __syncthreads();
}

namespace pg8 {
constexpr int BM = 256, BK = 64, HALF = 128, HTB = HALF * BK * 2, STAGE_BYTES = 8 * HTB, NXCD = 8, WGM = 4;
__device__ __forceinline__ int lds_byte(int r, int c) { const int st = (r >> 4) * 2 + (c >> 5), rr = r & 15, cc = c & 31, ob = rr * 64 + cc * 2; return st * 1024 + (ob ^ (((ob >> 9) & 1) << 5)); }
__device__ __forceinline__ void stage_rc(int b, int& R, int& C) { const int st = b / 1024, sb = b % 1024, swz = sb ^ (((sb >> 9) & 1) << 5); R = (st >> 1) * 16 + swz / 64; C = (st & 1) * 32 + (swz % 64) / 2; }
__device__ __forceinline__ int perm32(int rho) { const int n = rho >> 4, i = rho & 15; return 8 * (i >> 2) + 4 * n + (i & 3); }
struct Unit { int pm, pn, g, first, cnt, kofs, nt, flags, np, part, qmask; };
__device__ __forceinline__ bool static_next(int nM, int nN, int G, int c, int i, Unit& u) {
    const int nwg = nM * nN; const long L = (long)i * G + c; const bool ok = L < nwg;
    int wgid = ok ? (int)L : nwg - 1; { const int q = nwg / NXCD, r = nwg % NXCD, xcd = wgid % NXCD, off = wgid / NXCD; wgid = (xcd < r ? xcd * (q + 1) : r * (q + 1) + (xcd - r) * q) + off; }
    const int nig = WGM * nN, gid = wgid / nig, fm = gid * WGM, gsz = (nM - fm) < WGM ? (nM - fm) : WGM;
    u.pm = fm + ((wgid % nig) % gsz); u.pn = (wgid % nig) / gsz; return ok;
}
__device__ __forceinline__ bool sk_next(int nM, int nN, int nt2, int G, int c, int i, int pmax, Unit& u) {
    const int nwg = nM * nN, nfull = nwg / G, R = nwg - nfull * G;
    int P = 1; if (R > 0) { if (R * 8 <= G && pmax >= 8) P = 8; else if (R * 4 <= G && pmax >= 4) P = 4; else if (R * 2 <= G && pmax >= 2) P = 2; }
    const bool tail = (i >= nfull);
    const int x = c % NXCD, rho = c / NXCD, jj = rho / P, p = rho % P, j = jj * NXCD + x;
    const long L = tail ? (long)nfull * G + (j < R ? j : 0) : (long)i * G + c;
    int wgid = (int)(L < nwg ? L : nwg - 1); { const int q = nwg / NXCD, r = nwg % NXCD, xcd = wgid % NXCD, off = wgid / NXCD; wgid = (xcd < r ? xcd * (q + 1) : r * (q + 1) + (xcd - r) * q) + off; }
    const int nig = WGM * nN, gid = wgid / nig, fm = gid * WGM, gsz = (nM - fm) < WGM ? (nM - fm) : WGM;
    u.pm = fm + ((wgid % nig) % gsz); u.pn = (wgid % nig) / gsz;
    const int lo = tail ? p * nt2 / P : 0, hi = tail ? (p + 1) * nt2 / P : nt2;
    u.kofs = lo * 2 * BK * 2; u.nt = (hi - lo) * 2; u.flags = (tail && P > 1) ? 1 : 0; u.np = P; u.part = p;
    u.qmask = (tail && P > 1) ? (P == 4 ? (1 << p) : P == 2 ? (5 << p) : 0xF) : 0xF;
    return tail ? (i == nfull && j < R) : true;
}
struct SkCtl { f32x4* slots; unsigned* flag; unsigned* tmo; unsigned epoch; int c, G; };
template <class Epi, class Sched, bool GATHER>
__device__ __forceinline__ void gemm_phase(LAS unsigned char* lds, const int tid_in, const bf16_t* Aptr, const int K, const Sched& S, const Epi& E, const SkCtl sk = SkCtl{}) {
    int tid = tid_in; asm volatile("" : "+v"(tid));
    const int wid = __builtin_amdgcn_readfirstlane(tid >> 6), lane = tid & 63, wr = wid >> 2, wc = wid & 3, fr = lane & 15, fq = lane >> 4;
    int RA[2], CA[2]; unsigned voffA[2], voffB[2];
#pragma unroll
    for (int i = 0; i < 2; ++i) { int R, C; stage_rc(tid * 16 + i * 8192, R, C); const int Rb = Epi::PERM ? ((R & ~31) + perm32(R & 31)) : R; RA[i] = R; CA[i] = C; voffA[i] = (unsigned)(R * K + C) * 2u; voffB[i] = (unsigned)(Rb * K + C) * 2u; }
    const size_t kstep = (size_t)(BK * 2);
    const size_t hstep = (size_t)HALF * K * 2;
    const unsigned ldsw = (unsigned)wid * 1024u;
    const int aoff = lds_byte(wr * 64 + fr, fq * 8), boff = lds_byte(wc * 32 + fr, fq * 8);
    const char* const cAb = (const char*)Aptr;
#define PG8_SA(b, h) (((b) * 2 + (h)) * HTB)
#define PG8_SB(b, h) ((4 + (b) * 2 + (h)) * HTB)
#define PG8_STAGE(bufoff, gbase, voff) do { _Pragma("unroll") for (int _i = 0; _i < 2; ++_i) \
        __builtin_amdgcn_global_load_lds((const unsigned*)((const char*)(gbase) + (voff)[_i]), (LAS unsigned*)(lds + (bufoff) + ldsw + _i * 8192), 16, 0, 0); } while (0)
#define PG8_STAGEA(bufoff, vo, h, kb) do { _Pragma("unroll") for (int _i = 0; _i < 2; ++_i) { \
        if constexpr (GATHER) __builtin_amdgcn_global_load_lds((const unsigned*)(cAb + (size_t)(vo)[h][_i] + (size_t)(kb)), (LAS unsigned*)(lds + (bufoff) + ldsw + _i * 8192), 16, 0, 0); \
        else __builtin_amdgcn_global_load_lds((const unsigned*)(cAb + s##vo + (size_t)(h) * hstep + (size_t)(kb) + voffA[_i]), (LAS unsigned*)(lds + (bufoff) + ldsw + _i * 8192), 16, 0, 0); } } while (0)
#define PG8_LDA(dst, b, h) do { _Pragma("unroll") for (int m = 0; m < 4; ++m) _Pragma("unroll") for (int k = 0; k < 2; ++k) dst[m][k] = *(const LAS bf16x8*)(lds + PG8_SA(b, h) + aoff + m * 2048 + k * 1024); } while (0)
#define PG8_LDB(dst, b, h) do { _Pragma("unroll") for (int n = 0; n < 2; ++n) _Pragma("unroll") for (int k = 0; k < 2; ++k) dst[n][k] = *(const LAS bf16x8*)(lds + PG8_SB(b, h) + boff + n * 2048 + k * 1024); } while (0)
#define PG8_MMA(ai, bj, At, Bt) do { __builtin_amdgcn_s_setprio(1); _Pragma("unroll") for (int m = 0; m < 4; ++m) _Pragma("unroll") for (int n = 0; n < 2; ++n) _Pragma("unroll") for (int k = 0; k < 2; ++k) \
        acc[ai][bj][m][n] = __builtin_amdgcn_mfma_f32_16x16x32_bf16(Bt[n][k], At[m][k], acc[ai][bj][m][n], 0, 0, 0); __builtin_amdgcn_s_setprio(0); } while (0)
#define PG8_WAIT_V(n) asm volatile("s_waitcnt vmcnt(" #n ")" ::: "memory")
#define PG8_WAIT_L(n) asm volatile("s_waitcnt lgkmcnt(" #n ")" ::: "memory")
#define PG8_BAR __builtin_amdgcn_s_barrier()
#define PG8_SCHED __builtin_amdgcn_sched_barrier(0)
#define PG8_AOFFS(vo, u) do { if constexpr (GATHER) { _Pragma("unroll") for (int _h = 0; _h < 2; ++_h) _Pragma("unroll") for (int _i = 0; _i < 2; ++_i) \
        (vo)[_h][_i] = (unsigned)(((size_t)S.a_row(u, _h * HALF + RA[_i]) * (size_t)K + (size_t)CA[_i]) * 2u) + (unsigned)(u).kofs; } else { s##vo = (size_t)S.a_row(u, 0) * (size_t)K * 2u + (size_t)(u).kofs; } } while (0)
    Unit cur, nxt; int ui = 0;
    if (!S.next(0, cur)) return;
    f32x4 acc[2][2][4][2];
#pragma unroll
    for (int a = 0; a < 2; ++a)
#pragma unroll
        for (int b = 0; b < 2; ++b)
#pragma unroll
            for (int m = 0; m < 4; ++m)
#pragma unroll
                for (int n = 0; n < 2; ++n) acc[a][b][m][n] = (f32x4){0.f, 0.f, 0.f, 0.f};
    bf16x8 At[4][2], B0[2][2], B1[2][2];
    unsigned vA[2][2], vN[2][2];
    size_t svA = 0, svN = 0;
    PG8_AOFFS(vA, cur);
    const char* cB = S.b_ptr(cur) + cur.kofs;
    PG8_STAGE(PG8_SB(0, 0), cB, voffB); PG8_STAGE(PG8_SB(0, 1), cB + hstep, voffB); PG8_STAGEA(PG8_SA(0, 0), vA, 0, 0); PG8_STAGEA(PG8_SA(0, 1), vA, 1, 0);
    if (wr == 1) PG8_BAR;
    PG8_WAIT_V(2); PG8_BAR;
    PG8_STAGE(PG8_SB(1, 0), cB + kstep, voffB); PG8_STAGEA(PG8_SA(1, 0), vA, 0, kstep); PG8_STAGE(PG8_SB(1, 1), cB + hstep + kstep, voffB);
    PG8_WAIT_V(6); PG8_BAR;
    for (;;) {
        const bool has_next = S.next(ui + 1, nxt);
        const char* nB = has_next ? S.b_ptr(nxt) + nxt.kofs : cB;
        const int nt = cur.nt;
        if (has_next) { PG8_AOFFS(vN, nxt); } else { svN = svA;
#pragma unroll
            for (int _h = 0; _h < 2; ++_h)
#pragma unroll
                for (int _i = 0; _i < 2; ++_i) vN[_h][_i] = vA[_h][_i]; }
        if constexpr (GATHER) { *(LAS u32x4*)(lds + STAGE_BYTES + tid * 16) = (u32x4){vN[0][0], vN[0][1], vN[1][0], vN[1][1]}; }
        for (int t = 0; t < nt; t += 2) {
            const bool last = (t == nt - 2);
            const size_t k1 = (size_t)(t + 1) * kstep;
            const size_t k2 = last ? 0 : (size_t)(t + 2) * kstep, k3 = k2 + kstep;
            const char* b2 = last ? nB : cB + (size_t)(t + 2) * kstep; const char* b3 = b2 + kstep;
            unsigned v2[2][2]; const size_t sv2 = last ? svN : svA;
            if constexpr (GATHER) {
#pragma unroll
                for (int _h = 0; _h < 2; ++_h)
#pragma unroll
                    for (int _i = 0; _i < 2; ++_i) v2[_h][_i] = vA[_h][_i];
                if (last) { const u32x4 q = *(const LAS u32x4*)(lds + STAGE_BYTES + tid * 16); v2[0][0] = q.x; v2[0][1] = q.y; v2[1][0] = q.z; v2[1][1] = q.w; } }
            PG8_LDB(B0, 0, 0); PG8_LDB(B1, 0, 1); PG8_SCHED; PG8_LDA(At, 0, 0); PG8_STAGEA(PG8_SA(1, 1), vA, 1, k1);
            PG8_WAIT_V(8); PG8_WAIT_L(0); PG8_BAR; PG8_MMA(0, 0, At, B0); PG8_MMA(0, 1, At, B1); PG8_BAR; PG8_SCHED;
            PG8_LDA(At, 0, 1); PG8_STAGE(PG8_SB(0, 0), b2, voffB); PG8_STAGE(PG8_SB(0, 1), b2 + hstep, voffB); PG8_STAGEA(PG8_SA(0, 0), v2, 0, k2);
            PG8_WAIT_V(8); PG8_WAIT_L(0); PG8_BAR; PG8_MMA(1, 0, At, B0); PG8_MMA(1, 1, At, B1); PG8_BAR; PG8_SCHED;
            PG8_LDB(B0, 1, 0); PG8_LDB(B1, 1, 1); PG8_SCHED; PG8_LDA(At, 1, 0); PG8_STAGEA(PG8_SA(0, 1), v2, 1, k2);
            PG8_WAIT_V(8); PG8_WAIT_L(0); PG8_BAR; PG8_MMA(0, 0, At, B0); PG8_MMA(0, 1, At, B1); PG8_BAR; PG8_SCHED;
            PG8_LDA(At, 1, 1); PG8_STAGE(PG8_SB(1, 0), b3, voffB); PG8_STAGE(PG8_SB(1, 1), b3 + hstep, voffB); PG8_STAGEA(PG8_SA(1, 0), v2, 0, k3);
            PG8_WAIT_V(8); PG8_WAIT_L(0); PG8_BAR; PG8_MMA(1, 0, At, B0); PG8_MMA(1, 1, At, B1); PG8_BAR; PG8_SCHED;
        }
        if (wr == 0) PG8_BAR;
        if (cur.flags & 1) {
            const int P = cur.np, p = cur.part, c0 = sk.c - NXCD * p;
            int tl; asm volatile("v_mbcnt_lo_u32_b32 %0, -1, 0\n\tv_mbcnt_hi_u32_b32 %0, -1, %0" : "=v"(tl));
            const int tid = wid * 64 + tl;
            const __amdgpu_buffer_rsrc_t rs = __builtin_amdgcn_make_buffer_rsrc((void*)sk.slots, 0, (int)(sk.G * 32 * 512 * 16), 0x00020000);
            const unsigned so = (unsigned)((sk.c * (32 * 512) + tid) * 16);
#pragma unroll
            for (int a = 0; a < 2; ++a)
#pragma unroll
                for (int b = 0; b < 2; ++b) if (!((cur.qmask >> (a * 2 + b)) & 1)) {
#pragma unroll
                    for (int m = 0; m < 4; ++m)
#pragma unroll
                        for (int n = 0; n < 2; ++n) __builtin_amdgcn_raw_buffer_store_b128(__builtin_bit_cast(u32x4, acc[a][b][m][n]), rs, so + (unsigned)((((a * 2 + b) * 4 + m) * 2 + n) * 512 * 16), 0, 16); }
            PG8_WAIT_V(0); PG8_BAR; asm volatile("" ::: "memory");
            if (tid == 0) __hip_atomic_store(sk.flag + 64 * sk.c, sk.epoch, __ATOMIC_RELAXED, __HIP_MEMORY_SCOPE_AGENT);
            if (tid < 64) {
                for (int q = 0; q < P; ++q) if (q != p) { const int pc = c0 + NXCD * q; unsigned sp = 0;
                    while ((unsigned)__builtin_amdgcn_readfirstlane(__hip_atomic_load(sk.flag + 64 * pc, __ATOMIC_RELAXED, __HIP_MEMORY_SCOPE_AGENT)) != sk.epoch) { __builtin_amdgcn_s_sleep(1);
                        if ((++sp & 255u) == 0u) { if (__hip_atomic_load(sk.tmo, __ATOMIC_RELAXED, __HIP_MEMORY_SCOPE_AGENT)) break; if (sp > (1u << 20)) { if (tid == 0) atomicAdd(sk.tmo, 1u); break; } } } }
                __builtin_amdgcn_fence(__ATOMIC_ACQUIRE, "agent"); PG8_WAIT_V(0); }
            asm volatile("" ::: "memory"); PG8_BAR; asm volatile("" ::: "memory");
#pragma unroll
            for (int a = 0; a < 2; ++a)
#pragma unroll
                for (int b = 0; b < 2; ++b) if ((cur.qmask >> (a * 2 + b)) & 1) {
                    for (int q = 0; q < P; ++q) if (q != p) {
                        const GAS f32x4* sl = (const GAS f32x4*)sk.slots + (size_t)(c0 + NXCD * q) * (32 * 512) + (size_t)((a * 2 + b) * 8) * 512 + tid;
#pragma unroll
                        for (int h4 = 0; h4 < 2; ++h4) { f32x4 pv[4];
#pragma unroll
                            for (int v4 = 0; v4 < 4; ++v4) pv[v4] = sl[(h4 * 4 + v4) * 512];
#pragma unroll
                            for (int v4 = 0; v4 < 4; ++v4) acc[a][b][h4 * 2 + (v4 >> 1)][v4 & 1] += pv[v4]; } } }
        }
        { int fr_ = fr, fq_ = fq; asm volatile("" : "+v"(fr_), "+v"(fq_));
          E(acc, cur, wr, wc, fr_, fq_); }
        if (!has_next) break;
#pragma unroll
        for (int a = 0; a < 2; ++a)
#pragma unroll
            for (int b = 0; b < 2; ++b)
#pragma unroll
                for (int m = 0; m < 4; ++m)
#pragma unroll
                    for (int n = 0; n < 2; ++n) acc[a][b][m][n] = (f32x4){0.f, 0.f, 0.f, 0.f};
        cur = nxt; cB = nB; ++ui; svA = svN;
        if constexpr (GATHER) { const u32x4 q = *(const LAS u32x4*)(lds + STAGE_BYTES + tid * 16); vA[0][0] = q.x; vA[0][1] = q.y; vA[1][0] = q.z; vA[1][1] = q.w; }
        if (wr == 1) PG8_BAR;
    }
    PG8_WAIT_V(0);
    PG8_BAR;
#undef PG8_SA
#undef PG8_SB
#undef PG8_STAGE
#undef PG8_STAGEA
#undef PG8_LDA
#undef PG8_LDB
#undef PG8_MMA
#undef PG8_WAIT_V
#undef PG8_WAIT_L
#undef PG8_BAR
#undef PG8_SCHED
#undef PG8_AOFFS
}
}


template <bool SK>
struct SchedDense {
    const bf16_t* Bt; int nM, nN, G, c, K;
    __device__ __forceinline__ bool next(int i, pg8::Unit& u) const { u.g = 0; u.first = 0; u.cnt = 0;
        if constexpr (SK) return pg8::sk_next(nM, nN, K / 128, G, c, i, 4, u);
        else { u.kofs = 0; u.nt = K / 64; u.flags = 0; u.np = 1; u.part = 0; u.qmask = 0xF; return pg8::static_next(nM, nN, G, c, i, u); } }
    __device__ __forceinline__ const char* b_ptr(const pg8::Unit& u) const { return (const char*)Bt + (size_t)u.pn * 256 * K * 2; }
    __device__ __forceinline__ int a_row(const pg8::Unit& u, int r) const { return u.pm * 256 + r; }
};
struct MoeTab { volatile LAS unsigned* T;
    __device__ __forceinline__ int group_of(int blk) const { int g = 0;
#pragma unroll
        for (int j = 1; j < 16; ++j) g += (blk >= (int)T[16 + j]) ? 1 : 0; return g; }
};
template <bool GATHER, bool SK>
struct SchedMoe {
    const bf16_t* Wbase; size_t wx_stride; int nN, G, c, K, blk0, nblk; MoeTab tab; const int* ltok;
    __device__ __forceinline__ bool next(int i, pg8::Unit& u) const { bool ok;
        if constexpr (SK) ok = pg8::sk_next(nblk, nN, K / 128, G, c, i, 4, u); else { u.kofs = 0; u.nt = K / 64; u.flags = 0; u.np = 1; u.part = 0; u.qmask = 0xF; ok = pg8::static_next(nblk, nN, G, c, i, u); }
        u.pm += blk0;
        const int g = __builtin_amdgcn_readfirstlane(tab.group_of(u.pm)); u.g = g; u.first = __builtin_amdgcn_readfirstlane((int)tab.T[16 + g]); u.cnt = __builtin_amdgcn_readfirstlane((int)tab.T[32 + g]); return ok; }
    __device__ __forceinline__ const char* b_ptr(const pg8::Unit& u) const { return (const char*)Wbase + (size_t)(u.g & 7) * wx_stride + (size_t)u.pn * 256 * K * 2; }
    __device__ __forceinline__ int a_row(const pg8::Unit& u, int r) const {
        if (!GATHER) return u.pm * 256 + r;
        const int local = (u.pm - u.first) * 256 + r;
        return ltok[(size_t)u.g * TT + (local < u.cnt ? local : u.cnt - 1)]; }
};

struct EpiResid {
    static constexpr bool PERM = false;
    const float* xin_l; const float* xin_c; float* xout_l; float* xout_c; const float* mod; int which; float rs;
    __device__ __forceinline__ void operator()(const f32x4 (&acc)[2][2][4][2], const pg8::Unit& u, int wr, int wc, int fr, int fq) const {
        const bool lat = u.pm < TL / 256; const int b5 = lat ? u.pm / 32 : 4;
        const size_t rbase = (size_t)(lat ? u.pm : u.pm - TL / 256) * 256 + wr * 64 + fr;
        const float* xi = (lat ? xin_l : xin_c); float* xo = (lat ? xout_l : xout_c);
        const int col0 = u.pn * 256 + wc * 32 + 4 * fq;
        const float* gp = mod + (size_t)b5 * NMOD * DM + which * DM + col0;
        f32x4 gv[2][2];
#pragma unroll
        for (int bj = 0; bj < 2; ++bj)
#pragma unroll
            for (int n = 0; n < 2; ++n) gv[bj][n] = *(const f32x4*)(gp + bj * 128 + n * 16) * rs;
#pragma unroll
        for (int ai = 0; ai < 2; ++ai)
#pragma unroll
            for (int m = 0; m < 4; ++m) { const size_t off = (rbase + ai * 128 + m * 16) * DM + col0;
#pragma unroll
                for (int bj = 0; bj < 2; ++bj)
#pragma unroll
                    for (int n = 0; n < 2; ++n) if ((u.qmask >> (ai * 2 + bj)) & 1) *(f32x4*)(xo + off + bj * 128 + n * 16) = *(const f32x4*)(xi + off + bj * 128 + n * 16) + gv[bj][n] * acc[ai][bj][m][n];
                if (m & 1) asm volatile("" ::: "memory"); }
    }
};
struct EpiSwiglu {
    static constexpr bool PERM = true;
    bf16_t* act;
    __device__ __forceinline__ void operator()(const f32x4 (&acc)[2][2][4][2], const pg8::Unit& u, int wr, int wc, int fr, int fq) const {
        const size_t row0 = (size_t)u.pm * 256 + wr * 64 + fr; const int col0 = u.pn * 128 + wc * 32 + 8 * fq;
#pragma unroll
        for (int ai = 0; ai < 2; ++ai)
#pragma unroll
            for (int m = 0; m < 4; ++m) {
                const f32x4 g0 = acc[ai][0][m][0], g1 = acc[ai][0][m][1], u0 = acc[ai][1][m][0], u1 = acc[ai][1][m][1];
                u32x4 w;
                w.x = pk2(fast_silu(g0[0]) * u0[0], fast_silu(g0[1]) * u0[1]); w.y = pk2(fast_silu(g0[2]) * u0[2], fast_silu(g0[3]) * u0[3]);
                w.z = pk2(fast_silu(g1[0]) * u1[0], fast_silu(g1[1]) * u1[1]); w.w = pk2(fast_silu(g1[2]) * u1[2], fast_silu(g1[3]) * u1[3]);
                *(u32x4*)(act + (row0 + ai * 128 + m * 16) * DFF + col0) = w; }
    }
};
struct EpiQKV {
    static constexpr bool PERM = true;
    bf16_t *QB, *KB, *VB; const float2* rope;
    __device__ __forceinline__ void operator()(const f32x4 (&acc)[2][2][4][2], const pg8::Unit& u, int wr, int wc, int fr, int fq) const {
        const bool lat = u.pm < TL / 256; const int row0 = u.pm * 256 + wr * 64 + fr;
        const bool dorope = lat && u.pn < 5; const float qs = u.pn < 4 ? 0.125f * LOG2E : 1.f;
        const size_t doff = u.pn < 4 ? (size_t)0 : (u.pn == 4 ? (size_t)((BIG_K - BIG_Q) / 2) : (size_t)((BIG_V - BIG_Q) / 2));
        bf16_t* dst = QB + doff; const int ld = u.pn < 4 ? DM : 256, colt = u.pn < 4 ? u.pn * 256 : 0;
        const int a = wc & 1, f0 = 8 * (fq & 1); const float sg = (fq < 2) ? -1.f : 1.f;
#pragma unroll
        for (int ai = 0; ai < 2; ++ai)
#pragma unroll
            for (int m = 0; m < 4; ++m) { const int r = row0 + ai * 128 + m * 16; const int t = r & (SEQ - 1); const int pos = a ? (t & 63) : (t >> 6);
                const f32x4* csp = (const f32x4*)(rope + pos * 16 + f0);
#pragma unroll
                for (int bj = 0; bj < 2; ++bj) if ((u.qmask >> (ai * 2 + bj)) & 1) { f32x4 v[2];
#pragma unroll
                    for (int n = 0; n < 2; ++n) { v[n] = acc[ai][bj][m][n];
                        if (dorope) { const f32x4 c01 = csp[2 * n], c23 = csp[2 * n + 1];
#pragma unroll
                            for (int j = 0; j < 4; ++j) { const float pr = xor32(v[n][j], fq < 2); const float c = (j < 2 ? c01 : c23)[2 * (j & 1)], sn = (j < 2 ? c01 : c23)[2 * (j & 1) + 1]; v[n][j] = v[n][j] * c + sg * pr * sn; } }
                        v[n] = v[n] * qs; }
                    u32x4 w; w.x = pk2(v[0][0], v[0][1]); w.y = pk2(v[0][2], v[0][3]); w.z = pk2(v[1][0], v[1][1]); w.w = pk2(v[1][2], v[1][3]);
                    *(u32x4*)(dst + (size_t)r * ld + colt + bj * 128 + wc * 32 + 8 * fq) = w; }
                asm volatile("" ::: "memory"); }
    }
};
struct EpiMoeDown {
    static constexpr bool PERM = false;
    float* xl; float* xc; const float* mod; const int* ltok; const float* lw; float rs;
    __device__ __forceinline__ void operator()(const f32x4 (&acc)[2][2][4][2], const pg8::Unit& u, int wr, int wc, int fr, int fq) const {
        const int g = u.g; const int lbase = (u.pm - u.first) * 256 + wr * 64 + fr; const int cnt = u.cnt;
        const int col0 = u.pn * 256 + wc * 32 + 4 * fq;
        int tokv[2][4]; float wv[2][4];
#pragma unroll
        for (int ai = 0; ai < 2; ++ai)
#pragma unroll
            for (int m = 0; m < 4; ++m) { const int local = lbase + ai * 128 + m * 16, li = local < cnt ? local : cnt - 1; tokv[ai][m] = ltok[(size_t)g * TT + li]; wv[ai][m] = lw[(size_t)g * TT + li] * rs; }
#pragma unroll
        for (int ai = 0; ai < 2; ++ai)
#pragma unroll
            for (int m = 0; m < 4; ++m) { const int local = lbase + ai * 128 + m * 16;
                if (local < cnt) { const int tok = tokv[ai][m]; const float w = wv[ai][m];
                    const bool lat = tok < TL; const int b5 = lat ? tok / SEQ : 4; float* xr = (lat ? xl + (size_t)tok * DM : xc + (size_t)(tok - TL) * DM) + col0;
                    const float* gp = mod + (size_t)b5 * NMOD * DM + 5 * DM + col0;
#pragma unroll
                    for (int bj = 0; bj < 2; ++bj)
#pragma unroll
                        for (int n = 0; n < 2; ++n) if ((u.qmask >> (ai * 2 + bj)) & 1) { const f32x4 gv = *(const f32x4*)(gp + bj * 128 + n * 16); *(f32x4*)(xr + bj * 128 + n * 16) = *(const f32x4*)(xr + bj * 128 + n * 16) + gv * (w * acc[ai][bj][m][n]); } } }
    }
};
struct EpiMoeY {
    static constexpr bool PERM = true;
    bf16_t* ys; const float* mod; const int* ltok; const float* lw;
    __device__ __forceinline__ void operator()(const f32x4 (&acc)[2][2][4][2], const pg8::Unit& u, int wr, int wc, int fr, int fq) const {
        const int g = u.g; const int lbase = (u.pm - u.first) * 256 + wr * 64 + fr; const int cnt = u.cnt;
        const int col0 = u.pn * 256 + wc * 32 + 8 * fq;
        int tokv[2][4]; float wv[2][4];
#pragma unroll
        for (int ai = 0; ai < 2; ++ai)
#pragma unroll
            for (int m = 0; m < 4; ++m) { const int local = lbase + ai * 128 + m * 16, li = local < cnt ? local : cnt - 1; tokv[ai][m] = ltok[(size_t)g * TT + li]; wv[ai][m] = lw[(size_t)g * TT + li]; }
#pragma unroll
        for (int ai = 0; ai < 2; ++ai)
#pragma unroll
            for (int m = 0; m < 4; ++m) { const int local = lbase + ai * 128 + m * 16;
                if (local < cnt) { const int tok = tokv[ai][m]; const float w = wv[ai][m]; const int b5 = tok < TL ? tok / SEQ : 4;
                    const float* gp = mod + (size_t)b5 * NMOD * DM + 5 * DM + col0; bf16_t* yr = ys + ((size_t)u.pm * 256 + wr * 64 + fr + ai * 128 + m * 16) * DM + col0;
#pragma unroll
                    for (int bj = 0; bj < 2; ++bj) if ((u.qmask >> (ai * 2 + bj)) & 1) { const f32x4 g0 = *(const f32x4*)(gp + bj * 128), g1 = *(const f32x4*)(gp + bj * 128 + 4);
                        const f32x4 v0 = g0 * (w * acc[ai][bj][m][0]), v1 = g1 * (w * acc[ai][bj][m][1]);
                        u32x4 o; o.x = pk2(v0[0], v0[1]); o.y = pk2(v0[2], v0[3]); o.z = pk2(v1[0], v1[1]); o.w = pk2(v1[2], v1[3]);
                        *(u32x4*)(yr + bj * 128) = o; } } }
    }
};
struct Frame { LAS unsigned char* lds; volatile LAS unsigned* MISC; int tid, lane, wave, vcu, G; };

__device__ __forceinline__ void p0_transpose_item(const float* W, int K, int N, bf16_t* WT, int k0, int n0, int drow0, LAS float* scr, int lane) {
    f32x4 v[16];
#pragma unroll
    for (int i = 0; i < 16; ++i) v[i] = __builtin_nontemporal_load((const f32x4*)(W + (size_t)(k0 + 4 * i + (lane >> 4)) * N + n0 + 4 * (lane & 15)));
#pragma unroll
    for (int i = 0; i < 16; ++i) { LAS float* d = scr + (4 * i + (lane >> 4)) * 65 + 4 * (lane & 15); d[0] = v[i][0]; d[1] = v[i][1]; d[2] = v[i][2]; d[3] = v[i][3]; }
    asm volatile("s_waitcnt lgkmcnt(0)" ::: "memory");
    const int c = lane & 7;
#pragma unroll
    for (int j = 0; j < 8; ++j) { const int n = (lane >> 3) + 8 * j; const LAS float* sp = scr + (8 * c) * 65 + n;
        u32x4 o; o.x = pk2(sp[0 * 65], sp[1 * 65]); o.y = pk2(sp[2 * 65], sp[3 * 65]); o.z = pk2(sp[4 * 65], sp[5 * 65]); o.w = pk2(sp[6 * 65], sp[7 * 65]);
        *(u32x4*)(WT + (size_t)(drow0 + n) * K + k0 + 8 * c) = o; }
    asm volatile("s_waitcnt lgkmcnt(0)" ::: "memory");
}
__device__ __forceinline__ void p0_ffn_matrix(const Prm& p, int m, int r, LAS float* scr, int lane) {
    unsigned char* ws = p.ws; const float* src; bf16_t* dst; int t;
    if (m < 6) { const int j = m / 3; t = m % 3; src = (t == 0 ? p.fg : t == 1 ? p.fu : p.fd) + (size_t)j * DM * DFF; dst = (bf16_t*)(ws + WS_W + j * WE_STRIDE + (t == 2 ? WE_D : WE_GU)); }
    else { const int q = m - 6, j = q / 24, e = (q % 24) / 3; t = q % 3; src = (t == 0 ? p.mg : t == 1 ? p.mu : p.md) + ((size_t)j * NEXP + e) * DM * DFF; dst = (bf16_t*)(ws + WS_W + WO_BASE + j * WO_STRIDE + WO_EXP + e * WX_STRIDE + (t == 2 ? WX_D : WX_GU)); }
    if (t == 2) { const int nblk = DM / 64, q8 = r >> 3, w8 = r & 7, ngx = nblk / 2, kb = 4 * (q8 / ngx) + (w8 >> 1), nb = 2 * (q8 % ngx) + (w8 & 1); p0_transpose_item(src, DFF, DM, dst, 64 * kb, 64 * nb, 64 * nb, scr, lane); }
    else { const int nblk = DFF / 64, q8 = r >> 3, w8 = r & 7, ngx = nblk / 2, kb = 4 * (q8 / ngx) + (w8 >> 1), nb = 2 * (q8 % ngx) + (w8 & 1), n0 = 64 * nb; p0_transpose_item(src, DM, DFF, dst, 64 * kb, n0, (n0 / 128) * 256 + (n0 % 128) + (t == 1 ? 128 : 0), scr, lane); }
}
__device__ __forceinline__ void p0_prologue(const Prm& p, Frame& F) {
    unsigned char* ws = p.ws;
    { const int gt = F.vcu * 512 + F.tid, NT = F.G * 512;
      bf16_t* F1 = (bf16_t*)(ws + WS_TAB + TAB_F1); bf16_t* F2 = (bf16_t*)(ws + WS_TAB + TAB_F2); float2* TW = (float2*)(ws + WS_TAB + TAB_TW); float2* TWC = (float2*)(ws + WS_TAB + TAB_TWC);
      for (int i = gt; i < 256 * 128; i += NT) { const int row = i / 128, n1 = i % 128, k1 = row >> 1, c = row & 1; float sn, cs; sincospif(2.f * (float)((n1 * k1) & 127) / 128.f, &sn, &cs);
          F1[i] = (bf16_t)f2bf((c ? -sn : cs) * 0.08838834764831845f); }
      for (int i = gt; i < 128 * 128; i += NT) { const int row = i / 128, col = i % 128, k2 = row >> 1, cp = row & 1, n2 = col >> 1, c = col & 1; float sn, cs; sincospif(2.f * (float)((n2 * k2) & 63) / 64.f, &sn, &cs);
          const float v = cp == 0 ? (c == 0 ? cs : sn) : (c == 0 ? -sn : cs); F2[i] = (bf16_t)f2bf(v * 0.125f); }
      for (int i = gt; i < 64 * 128; i += NT) { const int n2 = i / 128, k1 = i % 128; float sn, cs; sincospif(2.f * (float)(n2 * k1) / 8192.f, &sn, &cs); TW[i] = make_float2(cs, -sn); }
      for (int i = gt; i < 2 * 128; i += NT) { const int n2 = i / 128, k1 = i % 128; float sn, cs; sincospif(2.f * (float)(n2 * k1) / 256.f, &sn, &cs); TWC[i] = make_float2(cs, -sn); }
      for (int i = gt; i < 128 * 16; i += NT) { const int pos = i / 16, f = i % 16; const float inv = powf(10000.f, -(float)f / 16.f); const float ang = (float)pos * inv;
          ((float2*)(ws + WS_ROPE))[i] = make_float2((float)cos((double)ang), (float)sin((double)ang)); }
    }
    { LAS float* sc = (LAS float*)(F.lds);
      LAS float* part = (LAS float*)(F.lds + 32768);
      for (int i = F.tid; i < 5 * DM; i += 512) { const int r = i / DM, k = i % DM; const float v = r < 4 ? p.c[r * DM + k] : p.c_ctx[k]; sc[i] = v / (1.f + expf(-v)); }
      __syncthreads();
      for (int it = F.vcu; it < DEPTH * 96; it += F.G) { const int l = it / 96, n = (it % 96) * 64 + F.lane;
          const float* w = p.ada_w + (size_t)l * DM * NMOD * DM + n; float a[5] = {0.f, 0.f, 0.f, 0.f, 0.f};
          for (int kb = 0; kb < 128; kb += 32) { float wv[32];
#pragma unroll
              for (int kk = 0; kk < 32; ++kk) wv[kk] = w[(size_t)(F.wave * 128 + kb + kk) * NMOD * DM];
#pragma unroll
              for (int kk = 0; kk < 32; ++kk) { const int k = F.wave * 128 + kb + kk;
#pragma unroll
                  for (int r = 0; r < 5; ++r) a[r] += sc[r * DM + k] * wv[kk]; } }
#pragma unroll
          for (int r = 0; r < 5; ++r) part[(F.wave * 5 + r) * 64 + F.lane] = a[r];
          __syncthreads();
          if (F.tid < 320) { const int r = F.tid / 64, ln = F.tid % 64; float sum = 0.f;
#pragma unroll
              for (int wv = 0; wv < 8; ++wv) sum += part[(wv * 5 + r) * 64 + ln];
              ((float*)(ws + WS_MOD))[((size_t)l * 5 + r) * NMOD * DM + (it % 96) * 64 + ln] = sum + p.ada_b[l * NMOD * DM + (it % 96) * 64 + ln]; }
          __syncthreads(); }
    }
    { LAS f32x2* cs256 = (LAS f32x2*)(F.lds);
      __syncthreads();
      for (int i = F.tid; i < 256; i += 512) { float sn, cs; sincospif(2.f * (float)i / 256.f, &sn, &cs); cs256[i] = (f32x2){cs * 0.0625f, sn * 0.0625f}; }
      __syncthreads();
      const int gw = F.vcu * 8 + F.wave, NGW = F.G * 8;
      for (int it = gw; it < 2 * 64 * 16; it += NGW) { const int j = it / 1024, kk0 = ((it / 16) % 64) * 32, n = (it % 16) * 64 + F.lane;
          const int type = kk0 / 1024, g = (kk0 % 1024) / 256, p0 = kk0 % 256;
          const float* w = p.fw + (size_t)j * DM * DM + (size_t)(g * 256) * DM + n; float a[32] = {};
          for (int qb = 0; qb < 256; qb += 16) { float wv[16];
#pragma unroll
              for (int qq = 0; qq < 16; ++qq) wv[qq] = w[(size_t)(qb + qq) * DM];
#pragma unroll
              for (int qq = 0; qq < 16; ++qq) { const int q = qb + qq; int idx = p0 * q;
#pragma unroll
                  for (int i = 0; i < 32; ++i) { const f32x2 t = cs256[idx & 255]; a[i] += (type ? t.y : t.x) * wv[qq]; idx += q; } } }
#pragma unroll
          for (int i8 = 0; i8 < 4; ++i8) { u32x4 o; o.x = pk2(a[8 * i8], a[8 * i8 + 1]); o.y = pk2(a[8 * i8 + 2], a[8 * i8 + 3]); o.z = pk2(a[8 * i8 + 4], a[8 * i8 + 5]); o.w = pk2(a[8 * i8 + 6], a[8 * i8 + 7]);
              *(u32x4*)((bf16_t*)(ws + WS_W + j * WE_STRIDE + WE_F) + (size_t)n * 2048 + kk0 + 8 * i8) = o; } }
      __syncthreads();
    }
    { LAS float* scr = (LAS float*)(F.lds + F.wave * 16640);
      const int gw = F.vcu * 8 + F.wave, NGW = F.G * 8;
      constexpr int I_FFN = 54 * 896, I_QKV = 2 * 384, I_O = 2 * 256;
      for (int it = gw; it < I_FFN + I_QKV + I_O; it += NGW) {
          if (it < I_FFN) { p0_ffn_matrix(p, it / 896, it % 896, scr, F.lane); continue; }
          int r = it - I_FFN;
          if (r < I_QKV) { const int j = r / 384, q = r % 384, nblk = QKVD / 64, kb = q / nblk, nb = q % nblk;
              p0_transpose_item(p.wqkv + (size_t)j * DM * QKVD, DM, QKVD, (bf16_t*)(ws + WS_W + WO_BASE + j * WO_STRIDE + WO_QKV), 64 * kb, 64 * nb, 64 * nb, scr, F.lane); continue; }
          r -= I_QKV;
          { const int j = r / 256, q = r % 256, nblk = DM / 64, kb = q / nblk, nb = q % nblk;
              p0_transpose_item(p.wo + (size_t)j * DM * DM, DM, DM, (bf16_t*)(ws + WS_W + WO_BASE + j * WO_STRIDE + WO_O), 64 * kb, 64 * nb, 64 * nb, scr, F.lane); }
      }
    }
}

template <bool ROUTER>
__device__ __forceinline__ void norm_phase(const Prm& p, Frame& F, const float* xl, const float* xc, const float* g, const float* mod  , int which, bf16_t* HB, int nrows,
                                            const float* wr, unsigned* mcnt, int* ltok, float* lw) {
    const int lane = F.lane;
    f32x4 gv[4];
#pragma unroll
    for (int j = 0; j < 4; ++j) gv[j] = *(const f32x4*)(g + 4 * (lane + 64 * j));
    float wreg[ROUTER ? 128 : 1];
    if (ROUTER) {
#pragma unroll
        for (int j = 0; j < 4; ++j)
#pragma unroll
            for (int i = 0; i < 4; ++i) { const int c = 4 * (lane + 64 * j) + i; const f32x4 w0 = *(const f32x4*)(wr + c * 8), w1 = *(const f32x4*)(wr + c * 8 + 4);
#pragma unroll
                for (int e = 0; e < 4; ++e) { wreg[(j * 4 + i) * 8 + e] = w0[e]; wreg[(j * 4 + i) * 8 + 4 + e] = w1[e]; } }
    }
    const int rpb = (nrows + F.G - 1) / F.G;
    const int r0 = ROUTER ? F.vcu * rpb : F.vcu * 8 + F.wave, r1 = ROUTER ? (r0 + rpb < nrows ? r0 + rpb : nrows) : nrows, rstep = ROUTER ? 8 : F.G * 8;
    LAS unsigned* ech = (LAS unsigned*)F.lds; LAS float* gch = (LAS float*)(F.lds + 4096);
    if (ROUTER) __syncthreads();
    for (int rr = ROUTER ? r0 + F.wave : r0; rr < r1; rr += 2 * rstep) {
        f32x4 v[2][4]; float ss[2];
#pragma unroll
        for (int q = 0; q < 2; ++q) { const int r = rr + q * rstep; ss[q] = 0.f;
            if (r < r1) { const float* xr = (r < TL) ? xl + (size_t)r * DM : xc + (size_t)(r - TL) * DM;
#pragma unroll
                for (int j = 0; j < 4; ++j) v[q][j] = *(const f32x4*)(xr + 4 * (lane + 64 * j)); } }
#pragma unroll
        for (int q = 0; q < 2; ++q) { const int r = rr + q * rstep;
            if (r < r1) {
#pragma unroll
                for (int j = 0; j < 4; ++j) ss[q] += (v[q][j][0] * v[q][j][0] + v[q][j][1] * v[q][j][1]) + (v[q][j][2] * v[q][j][2] + v[q][j][3] * v[q][j][3]); } }
#pragma unroll
        for (int q = 0; q < 2; ++q) { const int r = rr + q * rstep;
          if (r < r1) {
            const int b5 = (r < TL) ? r / SEQ : 4; const float* mp = mod + (size_t)b5 * NMOD * DM + which * DM;
            const float rstd = rsqrtf(wave_sum(ss[q]) * (1.f / DM) + EPS);
            float lg[8] = {};
#pragma unroll
            for (int j = 0; j < 4; ++j) { const f32x4 sh = *(const f32x4*)(mp + 4 * (lane + 64 * j)), sc = *(const f32x4*)(mp + DM + 4 * (lane + 64 * j));
                f32x4 h = v[q][j] * rstd * gv[j] * (sc + 1.f) + sh;
                u32x2 o; o.x = pk2(h[0], h[1]); o.y = pk2(h[2], h[3]); *(u32x2*)(HB + (size_t)r * DM + 4 * (lane + 64 * j)) = o;
                if (ROUTER) {
#pragma unroll
                    for (int i = 0; i < 4; ++i)
#pragma unroll
                        for (int e = 0; e < 8; ++e) lg[e] += h[i] * wreg[(j * 4 + i) * 8 + e]; } }
            if (ROUTER) {
                float a4[4], b2[2], c1;
#pragma unroll
                for (int t = 0; t < 4; ++t) { const float snd = (lane & 1) ? lg[t] : lg[t + 4], kp = (lane & 1) ? lg[t + 4] : lg[t]; a4[t] = kp + SWZ_XOR(snd, 1); }
#pragma unroll
                for (int t = 0; t < 2; ++t) { const float snd = (lane & 2) ? a4[t] : a4[t + 2], kp = (lane & 2) ? a4[t + 2] : a4[t]; b2[t] = kp + SWZ_XOR(snd, 2); }
                { const float snd = (lane & 4) ? b2[0] : b2[1], kp = (lane & 4) ? b2[1] : b2[0]; c1 = kp + SWZ_XOR(snd, 4); }
                c1 += SWZ_XOR(c1, 8); c1 += SWZ_XOR(c1, 16);
                const int cb = __builtin_bit_cast(int, c1);
#pragma unroll
                for (int e = 0; e < 8; ++e) { const int l = ((e >> 2) & 1) | (((e >> 1) & 1) << 1) | ((e & 1) << 2);
                    lg[e] = __builtin_bit_cast(float, __builtin_amdgcn_readlane(cb, l)) + __builtin_bit_cast(float, __builtin_amdgcn_readlane(cb, l + 32)); }
                int e0 = 0; float v0 = lg[0];
#pragma unroll
                for (int e = 1; e < 8; ++e) if (lg[e] > v0) { v0 = lg[e]; e0 = e; }
                int e1 = -1; float v1 = -INFINITY;
#pragma unroll
                for (int e = 0; e < 8; ++e) if (e != e0 && lg[e] > v1) { v1 = lg[e]; e1 = e; }
                const float g1 = 1.f / (1.f + expf(v0 - v1)), g0 = 1.f - g1;
                if (lane == 0) { ech[r - r0] = (unsigned)e0 | ((unsigned)e1 << 8); gch[2 * (r - r0)] = g0; gch[2 * (r - r0) + 1] = g1; }
            }
          } }
    }
    if (ROUTER) {
        __syncthreads();
        if (F.tid < 16) { const int grp = F.tid, k = grp >> 3, e = grp & 7, n = r1 - r0; int cnt = 0;
            for (int i = 0; i < n; ++i) cnt += (int)(((ech[i] >> (8 * k)) & 0xffu) == (unsigned)e);
            mcnt[(size_t)F.vcu * 16 + grp] = (unsigned)cnt; }
    }
}
__device__ __forceinline__ void moe_lists(Frame& F, const unsigned* cntw, unsigned* mcnt, int* ltok, float* lw, int nrows, int* tokslot) {
    const int rpb = (nrows + F.G - 1) / F.G; const int r0 = F.vcu * rpb, r1 = (r0 + rpb < nrows ? r0 + rpb : nrows);
    LAS unsigned* ech = (LAS unsigned*)F.lds; LAS float* gch = (LAS float*)(F.lds + 4096);
    unsigned pos = 0u, tot = 0u; const int grp = F.tid & 15, k = grp >> 3, e = grp & 7, n = r1 - r0;
    if (F.tid < 16) {
        for (int w = 0; w < F.G; ++w) { const unsigned c = cntw[(size_t)w * 16 + grp]; tot += c; pos += (w < F.vcu) ? c : 0u; }
        if (F.vcu == 0) mcnt[grp] = tot;
        F.MISC[64 + grp] = (tot + 255u) / 256u; }
    __syncthreads();
    if (F.tid < 16) { unsigned first = 0u;
        for (int g2 = 0; g2 < grp; ++g2) first += F.MISC[64 + g2];
        for (int i = 0; i < n; ++i) if (((ech[i] >> (8 * k)) & 0xffu) == (unsigned)e) { ltok[(size_t)grp * TT + pos] = r0 + i; lw[(size_t)grp * TT + pos] = gch[2 * i + k];
            if (tokslot) tokslot[(size_t)(r0 + i) * 2 + k] = (int)(first * 256u + pos); ++pos; } }
}
__device__ __forceinline__ void final_norm_phase(const Prm& p, Frame& F, const bf16_t* ys, const int* tokslot) {
    const int gw = F.vcu * 8 + F.wave, NGW = F.G * 8, lane = F.lane;
    f32x4 gv[4];
#pragma unroll
    for (int j = 0; j < 4; ++j) gv[j] = *(const f32x4*)(p.fng + 4 * (lane + 64 * j));
    for (int rr = gw; rr < TL; rr += 2 * NGW) { f32x4 v[2][4];
#pragma unroll
        for (int q = 0; q < 2; ++q) { const int r = rr + q * NGW; if (r < TL) {
#pragma unroll
            for (int j = 0; j < 4; ++j) v[q][j] = *(const f32x4*)(p.out + (size_t)r * DM + 4 * (lane + 64 * j));
            const int s0 = tokslot[2 * r], s1 = tokslot[2 * r + 1];
#pragma unroll
            for (int j = 0; j < 4; ++j) { const u32x2 a = *(const u32x2*)(ys + (size_t)s0 * DM + 4 * (lane + 64 * j)), b = *(const u32x2*)(ys + (size_t)s1 * DM + 4 * (lane + 64 * j));
                v[q][j][0] += __uint_as_float(a.x << 16) + __uint_as_float(b.x << 16); v[q][j][1] += __uint_as_float(a.x & 0xffff0000u) + __uint_as_float(b.x & 0xffff0000u);
                v[q][j][2] += __uint_as_float(a.y << 16) + __uint_as_float(b.y << 16); v[q][j][3] += __uint_as_float(a.y & 0xffff0000u) + __uint_as_float(b.y & 0xffff0000u); } } }
#pragma unroll
        for (int q = 0; q < 2; ++q) { const int r = rr + q * NGW; if (r < TL) { float s = 0.f;
#pragma unroll
            for (int j = 0; j < 4; ++j) s += (v[q][j][0] * v[q][j][0] + v[q][j][1] * v[q][j][1]) + (v[q][j][2] * v[q][j][2] + v[q][j][3] * v[q][j][3]);
            const float rstd = rsqrtf(wave_sum(s) * (1.f / DM) + EPS);
#pragma unroll
            for (int j = 0; j < 4; ++j) *(f32x4*)(p.out + (size_t)r * DM + 4 * (lane + 64 * j)) = v[q][j] * rstd * gv[j]; } } }
}
__device__ __forceinline__ void moe_tables(Frame& F, const unsigned* mcnt) {
    __syncthreads();
    if (F.tid == 0) { unsigned first = 0u, nb0 = 0u;
        for (int g = 0; g < 16; ++g) { const unsigned c = __hip_atomic_load(mcnt + g, __ATOMIC_RELAXED, __HIP_MEMORY_SCOPE_AGENT); F.MISC[16 + g] = first; F.MISC[32 + g] = c; first += (c + 255u) / 256u; if (g == 7) nb0 = first; }
        F.MISC[48] = nb0; F.MISC[49] = first; }
    __syncthreads();
}


__device__ __forceinline__ int fresh_tid(int wave) { int tl; asm volatile("v_mbcnt_lo_u32_b32 %0, -1, 0\n\tv_mbcnt_hi_u32_b32 %0, -1, %0" : "=v"(tl)); return wave * 64 + tl; }
typedef short v4i16_t __attribute__((ext_vector_type(4)));
__device__ __forceinline__ unsigned off_b(unsigned row, unsigned ch) { return 256u * row + 16u * (ch ^ (((row & 3u) << 2) | ((row >> 2) & 3u))); }
__device__ __forceinline__ int crow(int r, int hi) { return (r & 3) + 8 * (r >> 2) + 4 * hi; }
__device__ __forceinline__ s16x4 trrd(const LAS unsigned char* p) { return __builtin_bit_cast(s16x4, __builtin_amdgcn_ds_read_tr16_b64_v4i16((LAS v4i16_t*)p)); }
template <int MB>
__device__ __forceinline__ void dft_mma(const LAS unsigned char* Aimg, const LAS unsigned char* Bimg, int wave, int lane, f32x16 (&acc)[MB]) {
    const int r32 = lane & 31, hi = lane >> 5;
    const unsigned X = ((r32 & 3) << 2) | ((r32 >> 2) & 3);
    const LAS unsigned char* bbase = Bimg + (wave >> 2) * 32768;
    const unsigned blk = (lane >> 4) & 1, q = (lane & 15) >> 2, pp = lane & 3, c = wave & 3;
    unsigned tra[2];
#pragma unroll
    for (int t = 0; t < 2; ++t) tra[t] = off_b(8 * hi + 4 * t + q, 4 * c + 2 * blk + (pp >> 1)) + 8 * (pp & 1);
#pragma unroll
    for (int ks = 0; ks < 8; ++ks) {
        const s16x4 lo = trrd(bbase + tra[0] + ks * 4096), hh = trrd(bbase + tra[1] + ks * 4096);
        const bf16x8 bf = (bf16x8){lo[0], lo[1], lo[2], lo[3], hh[0], hh[1], hh[2], hh[3]};
        const unsigned achunk = ((2 * ks + hi) ^ X) * 16;
#pragma unroll
        for (int mb = 0; mb < MB; ++mb) { const bf16x8 af = *(const LAS bf16x8*)(Aimg + 256 * (32 * mb + r32) + achunk);
            acc[mb] = __builtin_amdgcn_mfma_f32_32x32x16_bf16(af, bf, acc[mb], 0, 0, 0); }
    }
}
__device__ __forceinline__ void s1_phase(const Prm& p, Frame& F, const float* xl, const float* xc, const float* g, const float* mod, bf16_t* Y1, bf16_t* Y1C) {
    LAS unsigned char* Aimg = F.lds; LAS unsigned char* Bimg = F.lds + 65536;
    LAS float* rstd = (LAS float*)(F.lds + 131072); LAS f32x2* tw = (LAS f32x2*)(F.lds + 131584); LAS float* gm = (LAS float*)(F.lds + 132608); LAS float* shv = (LAS float*)(F.lds + 136704);
    const bf16_t* F1 = (const bf16_t*)(p.ws + WS_TAB + TAB_F1); const float2* TW = (const float2*)(p.ws + WS_TAB + TAB_TW); const float2* TWC = (const float2*)(p.ws + WS_TAB + TAB_TWC);
    const int tid = F.tid, lane = F.lane, wave = F.wave, r32 = lane & 31, hi = lane >> 5;
    __syncthreads();
    for (int qq = tid; qq < 256 * 16; qq += 512) { const int row = qq >> 4, ch = qq & 15; *(LAS u32x4*)(Aimg + off_b(row, ch)) = *(const u32x4*)(F1 + row * 128 + ch * 8); }
    for (int w = F.vcu; w < 288; w += F.G) {
        const int u = w < 256 ? w : 256 + ((w - 256) >> 2), c_lo = w < 256 ? 0 : (w - 256) & 3, c_hi = w < 256 ? 4 : c_lo + 1;
        const bool lat = u < 256; const int b = lat ? u >> 6 : (u - 256) >> 1, n2 = lat ? u & 63 : (u - 256) & 1;
        const float* xs = lat ? xl + ((size_t)b * SEQ + n2) * DM : xc + ((size_t)b * CTXL + n2) * DM; const size_t rstride = (size_t)(lat ? 64 : 2) * DM;
        const float* mp = mod + (size_t)(lat ? b : 4) * NMOD * DM;
        __syncthreads();
        for (int c = tid; c < DM; c += 512) { gm[c] = g[c] * (1.f + mp[DM + c]); shv[c] = mp[c]; }
        if (tid < 128) { const float2 t = lat ? TW[n2 * 128 + tid] : TWC[n2 * 128 + tid]; tw[tid] = (f32x2){t.x, t.y}; }
#pragma unroll 4
        for (int i = 0; i < 16; ++i) { const int n1 = 16 * wave + i; const float* xr = xs + n1 * rstride; float sq = 0.f;
#pragma unroll
            for (int j = 0; j < 4; ++j) { const f32x4 v = *(const f32x4*)(xr + 4 * (lane + 64 * j)); sq += (v[0] * v[0] + v[1] * v[1]) + (v[2] * v[2] + v[3] * v[3]); }
            sq = wave_sum(sq); if (lane == 0) rstd[n1] = rsqrtf(sq * (1.f / DM) + EPS); }
        __syncthreads();
        for (int cc = c_lo; cc < c_hi; ++cc) {
            { const int tt = fresh_tid(wave); const int cols4 = tt & 63, rb = tt >> 6, c0 = 256 * cc + 4 * cols4;
              f32x4 xv[16];
#pragma unroll
              for (int i = 0; i < 16; ++i) xv[i] = *(const f32x4*)(xs + (size_t)(rb + 8 * i) * rstride + c0);
              const f32x4 gv = *(const LAS f32x4*)(gm + c0), sv = *(const LAS f32x4*)(shv + c0);
              LAS unsigned char* bw = Bimg + (cols4 >> 5) * 32768 + 8 * (cols4 & 1);
#pragma unroll
              for (int i = 0; i < 16; ++i) { const int n1 = rb + 8 * i; const f32x4 h = xv[i] * rstd[n1] * gv + sv; u32x2 o; o.x = pk2(h[0], h[1]); o.y = pk2(h[2], h[3]);
                  *(LAS u32x2*)(bw + off_b(n1, (cols4 & 31) >> 1)) = o; } }
            __syncthreads();
            f32x16 acc[8];
#pragma unroll
            for (int mb = 0; mb < 8; ++mb) acc[mb] = (f32x16){};
            dft_mma<8>(Aimg, Bimg, wave, lane, acc);
            __syncthreads();
            bf16_t* Y = lat ? Y1 : Y1C; const size_t k1stride = (size_t)(lat ? 128 : 4) * DM;
            const size_t ybase = (lat ? ((size_t)b * 128 * 64 + n2) * 2 : ((size_t)b * 128 * 2 + n2) * 2) * DM + 256 * cc;
            LAS bf16_t* ost = (LAS bf16_t*)Bimg + (4 * hi) * 256 + 32 * wave + r32;
#pragma unroll
            for (int hf = 0; hf < 2; ++hf) {
#pragma unroll
                for (int mb = 0; mb < 4; ++mb)
#pragma unroll
                    for (int r = 0; r < 16; r += 2) { const int k1 = (32 * (4 * hf + mb) + crow(r, hi)) >> 1; const f32x2 t = tw[k1]; const float re = acc[4 * hf + mb][r], im = acc[4 * hf + mb][r + 1];
                        ost[(32 * mb + (r & 3) + 8 * (r >> 2)) * 256] = (bf16_t)f2bf(re * t.x - im * t.y); ost[(32 * mb + (r & 3) + 8 * (r >> 2) + 1) * 256] = (bf16_t)f2bf(re * t.y + im * t.x);
                        if ((r & 7) == 6) asm volatile("" ::: "memory"); }
                __syncthreads();
                const int t2 = fresh_tid(wave);
#pragma unroll
                for (int i = 0; i < 8; ++i) { const int qq = t2 + 512 * i, row = qq >> 5, ch = qq & 31;
                    const u32x4 v = *(const LAS u32x4*)((const LAS unsigned char*)Bimg + row * 512 + ch * 16);
                    const int k1 = 64 * hf + (row >> 1);
                    *(u32x4*)(Y + ybase + (size_t)k1 * k1stride + (size_t)(row & 1) * DM + ch * 8) = v; }
                __syncthreads();
            }
        }
    }
}
__device__ __forceinline__ void s2_phase(const Prm& p, Frame& F, const bf16_t* Y1, const bf16_t* Y1C, bf16_t* PQ) {
    LAS unsigned char* Aimg = F.lds; LAS unsigned char* Bimg = F.lds + 65536;
    const bf16_t* F2 = (const bf16_t*)(p.ws + WS_TAB + TAB_F2);
    const int tid = F.tid, lane = F.lane, wave = F.wave, r32 = lane & 31, hi = lane >> 5;
    __syncthreads();
    for (int qq = tid; qq < 128 * 16; qq += 512) { const int row = qq >> 4, ch = qq & 15; *(LAS u32x4*)(Aimg + off_b(row, ch)) = *(const u32x4*)(F2 + row * 128 + ch * 8); }
    u32x4 v[8];
    { const int u = F.vcu; if (u < 2048) { const int cc = u & 3, k1 = (u >> 2) & 127, b = u >> 9; const bf16_t* src = Y1 + ((size_t)b * 128 + k1) * 128 * DM + 256 * cc;
#pragma unroll
        for (int i = 0; i < 8; ++i) { const int qq = tid + 512 * i; v[i] = *(const u32x4*)(src + (size_t)(qq >> 5) * DM + (qq & 31) * 8); } } }
    for (int u = F.vcu; u < 2048; u += F.G) {
        const int cc = u & 3, k1 = (u >> 2) & 127, b = u >> 9;
        __syncthreads();
#pragma unroll
        for (int i = 0; i < 8; ++i) { const int qq = tid + 512 * i, row = qq >> 5, ch32 = qq & 31; *(LAS u32x4*)(Bimg + (ch32 >> 4) * 32768 + off_b(row, ch32 & 15)) = v[i]; }
        __syncthreads();
        { const int un = u + F.G; if (un < 2048) { const int ccn = un & 3, k1n = (un >> 2) & 127, bn = un >> 9; const bf16_t* src = Y1 + ((size_t)bn * 128 + k1n) * 128 * DM + 256 * ccn;
#pragma unroll
            for (int i = 0; i < 8; ++i) { const int qq = tid + 512 * i; v[i] = *(const u32x4*)(src + (size_t)(qq >> 5) * DM + (qq & 31) * 8); } } }
        f32x16 acc[4];
#pragma unroll
        for (int mb = 0; mb < 4; ++mb) acc[mb] = (f32x16){};
        dft_mma<4>(Aimg, Bimg, wave, lane, acc);
        __syncthreads();
        { LAS bf16_t* ost = (LAS bf16_t*)Bimg + (4 * hi) * 256 + 32 * wave + r32;
#pragma unroll
          for (int mb = 0; mb < 4; ++mb)
#pragma unroll
              for (int r = 0; r < 16; ++r) ost[(32 * mb + (r & 3) + 8 * (r >> 2)) * 256] = (bf16_t)f2bf(acc[mb][r]); }
        __syncthreads();
        { const int t2 = fresh_tid(wave);
#pragma unroll
          for (int i = 0; i < 8; ++i) { const int qq = t2 + 512 * i, row = qq >> 5, ch = qq & 31, k2 = row >> 1, cp = row & 1;
              const u32x4 o = *(const LAS u32x4*)((const LAS unsigned char*)Bimg + row * 512 + ch * 16);
              *(u32x4*)(PQ + ((size_t)b * SEQ + k1 + 128 * k2) * 2048 + cp * DM + 256 * cc + ch * 8) = o; } }
    }
    { const int gt = F.vcu * 512 + fresh_tid(wave), NT = F.G * 512; const float sc = 0.70710678118654752f;
      for (int i = gt; i < NB * 128 * DM; i += NT) { const int ch = i & (DM - 1), k1 = (i >> 10) & 127, b = i >> 17;
          const bf16_t* y = Y1C + ((size_t)b * 128 + k1) * 4 * DM + ch;
          const float y0r = __uint_as_float((unsigned)y[0] << 16), y0i = __uint_as_float((unsigned)y[DM] << 16), y1r = __uint_as_float((unsigned)y[2 * DM] << 16), y1i = __uint_as_float((unsigned)y[3 * DM] << 16);
          bf16_t* o0 = PQ + ((size_t)TL + b * CTXL + k1) * 2048 + ch; bf16_t* o1 = o0 + (size_t)128 * 2048;
          o0[0] = (bf16_t)f2bf((y0r + y1r) * sc); o0[DM] = (bf16_t)f2bf((y0i + y1i) * sc); o1[0] = (bf16_t)f2bf((y0r - y1r) * sc); o1[DM] = (bf16_t)f2bf((y0i - y1i) * sc); } }
}

__device__ __forceinline__ void attn_phase(const Prm& p, Frame& F, const bf16_t* QB, const bf16_t* KB, const bf16_t* VB, bf16_t* OB, const float* sinks, int nunits) {
    LAS unsigned char* Ks = F.lds; LAS unsigned char* Vs = F.lds + 8192; LAS float* wsf = (LAS float*)(F.lds + 32768) + F.wave * 64; LAS bf16_t* stg = (LAS bf16_t*)(F.lds + 34816 + F.wave * 4096);
    const int lane = F.lane, wave = F.wave, r32 = lane & 31, hi = lane >> 5;
    for (int u = F.vcu; u < nunits; u += F.G) {
        const bool isctx = u >= 2048; const int uu = isctx ? u - 2048 : u;
        const int pb = isctx ? (uu & 3) : (uu & 127), kv = isctx ? ((uu >> 2) & 3) : ((uu >> 7) & 3), b = isctx ? (uu >> 4) : (uu >> 9);
        const int h = kv * 4 + (wave >> 1); const int qq = 32 * (wave & 1) + r32;
        const size_t qrow0 = (size_t)(isctx ? TL + b * CTXL : b * SEQ) + 64 * pb + 32 * (wave & 1);
        bf16x8 qr[4];
#pragma unroll
        for (int d0 = 0; d0 < 4; ++d0) qr[d0] = *(const bf16x8*)(QB + (qrow0 + r32) * DM + h * 64 + d0 * 16 + hi * 8);
        float m = sinks[h] * LOG2E, l = hi ? 0.f : 1.f; f32x16 o[2]; o[0] = (f32x16){}; o[1] = (f32x16){};
        const int ntl = isctx ? 0 : 5;
        const int t_first = isctx ? 0 : (pb < 2 ? 2 - pb : 0), t_lastl = isctx ? -1 : (pb > 125 ? 129 - pb : 4);
        const bf16_t* kbase = KB + (size_t)lane * 256 + kv * 64 + wave * 8;
        const bf16_t* vbase = VB + (size_t)(16 * (wave & 3) + (lane >> 2)) * 256 + kv * 64 + (wave >> 2) * 32 + (lane & 3) * 8;
        auto tile_row0 = [&](int ti) -> size_t { return ti < ntl ? (size_t)b * SEQ + 64 * (pb - 2 + ti) : (size_t)TL + b * CTXL + 64 * (ti - ntl); };
        int ti = isctx ? 0 : t_first; int slot = 0;
        u32x4 kreg = *(const u32x4*)(kbase + tile_row0(ti) * 256), vreg = *(const u32x4*)(vbase + tile_row0(ti) * 256);
        __syncthreads();
        *(LAS u32x4*)(Ks + wave * 1024 + lane * 16) = kreg; *(LAS u32x4*)(Vs + wave * 1024 + lane * 16) = vreg;
        { int tn0 = ti + 1; if (tn0 > t_lastl && tn0 < ntl) tn0 = ntl; kreg = *(const u32x4*)(kbase + tile_row0(tn0) * 256); vreg = *(const u32x4*)(vbase + tile_row0(tn0) * 256); }
        __syncthreads();
        while (ti < ntl + 4) {
            const int mode = (ti < ntl) ? ((ti == 0) ? 1 : (ti == 4) ? 2 : 0) : 0;
            int tn = ti + 1; if (tn > t_lastl && tn < ntl) tn = ntl;
            int tnn = tn + 1; if (tnn > t_lastl && tnn < ntl) tnn = ntl;
            const LAS unsigned char* kb = Ks + slot * 16384 + hi * 1024 + r32 * 16;
            const LAS unsigned char* vp = Vs + slot * 16384 + ((lane >> 4) & 1) * 32 + (lane & 3) * 8 + (4 * hi + ((lane & 15) >> 2)) * 64;
            f32x16 p0 = (f32x16){}, p1 = (f32x16){};
#pragma unroll
            for (int d0 = 0; d0 < 4; ++d0) { const bf16x8 b0 = *(const LAS bf16x8*)(kb + d0 * 2048), b1 = *(const LAS bf16x8*)(kb + d0 * 2048 + 512);
                p0 = __builtin_amdgcn_mfma_f32_32x32x16_bf16(b0, qr[d0], p0, 0, 0, 0); p1 = __builtin_amdgcn_mfma_f32_32x32x16_bf16(b1, qr[d0], p1, 0, 0, 0); }
            if (mode) {
#pragma unroll
                for (int r = 0; r < 16; ++r) { const int kk = crow(r, hi); const bool m0 = (mode == 1) ? (kk < qq) : (kk > qq), m1 = (mode == 1) ? (kk + 32 < qq) : (kk + 32 > qq);
                    if (m0) p0[r] = -INFINITY; if (m1) p1[r] = -INFINITY; } }
            float rm = fmaxf(p0[0], p1[0]);
#pragma unroll
            for (int r = 1; r < 16; ++r) rm = fmaxf(rm, fmaxf(p0[r], p1[r]));
            { auto rr = __builtin_amdgcn_permlane32_swap(__float_as_uint(rm), __float_as_uint(rm), false, false); rm = fmaxf(__uint_as_float(rr[0]), __uint_as_float(rr[1])); }
            const float mnew = fmaxf(m, rm), alpha = __builtin_amdgcn_exp2f(m - mnew); m = mnew;
            float ps = 0.f;
#pragma unroll
            for (int r = 0; r < 16; ++r) { p0[r] = __builtin_amdgcn_exp2f(p0[r] - m); p1[r] = __builtin_amdgcn_exp2f(p1[r] - m); ps += p0[r] + p1[r]; }
            l = l * alpha + ps;
            if (hi == 0) wsf[r32] = alpha;
#pragma unroll
            for (int r = 0; r < 16; ++r) { const float a = wsf[crow(r, hi)]; o[0][r] *= a; o[1][r] *= a; }
            u32x4 pw[4];
            pw[0] = (u32x4){pk2(p0[0], p0[1]), pk2(p0[2], p0[3]), pk2(p0[4], p0[5]), pk2(p0[6], p0[7])};
            pw[1] = (u32x4){pk2(p0[8], p0[9]), pk2(p0[10], p0[11]), pk2(p0[12], p0[13]), pk2(p0[14], p0[15])};
            pw[2] = (u32x4){pk2(p1[0], p1[1]), pk2(p1[2], p1[3]), pk2(p1[4], p1[5]), pk2(p1[6], p1[7])};
            pw[3] = (u32x4){pk2(p1[8], p1[9]), pk2(p1[10], p1[11]), pk2(p1[12], p1[13]), pk2(p1[14], p1[15])};
#pragma unroll
            for (int d0 = 0; d0 < 2; ++d0)
#pragma unroll
                for (int ks = 0; ks < 4; ++ks) { const s16x4 lo = trrd(vp + d0 * 4096 + ks * 1024), hh = trrd(vp + d0 * 4096 + ks * 1024 + 512);
                    const bf16x8 vf = (bf16x8){lo[0], lo[1], lo[2], lo[3], hh[0], hh[1], hh[2], hh[3]};
                    o[d0] = __builtin_amdgcn_mfma_f32_32x32x16_bf16(__builtin_bit_cast(bf16x8, pw[ks]), vf, o[d0], 0, 0, 0); }
            if (tn < ntl + 4) {
                *(LAS u32x4*)(Ks + (slot ^ 1) * 16384 + wave * 1024 + lane * 16) = kreg; *(LAS u32x4*)(Vs + (slot ^ 1) * 16384 + wave * 1024 + lane * 16) = vreg;
                if (tnn < ntl + 4) { kreg = *(const u32x4*)(kbase + tile_row0(tnn) * 256); vreg = *(const u32x4*)(vbase + tile_row0(tnn) * 256); }
                __syncthreads(); }
            ti = tn; slot ^= 1;
        }
        { auto rr = __builtin_amdgcn_permlane32_swap(__float_as_uint(l), __float_as_uint(l), false, false); l = __uint_as_float(rr[0]) + __uint_as_float(rr[1]); }
        if (hi == 0) wsf[32 + r32] = l;
#pragma unroll
        for (int r = 0; r < 16; ++r) { const int orow = crow(r, hi); const float rl = __builtin_amdgcn_rcpf(wsf[32 + orow]);
            stg[orow * 64 + r32] = (bf16_t)f2bf(o[0][r] * rl); stg[orow * 64 + 32 + r32] = (bf16_t)f2bf(o[1][r] * rl); }
#pragma unroll
        for (int i = 0; i < 4; ++i) { const int row = i * 8 + (lane >> 3), ch = lane & 7; const u32x4 v = *(const LAS u32x4*)(stg + row * 64 + ch * 8);
            *(u32x4*)(OB + (qrow0 + row) * DM + h * 64 + ch * 8) = v; }
    }
}


__device__ __forceinline__ int next_real(int ph) { int q = ph + 1; if (q >= 1 && q <= 32) { const int i = (q - 1) >> 3, o = (q - 1) & 7; if ((i & 1) == 0 && o >= 6) q = 1 + 8 * (i + 1); } return q; }
__global__ void __launch_bounds__(512, 2) mk_fwd(Args a) {
    extern __shared__ __attribute__((aligned(16))) unsigned char lds_raw[];
    Frame F; F.lds = (LAS unsigned char*)lds_raw; F.MISC = (volatile LAS unsigned*)(F.lds + LDS_MISC);
    F.tid = threadIdx.x; F.lane = F.tid & 63; F.wave = __builtin_amdgcn_readfirstlane(F.tid >> 6);
    F.G = gridDim.x; { const int bx = blockIdx.x; F.vcu = (F.G % 8 == 0) ? (bx % 8) * (F.G / 8) + bx / 8 : bx; }
    const Prm& p = a.p; GAS unsigned char* ws = (GAS unsigned char*)a.p.ws;
    for (int u = F.tid; u < 128; u += 512) F.MISC[u] = 0u;
    __syncthreads();
    unsigned* ctl = (unsigned*)(ws + WS_CTL);
    XcdBarrier bar = xcd_barrier_post(ctl + CW_BAR, F.MISC + 8);
    const int lo = a.ph_lo, hi = a.ph_hi;
    const int wave0 = __builtin_amdgcn_readfirstlane((int)threadIdx.x >> 6);
#ifndef ONLY
#define ONLY -1
#endif
#ifndef PROBE_KIND
#define PROBE_KIND -1
#endif
#ifndef PROBE_GEMMS
#define PROBE_GEMMS 0
#endif
#define NREP(k) (((k) == PROBE_KIND) || (PROBE_GEMMS && ((k) == 3 || (k) == 5 || (k) == 6 || (k) == 7 || (k) == 9 || (k) == 11 || (k) == 12)) ? 2 : 1)
#define EN(k) (ONLY == -1 || ONLY == (k))
#define RUN(ph) (lo <= (ph) && (ph) < hi)
#define SEAM(ph) do { if (next_real(ph) < hi) xcd_barrier(bar); } while (0)
#define FRESH() do { const int t_ = fresh_tid(wave0);     F.tid = t_; F.lane = t_ & 63; F.wave = __builtin_amdgcn_readfirstlane(t_ >> 6); asm volatile("" : "+s"(ws)); } while (0)
    const int cblk = (int)blockIdx.x;
#define WSP(T, off) ((T*)(GAS T*)(ws + (off)))
#define SKCTL(slots_off, ph) pg8::SkCtl{WSP(f32x4, slots_off), WSP(unsigned, WS_CTL) + CW_SKF, WSP(unsigned, WS_CTL) + CW_BAR + XB_TMO, (unsigned)((ph) * 4 + rep + 1), cblk, F.G}
    for (int rep = 0; rep < NREP(0); ++rep) if (EN(0) && RUN(0)) { FRESH(); p0_prologue(p, F); SEAM(0); }

    for (int lp = 0; lp < 2; ++lp) {
        const int ie = 2 * lp, io = 2 * lp + 1, j = lp;
        { const int base = 1 + 8 * ie;
          for (int rep = 0; rep < NREP(1); ++rep) if (EN(1) && RUN(base + 0)) { FRESH(); s1_phase(p, F, ie == 0 ? p.x : p.out, ie == 0 ? p.ctx : WSP(const float, WS_XC), p.nmg + ie * DM, WSP(const float, WS_MOD) + (size_t)ie * 5 * NMOD * DM,
                                                  WSP(bf16_t, WS_MS + MS_BIG + BIG_Y1), WSP(bf16_t, WS_MS + MS_BIG + BIG_Y1C)); SEAM(base + 0); }
          for (int rep = 0; rep < NREP(2); ++rep) if (EN(2) && RUN(base + 1)) { FRESH(); s2_phase(p, F, WSP(const bf16_t, WS_MS + MS_BIG + BIG_Y1), WSP(const bf16_t, WS_MS + MS_BIG + BIG_Y1C), WSP(bf16_t, WS_MS + MS_BIG + BIG_PQ)); SEAM(base + 1); }
          for (int rep = 0; rep < NREP(3); ++rep) if (EN(3) && RUN(base + 2)) { FRESH(); SchedDense<true> S{WSP(const bf16_t, WS_W + j * WE_STRIDE + WE_F), TT / 256, DM / 256, F.G, cblk, 2048};
              EpiResid E{ie == 0 ? p.x : p.out, ie == 0 ? p.ctx : WSP(const float, WS_XC), p.out, WSP(float, WS_XC), WSP(const float, WS_MOD) + (size_t)ie * 5 * NMOD * DM, 2, rep ? 0.f : 1.f};
              pg8::gemm_phase<EpiResid, SchedDense<true>, false>(F.lds, F.tid, WSP(const bf16_t, WS_MS + MS_BIG + BIG_PQ), 2048, S, E, SKCTL(WS_MS + MS_HB, base + 2)); SEAM(base + 2); }
          for (int rep = 0; rep < NREP(4); ++rep) if (EN(4) && RUN(base + 3)) { FRESH(); norm_phase<false>(p, F, p.out, WSP(const float, WS_XC), p.nfg + ie * DM, WSP(const float, WS_MOD) + (size_t)ie * 5 * NMOD * DM, 3, WSP(bf16_t, WS_MS + MS_HB), TT, nullptr, nullptr, nullptr, nullptr); SEAM(base + 3); }
          for (int rep = 0; rep < NREP(5); ++rep) if (EN(5) && RUN(base + 4)) { FRESH(); SchedDense<false> S{WSP(const bf16_t, WS_W + j * WE_STRIDE + WE_GU), TT / 256, 2 * DFF / 256, F.G, cblk, DM}; EpiSwiglu E{WSP(bf16_t, WS_MS + MS_BIG + BIG_ACT)};
              pg8::gemm_phase<EpiSwiglu, SchedDense<false>, false>(F.lds, F.tid, WSP(const bf16_t, WS_MS + MS_HB), DM, S, E); SEAM(base + 4); }
          for (int rep = 0; rep < NREP(6); ++rep) if (EN(6) && RUN(base + 5)) { FRESH(); SchedDense<true> S{WSP(const bf16_t, WS_W + j * WE_STRIDE + WE_D), TT / 256, DM / 256, F.G, cblk, DFF};
              EpiResid E{p.out, WSP(const float, WS_XC), p.out, WSP(float, WS_XC), WSP(const float, WS_MOD) + (size_t)ie * 5 * NMOD * DM, 5, rep ? 0.f : 1.f};
              pg8::gemm_phase<EpiResid, SchedDense<true>, false>(F.lds, F.tid, WSP(const bf16_t, WS_MS + MS_BIG + BIG_ACT), DFF, S, E, SKCTL(WS_MS + MS_HB, base + 5)); SEAM(base + 5); }
        }
        { const int base = 1 + 8 * io; const bool last = (io == DEPTH - 1); const int nrows = last ? TL : TT;
          const size_t wo = WS_W + WO_BASE + j * WO_STRIDE;
          for (int rep = 0; rep < NREP(4); ++rep) if (EN(4) && RUN(base + 0)) { FRESH(); norm_phase<false>(p, F, p.out, WSP(const float, WS_XC), p.nmg + io * DM, WSP(const float, WS_MOD) + (size_t)io * 5 * NMOD * DM, 0, WSP(bf16_t, WS_MS + MS_HB), TT, nullptr, nullptr, nullptr, nullptr); SEAM(base + 0); }
          for (int rep = 0; rep < NREP(7); ++rep) if (EN(7) && RUN(base + 1)) { FRESH(); SchedDense<true> S{WSP(const bf16_t, wo + WO_QKV), TT / 256, QKVD / 256, F.G, cblk, DM};
              EpiQKV E{WSP(bf16_t, WS_MS + MS_BIG + BIG_Q), WSP(bf16_t, WS_MS + MS_BIG + BIG_K), WSP(bf16_t, WS_MS + MS_BIG + BIG_V), WSP(const float2, WS_ROPE)};
              pg8::gemm_phase<EpiQKV, SchedDense<true>, false>(F.lds, F.tid, WSP(const bf16_t, WS_MS + MS_HB), DM, S, E, SKCTL(WS_MS + MS_BIG + 300 * MiB, base + 1)); SEAM(base + 1); }
          for (int rep = 0; rep < NREP(8); ++rep) if (EN(8) && RUN(base + 2)) { FRESH(); attn_phase(p, F, WSP(const bf16_t, WS_MS + MS_BIG + BIG_Q), WSP(const bf16_t, WS_MS + MS_BIG + BIG_K), WSP(const bf16_t, WS_MS + MS_BIG + BIG_V), WSP(bf16_t, WS_MS + MS_BIG + BIG_O), p.sinks + j * NH, last ? 2048 : 2048 + 64); SEAM(base + 2); }
          for (int rep = 0; rep < NREP(9); ++rep) if (EN(9) && RUN(base + 3)) { FRESH(); SchedDense<true> S{WSP(const bf16_t, wo + WO_O), nrows / 256, DM / 256, F.G, cblk, DM};
              EpiResid E{p.out, WSP(const float, WS_XC), p.out, WSP(float, WS_XC), WSP(const float, WS_MOD) + (size_t)io * 5 * NMOD * DM, 2, rep ? 0.f : 1.f};
              pg8::gemm_phase<EpiResid, SchedDense<true>, false>(F.lds, F.tid, WSP(const bf16_t, WS_MS + MS_BIG + BIG_O), DM, S, E, SKCTL(WS_MS + MS_HB, base + 3)); SEAM(base + 3); }
          for (int rep = 0; rep < NREP(10); ++rep) if (EN(10) && RUN(base + 4)) { FRESH(); norm_phase<true>(p, F, p.out, WSP(const float, WS_XC), p.nfg + io * DM, WSP(const float, WS_MOD) + (size_t)io * 5 * NMOD * DM, 3, WSP(bf16_t, WS_MS + MS_HB), nrows,
                                                       p.mr + (size_t)j * DM * NEXP, WSP(unsigned, WS_CTL) + CW_CNTW + 4096 * j, WSP(int, WS_ROUTE), WSP(float, WS_ROUTE) + 16 * TT); SEAM(base + 4); }
          for (int rep = 0; rep < NREP(11); ++rep) if (EN(11) && RUN(base + 5)) { FRESH(); if (rep == 0) { moe_lists(F, WSP(const unsigned, WS_CTL) + CW_CNTW + 4096 * j, WSP(unsigned, WS_CTL) + CW_MCNT + 64 * j, WSP(int, WS_ROUTE), WSP(float, WS_ROUTE) + 16 * TT, nrows, last ? WSP(int, WS_TOKSLOT) : (int*)nullptr); xcd_barrier(bar); }
              FRESH(); moe_tables(F, WSP(unsigned, WS_CTL) + CW_MCNT + 64 * j); MoeTab tab{F.MISC};
              SchedMoe<true, false> S{WSP(const bf16_t, wo + WO_EXP + WX_GU), WX_STRIDE, 2 * DFF / 256, F.G, cblk, DM, 0, (int)F.MISC[49], tab, WSP(const int, WS_ROUTE)}; EpiSwiglu E{WSP(bf16_t, WS_MS + MS_BIG + BIG_ACT)};
              pg8::gemm_phase<EpiSwiglu, SchedMoe<true, false>, true>(F.lds, F.tid, WSP(const bf16_t, WS_MS + MS_HB), DM, S, E); SEAM(base + 5); }
#pragma unroll
          for (int k = 0; k < 2; ++k)
          for (int rep = 0; rep < NREP(12); ++rep) if (EN(12) && RUN(base + 6 + k) && !last) { FRESH(); moe_tables(F, WSP(unsigned, WS_CTL) + CW_MCNT + 64 * j); MoeTab tab{F.MISC};
              const int nb0 = (int)F.MISC[48], nba = (int)F.MISC[49];
              SchedMoe<false, true> S{WSP(const bf16_t, wo + WO_EXP + WX_D), WX_STRIDE, DM / 256, F.G, cblk, DFF, k ? nb0 : 0, k ? nba - nb0 : nb0, tab, WSP(const int, WS_ROUTE)};
              EpiMoeDown E{p.out, WSP(float, WS_XC), WSP(const float, WS_MOD) + (size_t)io * 5 * NMOD * DM, WSP(const int, WS_ROUTE), WSP(const float, WS_ROUTE) + 16 * TT, rep ? 0.f : 1.f};
              pg8::gemm_phase<EpiMoeDown, SchedMoe<false, true>, false>(F.lds, F.tid, WSP(const bf16_t, WS_MS + MS_BIG + BIG_ACT), DFF, S, E, SKCTL(WS_MS + MS_HB, base + 6 + k)); SEAM(base + 6 + k); }
          for (int rep = 0; rep < NREP(14); ++rep) if (EN(12) && RUN(base + 6) && last) { FRESH(); moe_tables(F, WSP(unsigned, WS_CTL) + CW_MCNT + 64 * j); MoeTab tab{F.MISC};
              SchedMoe<false, true> S{WSP(const bf16_t, wo + WO_EXP + WX_D), WX_STRIDE, DM / 256, F.G, cblk, DFF, 0, (int)F.MISC[49], tab, WSP(const int, WS_ROUTE)};
              EpiMoeY E{WSP(bf16_t, WS_YS), WSP(const float, WS_MOD) + (size_t)io * 5 * NMOD * DM, WSP(const int, WS_ROUTE), WSP(const float, WS_ROUTE) + 16 * TT};
              pg8::gemm_phase<EpiMoeY, SchedMoe<false, true>, false>(F.lds, F.tid, WSP(const bf16_t, WS_MS + MS_BIG + BIG_ACT), DFF, S, E, SKCTL(WS_MS + MS_HB, base + 6)); SEAM(base + 7); }
        }
    }
    if (EN(13) && RUN(33)) { FRESH(); final_norm_phase(p, F, WSP(const bf16_t, WS_YS), WSP(const int, WS_TOKSLOT)); }
#undef WSP
#undef RUN
#undef SEAM
}

static int g_grid = 0;
static void mega_launch(const Prm& p, int lo, int hi, hipStream_t st) {
    if (g_grid == 0) {
        int dev = 0, cus = 0; hipGetDevice(&dev); hipDeviceGetAttribute(&cus, hipDeviceAttributeMultiprocessorCount, dev);
        if (hipFuncSetAttribute((const void*)mk_fwd, hipFuncAttributeMaxDynamicSharedMemorySize, LDS_BYTES) != hipSuccess) { fprintf(stderr, "hipFuncSetAttribute failed\n"); g_grid = -1; return; }
        int per_cu = 0; if (hipOccupancyMaxActiveBlocksPerMultiprocessor(&per_cu, (const void*)mk_fwd, 512, LDS_BYTES) != hipSuccess || per_cu < 1) fprintf(stderr, "occupancy query: %d\n", per_cu);
        (void)hipGetLastError();
        g_grid = cus & ~7;
    }
    if (g_grid < 0) return;
    hipMemsetAsync(p.ws + WS_CTL + CW_BAR * 4, 0, XCD_BAR_WORDS * 4, st);
    Args a{}; a.p = p; a.ph_lo = lo; a.ph_hi = hi;
    hipLaunchKernelGGL(mk_fwd, dim3(g_grid), dim3(512), LDS_BYTES, st, a);
}

template <class FA, class FB, class FE> static void ngemm(hipStream_t st, int Mmax, int N, int K, FA fa, FB fb, FE fe) {
    hipLaunchKernelGGL((nk_gemm<FA, FB, FE>), dim3(N / 64, (Mmax + 63) / 64), dim3(256), 0, st, Mmax, N, K, fa, fb, fe);
}

#ifndef MEGA_MASK
#define MEGA_MASK 0xFF
#endif
static void naive_forward(const Prm& p, hipStream_t st) {
    unsigned char* ws = p.ws;
    hipMemsetAsync(ws + WS_CTL, 0, 1 * MiB, st);
    if (MEGA_MASK) mega_launch(p, 0, 1, st);
    if (!(MEGA_MASK & 0x20)) {
    hipLaunchKernelGGL(nk_adaln, dim3((DEPTH * 5 * NMOD * DM + 255) / 256), dim3(256), 0, st, p);
    hipLaunchKernelGGL(nk_rope, dim3(8), dim3(256), 0, st, p); }
    hipMemcpyAsync(p.out, p.x, (size_t)TL * DM * 4, hipMemcpyDeviceToDevice, st);
    hipMemcpyAsync(ws + WS_XC, p.ctx, (size_t)TC * DM * 4, hipMemcpyDeviceToDevice, st);
    float* H = (float*)(ws + WS_S);
    unsigned char* S2 = ws + WS_S + 136 * MiB;
    for (int i = 0; i < DEPTH; ++i) {
        const int j = i / 2; const bool last = (i == DEPTH - 1);
        const int nrows = last ? TL : TT;
        const int pbase = 1 + 8 * i;
        if ((i % 2 == 0) && (MEGA_MASK & 0x08)) mega_launch(p, pbase + 0, pbase + 3, st);
        else if ((i % 2 == 1) && (MEGA_MASK & 0x04)) mega_launch(p, pbase + 0, pbase + 4, st);
        else {
        hipLaunchKernelGGL(nk_norm_mod, dim3(TT), dim3(256), 0, st, p, p.nmg + i * DM, i, 0, H, TT);
        if (i % 2 == 0) {
            float2* Y1 = (float2*)S2;
            float2* Z = (float2*)(S2 + 64 * MiB);
            for (int b = 0; b < NB; ++b) {
                hipLaunchKernelGGL(nk_fft_s1, dim3(SEQ * DM / 256), dim3(256), 0, st, H, b, Y1);
                hipLaunchKernelGGL(nk_fft_s2, dim3(SEQ * DM / 256), dim3(256), 0, st, Y1, b, Z);
            }
            hipLaunchKernelGGL(nk_dft_ctx, dim3(TC * DM / 256), dim3(256), 0, st, H, Z);
            hipLaunchKernelGGL(nk_chan_dft, dim3(TT * (DM / 256)), dim3(256), 0, st, Z, H);
            ngemm(st, nrows, DM, DM, ADense{H, DM, nrows}, BDense{p.fw + (size_t)j * DM * DM, DM, 0}, EResid{p, i, 2, 0, nrows});
        } else {
            float* QKV = (float*)S2;
            ngemm(st, TT, QKVD, DM, ADense{H, DM, TT}, BDense{p.wqkv + (size_t)j * DM * QKVD, QKVD, 0}, EStore{QKV, QKVD, TT});
            hipLaunchKernelGGL(nk_rope_apply, dim3((unsigned)(((size_t)TL * 640 + 255) / 256)), dim3(256), 0, st, p, QKV);
            hipLaunchKernelGGL(nk_attn, dim3((unsigned)(((size_t)nrows * NH + 63) / 64)), dim3(64), 0, st, p, QKV, p.sinks + j * NH, H, nrows);
            ngemm(st, nrows, DM, DM, ADense{H, DM, nrows}, BDense{p.wo + (size_t)j * DM * DM, DM, 0}, EResid{p, i, 2, 0, nrows});
        } }
        if ((i % 2 == 0) && (MEGA_MASK & 0x01)) { mega_launch(p, pbase + 3, pbase + 6, st); continue; }
        if ((i % 2 == 1) && (MEGA_MASK & 0x02)) { mega_launch(p, pbase + 4, pbase + 8, st); continue; }
        hipLaunchKernelGGL(nk_norm_mod, dim3(nrows), dim3(256), 0, st, p, p.nfg + i * DM, i, 3, H, nrows);
        constexpr int CH = 8448;
        float* ACT = (float*)S2;
        if (i % 2 == 0) {
            for (int r0 = 0; r0 < nrows; r0 += CH) {
                const int m = nrows - r0 < CH ? nrows - r0 : CH;
                ngemm(st, m, DFF, DM, ADense{H + (size_t)r0 * DM, DM, m}, BDense{p.fg + (size_t)j * DM * DFF, DFF, 0}, ESilu{ACT, DFF, m});
                ngemm(st, m, DFF, DM, ADense{H + (size_t)r0 * DM, DM, m}, BDense{p.fu + (size_t)j * DM * DFF, DFF, 0}, EMulInto{ACT, DFF, m});
                ngemm(st, m, DM, DFF, ADense{ACT, DFF, m}, BDense{p.fd + (size_t)j * DFF * DM, DM, 0}, EResid{p, i, 5, r0, m});
            }
        } else {
            int* cnt = (int*)(ws + WS_CTL) + 1024 + 64 * i;
            int* ltok = (int*)(ws + WS_ROUTE); float* lw = (float*)(ltok + NEXP * TT); int* lk = (int*)(lw + NEXP * TT);
            float* Y0 = (float*)(S2 + 120 * MiB); float* Y1 = Y0 + (size_t)TT * DM;
            hipLaunchKernelGGL(nk_router, dim3((nrows + 255) / 256), dim3(256), 0, st, p, H, p.mr + (size_t)j * DM * NEXP, nrows, cnt, ltok, lw, lk);
            for (int e = 0; e < NEXP; ++e) {
                const size_t we = ((size_t)j * NEXP + e) * DM * DFF;
                for (int r0 = 0; r0 < nrows; r0 += CH) {
                    ngemm(st, CH, DFF, DM, AGather{H, ltok + e * TT, cnt + e, r0, CH}, BDense{p.mg + we, DFF, 0}, ESiluCnt{ACT, cnt + e, DFF, r0, CH, 0});
                    ngemm(st, CH, DFF, DM, AGather{H, ltok + e * TT, cnt + e, r0, CH}, BDense{p.mu + we, DFF, 0}, EMulCnt{ACT, cnt + e, DFF, r0, CH, 0});
                    ngemm(st, CH, DM, DFF, ADenseCnt{ACT, cnt + e, DFF, r0, CH, 0}, BDense{p.md + we, DM, 0}, EScatterY{Y0, Y1, ltok + e * TT, lw + e * TT, lk + e * TT, cnt + e, r0, CH});
                }
            }
            hipLaunchKernelGGL(nk_moe_combine, dim3((unsigned)(((size_t)nrows * DM + 255) / 256)), dim3(256), 0, st, p, Y0, Y1, i, nrows);
        }
    }
    if (MEGA_MASK & 0x10) mega_launch(p, 33, 34, st); else hipLaunchKernelGGL(nk_final_norm, dim3(TL), dim3(256), 0, st, p);
}

extern "C" void kernel_launch(void* const* d_in, const int* in_sizes, int n_in, void* d_out, int out_size, void* d_ws, size_t ws_size, hipStream_t stream) {
    if (n_in != 20 || out_size != TL * DM || ws_size < WS_MEGA_END) { fprintf(stderr, "kernel_launch: unexpected shapes n_in %d out %d ws %zu\n", n_in, out_size, ws_size); return; }
    Prm p{};
    const float** f = (const float**)&p;
    for (int i = 0; i < 20; ++i) f[i] = (const float*)d_in[i];
    p.out = (float*)d_out; p.ws = (unsigned char*)d_ws;
    if (MEGA_MASK == 0xFF) {
        hipMemsetAsync(p.ws + WS_CTL, 0, 1 * MiB, stream);
        mega_launch(p, 0, 34, stream);
    } else naive_forward(p, stream);
}
```

```cpp
#include <hip/hip_runtime.h>
#include <cstdio>
#include <cstdint>
#include <cmath>

constexpr int DM = 1024, NB = 4, SEQ = 8192, DEPTH = 4, CTXL = 256;
constexpr int TL = NB * SEQ;
constexpr int TC = NB * CTXL;
constexpr int TT = TL + TC;
constexpr int NMOD = 6, DFF = 3584, NEXP = 8, QKVD = 1536, NH = 16, NKV = 4, HD = 64;
constexpr int FN1 = 128, FN2 = 64;
constexpr float EPS = 1e-6f;

constexpr size_t MiB = 1ull << 20;
constexpr size_t WS_CTL = 0;
constexpr size_t WS_MOD = 1 * MiB;
constexpr size_t WS_ROPE = 2 * MiB;
constexpr size_t WS_XC = 3 * MiB;
constexpr size_t WS_ROUTE = 8 * MiB;
constexpr size_t WS_S = 416 * MiB;

struct Prm {
    const float *x, *c, *ctx, *c_ctx, *ada_w, *ada_b, *nmg, *nfg, *fw, *wqkv, *wo, *sinks, *fg, *fu, *fd, *mr, *mg, *mu, *md, *fng;
    float* out; unsigned char* ws;
};

__device__ __forceinline__ float silu_f(float v) { return v / (1.f + expf(-v)); }
__device__ __forceinline__ int row_b5(int r) { return r < TL ? r / SEQ : 4; }
__device__ __forceinline__ float* xrow(const Prm& p, int r) { return r < TL ? p.out + (size_t)r * DM : (float*)(p.ws + WS_XC) + (size_t)(r - TL) * DM; }

__global__ void nk_adaln(Prm p) {
    const int idx = blockIdx.x * blockDim.x + threadIdx.x;
    if (idx >= DEPTH * 5 * NMOD * DM) return;
    const int n = idx % (NMOD * DM), r = (idx / (NMOD * DM)) % 5, l = idx / (5 * NMOD * DM);
    const float* cv = r < 4 ? p.c + r * DM : p.c_ctx;
    const float* w = p.ada_w + (size_t)l * DM * NMOD * DM;
    float acc = 0.f;
    for (int k = 0; k < DM; ++k) acc += silu_f(cv[k]) * w[(size_t)k * NMOD * DM + n];
    ((float*)(p.ws + WS_MOD))[idx] = acc + p.ada_b[l * NMOD * DM + n];
}
__global__ void nk_rope(Prm p) {
    const int idx = blockIdx.x * blockDim.x + threadIdx.x;
    if (idx >= 128 * 16) return;
    const int pos = idx / 16, f = idx % 16;
    const float inv = powf(10000.f, -(float)f / 16.f);
    const float ang = (float)pos * inv;
    ((float2*)(p.ws + WS_ROPE))[idx] = make_float2((float)cos((double)ang), (float)sin((double)ang));
}
__global__ void nk_norm_mod(Prm p, const float* g, int layer, int which  , float* H, int nrows) {
    const int r = blockIdx.x; if (r >= nrows) return;
    const float* xr = xrow(p, r);
    __shared__ float red[256];
    float s = 0.f;
    for (int c = threadIdx.x; c < DM; c += 256) { const float v = xr[c]; s += v * v; }
    red[threadIdx.x] = s; __syncthreads();
    for (int o = 128; o > 0; o >>= 1) { if (threadIdx.x < o) red[threadIdx.x] += red[threadIdx.x + o]; __syncthreads(); }
    const float rstd = rsqrtf(red[0] / DM + EPS);
    const float* mod = (const float*)(p.ws + WS_MOD) + ((size_t)layer * 5 + row_b5(r)) * NMOD * DM;
    for (int c = threadIdx.x; c < DM; c += 256) H[(size_t)r * DM + c] = xr[c] * rstd * g[c] * (1.f + mod[(which + 1) * DM + c]) + mod[which * DM + c];
}
__global__ void nk_final_norm(Prm p) {
    const int r = blockIdx.x;
    float* xr = p.out + (size_t)r * DM;
    __shared__ float red[256];
    float s = 0.f;
    for (int c = threadIdx.x; c < DM; c += 256) { const float v = xr[c]; s += v * v; }
    red[threadIdx.x] = s; __syncthreads();
    for (int o = 128; o > 0; o >>= 1) { if (threadIdx.x < o) red[threadIdx.x] += red[threadIdx.x + o]; __syncthreads(); }
    const float rstd = rsqrtf(red[0] / DM + EPS);
    for (int c = threadIdx.x; c < DM; c += 256) xr[c] = xr[c] * rstd * p.fng[c];
}
template <class FA, class FB, class FE>
__global__ void __launch_bounds__(256) nk_gemm(int M, int N, int K, FA fa, FB fb, FE fe) {
    __shared__ float As[16][68], Bs[16][68];
    const int m0 = blockIdx.y * 64, n0 = blockIdx.x * 64;
    if (m0 >= fa.rows()) return;
    const int t = threadIdx.x, tx = t % 16, ty = t / 16;
    float acc[4][4] = {};
    for (int k0 = 0; k0 < K; k0 += 16) {
        { const int m = t / 4, kq = (t % 4) * 4;
#pragma unroll
          for (int i = 0; i < 4; ++i) As[kq + i][m] = fa(m0 + m, k0 + kq + i); }
        { const int k = t / 16, nq = (t % 16) * 4;
#pragma unroll
          for (int i = 0; i < 4; ++i) Bs[k][nq + i] = fb(k0 + k, n0 + nq + i); }
        __syncthreads();
#pragma unroll
        for (int kk = 0; kk < 16; ++kk) {
            float a[4], b[4];
#pragma unroll
            for (int i = 0; i < 4; ++i) { a[i] = As[kk][ty * 4 + i]; b[i] = Bs[kk][tx * 4 + i]; }
#pragma unroll
            for (int i = 0; i < 4; ++i)
#pragma unroll
                for (int j = 0; j < 4; ++j) acc[i][j] += a[i] * b[j];
        }
        __syncthreads();
    }
#pragma unroll
    for (int i = 0; i < 4; ++i)
#pragma unroll
        for (int j = 0; j < 4; ++j) fe(m0 + ty * 4 + i, n0 + tx * 4 + j, acc[i][j]);
}
struct ADense { const float* A; int lda, M; __device__ int rows() const { return M; } __device__ float operator()(int m, int k) const { return m < M ? A[(size_t)m * lda + k] : 0.f; } };
struct BDense { const float* B; int ldb, pad; __device__ float operator()(int k, int n) const { return B[(size_t)k * ldb + n]; } };
struct EStore { float* C; int ldc, M; __device__ void operator()(int m, int n, float v) const { if (m < M) C[(size_t)m * ldc + n] = v; } };
struct ESilu { float* C; int ldc, M; __device__ void operator()(int m, int n, float v) const { if (m < M) C[(size_t)m * ldc + n] = silu_f(v); } };
struct EMulInto { float* C; int ldc, M; __device__ void operator()(int m, int n, float v) const { if (m < M) C[(size_t)m * ldc + n] *= v; } };
struct EResid { Prm p; int layer, which  , row0, M;
    __device__ void operator()(int m, int n, float v) const { if (m < M) { const int r = row0 + m; const float* mod = (const float*)(p.ws + WS_MOD) + ((size_t)layer * 5 + row_b5(r)) * NMOD * DM; xrow(p, r)[n] += mod[which * DM + n] * v; } } };
struct AGather { const float* H; const int* tok; const int* cnt; int r0, rmax; __device__ int rows() const { int c = *cnt - r0; return c < rmax ? c : rmax; }
    __device__ float operator()(int m, int k) const { return m < rows() ? H[(size_t)tok[r0 + m] * DM + k] : 0.f; } };
struct ADenseCnt { const float* A; const int* cnt; int lda, r0, rmax, pad; __device__ int rows() const { int c = *cnt - r0; return c < rmax ? c : rmax; }
    __device__ float operator()(int m, int k) const { return m < rows() ? A[(size_t)m * lda + k] : 0.f; } };
struct ESiluCnt { float* C; const int* cnt; int ldc, r0, rmax, pad; __device__ void operator()(int m, int n, float v) const { int c = *cnt - r0; c = c < rmax ? c : rmax; if (m < c) C[(size_t)m * ldc + n] = silu_f(v); } };
struct EMulCnt { float* C; const int* cnt; int ldc, r0, rmax, pad; __device__ void operator()(int m, int n, float v) const { int c = *cnt - r0; c = c < rmax ? c : rmax; if (m < c) C[(size_t)m * ldc + n] *= v; } };
struct EScatterY { float* Y0; float* Y1; const int* tok; const float* w; const int* kk; const int* cnt; int r0, rmax;
    __device__ void operator()(int m, int n, float v) const { int c = *cnt - r0; c = c < rmax ? c : rmax; if (m < c) { const int i = r0 + m; (kk[i] ? Y1 : Y0)[(size_t)tok[i] * DM + n] = w[i] * v; } } };

__global__ void nk_fft_s1(const float* H, int b, float2* Y1) {
    const size_t idx = (size_t)blockIdx.x * blockDim.x + threadIdx.x;
    const int ch = idx % DM, n2 = (idx / DM) % FN2, k1 = idx / ((size_t)DM * FN2);
    float re = 0.f, im = 0.f;
    for (int n1 = 0; n1 < FN1; ++n1) {
        const float v = H[((size_t)b * SEQ + n1 * FN2 + n2) * DM + ch];
        const int ph = (n1 * k1) % FN1; double s, c; sincospi(-2.0 * ph / FN1, &s, &c);
        re += v * (float)c; im += v * (float)s;
    }
    double s, c; sincospi(-2.0 * (double)(n2 * k1) / (FN1 * FN2), &s, &c);
    Y1[idx] = make_float2(re * (float)c - im * (float)s, re * (float)s + im * (float)c);
}
__global__ void nk_fft_s2(const float2* Y1, int b, float2* Z) {
    const size_t idx = (size_t)blockIdx.x * blockDim.x + threadIdx.x;
    const int ch = idx % DM, k1 = (idx / DM) % FN1, k2 = idx / ((size_t)DM * FN1);
    float re = 0.f, im = 0.f;
    for (int n2 = 0; n2 < FN2; ++n2) {
        const float2 v = Y1[((size_t)k1 * FN2 + n2) * DM + ch];
        const int ph = (n2 * k2) % FN2; double s, c; sincospi(-2.0 * ph / FN2, &s, &c);
        re += v.x * (float)c - v.y * (float)s; im += v.x * (float)s + v.y * (float)c;
    }
    Z[((size_t)b * SEQ + k1 + FN1 * k2) * DM + ch] = make_float2(re, im);
}
__global__ void nk_dft_ctx(const float* H, float2* Z) {
    const size_t idx = (size_t)blockIdx.x * blockDim.x + threadIdx.x;
    const int ch = idx % DM, k = (idx / DM) % CTXL, b = idx / ((size_t)DM * CTXL);
    float re = 0.f, im = 0.f;
    for (int n = 0; n < CTXL; ++n) {
        const float v = H[((size_t)TL + b * CTXL + n) * DM + ch];
        const int ph = (n * k) % CTXL; double s, c; sincospi(-2.0 * ph / CTXL, &s, &c);
        re += v * (float)c; im += v * (float)s;
    }
    Z[((size_t)TL + b * CTXL + k) * DM + ch] = make_float2(re, im);
}
__global__ void nk_chan_dft(const float2* Z, float* R) {
    const size_t idx = (size_t)blockIdx.x * blockDim.x + threadIdx.x;
    const int col = idx % DM, row = idx / DM, g = col / 256, q = col % 256;
    float acc = 0.f;
    for (int pp = 0; pp < 256; ++pp) {
        const float2 v = Z[(size_t)row * DM + g * 256 + pp];
        const int ph = (pp * q) % 256; double s, c; sincospi(2.0 * ph / 256, &s, &c);
        acc += v.x * (float)c + v.y * (float)s;
    }
    const float scale = row < TL ? 1.f / sqrtf((float)SEQ * 256.f) : 1.f / sqrtf((float)CTXL * 256.f);
    R[idx] = acc * scale;
}
__global__ void nk_rope_apply(Prm p, float* QKV) {
    const size_t idx = (size_t)blockIdx.x * blockDim.x + threadIdx.x;
    const int f = idx % 16, a = (idx / 16) % 2, hh = (idx / 32) % 20; const size_t row = idx / 640;
    if (row >= TL) return;
    const int t = row % SEQ, pos = a ? (t % 64) : (t / 64);
    const float2 cs = ((const float2*)(p.ws + WS_ROPE))[pos * 16 + f];
    float* base = QKV + row * QKVD + hh * 64 + a * 32;
    const float x1 = base[f], x2 = base[16 + f];
    base[f] = x1 * cs.x - x2 * cs.y; base[16 + f] = x2 * cs.x + x1 * cs.y;
}
__global__ void __launch_bounds__(64) nk_attn(Prm p, const float* QKV, const float* sinks, float* O, int nrows) {
    const size_t idx = (size_t)blockIdx.x * blockDim.x + threadIdx.x;
    const int h = idx % NH; const size_t row = idx / NH;
    if (row >= (size_t)nrows) return;
    const int kv = h / 4;
    float q[64], o[64];
#pragma unroll
    for (int d = 0; d < 64; ++d) { q[d] = QKV[row * QKVD + h * 64 + d] * 0.125f; o[d] = 0.f; }
    float m = sinks[h], l = 1.f;
    const bool lat = row < TL; const int b = lat ? row / SEQ : (row - TL) / CTXL; const int t = lat ? row % SEQ : 0;
    const int j0 = lat ? (t - 128 < 0 ? 0 : t - 128) : 0, j1 = lat ? (t + 128 > SEQ - 1 ? SEQ - 1 : t + 128) : -1;
    const int nlat = j1 - j0 + 1;
    for (int jj = 0; jj < nlat + CTXL; ++jj) {
        const size_t krow = jj < nlat ? (size_t)b * SEQ + j0 + jj : (size_t)TL + b * CTXL + (jj - nlat);
        const float* kp = QKV + krow * QKVD + 1024 + kv * 64; const float* vp = kp + 256;
        float s = 0.f;
#pragma unroll
        for (int d = 0; d < 64; ++d) s += q[d] * kp[d];
        if (s > m) { const float f = expf(m - s); l *= f;
#pragma unroll
            for (int d = 0; d < 64; ++d) o[d] *= f;
            m = s; }
        const float pe = expf(s - m); l += pe;
#pragma unroll
        for (int d = 0; d < 64; ++d) o[d] += pe * vp[d];
    }
    const float il = 1.f / l;
#pragma unroll
    for (int d = 0; d < 64; ++d) O[row * DM + h * 64 + d] = o[d] * il;
}
__global__ void nk_router(Prm p, const float* H, const float* wr, int nrows, int* cnt, int* ltok, float* lw, int* lk) {
    const int r = blockIdx.x * blockDim.x + threadIdx.x; if (r >= nrows) return;
    float lg[NEXP] = {};
    for (int k = 0; k < DM; ++k) { const float hv = H[(size_t)r * DM + k];
#pragma unroll
        for (int e = 0; e < NEXP; ++e) lg[e] += hv * wr[k * NEXP + e]; }
    int e0 = 0; float v0 = lg[0];
#pragma unroll
    for (int e = 1; e < NEXP; ++e) if (lg[e] > v0) { v0 = lg[e]; e0 = e; }
    int e1 = -1; float v1 = -INFINITY;
#pragma unroll
    for (int e = 0; e < NEXP; ++e) if (e != e0 && lg[e] > v1) { v1 = lg[e]; e1 = e; }
    const float g1 = 1.f / (1.f + expf(v0 - v1)), g0 = 1.f - g1;
    int i0 = atomicAdd(&cnt[e0], 1); ltok[e0 * TT + i0] = r; lw[e0 * TT + i0] = g0; lk[e0 * TT + i0] = 0;
    int i1 = atomicAdd(&cnt[e1], 1); ltok[e1 * TT + i1] = r; lw[e1 * TT + i1] = g1; lk[e1 * TT + i1] = 1;
}
__global__ void nk_moe_combine(Prm p, const float* Y0, const float* Y1, int layer, int nrows) {
    const size_t idx = (size_t)blockIdx.x * blockDim.x + threadIdx.x; const int n = idx % DM; const size_t r = idx / DM;
    if (r >= (size_t)nrows) return;
    const float* mod = (const float*)(p.ws + WS_MOD) + ((size_t)layer * 5 + row_b5((int)r)) * NMOD * DM;
    xrow(p, (int)r)[n] += mod[5 * DM + n] * (Y0[idx] + Y1[idx]);
}


#define GAS __attribute__((address_space(1)))
#define LAS __attribute__((address_space(3)))
typedef unsigned short bf16_t;
typedef short bf16x8 __attribute__((ext_vector_type(8)));
typedef short s16x4 __attribute__((ext_vector_type(4)));
typedef float f32x4 __attribute__((ext_vector_type(4)));
typedef float f32x16 __attribute__((ext_vector_type(16)));
typedef unsigned u32x4 __attribute__((ext_vector_type(4)));
typedef unsigned u32x2 __attribute__((ext_vector_type(2)));
typedef float f32x2 __attribute__((ext_vector_type(2)));

constexpr size_t WS_TAB = 13 * MiB;
constexpr size_t TAB_F1 = 0, TAB_F2 = 65536, TAB_TW = 131072, TAB_TWC = 196608;
constexpr size_t WS_W = 16 * MiB;
constexpr size_t WE_STRIDE = 25 * MiB, WE_F = 0, WE_GU = 4 * MiB, WE_D = 18 * MiB;
constexpr size_t WO_BASE = 50 * MiB, WO_STRIDE = 173 * MiB, WO_QKV = 0, WO_O = 3 * MiB, WO_EXP = 5 * MiB, WX_STRIDE = 21 * MiB, WX_GU = 0, WX_D = 14 * MiB;
constexpr size_t WS_MS = 416 * MiB;
constexpr size_t MS_HB = 0;
constexpr size_t MS_BIG = 66 * MiB;
constexpr size_t BIG_ACT = 0;
constexpr size_t BIG_Y1 = 0, BIG_Y1C = 128 * MiB, BIG_PQ = 136 * MiB;
constexpr size_t BIG_Q = 0, BIG_K = 66 * MiB, BIG_V = 83 * MiB, BIG_O = 100 * MiB;
constexpr size_t WS_MEGA_END = WS_MS + MS_BIG + 490 * MiB;
constexpr size_t WS_YS = WS_W + WO_BASE;
constexpr size_t WS_TOKSLOT = WS_ROUTE + 4352 * 1024;
constexpr int MAXBLK = 280;
constexpr int CW_BAR = 4096;
constexpr int CW_CNT = 1024;
constexpr int CW_CNTW = 65536;
constexpr int CW_SKF = 32768;
constexpr int CW_MCNT = 2048;
constexpr int LDS_BYTES = 147456;
constexpr int LDS_MISC = 146944;
constexpr float LOG2E = 1.4426950408889634f;

struct Args { Prm p; int ph_lo, ph_hi; };

__device__ __forceinline__ unsigned f2bf(float f) { unsigned u = __builtin_bit_cast(unsigned, f); return (u + 0x7fffu + ((u >> 16) & 1u)) >> 16; }
__device__ __forceinline__ unsigned pk2(float lo, float hi) { typedef float f2 __attribute__((ext_vector_type(2))); typedef __bf16 b2 __attribute__((ext_vector_type(2))); f2 v = {lo, hi}; b2 b = __builtin_convertvector(v, b2); return __builtin_bit_cast(unsigned, b); }
#define SWZ_XOR(v, m) __builtin_bit_cast(float, __builtin_amdgcn_ds_swizzle(__builtin_bit_cast(int, (v)), ((m) << 10) | 0x1f))
__device__ __forceinline__ float xor32(float v, bool lower) { unsigned a = __builtin_bit_cast(unsigned, v), b = a; asm volatile("" : "+v"(b));
    auto rr = __builtin_amdgcn_permlane32_swap(a, b, false, false); return __builtin_bit_cast(float, lower ? rr[1] : rr[0]); }
__device__ __forceinline__ float wave_sum(float v) {
    v += SWZ_XOR(v, 1); v += SWZ_XOR(v, 2); v += SWZ_XOR(v, 4); v += SWZ_XOR(v, 8); v += SWZ_XOR(v, 16);
    return __builtin_bit_cast(float, __builtin_amdgcn_readlane(__builtin_bit_cast(int, v), 0)) + __builtin_bit_cast(float, __builtin_amdgcn_readlane(__builtin_bit_cast(int, v), 32));
}
__device__ __forceinline__ float fast_silu(float v) { return v * __builtin_amdgcn_rcpf(1.f + __builtin_amdgcn_exp2f(-v * LOG2E)); }

#define XB_TMO      128
#define XB_XCNT(j)  (256  + 64 * (j))
#define XB_XSUB(j)  (1280 + 64 * (j))
#define XB_XGEN(j)  (2304 + 64 * (j))
#define XB_TOP      3328
#define XB_TOPGEN   3392
#define XCD_BAR_WORDS 3456
#define XB_SPIN_CAP (1u << 18)
__device__ __forceinline__ unsigned xb_ld(unsigned* p)              { return __hip_atomic_load(p, __ATOMIC_RELAXED, __HIP_MEMORY_SCOPE_AGENT); }
__device__ __forceinline__ unsigned xb_add(unsigned* p, unsigned v) { return __hip_atomic_fetch_add(p, v, __ATOMIC_RELAXED, __HIP_MEMORY_SCOPE_AGENT); }
__device__ __forceinline__ unsigned xb_xcc_id() { return (unsigned)__builtin_amdgcn_s_getreg((3 << 11) | 20) & 0xFu; }
#define XB_SPIN(cond, bar) do { unsigned _sp = 0; while (cond) { __builtin_amdgcn_s_sleep(1); \
    if ((++_sp & 255u) == 0u) { if (xb_ld(&(bar)[XB_TMO])) break; if (_sp > XB_SPIN_CAP) { atomicAdd(&(bar)[XB_TMO], 1u); break; } } } } while (0)
struct XcdBarrier { unsigned* bar; unsigned x; volatile LAS unsigned* st; };
__device__ __forceinline__ XcdBarrier xcd_barrier_post(unsigned* bar, volatile LAS unsigned* st) {
    XcdBarrier b; b.bar = bar; b.x = xb_xcc_id(); b.st = st;
    if (threadIdx.x == 0) (void)xb_add(&bar[XB_XCNT(b.x)], 1u);
    return b;
}
__device__ __forceinline__ void xcd_barrier_complete(unsigned* bar, unsigned x, unsigned& nloc, unsigned& nx) {
    const unsigned G = gridDim.x * gridDim.y * gridDim.z;
    unsigned sum, cnt, mine, sp = 0u;
    for (;;) {
        sum = 0u; cnt = 0u; mine = 0u;
#pragma unroll
        for (unsigned j = 0; j < 16; ++j) { const unsigned c = xb_ld(&bar[XB_XCNT(j)]); sum += c; cnt += (c > 0u) ? 1u : 0u; mine = (j == x) ? c : mine; }
        if (sum == G) break;
        __builtin_amdgcn_s_sleep(1);
        if ((++sp & 255u) == 0u) { if (xb_ld(&bar[XB_TMO])) break; if (sp > XB_SPIN_CAP) { atomicAdd(&bar[XB_TMO], 1u); break; } }
    }
    nloc = mine > 0u ? mine : 1u; nx = cnt > 0u ? cnt : 1u;
}
__device__ __forceinline__ void xcd_barrier(const XcdBarrier& b) {
    asm volatile("s_waitcnt vmcnt(0)" ::: "memory");
    __syncthreads();
    if (threadIdx.x == 0) {
        unsigned* bar = b.bar;
        __builtin_amdgcn_s_waitcnt(0);
        unsigned nloc = b.st[0], nx = b.st[1];
        if (nloc == 0u) { xcd_barrier_complete(bar, b.x, nloc, nx); b.st[0] = nloc; b.st[1] = nx; }
        const unsigned old = xb_add(&bar[XB_XSUB(b.x)], 1u);
        const unsigned gen = old / nloc;
        if (old + 1u == (gen + 1u) * nloc) {
            __builtin_amdgcn_fence(__ATOMIC_RELEASE, "agent");
            asm volatile("s_waitcnt vmcnt(0)" ::: "memory");
            const unsigned og = xb_add(&bar[XB_TOP], 1u);
            const unsigned tg = og / nx;
            if (og + 1u == (tg + 1u) * nx) xb_add(&bar[XB_TOPGEN], 1u);
            else XB_SPIN(xb_ld(&bar[XB_TOPGEN]) == tg, bar);
            __builtin_amdgcn_fence(__ATOMIC_ACQUIRE, "agent");
            xb_add(&bar[XB_XGEN(b.x)], 1u);
            asm volatile("s_waitcnt vmcnt(0)" ::: "memory");
        } else {
            XB_SPIN(xb_ld(&bar[XB_XGEN(b.x)]) == gen, bar);
            __builtin_amdgcn_fence(__ATOMIC_ACQUIRE, "agent");
            asm volatile("s_waitcnt vmcnt(0)" ::: "memory");
        }
    }
    __syncthreads();
}

namespace pg8 {
constexpr int BM = 256, BK = 64, HALF = 128, HTB = HALF * BK * 2, STAGE_BYTES = 8 * HTB, NXCD = 8, WGM = 4;
__device__ __forceinline__ int lds_byte(int r, int c) { const int st = (r >> 4) * 2 + (c >> 5), rr = r & 15, cc = c & 31, ob = rr * 64 + cc * 2; return st * 1024 + (ob ^ (((ob >> 9) & 1) << 5)); }
__device__ __forceinline__ void stage_rc(int b, int& R, int& C) { const int st = b / 1024, sb = b % 1024, swz = sb ^ (((sb >> 9) & 1) << 5); R = (st >> 1) * 16 + swz / 64; C = (st & 1) * 32 + (swz % 64) / 2; }
__device__ __forceinline__ int perm32(int rho) { const int n = rho >> 4, i = rho & 15; return 8 * (i >> 2) + 4 * n + (i & 3); }
struct Unit { int pm, pn, g, first, cnt, kofs, nt, flags, np, part, qmask; };
__device__ __forceinline__ bool static_next(int nM, int nN, int G, int c, int i, Unit& u) {
    const int nwg = nM * nN; const long L = (long)i * G + c; const bool ok = L < nwg;
    int wgid = ok ? (int)L : nwg - 1; { const int q = nwg / NXCD, r = nwg % NXCD, xcd = wgid % NXCD, off = wgid / NXCD; wgid = (xcd < r ? xcd * (q + 1) : r * (q + 1) + (xcd - r) * q) + off; }
    const int nig = WGM * nN, gid = wgid / nig, fm = gid * WGM, gsz = (nM - fm) < WGM ? (nM - fm) : WGM;
    u.pm = fm + ((wgid % nig) % gsz); u.pn = (wgid % nig) / gsz; return ok;
}
__device__ __forceinline__ bool sk_next(int nM, int nN, int nt2, int G, int c, int i, int pmax, Unit& u) {
    const int nwg = nM * nN, nfull = nwg / G, R = nwg - nfull * G;
    int P = 1; if (R > 0) { if (R * 8 <= G && pmax >= 8) P = 8; else if (R * 4 <= G && pmax >= 4) P = 4; else if (R * 2 <= G && pmax >= 2) P = 2; }
    const bool tail = (i >= nfull);
    const int x = c % NXCD, rho = c / NXCD, jj = rho / P, p = rho % P, j = jj * NXCD + x;
    const long L = tail ? (long)nfull * G + (j < R ? j : 0) : (long)i * G + c;
    int wgid = (int)(L < nwg ? L : nwg - 1); { const int q = nwg / NXCD, r = nwg % NXCD, xcd = wgid % NXCD, off = wgid / NXCD; wgid = (xcd < r ? xcd * (q + 1) : r * (q + 1) + (xcd - r) * q) + off; }
    const int nig = WGM * nN, gid = wgid / nig, fm = gid * WGM, gsz = (nM - fm) < WGM ? (nM - fm) : WGM;
    u.pm = fm + ((wgid % nig) % gsz); u.pn = (wgid % nig) / gsz;
    const int lo = tail ? p * nt2 / P : 0, hi = tail ? (p + 1) * nt2 / P : nt2;
    u.kofs = lo * 2 * BK * 2; u.nt = (hi - lo) * 2; u.flags = (tail && P > 1) ? 1 : 0; u.np = P; u.part = p;
    u.qmask = (tail && P > 1) ? (P == 4 ? (1 << p) : P == 2 ? (5 << p) : 0xF) : 0xF;
    return tail ? (i == nfull && j < R) : true;
}
struct SkCtl { f32x4* slots; unsigned* flag; unsigned* tmo; unsigned epoch; int c, G; };
template <class Epi, class Sched, bool GATHER>
__device__ __forceinline__ void gemm_phase(LAS unsigned char* lds, const int tid_in, const bf16_t* Aptr, const int K, const Sched& S, const Epi& E, const SkCtl sk = SkCtl{}) {
    int tid = tid_in; asm volatile("" : "+v"(tid));
    const int wid = __builtin_amdgcn_readfirstlane(tid >> 6), lane = tid & 63, wr = wid >> 2, wc = wid & 3, fr = lane & 15, fq = lane >> 4;
    int RA[2], CA[2]; unsigned voffA[2], voffB[2];
#pragma unroll
    for (int i = 0; i < 2; ++i) { int R, C; stage_rc(tid * 16 + i * 8192, R, C); const int Rb = Epi::PERM ? ((R & ~31) + perm32(R & 31)) : R; RA[i] = R; CA[i] = C; voffA[i] = (unsigned)(R * K + C) * 2u; voffB[i] = (unsigned)(Rb * K + C) * 2u; }
    const size_t kstep = (size_t)(BK * 2);
    const size_t hstep = (size_t)HALF * K * 2;
    const unsigned ldsw = (unsigned)wid * 1024u;
    const int aoff = lds_byte(wr * 64 + fr, fq * 8), boff = lds_byte(wc * 32 + fr, fq * 8);
    const char* const cAb = (const char*)Aptr;
#define PG8_SA(b, h) (((b) * 2 + (h)) * HTB)
#define PG8_SB(b, h) ((4 + (b) * 2 + (h)) * HTB)
#define PG8_STAGE(bufoff, gbase, voff) do { _Pragma("unroll") for (int _i = 0; _i < 2; ++_i) \
        __builtin_amdgcn_global_load_lds((const unsigned*)((const char*)(gbase) + (voff)[_i]), (LAS unsigned*)(lds + (bufoff) + ldsw + _i * 8192), 16, 0, 0); } while (0)
#define PG8_STAGEA(bufoff, vo, h, kb) do { _Pragma("unroll") for (int _i = 0; _i < 2; ++_i) { \
        if constexpr (GATHER) __builtin_amdgcn_global_load_lds((const unsigned*)(cAb + (size_t)(vo)[h][_i] + (size_t)(kb)), (LAS unsigned*)(lds + (bufoff) + ldsw + _i * 8192), 16, 0, 0); \
        else __builtin_amdgcn_global_load_lds((const unsigned*)(cAb + s##vo + (size_t)(h) * hstep + (size_t)(kb) + voffA[_i]), (LAS unsigned*)(lds + (bufoff) + ldsw + _i * 8192), 16, 0, 0); } } while (0)
#define PG8_LDA(dst, b, h) do { _Pragma("unroll") for (int m = 0; m < 4; ++m) _Pragma("unroll") for (int k = 0; k < 2; ++k) dst[m][k] = *(const LAS bf16x8*)(lds + PG8_SA(b, h) + aoff + m * 2048 + k * 1024); } while (0)
#define PG8_LDB(dst, b, h) do { _Pragma("unroll") for (int n = 0; n < 2; ++n) _Pragma("unroll") for (int k = 0; k < 2; ++k) dst[n][k] = *(const LAS bf16x8*)(lds + PG8_SB(b, h) + boff + n * 2048 + k * 1024); } while (0)
#define PG8_MMA(ai, bj, At, Bt) do { __builtin_amdgcn_s_setprio(1); _Pragma("unroll") for (int m = 0; m < 4; ++m) _Pragma("unroll") for (int n = 0; n < 2; ++n) _Pragma("unroll") for (int k = 0; k < 2; ++k) \
        acc[ai][bj][m][n] = __builtin_amdgcn_mfma_f32_16x16x32_bf16(Bt[n][k], At[m][k], acc[ai][bj][m][n], 0, 0, 0); __builtin_amdgcn_s_setprio(0); } while (0)
#define PG8_WAIT_V(n) asm volatile("s_waitcnt vmcnt(" #n ")" ::: "memory")
#define PG8_WAIT_L(n) asm volatile("s_waitcnt lgkmcnt(" #n ")" ::: "memory")
#define PG8_BAR __builtin_amdgcn_s_barrier()
#define PG8_SCHED __builtin_amdgcn_sched_barrier(0)
#define PG8_AOFFS(vo, u) do { if constexpr (GATHER) { _Pragma("unroll") for (int _h = 0; _h < 2; ++_h) _Pragma("unroll") for (int _i = 0; _i < 2; ++_i) \
        (vo)[_h][_i] = (unsigned)(((size_t)S.a_row(u, _h * HALF + RA[_i]) * (size_t)K + (size_t)CA[_i]) * 2u) + (unsigned)(u).kofs; } else { s##vo = (size_t)S.a_row(u, 0) * (size_t)K * 2u + (size_t)(u).kofs; } } while (0)
    Unit cur, nxt; int ui = 0;
    if (!S.next(0, cur)) return;
    f32x4 acc[2][2][4][2];
#pragma unroll
    for (int a = 0; a < 2; ++a)
#pragma unroll
        for (int b = 0; b < 2; ++b)
#pragma unroll
            for (int m = 0; m < 4; ++m)
#pragma unroll
                for (int n = 0; n < 2; ++n) acc[a][b][m][n] = (f32x4){0.f, 0.f, 0.f, 0.f};
    bf16x8 At[4][2], B0[2][2], B1[2][2];
    unsigned vA[2][2], vN[2][2];
    size_t svA = 0, svN = 0;
    PG8_AOFFS(vA, cur);
    const char* cB = S.b_ptr(cur) + cur.kofs;
    PG8_STAGE(PG8_SB(0, 0), cB, voffB); PG8_STAGE(PG8_SB(0, 1), cB + hstep, voffB); PG8_STAGEA(PG8_SA(0, 0), vA, 0, 0); PG8_STAGEA(PG8_SA(0, 1), vA, 1, 0);
    if (wr == 1) PG8_BAR;
    PG8_WAIT_V(2); PG8_BAR;
    PG8_STAGE(PG8_SB(1, 0), cB + kstep, voffB); PG8_STAGEA(PG8_SA(1, 0), vA, 0, kstep); PG8_STAGE(PG8_SB(1, 1), cB + hstep + kstep, voffB);
    PG8_WAIT_V(6); PG8_BAR;
    for (;;) {
        const bool has_next = S.next(ui + 1, nxt);
        const char* nB = has_next ? S.b_ptr(nxt) + nxt.kofs : cB;
        const int nt = cur.nt;
        if (has_next) { PG8_AOFFS(vN, nxt); } else { svN = svA;
#pragma unroll
            for (int _h = 0; _h < 2; ++_h)
#pragma unroll
                for (int _i = 0; _i < 2; ++_i) vN[_h][_i] = vA[_h][_i]; }
        if constexpr (GATHER) { *(LAS u32x4*)(lds + STAGE_BYTES + tid * 16) = (u32x4){vN[0][0], vN[0][1], vN[1][0], vN[1][1]}; }
        for (int t = 0; t < nt; t += 2) {
            const bool last = (t == nt - 2);
            const size_t k1 = (size_t)(t + 1) * kstep;
            const size_t k2 = last ? 0 : (size_t)(t + 2) * kstep, k3 = k2 + kstep;
            const char* b2 = last ? nB : cB + (size_t)(t + 2) * kstep; const char* b3 = b2 + kstep;
            unsigned v2[2][2]; const size_t sv2 = last ? svN : svA;
            if constexpr (GATHER) {
#pragma unroll
                for (int _h = 0; _h < 2; ++_h)
#pragma unroll
                    for (int _i = 0; _i < 2; ++_i) v2[_h][_i] = vA[_h][_i];
                if (last) { const u32x4 q = *(const LAS u32x4*)(lds + STAGE_BYTES + tid * 16); v2[0][0] = q.x; v2[0][1] = q.y; v2[1][0] = q.z; v2[1][1] = q.w; } }
            PG8_LDB(B0, 0, 0); PG8_LDB(B1, 0, 1); PG8_SCHED; PG8_LDA(At, 0, 0); PG8_STAGEA(PG8_SA(1, 1), vA, 1, k1);
            PG8_WAIT_V(8); PG8_WAIT_L(0); PG8_BAR; PG8_MMA(0, 0, At, B0); PG8_MMA(0, 1, At, B1); PG8_BAR; PG8_SCHED;
            PG8_LDA(At, 0, 1); PG8_STAGE(PG8_SB(0, 0), b2, voffB); PG8_STAGE(PG8_SB(0, 1), b2 + hstep, voffB); PG8_STAGEA(PG8_SA(0, 0), v2, 0, k2);
            PG8_WAIT_V(8); PG8_WAIT_L(0); PG8_BAR; PG8_MMA(1, 0, At, B0); PG8_MMA(1, 1, At, B1); PG8_BAR; PG8_SCHED;
            PG8_LDB(B0, 1, 0); PG8_LDB(B1, 1, 1); PG8_SCHED; PG8_LDA(At, 1, 0); PG8_STAGEA(PG8_SA(0, 1), v2, 1, k2);
            PG8_WAIT_V(8); PG8_WAIT_L(0); PG8_BAR; PG8_MMA(0, 0, At, B0); PG8_MMA(0, 1, At, B1); PG8_BAR; PG8_SCHED;
            PG8_LDA(At, 1, 1); PG8_STAGE(PG8_SB(1, 0), b3, voffB); PG8_STAGE(PG8_SB(1, 1), b3 + hstep, voffB); PG8_STAGEA(PG8_SA(1, 0), v2, 0, k3);
            PG8_WAIT_V(8); PG8_WAIT_L(0); PG8_BAR; PG8_MMA(1, 0, At, B0); PG8_MMA(1, 1, At, B1); PG8_BAR; PG8_SCHED;
        }
        if (wr == 0) PG8_BAR;
        if (cur.flags & 1) {
            const int P = cur.np, p = cur.part, c0 = sk.c - NXCD * p;
            int tl; asm volatile("v_mbcnt_lo_u32_b32 %0, -1, 0\n\tv_mbcnt_hi_u32_b32 %0, -1, %0" : "=v"(tl));
            const int tid = wid * 64 + tl;
            const __amdgpu_buffer_rsrc_t rs = __builtin_amdgcn_make_buffer_rsrc((void*)sk.slots, 0, (int)(sk.G * 32 * 512 * 16), 0x00020000);
            const unsigned so = (unsigned)((sk.c * (32 * 512) + tid) * 16);
#pragma unroll
            for (int a = 0; a < 2; ++a)
#pragma unroll
                for (int b = 0; b < 2; ++b) if (!((cur.qmask >> (a * 2 + b)) & 1)) {
#pragma unroll
                    for (int m = 0; m < 4; ++m)
#pragma unroll
                        for (int n = 0; n < 2; ++n) __builtin_amdgcn_raw_buffer_store_b128(__builtin_bit_cast(u32x4, acc[a][b][m][n]), rs, so + (unsigned)((((a * 2 + b) * 4 + m) * 2 + n) * 512 * 16), 0, 16); }
            PG8_WAIT_V(0); PG8_BAR; asm volatile("" ::: "memory");
            if (tid == 0) __hip_atomic_store(sk.flag + 64 * sk.c, sk.epoch, __ATOMIC_RELAXED, __HIP_MEMORY_SCOPE_AGENT);
            if (tid < 64) {
                for (int q = 0; q < P; ++q) if (q != p) { const int pc = c0 + NXCD * q; unsigned sp = 0;
                    while ((unsigned)__builtin_amdgcn_readfirstlane(__hip_atomic_load(sk.flag + 64 * pc, __ATOMIC_RELAXED, __HIP_MEMORY_SCOPE_AGENT)) != sk.epoch) { __builtin_amdgcn_s_sleep(1);
                        if ((++sp & 255u) == 0u) { if (__hip_atomic_load(sk.tmo, __ATOMIC_RELAXED, __HIP_MEMORY_SCOPE_AGENT)) break; if (sp > (1u << 20)) { if (tid == 0) atomicAdd(sk.tmo, 1u); break; } } } }
                __builtin_amdgcn_fence(__ATOMIC_ACQUIRE, "agent"); PG8_WAIT_V(0); }
            asm volatile("" ::: "memory"); PG8_BAR; asm volatile("" ::: "memory");
#pragma unroll
            for (int a = 0; a < 2; ++a)
#pragma unroll
                for (int b = 0; b < 2; ++b) if ((cur.qmask >> (a * 2 + b)) & 1) {
                    for (int q = 0; q < P; ++q) if (q != p) {
                        const GAS f32x4* sl = (const GAS f32x4*)sk.slots + (size_t)(c0 + NXCD * q) * (32 * 512) + (size_t)((a * 2 + b) * 8) * 512 + tid;
#pragma unroll
                        for (int h4 = 0; h4 < 2; ++h4) { f32x4 pv[4];
#pragma unroll
                            for (int v4 = 0; v4 < 4; ++v4) pv[v4] = sl[(h4 * 4 + v4) * 512];
#pragma unroll
                            for (int v4 = 0; v4 < 4; ++v4) acc[a][b][h4 * 2 + (v4 >> 1)][v4 & 1] += pv[v4]; } } }
        }
        { int fr_ = fr, fq_ = fq; asm volatile("" : "+v"(fr_), "+v"(fq_));
          E(acc, cur, wr, wc, fr_, fq_); }
        if (!has_next) break;
#pragma unroll
        for (int a = 0; a < 2; ++a)
#pragma unroll
            for (int b = 0; b < 2; ++b)
#pragma unroll
                for (int m = 0; m < 4; ++m)
#pragma unroll
                    for (int n = 0; n < 2; ++n) acc[a][b][m][n] = (f32x4){0.f, 0.f, 0.f, 0.f};
        cur = nxt; cB = nB; ++ui; svA = svN;
        if constexpr (GATHER) { const u32x4 q = *(const LAS u32x4*)(lds + STAGE_BYTES + tid * 16); vA[0][0] = q.x; vA[0][1] = q.y; vA[1][0] = q.z; vA[1][1] = q.w; }
        if (wr == 1) PG8_BAR;
    }
    PG8_WAIT_V(0);
    PG8_BAR;
#undef PG8_SA
#undef PG8_SB
#undef PG8_STAGE
#undef PG8_STAGEA
#undef PG8_LDA
#undef PG8_LDB
#undef PG8_MMA
#undef PG8_WAIT_V
#undef PG8_WAIT_L
#undef PG8_BAR
#undef PG8_SCHED
#undef PG8_AOFFS
}
}


template <bool SK>
struct SchedDense {
    const bf16_t* Bt; int nM, nN, G, c, K;
    __device__ __forceinline__ bool next(int i, pg8::Unit& u) const { u.g = 0; u.first = 0; u.cnt = 0;
        if constexpr (SK) return pg8::sk_next(nM, nN, K / 128, G, c, i, 4, u);
        else { u.kofs = 0; u.nt = K / 64; u.flags = 0; u.np = 1; u.part = 0; u.qmask = 0xF; return pg8::static_next(nM, nN, G, c, i, u); } }
    __device__ __forceinline__ const char* b_ptr(const pg8::Unit& u) const { return (const char*)Bt + (size_t)u.pn * 256 * K * 2; }
    __device__ __forceinline__ int a_row(const pg8::Unit& u, int r) const { return u.pm * 256 + r; }
};
struct MoeTab { volatile LAS unsigned* T;
    __device__ __forceinline__ int group_of(int blk) const { int g = 0;
#pragma unroll
        for (int j = 1; j < 16; ++j) g += (blk >= (int)T[16 + j]) ? 1 : 0; return g; }
};
template <bool GATHER, bool SK>
struct SchedMoe {
    const bf16_t* Wbase; size_t wx_stride; int nN, G, c, K, blk0, nblk; MoeTab tab; const int* ltok;
    __device__ __forceinline__ bool next(int i, pg8::Unit& u) const { bool ok;
        if constexpr (SK) ok = pg8::sk_next(nblk, nN, K / 128, G, c, i, 4, u); else { u.kofs = 0; u.nt = K / 64; u.flags = 0; u.np = 1; u.part = 0; u.qmask = 0xF; ok = pg8::static_next(nblk, nN, G, c, i, u); }
        u.pm += blk0;
        const int g = __builtin_amdgcn_readfirstlane(tab.group_of(u.pm)); u.g = g; u.first = __builtin_amdgcn_readfirstlane((int)tab.T[16 + g]); u.cnt = __builtin_amdgcn_readfirstlane((int)tab.T[32 + g]); return ok; }
    __device__ __forceinline__ const char* b_ptr(const pg8::Unit& u) const { return (const char*)Wbase + (size_t)(u.g & 7) * wx_stride + (size_t)u.pn * 256 * K * 2; }
    __device__ __forceinline__ int a_row(const pg8::Unit& u, int r) const {
        if (!GATHER) return u.pm * 256 + r;
        const int local = (u.pm - u.first) * 256 + r;
        return ltok[(size_t)u.g * TT + (local < u.cnt ? local : u.cnt - 1)]; }
};

struct EpiResid {
    static constexpr bool PERM = false;
    const float* xin_l; const float* xin_c; float* xout_l; float* xout_c; const float* mod; int which; float rs;
    __device__ __forceinline__ void operator()(const f32x4 (&acc)[2][2][4][2], const pg8::Unit& u, int wr, int wc, int fr, int fq) const {
        const bool lat = u.pm < TL / 256; const int b5 = lat ? u.pm / 32 : 4;
        const size_t rbase = (size_t)(lat ? u.pm : u.pm - TL / 256) * 256 + wr * 64 + fr;
        const float* xi = (lat ? xin_l : xin_c); float* xo = (lat ? xout_l : xout_c);
        const int col0 = u.pn * 256 + wc * 32 + 4 * fq;
        const float* gp = mod + (size_t)b5 * NMOD * DM + which * DM + col0;
        f32x4 gv[2][2];
#pragma unroll
        for (int bj = 0; bj < 2; ++bj)
#pragma unroll
            for (int n = 0; n < 2; ++n) gv[bj][n] = *(const f32x4*)(gp + bj * 128 + n * 16) * rs;
#pragma unroll
        for (int ai = 0; ai < 2; ++ai) { const size_t off0 = (rbase + ai * 128) * DM + col0;
            if (u.qmask == 0xF) { f32x4 xv[4][2][2];
#pragma unroll
                for (int m = 0; m < 4; ++m)
#pragma unroll
                    for (int bj = 0; bj < 2; ++bj)
#pragma unroll
                        for (int n = 0; n < 2; ++n) xv[m][bj][n] = *(const f32x4*)(xi + off0 + (size_t)m * 16 * DM + bj * 128 + n * 16);
#pragma unroll
                for (int m = 0; m < 4; ++m)
#pragma unroll
                    for (int bj = 0; bj < 2; ++bj)
#pragma unroll
                        for (int n = 0; n < 2; ++n) *(f32x4*)(xo + off0 + (size_t)m * 16 * DM + bj * 128 + n * 16) = xv[m][bj][n] + gv[bj][n] * acc[ai][bj][m][n];
            } else {
#pragma unroll
                for (int bj = 0; bj < 2; ++bj) if ((u.qmask >> (ai * 2 + bj)) & 1) { f32x4 xv[4][2];
#pragma unroll
                    for (int m = 0; m < 4; ++m)
#pragma unroll
                        for (int n = 0; n < 2; ++n) xv[m][n] = *(const f32x4*)(xi + off0 + (size_t)m * 16 * DM + bj * 128 + n * 16);
#pragma unroll
                    for (int m = 0; m < 4; ++m)
#pragma unroll
                        for (int n = 0; n < 2; ++n) *(f32x4*)(xo + off0 + (size_t)m * 16 * DM + bj * 128 + n * 16) = xv[m][n] + gv[bj][n] * acc[ai][bj][m][n]; } }
            asm volatile("" ::: "memory"); }
    }
};
struct EpiSwiglu {
    static constexpr bool PERM = true;
    bf16_t* act;
    __device__ __forceinline__ void operator()(const f32x4 (&acc)[2][2][4][2], const pg8::Unit& u, int wr, int wc, int fr, int fq) const {
        const size_t row0 = (size_t)u.pm * 256 + wr * 64 + fr; const int col0 = u.pn * 128 + wc * 32 + 8 * fq;
#pragma unroll
        for (int ai = 0; ai < 2; ++ai)
#pragma unroll
            for (int m = 0; m < 4; ++m) {
                const f32x4 g0 = acc[ai][0][m][0], g1 = acc[ai][0][m][1], u0 = acc[ai][1][m][0], u1 = acc[ai][1][m][1];
                u32x4 w;
                w.x = pk2(fast_silu(g0[0]) * u0[0], fast_silu(g0[1]) * u0[1]); w.y = pk2(fast_silu(g0[2]) * u0[2], fast_silu(g0[3]) * u0[3]);
                w.z = pk2(fast_silu(g1[0]) * u1[0], fast_silu(g1[1]) * u1[1]); w.w = pk2(fast_silu(g1[2]) * u1[2], fast_silu(g1[3]) * u1[3]);
                *(u32x4*)(act + (row0 + ai * 128 + m * 16) * DFF + col0) = w; }
    }
};
struct EpiQKV {
    static constexpr bool PERM = true;
    bf16_t *QB, *KB, *VB; const float2* rope;
    __device__ __forceinline__ void operator()(const f32x4 (&acc)[2][2][4][2], const pg8::Unit& u, int wr, int wc, int fr, int fq) const {
        const bool lat = u.pm < TL / 256; const int row0 = u.pm * 256 + wr * 64 + fr;
        const bool dorope = lat && u.pn < 5; const float qs = u.pn < 4 ? 0.125f * LOG2E : 1.f;
        const size_t doff = u.pn < 4 ? (size_t)0 : (u.pn == 4 ? (size_t)((BIG_K - BIG_Q) / 2) : (size_t)((BIG_V - BIG_Q) / 2));
        bf16_t* dst = QB + doff; const int ld = u.pn < 4 ? DM : 256, colt = u.pn < 4 ? u.pn * 256 : 0;
        const int a = wc & 1, f0 = 8 * (fq & 1); const float sg = (fq < 2) ? -1.f : 1.f;
#pragma unroll
        for (int ai = 0; ai < 2; ++ai) { f32x4 cs[4][4];
            if (dorope) {
#pragma unroll
                for (int m = 0; m < 4; ++m) { const int r = row0 + ai * 128 + m * 16; const int t = r & (SEQ - 1); const int pos = a ? (t & 63) : (t >> 6);
                    const f32x4* csp = (const f32x4*)(rope + pos * 16 + f0);
#pragma unroll
                    for (int q4 = 0; q4 < 4; ++q4) cs[m][q4] = csp[q4]; } }
#pragma unroll
            for (int m = 0; m < 4; ++m) { const int r = row0 + ai * 128 + m * 16;
#pragma unroll
                for (int bj = 0; bj < 2; ++bj) if ((u.qmask >> (ai * 2 + bj)) & 1) { f32x4 v[2];
#pragma unroll
                    for (int n = 0; n < 2; ++n) { v[n] = acc[ai][bj][m][n];
                        if (dorope) { const f32x4 c01 = cs[m][2 * n], c23 = cs[m][2 * n + 1];
#pragma unroll
                            for (int j = 0; j < 4; ++j) { const float pr = xor32(v[n][j], fq < 2); const float c = (j < 2 ? c01 : c23)[2 * (j & 1)], sn = (j < 2 ? c01 : c23)[2 * (j & 1) + 1]; v[n][j] = v[n][j] * c + sg * pr * sn; } }
                        v[n] = v[n] * qs; }
                    u32x4 w; w.x = pk2(v[0][0], v[0][1]); w.y = pk2(v[0][2], v[0][3]); w.z = pk2(v[1][0], v[1][1]); w.w = pk2(v[1][2], v[1][3]);
                    *(u32x4*)(dst + (size_t)r * ld + colt + bj * 128 + wc * 32 + 8 * fq) = w; } }
            asm volatile("" ::: "memory"); }
    }
};
struct EpiMoeDown {
    static constexpr bool PERM = false;
    float* xl; float* xc; const float* mod; const int* ltok; const float* lw; float rs;
    __device__ __forceinline__ void operator()(const f32x4 (&acc)[2][2][4][2], const pg8::Unit& u, int wr, int wc, int fr, int fq) const {
        const int g = u.g; const int lbase = (u.pm - u.first) * 256 + wr * 64 + fr; const int cnt = u.cnt;
        const int col0 = u.pn * 256 + wc * 32 + 4 * fq;
        int tokv[2][4]; float wv[2][4];
#pragma unroll
        for (int ai = 0; ai < 2; ++ai)
#pragma unroll
            for (int m = 0; m < 4; ++m) { const int local = lbase + ai * 128 + m * 16, li = local < cnt ? local : cnt - 1; tokv[ai][m] = ltok[(size_t)g * TT + li]; wv[ai][m] = lw[(size_t)g * TT + li] * rs; }
        const int b50 = tokv[0][0] < TL ? tokv[0][0] / SEQ : 4;
        f32x4 gv[2][2];
#pragma unroll
        for (int bj = 0; bj < 2; ++bj)
#pragma unroll
            for (int n = 0; n < 2; ++n) gv[bj][n] = *(const f32x4*)(mod + (size_t)b50 * NMOD * DM + 5 * DM + col0 + bj * 128 + n * 16);
#pragma unroll
        for (int am = 0; am < 4; ++am) { const int ai = am >> 1; f32x4 xv[2][2][2];
#pragma unroll
            for (int mm = 0; mm < 2; ++mm) { const int m = (am & 1) * 2 + mm; const int local = lbase + ai * 128 + m * 16;
                if (local < cnt) { const int tok = tokv[ai][m]; const float* xr = (tok < TL ? xl + (size_t)tok * DM : xc + (size_t)(tok - TL) * DM) + col0;
#pragma unroll
                    for (int bj = 0; bj < 2; ++bj) if ((u.qmask >> (ai * 2 + bj)) & 1) {
#pragma unroll
                        for (int n = 0; n < 2; ++n) xv[mm][bj][n] = *(const f32x4*)(xr + bj * 128 + n * 16); } } }
#pragma unroll
            for (int mm = 0; mm < 2; ++mm) { const int m = (am & 1) * 2 + mm; const int local = lbase + ai * 128 + m * 16;
                if (local < cnt) { const int tok = tokv[ai][m]; const float w = wv[ai][m];
                    const bool lat = tok < TL; const int b5 = lat ? tok / SEQ : 4; float* xr = (lat ? xl + (size_t)tok * DM : xc + (size_t)(tok - TL) * DM) + col0;
                    if (b5 == b50) {
#pragma unroll
                        for (int bj = 0; bj < 2; ++bj) if ((u.qmask >> (ai * 2 + bj)) & 1) {
#pragma unroll
                            for (int n = 0; n < 2; ++n) *(f32x4*)(xr + bj * 128 + n * 16) = xv[mm][bj][n] + gv[bj][n] * (w * acc[ai][bj][m][n]); }
                    } else { const float* gp = mod + (size_t)b5 * NMOD * DM + 5 * DM + col0;
#pragma unroll
                        for (int bj = 0; bj < 2; ++bj) if ((u.qmask >> (ai * 2 + bj)) & 1) {
#pragma unroll
                            for (int n = 0; n < 2; ++n) { const f32x4 gr = *(const f32x4*)(gp + bj * 128 + n * 16); *(f32x4*)(xr + bj * 128 + n * 16) = xv[mm][bj][n] + gr * (w * acc[ai][bj][m][n]); } } } } }
            asm volatile("" ::: "memory"); }
    }
};
struct EpiMoeY {
    static constexpr bool PERM = true;
    bf16_t* ys; const float* mod; const int* ltok; const float* lw;
    __device__ __forceinline__ void operator()(const f32x4 (&acc)[2][2][4][2], const pg8::Unit& u, int wr, int wc, int fr, int fq) const {
        const int g = u.g; const int lbase = (u.pm - u.first) * 256 + wr * 64 + fr; const int cnt = u.cnt;
        const int col0 = u.pn * 256 + wc * 32 + 8 * fq;
        int tokv[2][4]; float wv[2][4];
#pragma unroll
        for (int ai = 0; ai < 2; ++ai)
#pragma unroll
            for (int m = 0; m < 4; ++m) { const int local = lbase + ai * 128 + m * 16, li = local < cnt ? local : cnt - 1; tokv[ai][m] = ltok[(size_t)g * TT + li]; wv[ai][m] = lw[(size_t)g * TT + li]; }
        const int b50 = tokv[0][0] < TL ? tokv[0][0] / SEQ : 4;
        f32x4 gv[2][2];
#pragma unroll
        for (int bj = 0; bj < 2; ++bj)
#pragma unroll
            for (int n = 0; n < 2; ++n) gv[bj][n] = *(const f32x4*)(mod + (size_t)b50 * NMOD * DM + 5 * DM + col0 + bj * 128 + n * 4);
#pragma unroll
        for (int ai = 0; ai < 2; ++ai)
#pragma unroll
            for (int m = 0; m < 4; ++m) { const int local = lbase + ai * 128 + m * 16;
                if (local < cnt) { const int tok = tokv[ai][m]; const float w = wv[ai][m]; const int b5 = tok < TL ? tok / SEQ : 4;
                    bf16_t* yr = ys + ((size_t)u.pm * 256 + wr * 64 + fr + ai * 128 + m * 16) * DM + col0;
                    if (b5 == b50) {
#pragma unroll
                        for (int bj = 0; bj < 2; ++bj) if ((u.qmask >> (ai * 2 + bj)) & 1) {
                            const f32x4 v0 = gv[bj][0] * (w * acc[ai][bj][m][0]), v1 = gv[bj][1] * (w * acc[ai][bj][m][1]);
                            u32x4 o; o.x = pk2(v0[0], v0[1]); o.y = pk2(v0[2], v0[3]); o.z = pk2(v1[0], v1[1]); o.w = pk2(v1[2], v1[3]);
                            *(u32x4*)(yr + bj * 128) = o; }
                    } else { const float* gp = mod + (size_t)b5 * NMOD * DM + 5 * DM + col0;
#pragma unroll
                        for (int bj = 0; bj < 2; ++bj) if ((u.qmask >> (ai * 2 + bj)) & 1) { const f32x4 g0 = *(const f32x4*)(gp + bj * 128), g1 = *(const f32x4*)(gp + bj * 128 + 4);
                            const f32x4 v0 = g0 * (w * acc[ai][bj][m][0]), v1 = g1 * (w * acc[ai][bj][m][1]);
                            u32x4 o; o.x = pk2(v0[0], v0[1]); o.y = pk2(v0[2], v0[3]); o.z = pk2(v1[0], v1[1]); o.w = pk2(v1[2], v1[3]);
                            *(u32x4*)(yr + bj * 128) = o; } } } }
    }
};
struct Frame { LAS unsigned char* lds; volatile LAS unsigned* MISC; int tid, lane, wave, vcu, G; };

__device__ __forceinline__ void p0_transpose_item(const float* W, int K, int N, bf16_t* WT, int k0, int n0, int drow0, LAS float* scr, int lane) {
    f32x4 v[16];
#pragma unroll
    for (int i = 0; i < 16; ++i) v[i] = __builtin_nontemporal_load((const f32x4*)(W + (size_t)(k0 + 4 * i + (lane >> 4)) * N + n0 + 4 * (lane & 15)));
#pragma unroll
    for (int i = 0; i < 16; ++i) { LAS float* d = scr + (4 * i + (lane >> 4)) * 65 + 4 * (lane & 15); d[0] = v[i][0]; d[1] = v[i][1]; d[2] = v[i][2]; d[3] = v[i][3]; }
    asm volatile("s_waitcnt lgkmcnt(0)" ::: "memory");
    const int c = lane & 7;
#pragma unroll
    for (int j = 0; j < 8; ++j) { const int n = (lane >> 3) + 8 * j; const LAS float* sp = scr + (8 * c) * 65 + n;
        u32x4 o; o.x = pk2(sp[0 * 65], sp[1 * 65]); o.y = pk2(sp[2 * 65], sp[3 * 65]); o.z = pk2(sp[4 * 65], sp[5 * 65]); o.w = pk2(sp[6 * 65], sp[7 * 65]);
        *(u32x4*)(WT + (size_t)(drow0 + n) * K + k0 + 8 * c) = o; }
    asm volatile("s_waitcnt lgkmcnt(0)" ::: "memory");
}
__device__ __forceinline__ void p0_ffn_matrix(const Prm& p, int m, int r, LAS float* scr, int lane) {
    unsigned char* ws = p.ws; const float* src; bf16_t* dst; int t;
    if (m < 6) { const int j = m / 3; t = m % 3; src = (t == 0 ? p.fg : t == 1 ? p.fu : p.fd) + (size_t)j * DM * DFF; dst = (bf16_t*)(ws + WS_W + j * WE_STRIDE + (t == 2 ? WE_D : WE_GU)); }
    else { const int q = m - 6, j = q / 24, e = (q % 24) / 3; t = q % 3; src = (t == 0 ? p.mg : t == 1 ? p.mu : p.md) + ((size_t)j * NEXP + e) * DM * DFF; dst = (bf16_t*)(ws + WS_W + WO_BASE + j * WO_STRIDE + WO_EXP + e * WX_STRIDE + (t == 2 ? WX_D : WX_GU)); }
    if (t == 2) { const int nblk = DM / 64, q8 = r >> 3, w8 = r & 7, ngx = nblk / 2, kb = 4 * (q8 / ngx) + (w8 >> 1), nb = 2 * (q8 % ngx) + (w8 & 1); p0_transpose_item(src, DFF, DM, dst, 64 * kb, 64 * nb, 64 * nb, scr, lane); }
    else { const int nblk = DFF / 64, q8 = r >> 3, w8 = r & 7, ngx = nblk / 2, kb = 4 * (q8 / ngx) + (w8 >> 1), nb = 2 * (q8 % ngx) + (w8 & 1), n0 = 64 * nb; p0_transpose_item(src, DM, DFF, dst, 64 * kb, n0, (n0 / 128) * 256 + (n0 % 128) + (t == 1 ? 128 : 0), scr, lane); }
}
__device__ __forceinline__ void p0_prologue(const Prm& p, Frame& F) {
    unsigned char* ws = p.ws;
    { const int gt = F.vcu * 512 + F.tid, NT = F.G * 512;
      bf16_t* F1 = (bf16_t*)(ws + WS_TAB + TAB_F1); bf16_t* F2 = (bf16_t*)(ws + WS_TAB + TAB_F2); float2* TW = (float2*)(ws + WS_TAB + TAB_TW); float2* TWC = (float2*)(ws + WS_TAB + TAB_TWC);
      for (int i = gt; i < 256 * 128; i += NT) { const int row = i / 128, n1 = i % 128, k1 = row >> 1, c = row & 1; float sn, cs; sincospif(2.f * (float)((n1 * k1) & 127) / 128.f, &sn, &cs);
          F1[i] = (bf16_t)f2bf((c ? -sn : cs) * 0.08838834764831845f); }
      for (int i = gt; i < 128 * 128; i += NT) { const int row = i / 128, col = i % 128, k2 = row >> 1, cp = row & 1, n2 = col >> 1, c = col & 1; float sn, cs; sincospif(2.f * (float)((n2 * k2) & 63) / 64.f, &sn, &cs);
          const float v = cp == 0 ? (c == 0 ? cs : sn) : (c == 0 ? -sn : cs); F2[i] = (bf16_t)f2bf(v * 0.125f); }
      for (int i = gt; i < 64 * 128; i += NT) { const int n2 = i / 128, k1 = i % 128; float sn, cs; sincospif(2.f * (float)(n2 * k1) / 8192.f, &sn, &cs); TW[i] = make_float2(cs, -sn); }
      for (int i = gt; i < 2 * 128; i += NT) { const int n2 = i / 128, k1 = i % 128; float sn, cs; sincospif(2.f * (float)(n2 * k1) / 256.f, &sn, &cs); TWC[i] = make_float2(cs, -sn); }
      for (int i = gt; i < 128 * 16; i += NT) { const int pos = i / 16, f = i % 16; const float inv = powf(10000.f, -(float)f / 16.f); const float ang = (float)pos * inv;
          ((float2*)(ws + WS_ROPE))[i] = make_float2((float)cos((double)ang), (float)sin((double)ang)); }
    }
    { LAS float* sc = (LAS float*)(F.lds);
      LAS float* part = (LAS float*)(F.lds + 32768);
      for (int i = F.tid; i < 5 * DM; i += 512) { const int r = i / DM, k = i % DM; const float v = r < 4 ? p.c[r * DM + k] : p.c_ctx[k]; sc[i] = v / (1.f + expf(-v)); }
      __syncthreads();
      for (int it = F.vcu; it < DEPTH * 96; it += F.G) { const int l = it / 96, n = (it % 96) * 64 + F.lane;
          const float* w = p.ada_w + (size_t)l * DM * NMOD * DM + n; float a[5] = {0.f, 0.f, 0.f, 0.f, 0.f};
          for (int kb = 0; kb < 128; kb += 32) { float wv[32];
#pragma unroll
              for (int kk = 0; kk < 32; ++kk) wv[kk] = w[(size_t)(F.wave * 128 + kb + kk) * NMOD * DM];
#pragma unroll
              for (int kk = 0; kk < 32; ++kk) { const int k = F.wave * 128 + kb + kk;
#pragma unroll
                  for (int r = 0; r < 5; ++r) a[r] += sc[r * DM + k] * wv[kk]; } }
#pragma unroll
          for (int r = 0; r < 5; ++r) part[(F.wave * 5 + r) * 64 + F.lane] = a[r];
          __syncthreads();
          if (F.tid < 320) { const int r = F.tid / 64, ln = F.tid % 64; float sum = 0.f;
#pragma unroll
              for (int wv = 0; wv < 8; ++wv) sum += part[(wv * 5 + r) * 64 + ln];
              ((float*)(ws + WS_MOD))[((size_t)l * 5 + r) * NMOD * DM + (it % 96) * 64 + ln] = sum + p.ada_b[l * NMOD * DM + (it % 96) * 64 + ln]; }
          __syncthreads(); }
    }
    { LAS f32x2* cs256 = (LAS f32x2*)(F.lds);
      __syncthreads();
      for (int i = F.tid; i < 256; i += 512) { float sn, cs; sincospif(2.f * (float)i / 256.f, &sn, &cs); cs256[i] = (f32x2){cs * 0.0625f, sn * 0.0625f}; }
      __syncthreads();
      const int gw = F.vcu * 8 + F.wave, NGW = F.G * 8;
      for (int it = gw; it < 2 * 64 * 16; it += NGW) { const int j = it / 1024, kk0 = ((it / 16) % 64) * 32, n = (it % 16) * 64 + F.lane;
          const int type = kk0 / 1024, g = (kk0 % 1024) / 256, p0 = kk0 % 256;
          const float* w = p.fw + (size_t)j * DM * DM + (size_t)(g * 256) * DM + n; float a[32] = {};
          for (int qb = 0; qb < 256; qb += 16) { float wv[16];
#pragma unroll
              for (int qq = 0; qq < 16; ++qq) wv[qq] = w[(size_t)(qb + qq) * DM];
#pragma unroll
              for (int qq = 0; qq < 16; ++qq) { const int q = qb + qq; int idx = p0 * q;
#pragma unroll
                  for (int i = 0; i < 32; ++i) { const f32x2 t = cs256[idx & 255]; a[i] += (type ? t.y : t.x) * wv[qq]; idx += q; } } }
#pragma unroll
          for (int i8 = 0; i8 < 4; ++i8) { u32x4 o; o.x = pk2(a[8 * i8], a[8 * i8 + 1]); o.y = pk2(a[8 * i8 + 2], a[8 * i8 + 3]); o.z = pk2(a[8 * i8 + 4], a[8 * i8 + 5]); o.w = pk2(a[8 * i8 + 6], a[8 * i8 + 7]);
              *(u32x4*)((bf16_t*)(ws + WS_W + j * WE_STRIDE + WE_F) + (size_t)n * 2048 + kk0 + 8 * i8) = o; } }
      __syncthreads();
    }
    { LAS float* scr = (LAS float*)(F.lds + F.wave * 16640);
      const int gw = F.vcu * 8 + F.wave, NGW = F.G * 8;
      constexpr int I_FFN = 54 * 896, I_QKV = 2 * 384, I_O = 2 * 256;
      for (int it = gw; it < I_FFN + I_QKV + I_O; it += NGW) {
          if (it < I_FFN) { p0_ffn_matrix(p, it / 896, it % 896, scr, F.lane); continue; }
          int r = it - I_FFN;
          if (r < I_QKV) { const int j = r / 384, q = r % 384, nblk = QKVD / 64, kb = q / nblk, nb = q % nblk;
              p0_transpose_item(p.wqkv + (size_t)j * DM * QKVD, DM, QKVD, (bf16_t*)(ws + WS_W + WO_BASE + j * WO_STRIDE + WO_QKV), 64 * kb, 64 * nb, 64 * nb, scr, F.lane); continue; }
          r -= I_QKV;
          { const int j = r / 256, q = r % 256, nblk = DM / 64, kb = q / nblk, nb = q % nblk;
              p0_transpose_item(p.wo + (size_t)j * DM * DM, DM, DM, (bf16_t*)(ws + WS_W + WO_BASE + j * WO_STRIDE + WO_O), 64 * kb, 64 * nb, 64 * nb, scr, F.lane); }
      }
    }
}

template <bool ROUTER>
__device__ __forceinline__ void norm_phase(const Prm& p, Frame& F, const float* xl, const float* xc, const float* g, const float* mod  , int which, bf16_t* HB, int nrows,
                                            const float* wr, unsigned* mcnt, int* ltok, float* lw) {
    const int lane = F.lane;
    f32x4 gv[4];
#pragma unroll
    for (int j = 0; j < 4; ++j) gv[j] = *(const f32x4*)(g + 4 * (lane + 64 * j));
    float wreg[ROUTER ? 128 : 1];
    if (ROUTER) {
#pragma unroll
        for (int j = 0; j < 4; ++j)
#pragma unroll
            for (int i = 0; i < 4; ++i) { const int c = 4 * (lane + 64 * j) + i; const f32x4 w0 = *(const f32x4*)(wr + c * 8), w1 = *(const f32x4*)(wr + c * 8 + 4);
#pragma unroll
                for (int e = 0; e < 4; ++e) { wreg[(j * 4 + i) * 8 + e] = w0[e]; wreg[(j * 4 + i) * 8 + 4 + e] = w1[e]; } }
    }
    const int rpb = (nrows + F.G - 1) / F.G;
    const int r0 = ROUTER ? F.vcu * rpb : F.vcu * 8 + F.wave, r1 = ROUTER ? (r0 + rpb < nrows ? r0 + rpb : nrows) : nrows, rstep = ROUTER ? 8 : F.G * 8;
    LAS unsigned* ech = (LAS unsigned*)F.lds; LAS float* gch = (LAS float*)(F.lds + 4096);
    if (ROUTER) __syncthreads();
    for (int rr = ROUTER ? r0 + F.wave : r0; rr < r1; rr += 2 * rstep) {
        f32x4 v[2][4]; float ss[2];
#pragma unroll
        for (int q = 0; q < 2; ++q) { const int r = rr + q * rstep; ss[q] = 0.f;
            if (r < r1) { const float* xr = (r < TL) ? xl + (size_t)r * DM : xc + (size_t)(r - TL) * DM;
#pragma unroll
                for (int j = 0; j < 4; ++j) v[q][j] = *(const f32x4*)(xr + 4 * (lane + 64 * j)); } }
#pragma unroll
        for (int q = 0; q < 2; ++q) { const int r = rr + q * rstep;
            if (r < r1) {
#pragma unroll
                for (int j = 0; j < 4; ++j) ss[q] += (v[q][j][0] * v[q][j][0] + v[q][j][1] * v[q][j][1]) + (v[q][j][2] * v[q][j][2] + v[q][j][3] * v[q][j][3]); } }
#pragma unroll
        for (int q = 0; q < 2; ++q) { const int r = rr + q * rstep;
          if (r < r1) {
            const int b5 = (r < TL) ? r / SEQ : 4; const float* mp = mod + (size_t)b5 * NMOD * DM + which * DM;
            const float rstd = rsqrtf(wave_sum(ss[q]) * (1.f / DM) + EPS);
            float lg[8] = {};
#pragma unroll
            for (int j = 0; j < 4; ++j) { const f32x4 sh = *(const f32x4*)(mp + 4 * (lane + 64 * j)), sc = *(const f32x4*)(mp + DM + 4 * (lane + 64 * j));
                f32x4 h = v[q][j] * rstd * gv[j] * (sc + 1.f) + sh;
                u32x2 o; o.x = pk2(h[0], h[1]); o.y = pk2(h[2], h[3]); *(u32x2*)(HB + (size_t)r * DM + 4 * (lane + 64 * j)) = o;
                if (ROUTER) {
#pragma unroll
                    for (int i = 0; i < 4; ++i)
#pragma unroll
                        for (int e = 0; e < 8; ++e) lg[e] += h[i] * wreg[(j * 4 + i) * 8 + e]; } }
            if (ROUTER) {
                float a4[4], b2[2], c1;
#pragma unroll
                for (int t = 0; t < 4; ++t) { const float snd = (lane & 1) ? lg[t] : lg[t + 4], kp = (lane & 1) ? lg[t + 4] : lg[t]; a4[t] = kp + SWZ_XOR(snd, 1); }
#pragma unroll
                for (int t = 0; t < 2; ++t) { const float snd = (lane & 2) ? a4[t] : a4[t + 2], kp = (lane & 2) ? a4[t + 2] : a4[t]; b2[t] = kp + SWZ_XOR(snd, 2); }
                { const float snd = (lane & 4) ? b2[0] : b2[1], kp = (lane & 4) ? b2[1] : b2[0]; c1 = kp + SWZ_XOR(snd, 4); }
                c1 += SWZ_XOR(c1, 8); c1 += SWZ_XOR(c1, 16);
                const int cb = __builtin_bit_cast(int, c1);
#pragma unroll
                for (int e = 0; e < 8; ++e) { const int l = ((e >> 2) & 1) | (((e >> 1) & 1) << 1) | ((e & 1) << 2);
                    lg[e] = __builtin_bit_cast(float, __builtin_amdgcn_readlane(cb, l)) + __builtin_bit_cast(float, __builtin_amdgcn_readlane(cb, l + 32)); }
                int e0 = 0; float v0 = lg[0];
#pragma unroll
                for (int e = 1; e < 8; ++e) if (lg[e] > v0) { v0 = lg[e]; e0 = e; }
                int e1 = -1; float v1 = -INFINITY;
#pragma unroll
                for (int e = 0; e < 8; ++e) if (e != e0 && lg[e] > v1) { v1 = lg[e]; e1 = e; }
                const float g1 = 1.f / (1.f + expf(v0 - v1)), g0 = 1.f - g1;
                if (lane == 0) { ech[r - r0] = (unsigned)e0 | ((unsigned)e1 << 8); gch[2 * (r - r0)] = g0; gch[2 * (r - r0) + 1] = g1; }
            }
          } }
    }
    if (ROUTER) {
        __syncthreads();
        if (F.tid < 16) { const int grp = F.tid, k = grp >> 3, e = grp & 7, n = r1 - r0; int cnt = 0;
            for (int i = 0; i < n; ++i) cnt += (int)(((ech[i] >> (8 * k)) & 0xffu) == (unsigned)e);
            mcnt[(size_t)F.vcu * 16 + grp] = (unsigned)cnt; }
    }
}
__device__ __forceinline__ void moe_lists(Frame& F, const unsigned* cntw, unsigned* mcnt, int* ltok, float* lw, int nrows, int* tokslot) {
    const int rpb = (nrows + F.G - 1) / F.G; const int r0 = F.vcu * rpb, r1 = (r0 + rpb < nrows ? r0 + rpb : nrows);
    LAS unsigned* ech = (LAS unsigned*)F.lds; LAS float* gch = (LAS float*)(F.lds + 4096);
    unsigned pos = 0u, tot = 0u; const int grp = F.tid & 15, k = grp >> 3, e = grp & 7, n = r1 - r0;
    if (F.tid < 16) {
        for (int w = 0; w < F.G; ++w) { const unsigned c = cntw[(size_t)w * 16 + grp]; tot += c; pos += (w < F.vcu) ? c : 0u; }
        if (F.vcu == 0) mcnt[grp] = tot;
        F.MISC[64 + grp] = (tot + 255u) / 256u; }
    __syncthreads();
    if (F.tid < 16) { unsigned first = 0u;
        for (int g2 = 0; g2 < grp; ++g2) first += F.MISC[64 + g2];
        for (int i = 0; i < n; ++i) if (((ech[i] >> (8 * k)) & 0xffu) == (unsigned)e) { ltok[(size_t)grp * TT + pos] = r0 + i; lw[(size_t)grp * TT + pos] = gch[2 * i + k];
            if (tokslot) tokslot[(size_t)(r0 + i) * 2 + k] = (int)(first * 256u + pos); ++pos; } }
}
__device__ __forceinline__ void final_norm_phase(const Prm& p, Frame& F, const bf16_t* ys, const int* tokslot) {
    const int gw = F.vcu * 8 + F.wave, NGW = F.G * 8, lane = F.lane;
    f32x4 gv[4];
#pragma unroll
    for (int j = 0; j < 4; ++j) gv[j] = *(const f32x4*)(p.fng + 4 * (lane + 64 * j));
    for (int rr = gw; rr < TL; rr += 2 * NGW) { f32x4 v[2][4];
#pragma unroll
        for (int q = 0; q < 2; ++q) { const int r = rr + q * NGW; if (r < TL) {
#pragma unroll
            for (int j = 0; j < 4; ++j) v[q][j] = *(const f32x4*)(p.out + (size_t)r * DM + 4 * (lane + 64 * j));
            const int s0 = tokslot[2 * r], s1 = tokslot[2 * r + 1];
#pragma unroll
            for (int j = 0; j < 4; ++j) { const u32x2 a = *(const u32x2*)(ys + (size_t)s0 * DM + 4 * (lane + 64 * j)), b = *(const u32x2*)(ys + (size_t)s1 * DM + 4 * (lane + 64 * j));
                v[q][j][0] += __uint_as_float(a.x << 16) + __uint_as_float(b.x << 16); v[q][j][1] += __uint_as_float(a.x & 0xffff0000u) + __uint_as_float(b.x & 0xffff0000u);
                v[q][j][2] += __uint_as_float(a.y << 16) + __uint_as_float(b.y << 16); v[q][j][3] += __uint_as_float(a.y & 0xffff0000u) + __uint_as_float(b.y & 0xffff0000u); } } }
#pragma unroll
        for (int q = 0; q < 2; ++q) { const int r = rr + q * NGW; if (r < TL) { float s = 0.f;
#pragma unroll
            for (int j = 0; j < 4; ++j) s += (v[q][j][0] * v[q][j][0] + v[q][j][1] * v[q][j][1]) + (v[q][j][2] * v[q][j][2] + v[q][j][3] * v[q][j][3]);
            const float rstd = rsqrtf(wave_sum(s) * (1.f / DM) + EPS);
#pragma unroll
            for (int j = 0; j < 4; ++j) *(f32x4*)(p.out + (size_t)r * DM + 4 * (lane + 64 * j)) = v[q][j] * rstd * gv[j]; } } }
}
__device__ __forceinline__ void moe_tables(Frame& F, const unsigned* mcnt) {
    __syncthreads();
    if (F.tid == 0) { unsigned first = 0u, nb0 = 0u;
        for (int g = 0; g < 16; ++g) { const unsigned c = __hip_atomic_load(mcnt + g, __ATOMIC_RELAXED, __HIP_MEMORY_SCOPE_AGENT); F.MISC[16 + g] = first; F.MISC[32 + g] = c; first += (c + 255u) / 256u; if (g == 7) nb0 = first; }
        F.MISC[48] = nb0; F.MISC[49] = first; }
    __syncthreads();
}


__device__ __forceinline__ int fresh_tid(int wave) { int tl; asm volatile("v_mbcnt_lo_u32_b32 %0, -1, 0\n\tv_mbcnt_hi_u32_b32 %0, -1, %0" : "=v"(tl)); return wave * 64 + tl; }
typedef short v4i16_t __attribute__((ext_vector_type(4)));
__device__ __forceinline__ unsigned off_b(unsigned row, unsigned ch) { return 256u * row + 16u * (ch ^ (((row & 3u) << 2) | ((row >> 2) & 3u))); }
__device__ __forceinline__ int crow(int r, int hi) { return (r & 3) + 8 * (r >> 2) + 4 * hi; }
__device__ __forceinline__ s16x4 trrd(const LAS unsigned char* p) { return __builtin_bit_cast(s16x4, __builtin_amdgcn_ds_read_tr16_b64_v4i16((LAS v4i16_t*)p)); }
template <int MB>
__device__ __forceinline__ void dft_mma(const LAS unsigned char* Aimg, const LAS unsigned char* Bimg, int wave, int lane, f32x16 (&acc)[MB]) {
    const int r32 = lane & 31, hi = lane >> 5;
    const unsigned X = ((r32 & 3) << 2) | ((r32 >> 2) & 3);
    const LAS unsigned char* bbase = Bimg + (wave >> 2) * 32768;
    const unsigned blk = (lane >> 4) & 1, q = (lane & 15) >> 2, pp = lane & 3, c = wave & 3;
    unsigned tra[2];
#pragma unroll
    for (int t = 0; t < 2; ++t) tra[t] = off_b(8 * hi + 4 * t + q, 4 * c + 2 * blk + (pp >> 1)) + 8 * (pp & 1);
#pragma unroll
    for (int ks = 0; ks < 8; ++ks) {
        const s16x4 lo = trrd(bbase + tra[0] + ks * 4096), hh = trrd(bbase + tra[1] + ks * 4096);
        const bf16x8 bf = (bf16x8){lo[0], lo[1], lo[2], lo[3], hh[0], hh[1], hh[2], hh[3]};
        const unsigned achunk = ((2 * ks + hi) ^ X) * 16;
#pragma unroll
        for (int mb = 0; mb < MB; ++mb) { const bf16x8 af = *(const LAS bf16x8*)(Aimg + 256 * (32 * mb + r32) + achunk);
            acc[mb] = __builtin_amdgcn_mfma_f32_32x32x16_bf16(af, bf, acc[mb], 0, 0, 0); }
    }
}
__device__ __forceinline__ void s1_phase(const Prm& p, Frame& F, const float* xl, const float* xc, const float* g, const float* mod, bf16_t* Y1, bf16_t* Y1C) {
    LAS unsigned char* Aimg = F.lds; LAS unsigned char* Bimg = F.lds + 65536;
    LAS float* rstd = (LAS float*)(F.lds + 131072); LAS f32x2* tw = (LAS f32x2*)(F.lds + 131584); LAS float* gm = (LAS float*)(F.lds + 132608); LAS float* shv = (LAS float*)(F.lds + 136704);
    const bf16_t* F1 = (const bf16_t*)(p.ws + WS_TAB + TAB_F1); const float2* TW = (const float2*)(p.ws + WS_TAB + TAB_TW); const float2* TWC = (const float2*)(p.ws + WS_TAB + TAB_TWC);
    const int tid = F.tid, lane = F.lane, wave = F.wave, r32 = lane & 31, hi = lane >> 5;
    __syncthreads();
    for (int qq = tid; qq < 256 * 16; qq += 512) { const int row = qq >> 4, ch = qq & 15; *(LAS u32x4*)(Aimg + off_b(row, ch)) = *(const u32x4*)(F1 + row * 128 + ch * 8); }
    for (int w = F.vcu; w < 288; w += F.G) {
        const int u = w < 256 ? w : 256 + ((w - 256) >> 2), c_lo = w < 256 ? 0 : (w - 256) & 3, c_hi = w < 256 ? 4 : c_lo + 1;
        const bool lat = u < 256; const int b = lat ? u >> 6 : (u - 256) >> 1, n2 = lat ? u & 63 : (u - 256) & 1;
        const float* xs = lat ? xl + ((size_t)b * SEQ + n2) * DM : xc + ((size_t)b * CTXL + n2) * DM; const size_t rstride = (size_t)(lat ? 64 : 2) * DM;
        const float* mp = mod + (size_t)(lat ? b : 4) * NMOD * DM;
        __syncthreads();
        for (int c = tid; c < DM; c += 512) { gm[c] = g[c] * (1.f + mp[DM + c]); shv[c] = mp[c]; }
        if (tid < 128) { const float2 t = lat ? TW[n2 * 128 + tid] : TWC[n2 * 128 + tid]; tw[tid] = (f32x2){t.x, t.y}; }
#pragma unroll 4
        for (int i = 0; i < 16; ++i) { const int n1 = 16 * wave + i; const float* xr = xs + n1 * rstride; float sq = 0.f;
#pragma unroll
            for (int j = 0; j < 4; ++j) { const f32x4 v = *(const f32x4*)(xr + 4 * (lane + 64 * j)); sq += (v[0] * v[0] + v[1] * v[1]) + (v[2] * v[2] + v[3] * v[3]); }
            sq = wave_sum(sq); if (lane == 0) rstd[n1] = rsqrtf(sq * (1.f / DM) + EPS); }
        __syncthreads();
        for (int cc = c_lo; cc < c_hi; ++cc) {
            { const int tt = fresh_tid(wave); const int cols4 = tt & 63, rb = tt >> 6, c0 = 256 * cc + 4 * cols4;
              f32x4 xv[16];
#pragma unroll
              for (int i = 0; i < 16; ++i) xv[i] = *(const f32x4*)(xs + (size_t)(rb + 8 * i) * rstride + c0);
              const f32x4 gv = *(const LAS f32x4*)(gm + c0), sv = *(const LAS f32x4*)(shv + c0);
              LAS unsigned char* bw = Bimg + (cols4 >> 5) * 32768 + 8 * (cols4 & 1);
#pragma unroll
              for (int i = 0; i < 16; ++i) { const int n1 = rb + 8 * i; const f32x4 h = xv[i] * rstd[n1] * gv + sv; u32x2 o; o.x = pk2(h[0], h[1]); o.y = pk2(h[2], h[3]);
                  *(LAS u32x2*)(bw + off_b(n1, (cols4 & 31) >> 1)) = o; } }
            __syncthreads();
            f32x16 acc[8];
#pragma unroll
            for (int mb = 0; mb < 8; ++mb) acc[mb] = (f32x16){};
            dft_mma<8>(Aimg, Bimg, wave, lane, acc);
            __syncthreads();
            bf16_t* Y = lat ? Y1 : Y1C; const size_t k1stride = (size_t)(lat ? 128 : 4) * DM;
            const size_t ybase = (lat ? ((size_t)b * 128 * 64 + n2) * 2 : ((size_t)b * 128 * 2 + n2) * 2) * DM + 256 * cc;
            LAS bf16_t* ost = (LAS bf16_t*)Bimg + (4 * hi) * 256 + 32 * wave + r32;
#pragma unroll
            for (int hf = 0; hf < 2; ++hf) {
#pragma unroll
                for (int mb = 0; mb < 4; ++mb)
#pragma unroll
                    for (int r = 0; r < 16; r += 2) { const int k1 = (32 * (4 * hf + mb) + crow(r, hi)) >> 1; const f32x2 t = tw[k1]; const float re = acc[4 * hf + mb][r], im = acc[4 * hf + mb][r + 1];
                        ost[(32 * mb + (r & 3) + 8 * (r >> 2)) * 256] = (bf16_t)f2bf(re * t.x - im * t.y); ost[(32 * mb + (r & 3) + 8 * (r >> 2) + 1) * 256] = (bf16_t)f2bf(re * t.y + im * t.x);
                        if ((r & 7) == 6) asm volatile("" ::: "memory"); }
                __syncthreads();
                const int t2 = fresh_tid(wave);
#pragma unroll
                for (int i = 0; i < 8; ++i) { const int qq = t2 + 512 * i, row = qq >> 5, ch = qq & 31;
                    const u32x4 v = *(const LAS u32x4*)((const LAS unsigned char*)Bimg + row * 512 + ch * 16);
                    const int k1 = 64 * hf + (row >> 1);
                    *(u32x4*)(Y + ybase + (size_t)k1 * k1stride + (size_t)(row & 1) * DM + ch * 8) = v; }
                __syncthreads();
            }
        }
    }
}
__device__ __forceinline__ void s2_phase(const Prm& p, Frame& F, const bf16_t* Y1, const bf16_t* Y1C, bf16_t* PQ) {
    LAS unsigned char* Aimg = F.lds; LAS unsigned char* Bimg = F.lds + 65536;
    const bf16_t* F2 = (const bf16_t*)(p.ws + WS_TAB + TAB_F2);
    const int tid = F.tid, lane = F.lane, wave = F.wave, r32 = lane & 31, hi = lane >> 5;
    __syncthreads();
    for (int qq = tid; qq < 128 * 16; qq += 512) { const int row = qq >> 4, ch = qq & 15; *(LAS u32x4*)(Aimg + off_b(row, ch)) = *(const u32x4*)(F2 + row * 128 + ch * 8); }
    u32x4 v[8];
    { const int u = F.vcu; if (u < 2048) { const int cc = u & 3, k1 = (u >> 2) & 127, b = u >> 9; const bf16_t* src = Y1 + ((size_t)b * 128 + k1) * 128 * DM + 256 * cc;
#pragma unroll
        for (int i = 0; i < 8; ++i) { const int qq = tid + 512 * i; v[i] = *(const u32x4*)(src + (size_t)(qq >> 5) * DM + (qq & 31) * 8); } } }
    for (int u = F.vcu; u < 2048; u += F.G) {
        const int cc = u & 3, k1 = (u >> 2) & 127, b = u >> 9;
        __syncthreads();
#pragma unroll
        for (int i = 0; i < 8; ++i) { const int qq = tid + 512 * i, row = qq >> 5, ch32 = qq & 31; *(LAS u32x4*)(Bimg + (ch32 >> 4) * 32768 + off_b(row, ch32 & 15)) = v[i]; }
        __syncthreads();
        { const int un = u + F.G; if (un < 2048) { const int ccn = un & 3, k1n = (un >> 2) & 127, bn = un >> 9; const bf16_t* src = Y1 + ((size_t)bn * 128 + k1n) * 128 * DM + 256 * ccn;
#pragma unroll
            for (int i = 0; i < 8; ++i) { const int qq = tid + 512 * i; v[i] = *(const u32x4*)(src + (size_t)(qq >> 5) * DM + (qq & 31) * 8); } } }
        f32x16 acc[4];
#pragma unroll
        for (int mb = 0; mb < 4; ++mb) acc[mb] = (f32x16){};
        dft_mma<4>(Aimg, Bimg, wave, lane, acc);
        __syncthreads();
        { LAS bf16_t* ost = (LAS bf16_t*)Bimg + (4 * hi) * 256 + 32 * wave + r32;
#pragma unroll
          for (int mb = 0; mb < 4; ++mb)
#pragma unroll
              for (int r = 0; r < 16; ++r) ost[(32 * mb + (r & 3) + 8 * (r >> 2)) * 256] = (bf16_t)f2bf(acc[mb][r]); }
        __syncthreads();
        { const int t2 = fresh_tid(wave);
#pragma unroll
          for (int i = 0; i < 8; ++i) { const int qq = t2 + 512 * i, row = qq >> 5, ch = qq & 31, k2 = row >> 1, cp = row & 1;
              const u32x4 o = *(const LAS u32x4*)((const LAS unsigned char*)Bimg + row * 512 + ch * 16);
              *(u32x4*)(PQ + ((size_t)b * SEQ + k1 + 128 * k2) * 2048 + cp * DM + 256 * cc + ch * 8) = o; } }
    }
    { const int gt = F.vcu * 512 + fresh_tid(wave), NT = F.G * 512; const float sc = 0.70710678118654752f;
      for (int i = gt; i < NB * 128 * DM; i += NT) { const int ch = i & (DM - 1), k1 = (i >> 10) & 127, b = i >> 17;
          const bf16_t* y = Y1C + ((size_t)b * 128 + k1) * 4 * DM + ch;
          const float y0r = __uint_as_float((unsigned)y[0] << 16), y0i = __uint_as_float((unsigned)y[DM] << 16), y1r = __uint_as_float((unsigned)y[2 * DM] << 16), y1i = __uint_as_float((unsigned)y[3 * DM] << 16);
          bf16_t* o0 = PQ + ((size_t)TL + b * CTXL + k1) * 2048 + ch; bf16_t* o1 = o0 + (size_t)128 * 2048;
          o0[0] = (bf16_t)f2bf((y0r + y1r) * sc); o0[DM] = (bf16_t)f2bf((y0i + y1i) * sc); o1[0] = (bf16_t)f2bf((y0r - y1r) * sc); o1[DM] = (bf16_t)f2bf((y0i - y1i) * sc); } }
}

__device__ __forceinline__ void attn_phase(const Prm& p, Frame& F, const bf16_t* QB, const bf16_t* KB, const bf16_t* VB, bf16_t* OB, const float* sinks, int nunits) {
    LAS unsigned char* Ks = F.lds; LAS unsigned char* Vs = F.lds + 8192; LAS float* wsf = (LAS float*)(F.lds + 32768) + F.wave * 64; LAS bf16_t* stg = (LAS bf16_t*)(F.lds + 34816 + F.wave * 4096);
    const int lane = F.lane, wave = F.wave, r32 = lane & 31, hi = lane >> 5;
    for (int u = F.vcu; u < nunits; u += F.G) {
        const bool isctx = u >= 2048; const int uu = isctx ? u - 2048 : u;
        const int pb = isctx ? (uu & 3) : (uu & 127), kv = isctx ? ((uu >> 2) & 3) : ((uu >> 7) & 3), b = isctx ? (uu >> 4) : (uu >> 9);
        const int h = kv * 4 + (wave >> 1); const int qq = 32 * (wave & 1) + r32;
        const size_t qrow0 = (size_t)(isctx ? TL + b * CTXL : b * SEQ) + 64 * pb + 32 * (wave & 1);
        bf16x8 qr[4];
#pragma unroll
        for (int d0 = 0; d0 < 4; ++d0) qr[d0] = *(const bf16x8*)(QB + (qrow0 + r32) * DM + h * 64 + d0 * 16 + hi * 8);
        float m = sinks[h] * LOG2E, l = hi ? 0.f : 1.f; f32x16 o[2]; o[0] = (f32x16){}; o[1] = (f32x16){};
        const int ntl = isctx ? 0 : 5;
        const int t_first = isctx ? 0 : (pb < 2 ? 2 - pb : 0), t_lastl = isctx ? -1 : (pb > 125 ? 129 - pb : 4);
        const bf16_t* kbase = KB + (size_t)lane * 256 + kv * 64 + wave * 8;
        const bf16_t* vbase = VB + (size_t)(16 * (wave & 3) + (lane >> 2)) * 256 + kv * 64 + (wave >> 2) * 32 + (lane & 3) * 8;
        auto tile_row0 = [&](int ti) -> size_t { return ti < ntl ? (size_t)b * SEQ + 64 * (pb - 2 + ti) : (size_t)TL + b * CTXL + 64 * (ti - ntl); };
        int ti = isctx ? 0 : t_first; int slot = 0;
        u32x4 kreg = *(const u32x4*)(kbase + tile_row0(ti) * 256), vreg = *(const u32x4*)(vbase + tile_row0(ti) * 256);
        __syncthreads();
        *(LAS u32x4*)(Ks + wave * 1024 + lane * 16) = kreg; *(LAS u32x4*)(Vs + wave * 1024 + lane * 16) = vreg;
        { int tn0 = ti + 1; if (tn0 > t_lastl && tn0 < ntl) tn0 = ntl; kreg = *(const u32x4*)(kbase + tile_row0(tn0) * 256); vreg = *(const u32x4*)(vbase + tile_row0(tn0) * 256); }
        __syncthreads();
        while (ti < ntl + 4) {
            const int mode = (ti < ntl) ? ((ti == 0) ? 1 : (ti == 4) ? 2 : 0) : 0;
            int tn = ti + 1; if (tn > t_lastl && tn < ntl) tn = ntl;
            int tnn = tn + 1; if (tnn > t_lastl && tnn < ntl) tnn = ntl;
            const LAS unsigned char* kb = Ks + slot * 16384 + hi * 1024 + r32 * 16;
            const LAS unsigned char* vp = Vs + slot * 16384 + ((lane >> 4) & 1) * 32 + (lane & 3) * 8 + (4 * hi + ((lane & 15) >> 2)) * 64;
            f32x16 p0 = (f32x16){}, p1 = (f32x16){};
#pragma unroll
            for (int d0 = 0; d0 < 4; ++d0) { const bf16x8 b0 = *(const LAS bf16x8*)(kb + d0 * 2048), b1 = *(const LAS bf16x8*)(kb + d0 * 2048 + 512);
                p0 = __builtin_amdgcn_mfma_f32_32x32x16_bf16(b0, qr[d0], p0, 0, 0, 0); p1 = __builtin_amdgcn_mfma_f32_32x32x16_bf16(b1, qr[d0], p1, 0, 0, 0); }
            if (mode) {
#pragma unroll
                for (int r = 0; r < 16; ++r) { const int kk = crow(r, hi); const bool m0 = (mode == 1) ? (kk < qq) : (kk > qq), m1 = (mode == 1) ? (kk + 32 < qq) : (kk + 32 > qq);
                    if (m0) p0[r] = -INFINITY; if (m1) p1[r] = -INFINITY; } }
            float rm = fmaxf(p0[0], p1[0]);
#pragma unroll
            for (int r = 1; r < 16; ++r) rm = fmaxf(rm, fmaxf(p0[r], p1[r]));
            { auto rr = __builtin_amdgcn_permlane32_swap(__float_as_uint(rm), __float_as_uint(rm), false, false); rm = fmaxf(__uint_as_float(rr[0]), __uint_as_float(rr[1])); }
            const float mnew = fmaxf(m, rm), alpha = __builtin_amdgcn_exp2f(m - mnew); m = mnew;
            float ps = 0.f;
#pragma unroll
            for (int r = 0; r < 16; ++r) { p0[r] = __builtin_amdgcn_exp2f(p0[r] - m); p1[r] = __builtin_amdgcn_exp2f(p1[r] - m); ps += p0[r] + p1[r]; }
            l = l * alpha + ps;
            if (hi == 0) wsf[r32] = alpha;
#pragma unroll
            for (int r = 0; r < 16; ++r) { const float a = wsf[crow(r, hi)]; o[0][r] *= a; o[1][r] *= a; }
            u32x4 pw[4];
            pw[0] = (u32x4){pk2(p0[0], p0[1]), pk2(p0[2], p0[3]), pk2(p0[4], p0[5]), pk2(p0[6], p0[7])};
            pw[1] = (u32x4){pk2(p0[8], p0[9]), pk2(p0[10], p0[11]), pk2(p0[12], p0[13]), pk2(p0[14], p0[15])};
            pw[2] = (u32x4){pk2(p1[0], p1[1]), pk2(p1[2], p1[3]), pk2(p1[4], p1[5]), pk2(p1[6], p1[7])};
            pw[3] = (u32x4){pk2(p1[8], p1[9]), pk2(p1[10], p1[11]), pk2(p1[12], p1[13]), pk2(p1[14], p1[15])};
#pragma unroll
            for (int d0 = 0; d0 < 2; ++d0)
#pragma unroll
                for (int ks = 0; ks < 4; ++ks) { const s16x4 lo = trrd(vp + d0 * 4096 + ks * 1024), hh = trrd(vp + d0 * 4096 + ks * 1024 + 512);
                    const bf16x8 vf = (bf16x8){lo[0], lo[1], lo[2], lo[3], hh[0], hh[1], hh[2], hh[3]};
                    o[d0] = __builtin_amdgcn_mfma_f32_32x32x16_bf16(__builtin_bit_cast(bf16x8, pw[ks]), vf, o[d0], 0, 0, 0); }
            if (tn < ntl + 4) {
                *(LAS u32x4*)(Ks + (slot ^ 1) * 16384 + wave * 1024 + lane * 16) = kreg; *(LAS u32x4*)(Vs + (slot ^ 1) * 16384 + wave * 1024 + lane * 16) = vreg;
                if (tnn < ntl + 4) { kreg = *(const u32x4*)(kbase + tile_row0(tnn) * 256); vreg = *(const u32x4*)(vbase + tile_row0(tnn) * 256); }
                __syncthreads(); }
            ti = tn; slot ^= 1;
        }
        { auto rr = __builtin_amdgcn_permlane32_swap(__float_as_uint(l), __float_as_uint(l), false, false); l = __uint_as_float(rr[0]) + __uint_as_float(rr[1]); }
        if (hi == 0) wsf[32 + r32] = l;
#pragma unroll
        for (int r = 0; r < 16; ++r) { const int orow = crow(r, hi); const float rl = __builtin_amdgcn_rcpf(wsf[32 + orow]);
            stg[orow * 64 + r32] = (bf16_t)f2bf(o[0][r] * rl); stg[orow * 64 + 32 + r32] = (bf16_t)f2bf(o[1][r] * rl); }
#pragma unroll
        for (int i = 0; i < 4; ++i) { const int row = i * 8 + (lane >> 3), ch = lane & 7; const u32x4 v = *(const LAS u32x4*)(stg + row * 64 + ch * 8);
            *(u32x4*)(OB + (qrow0 + row) * DM + h * 64 + ch * 8) = v; }
    }
}


__device__ __forceinline__ int next_real(int ph) { int q = ph + 1; if (q >= 1 && q <= 32) { const int i = (q - 1) >> 3, o = (q - 1) & 7; if ((i & 1) == 0 && o >= 6) q = 1 + 8 * (i + 1); } return q; }
__global__ void __launch_bounds__(512, 2) mk_fwd(Args a) {
    extern __shared__ __attribute__((aligned(16))) unsigned char lds_raw[];
    Frame F; F.lds = (LAS unsigned char*)lds_raw; F.MISC = (volatile LAS unsigned*)(F.lds + LDS_MISC);
    F.tid = threadIdx.x; F.lane = F.tid & 63; F.wave = __builtin_amdgcn_readfirstlane(F.tid >> 6);
    F.G = gridDim.x; { const int bx = blockIdx.x; F.vcu = (F.G % 8 == 0) ? (bx % 8) * (F.G / 8) + bx / 8 : bx; }
    const Prm& p = a.p; GAS unsigned char* ws = (GAS unsigned char*)a.p.ws;
    for (int u = F.tid; u < 128; u += 512) F.MISC[u] = 0u;
    __syncthreads();
    unsigned* ctl = (unsigned*)(ws + WS_CTL);
    XcdBarrier bar = xcd_barrier_post(ctl + CW_BAR, F.MISC + 8);
    const int lo = a.ph_lo, hi = a.ph_hi;
    const int wave0 = __builtin_amdgcn_readfirstlane((int)threadIdx.x >> 6);
#ifndef ONLY
#define ONLY -1
#endif
#ifndef PROBE_KIND
#define PROBE_KIND -1
#endif
#ifndef PROBE_GEMMS
#define PROBE_GEMMS 0
#endif
#define NREP(k) (((k) == PROBE_KIND) || (PROBE_GEMMS && ((k) == 3 || (k) == 5 || (k) == 6 || (k) == 7 || (k) == 9 || (k) == 11 || (k) == 12)) ? 2 : 1)
#define EN(k) (ONLY == -1 || ONLY == (k))
#define RUN(ph) (lo <= (ph) && (ph) < hi)
#define SEAM(ph) do { if (next_real(ph) < hi) xcd_barrier(bar); } while (0)
#define FRESH() do { const int t_ = fresh_tid(wave0);     F.tid = t_; F.lane = t_ & 63; F.wave = __builtin_amdgcn_readfirstlane(t_ >> 6); asm volatile("" : "+s"(ws)); } while (0)
    const int cblk = (int)blockIdx.x;
#define WSP(T, off) ((T*)(GAS T*)(ws + (off)))
#define SKCTL(slots_off, ph) pg8::SkCtl{WSP(f32x4, slots_off), WSP(unsigned, WS_CTL) + CW_SKF, WSP(unsigned, WS_CTL) + CW_BAR + XB_TMO, (unsigned)((ph) * 4 + rep + 1), cblk, F.G}
    for (int rep = 0; rep < NREP(0); ++rep) if (EN(0) && RUN(0)) { FRESH(); p0_prologue(p, F); SEAM(0); }

    for (int lp = 0; lp < 2; ++lp) {
        const int ie = 2 * lp, io = 2 * lp + 1, j = lp;
        { const int base = 1 + 8 * ie;
          for (int rep = 0; rep < NREP(1); ++rep) if (EN(1) && RUN(base + 0)) { FRESH(); s1_phase(p, F, ie == 0 ? p.x : p.out, ie == 0 ? p.ctx : WSP(const float, WS_XC), p.nmg + ie * DM, WSP(const float, WS_MOD) + (size_t)ie * 5 * NMOD * DM,
                                                  WSP(bf16_t, WS_MS + MS_BIG + BIG_Y1), WSP(bf16_t, WS_MS + MS_BIG + BIG_Y1C)); SEAM(base + 0); }
          for (int rep = 0; rep < NREP(2); ++rep) if (EN(2) && RUN(base + 1)) { FRESH(); s2_phase(p, F, WSP(const bf16_t, WS_MS + MS_BIG + BIG_Y1), WSP(const bf16_t, WS_MS + MS_BIG + BIG_Y1C), WSP(bf16_t, WS_MS + MS_BIG + BIG_PQ)); SEAM(base + 1); }
          for (int rep = 0; rep < NREP(3); ++rep) if (EN(3) && RUN(base + 2)) { FRESH(); SchedDense<true> S{WSP(const bf16_t, WS_W + j * WE_STRIDE + WE_F), TT / 256, DM / 256, F.G, cblk, 2048};
              EpiResid E{ie == 0 ? p.x : p.out, ie == 0 ? p.ctx : WSP(const float, WS_XC), p.out, WSP(float, WS_XC), WSP(const float, WS_MOD) + (size_t)ie * 5 * NMOD * DM, 2, rep ? 0.f : 1.f};
              pg8::gemm_phase<EpiResid, SchedDense<true>, false>(F.lds, F.tid, WSP(const bf16_t, WS_MS + MS_BIG + BIG_PQ), 2048, S, E, SKCTL(WS_MS + MS_HB, base + 2)); SEAM(base + 2); }
          for (int rep = 0; rep < NREP(4); ++rep) if (EN(4) && RUN(base + 3)) { FRESH(); norm_phase<false>(p, F, p.out, WSP(const float, WS_XC), p.nfg + ie * DM, WSP(const float, WS_MOD) + (size_t)ie * 5 * NMOD * DM, 3, WSP(bf16_t, WS_MS + MS_HB), TT, nullptr, nullptr, nullptr, nullptr); SEAM(base + 3); }
          for (int rep = 0; rep < NREP(5); ++rep) if (EN(5) && RUN(base + 4)) { FRESH(); SchedDense<false> S{WSP(const bf16_t, WS_W + j * WE_STRIDE + WE_GU), TT / 256, 2 * DFF / 256, F.G, cblk, DM}; EpiSwiglu E{WSP(bf16_t, WS_MS + MS_BIG + BIG_ACT)};
              pg8::gemm_phase<EpiSwiglu, SchedDense<false>, false>(F.lds, F.tid, WSP(const bf16_t, WS_MS + MS_HB), DM, S, E); SEAM(base + 4); }
          for (int rep = 0; rep < NREP(6); ++rep) if (EN(6) && RUN(base + 5)) { FRESH(); SchedDense<true> S{WSP(const bf16_t, WS_W + j * WE_STRIDE + WE_D), TT / 256, DM / 256, F.G, cblk, DFF};
              EpiResid E{p.out, WSP(const float, WS_XC), p.out, WSP(float, WS_XC), WSP(const float, WS_MOD) + (size_t)ie * 5 * NMOD * DM, 5, rep ? 0.f : 1.f};
              pg8::gemm_phase<EpiResid, SchedDense<true>, false>(F.lds, F.tid, WSP(const bf16_t, WS_MS + MS_BIG + BIG_ACT), DFF, S, E, SKCTL(WS_MS + MS_HB, base + 5)); SEAM(base + 5); }
        }
        { const int base = 1 + 8 * io; const bool last = (io == DEPTH - 1); const int nrows = last ? TL : TT;
          const size_t wo = WS_W + WO_BASE + j * WO_STRIDE;
          for (int rep = 0; rep < NREP(4); ++rep) if (EN(4) && RUN(base + 0)) { FRESH(); norm_phase<false>(p, F, p.out, WSP(const float, WS_XC), p.nmg + io * DM, WSP(const float, WS_MOD) + (size_t)io * 5 * NMOD * DM, 0, WSP(bf16_t, WS_MS + MS_HB), TT, nullptr, nullptr, nullptr, nullptr); SEAM(base + 0); }
          for (int rep = 0; rep < NREP(7); ++rep) if (EN(7) && RUN(base + 1)) { FRESH(); SchedDense<true> S{WSP(const bf16_t, wo + WO_QKV), TT / 256, QKVD / 256, F.G, cblk, DM};
              EpiQKV E{WSP(bf16_t, WS_MS + MS_BIG + BIG_Q), WSP(bf16_t, WS_MS + MS_BIG + BIG_K), WSP(bf16_t, WS_MS + MS_BIG + BIG_V), WSP(const float2, WS_ROPE)};
              pg8::gemm_phase<EpiQKV, SchedDense<true>, false>(F.lds, F.tid, WSP(const bf16_t, WS_MS + MS_HB), DM, S, E, SKCTL(WS_MS + MS_BIG + 300 * MiB, base + 1)); SEAM(base + 1); }
          for (int rep = 0; rep < NREP(8); ++rep) if (EN(8) && RUN(base + 2)) { FRESH(); attn_phase(p, F, WSP(const bf16_t, WS_MS + MS_BIG + BIG_Q), WSP(const bf16_t, WS_MS + MS_BIG + BIG_K), WSP(const bf16_t, WS_MS + MS_BIG + BIG_V), WSP(bf16_t, WS_MS + MS_BIG + BIG_O), p.sinks + j * NH, last ? 2048 : 2048 + 64); SEAM(base + 2); }
          for (int rep = 0; rep < NREP(9); ++rep) if (EN(9) && RUN(base + 3)) { FRESH(); SchedDense<true> S{WSP(const bf16_t, wo + WO_O), nrows / 256, DM / 256, F.G, cblk, DM};
              EpiResid E{p.out, WSP(const float, WS_XC), p.out, WSP(float, WS_XC), WSP(const float, WS_MOD) + (size_t)io * 5 * NMOD * DM, 2, rep ? 0.f : 1.f};
              pg8::gemm_phase<EpiResid, SchedDense<true>, false>(F.lds, F.tid, WSP(const bf16_t, WS_MS + MS_BIG + BIG_O), DM, S, E, SKCTL(WS_MS + MS_HB, base + 3)); SEAM(base + 3); }
          for (int rep = 0; rep < NREP(10); ++rep) if (EN(10) && RUN(base + 4)) { FRESH(); norm_phase<true>(p, F, p.out, WSP(const float, WS_XC), p.nfg + io * DM, WSP(const float, WS_MOD) + (size_t)io * 5 * NMOD * DM, 3, WSP(bf16_t, WS_MS + MS_HB), nrows,
                                                       p.mr + (size_t)j * DM * NEXP, WSP(unsigned, WS_CTL) + CW_CNTW + 4096 * j, WSP(int, WS_ROUTE), WSP(float, WS_ROUTE) + 16 * TT); SEAM(base + 4); }
          for (int rep = 0; rep < NREP(11); ++rep) if (EN(11) && RUN(base + 5)) { FRESH(); if (rep == 0) { moe_lists(F, WSP(const unsigned, WS_CTL) + CW_CNTW + 4096 * j, WSP(unsigned, WS_CTL) + CW_MCNT + 64 * j, WSP(int, WS_ROUTE), WSP(float, WS_ROUTE) + 16 * TT, nrows, last ? WSP(int, WS_TOKSLOT) : (int*)nullptr); xcd_barrier(bar); }
              FRESH(); moe_tables(F, WSP(unsigned, WS_CTL) + CW_MCNT + 64 * j); MoeTab tab{F.MISC};
              SchedMoe<true, false> S{WSP(const bf16_t, wo + WO_EXP + WX_GU), WX_STRIDE, 2 * DFF / 256, F.G, cblk, DM, 0, (int)F.MISC[49], tab, WSP(const int, WS_ROUTE)}; EpiSwiglu E{WSP(bf16_t, WS_MS + MS_BIG + BIG_ACT)};
              pg8::gemm_phase<EpiSwiglu, SchedMoe<true, false>, true>(F.lds, F.tid, WSP(const bf16_t, WS_MS + MS_HB), DM, S, E); SEAM(base + 5); }
#pragma unroll
          for (int k = 0; k < 2; ++k)
          for (int rep = 0; rep < NREP(12); ++rep) if (EN(12) && RUN(base + 6 + k) && !last) { FRESH(); moe_tables(F, WSP(unsigned, WS_CTL) + CW_MCNT + 64 * j); MoeTab tab{F.MISC};
              const int nb0 = (int)F.MISC[48], nba = (int)F.MISC[49];
              SchedMoe<false, true> S{WSP(const bf16_t, wo + WO_EXP + WX_D), WX_STRIDE, DM / 256, F.G, cblk, DFF, k ? nb0 : 0, k ? nba - nb0 : nb0, tab, WSP(const int, WS_ROUTE)};
              EpiMoeDown E{p.out, WSP(float, WS_XC), WSP(const float, WS_MOD) + (size_t)io * 5 * NMOD * DM, WSP(const int, WS_ROUTE), WSP(const float, WS_ROUTE) + 16 * TT, rep ? 0.f : 1.f};
              pg8::gemm_phase<EpiMoeDown, SchedMoe<false, true>, false>(F.lds, F.tid, WSP(const bf16_t, WS_MS + MS_BIG + BIG_ACT), DFF, S, E, SKCTL(WS_MS + MS_HB, base + 6 + k)); SEAM(base + 6 + k); }
          for (int rep = 0; rep < NREP(14); ++rep) if (EN(12) && RUN(base + 6) && last) { FRESH(); moe_tables(F, WSP(unsigned, WS_CTL) + CW_MCNT + 64 * j); MoeTab tab{F.MISC};
              SchedMoe<false, true> S{WSP(const bf16_t, wo + WO_EXP + WX_D), WX_STRIDE, DM / 256, F.G, cblk, DFF, 0, (int)F.MISC[49], tab, WSP(const int, WS_ROUTE)};
              EpiMoeY E{WSP(bf16_t, WS_YS), WSP(const float, WS_MOD) + (size_t)io * 5 * NMOD * DM, WSP(const int, WS_ROUTE), WSP(const float, WS_ROUTE) + 16 * TT};
              pg8::gemm_phase<EpiMoeY, SchedMoe<false, true>, false>(F.lds, F.tid, WSP(const bf16_t, WS_MS + MS_BIG + BIG_ACT), DFF, S, E, SKCTL(WS_MS + MS_HB, base + 6)); SEAM(base + 7); }
        }
    }
    if (EN(13) && RUN(33)) { FRESH(); final_norm_phase(p, F, WSP(const bf16_t, WS_YS), WSP(const int, WS_TOKSLOT)); }
#undef WSP
#undef RUN
#undef SEAM
}

static int g_grid = 0;
static void mega_launch(const Prm& p, int lo, int hi, hipStream_t st) {
    if (g_grid == 0) {
        int dev = 0, cus = 0; hipGetDevice(&dev); hipDeviceGetAttribute(&cus, hipDeviceAttributeMultiprocessorCount, dev);
        if (hipFuncSetAttribute((const void*)mk_fwd, hipFuncAttributeMaxDynamicSharedMemorySize, LDS_BYTES) != hipSuccess) { fprintf(stderr, "hipFuncSetAttribute failed\n"); g_grid = -1; return; }
        int per_cu = 0; if (hipOccupancyMaxActiveBlocksPerMultiprocessor(&per_cu, (const void*)mk_fwd, 512, LDS_BYTES) != hipSuccess || per_cu < 1) fprintf(stderr, "occupancy query: %d\n", per_cu);
        (void)hipGetLastError();
        g_grid = cus & ~7;
    }
    if (g_grid < 0) return;
    hipMemsetAsync(p.ws + WS_CTL + CW_BAR * 4, 0, XCD_BAR_WORDS * 4, st);
    Args a{}; a.p = p; a.ph_lo = lo; a.ph_hi = hi;
    hipLaunchKernelGGL(mk_fwd, dim3(g_grid), dim3(512), LDS_BYTES, st, a);
}

template <class FA, class FB, class FE> static void ngemm(hipStream_t st, int Mmax, int N, int K, FA fa, FB fb, FE fe) {
    hipLaunchKernelGGL((nk_gemm<FA, FB, FE>), dim3(N / 64, (Mmax + 63) / 64), dim3(256), 0, st, Mmax, N, K, fa, fb, fe);
}

#ifndef MEGA_MASK
#define MEGA_MASK 0xFF
#endif
static void naive_forward(const Prm& p, hipStream_t st) {
    unsigned char* ws = p.ws;
    hipMemsetAsync(ws + WS_CTL, 0, 1 * MiB, st);
    if (MEGA_MASK) mega_launch(p, 0, 1, st);
    if (!(MEGA_MASK & 0x20)) {
    hipLaunchKernelGGL(nk_adaln, dim3((DEPTH * 5 * NMOD * DM + 255) / 256), dim3(256), 0, st, p);
    hipLaunchKernelGGL(nk_rope, dim3(8), dim3(256), 0, st, p); }
    hipMemcpyAsync(p.out, p.x, (size_t)TL * DM * 4, hipMemcpyDeviceToDevice, st);
    hipMemcpyAsync(ws + WS_XC, p.ctx, (size_t)TC * DM * 4, hipMemcpyDeviceToDevice, st);
    float* H = (float*)(ws + WS_S);
    unsigned char* S2 = ws + WS_S + 136 * MiB;
    for (int i = 0; i < DEPTH; ++i) {
        const int j = i / 2; const bool last = (i == DEPTH - 1);
        const int nrows = last ? TL : TT;
        const int pbase = 1 + 8 * i;
        if ((i % 2 == 0) && (MEGA_MASK & 0x08)) mega_launch(p, pbase + 0, pbase + 3, st);
        else if ((i % 2 == 1) && (MEGA_MASK & 0x04)) mega_launch(p, pbase + 0, pbase + 4, st);
        else {
        hipLaunchKernelGGL(nk_norm_mod, dim3(TT), dim3(256), 0, st, p, p.nmg + i * DM, i, 0, H, TT);
        if (i % 2 == 0) {
            float2* Y1 = (float2*)S2;
            float2* Z = (float2*)(S2 + 64 * MiB);
            for (int b = 0; b < NB; ++b) {
                hipLaunchKernelGGL(nk_fft_s1, dim3(SEQ * DM / 256), dim3(256), 0, st, H, b, Y1);
                hipLaunchKernelGGL(nk_fft_s2, dim3(SEQ * DM / 256), dim3(256), 0, st, Y1, b, Z);
            }
            hipLaunchKernelGGL(nk_dft_ctx, dim3(TC * DM / 256), dim3(256), 0, st, H, Z);
            hipLaunchKernelGGL(nk_chan_dft, dim3(TT * (DM / 256)), dim3(256), 0, st, Z, H);
            ngemm(st, nrows, DM, DM, ADense{H, DM, nrows}, BDense{p.fw + (size_t)j * DM * DM, DM, 0}, EResid{p, i, 2, 0, nrows});
        } else {
            float* QKV = (float*)S2;
            ngemm(st, TT, QKVD, DM, ADense{H, DM, TT}, BDense{p.wqkv + (size_t)j * DM * QKVD, QKVD, 0}, EStore{QKV, QKVD, TT});
            hipLaunchKernelGGL(nk_rope_apply, dim3((unsigned)(((size_t)TL * 640 + 255) / 256)), dim3(256), 0, st, p, QKV);
            hipLaunchKernelGGL(nk_attn, dim3((unsigned)(((size_t)nrows * NH + 63) / 64)), dim3(64), 0, st, p, QKV, p.sinks + j * NH, H, nrows);
            ngemm(st, nrows, DM, DM, ADense{H, DM, nrows}, BDense{p.wo + (size_t)j * DM * DM, DM, 0}, EResid{p, i, 2, 0, nrows});
        } }
        if ((i % 2 == 0) && (MEGA_MASK & 0x01)) { mega_launch(p, pbase + 3, pbase + 6, st); continue; }
        if ((i % 2 == 1) && (MEGA_MASK & 0x02)) { mega_launch(p, pbase + 4, pbase + 8, st); continue; }
        hipLaunchKernelGGL(nk_norm_mod, dim3(nrows), dim3(256), 0, st, p, p.nfg + i * DM, i, 3, H, nrows);
        constexpr int CH = 8448;
        float* ACT = (float*)S2;
        if (i % 2 == 0) {
            for (int r0 = 0; r0 < nrows; r0 += CH) {
                const int m = nrows - r0 < CH ? nrows - r0 : CH;
                ngemm(st, m, DFF, DM, ADense{H + (size_t)r0 * DM, DM, m}, BDense{p.fg + (size_t)j * DM * DFF, DFF, 0}, ESilu{ACT, DFF, m});
                ngemm(st, m, DFF, DM, ADense{H + (size_t)r0 * DM, DM, m}, BDense{p.fu + (size_t)j * DM * DFF, DFF, 0}, EMulInto{ACT, DFF, m});
                ngemm(st, m, DM, DFF, ADense{ACT, DFF, m}, BDense{p.fd + (size_t)j * DFF * DM, DM, 0}, EResid{p, i, 5, r0, m});
            }
        } else {
            int* cnt = (int*)(ws + WS_CTL) + 1024 + 64 * i;
            int* ltok = (int*)(ws + WS_ROUTE); float* lw = (float*)(ltok + NEXP * TT); int* lk = (int*)(lw + NEXP * TT);
            float* Y0 = (float*)(S2 + 120 * MiB); float* Y1 = Y0 + (size_t)TT * DM;
            hipLaunchKernelGGL(nk_router, dim3((nrows + 255) / 256), dim3(256), 0, st, p, H, p.mr + (size_t)j * DM * NEXP, nrows, cnt, ltok, lw, lk);
            for (int e = 0; e < NEXP; ++e) {
                const size_t we = ((size_t)j * NEXP + e) * DM * DFF;
                for (int r0 = 0; r0 < nrows; r0 += CH) {
                    ngemm(st, CH, DFF, DM, AGather{H, ltok + e * TT, cnt + e, r0, CH}, BDense{p.mg + we, DFF, 0}, ESiluCnt{ACT, cnt + e, DFF, r0, CH, 0});
                    ngemm(st, CH, DFF, DM, AGather{H, ltok + e * TT, cnt + e, r0, CH}, BDense{p.mu + we, DFF, 0}, EMulCnt{ACT, cnt + e, DFF, r0, CH, 0});
                    ngemm(st, CH, DM, DFF, ADenseCnt{ACT, cnt + e, DFF, r0, CH, 0}, BDense{p.md + we, DM, 0}, EScatterY{Y0, Y1, ltok + e * TT, lw + e * TT, lk + e * TT, cnt + e, r0, CH});
                }
            }
            hipLaunchKernelGGL(nk_moe_combine, dim3((unsigned)(((size_t)nrows * DM + 255) / 256)), dim3(256), 0, st, p, Y0, Y1, i, nrows);
        }
    }
    if (MEGA_MASK & 0x10) mega_launch(p, 33, 34, st); else hipLaunchKernelGGL(nk_final_norm, dim3(TL), dim3(256), 0, st, p);
}

extern "C" void kernel_launch(void* const* d_in, const int* in_sizes, int n_in, void* d_out, int out_size, void* d_ws, size_t ws_size, hipStream_t stream) {
    if (n_in != 20 || out_size != TL * DM || ws_size < WS_MEGA_END) { fprintf(stderr, "kernel_launch: unexpected shapes n_in %d out %d ws %zu\n", n_in, out_size, ws_size); return; }
    Prm p{};
    const float** f = (const float**)&p;
    for (int i = 0; i < 20; ++i) f[i] = (const float*)d_in[i];
    p.out = (float*)d_out; p.ws = (unsigned char*)d_ws;
    if (MEGA_MASK == 0xFF) {
        hipMemsetAsync(p.ws + WS_CTL, 0, 1 * MiB, stream);
        mega_launch(p, 0, 34, stream);
    } else naive_forward(p, stream);
}
```

```cpp
#include <hip/hip_runtime.h>
#include <cstdio>
#include <cstdint>
#include <cmath>

constexpr int DM = 1024, NB = 4, SEQ = 8192, DEPTH = 4, CTXL = 256;
constexpr int TL = NB * SEQ;
constexpr int TC = NB * CTXL;
constexpr int TT = TL + TC;
constexpr int NMOD = 6, DFF = 3584, NEXP = 8, QKVD = 1536, NH = 16, NKV = 4, HD = 64;
constexpr int FN1 = 128, FN2 = 64;
constexpr float EPS = 1e-6f;

constexpr size_t MiB = 1ull << 20;
constexpr size_t WS_CTL = 0;
constexpr size_t WS_MOD = 1 * MiB;
constexpr size_t WS_ROPE = 2 * MiB;
constexpr size_t WS_XC = 3 * MiB;
constexpr size_t WS_ROUTE = 8 * MiB;
constexpr size_t WS_S = 416 * MiB;

struct Prm {
    const float *x, *c, *ctx, *c_ctx, *ada_w, *ada_b, *nmg, *nfg, *fw, *wqkv, *wo, *sinks, *fg, *fu, *fd, *mr, *mg, *mu, *md, *fng;
    float* out; unsigned char* ws;
};

__device__ __forceinline__ float silu_f(float v) { return v / (1.f + expf(-v)); }
__device__ __forceinline__ int row_b5(int r) { return r < TL ? r / SEQ : 4; }
__device__ __forceinline__ float* xrow(const Prm& p, int r) { return r < TL ? p.out + (size_t)r * DM : (float*)(p.ws + WS_XC) + (size_t)(r - TL) * DM; }

__global__ void nk_adaln(Prm p) {
    const int idx = blockIdx.x * blockDim.x + threadIdx.x;
    if (idx >= DEPTH * 5 * NMOD * DM) return;
    const int n = idx % (NMOD * DM), r = (idx / (NMOD * DM)) % 5, l = idx / (5 * NMOD * DM);
    const float* cv = r < 4 ? p.c + r * DM : p.c_ctx;
    const float* w = p.ada_w + (size_t)l * DM * NMOD * DM;
    float acc = 0.f;
    for (int k = 0; k < DM; ++k) acc += silu_f(cv[k]) * w[(size_t)k * NMOD * DM + n];
    ((float*)(p.ws + WS_MOD))[idx] = acc + p.ada_b[l * NMOD * DM + n];
}
__global__ void nk_rope(Prm p) {
    const int idx = blockIdx.x * blockDim.x + threadIdx.x;
    if (idx >= 128 * 16) return;
    const int pos = idx / 16, f = idx % 16;
    const float inv = powf(10000.f, -(float)f / 16.f);
    const float ang = (float)pos * inv;
    ((float2*)(p.ws + WS_ROPE))[idx] = make_float2((float)cos((double)ang), (float)sin((double)ang));
}
__global__ void nk_norm_mod(Prm p, const float* g, int layer, int which  , float* H, int nrows) {
    const int r = blockIdx.x; if (r >= nrows) return;
    const float* xr = xrow(p, r);
    __shared__ float red[256];
    float s = 0.f;
    for (int c = threadIdx.x; c < DM; c += 256) { const float v = xr[c]; s += v * v; }
    red[threadIdx.x] = s; __syncthreads();
    for (int o = 128; o > 0; o >>= 1) { if (threadIdx.x < o) red[threadIdx.x] += red[threadIdx.x + o]; __syncthreads(); }
    const float rstd = rsqrtf(red[0] / DM + EPS);
    const float* mod = (const float*)(p.ws + WS_MOD) + ((size_t)layer * 5 + row_b5(r)) * NMOD * DM;
    for (int c = threadIdx.x; c < DM; c += 256) H[(size_t)r * DM + c] = xr[c] * rstd * g[c] * (1.f + mod[(which + 1) * DM + c]) + mod[which * DM + c];
}
__global__ void nk_final_norm(Prm p) {
    const int r = blockIdx.x;
    float* xr = p.out + (size_t)r * DM;
    __shared__ float red[256];
    float s = 0.f;
    for (int c = threadIdx.x; c < DM; c += 256) { const float v = xr[c]; s += v * v; }
    red[threadIdx.x] = s; __syncthreads();
    for (int o = 128; o > 0; o >>= 1) { if (threadIdx.x < o) red[threadIdx.x] += red[threadIdx.x + o]; __syncthreads(); }
    const float rstd = rsqrtf(red[0] / DM + EPS);
    for (int c = threadIdx.x; c < DM; c += 256) xr[c] = xr[c] * rstd * p.fng[c];
}
template <class FA, class FB, class FE>
__global__ void __launch_bounds__(256) nk_gemm(int M, int N, int K, FA fa, FB fb, FE fe) {
    __shared__ float As[16][68], Bs[16][68];
    const int m0 = blockIdx.y * 64, n0 = blockIdx.x * 64;
    if (m0 >= fa.rows()) return;
    const int t = threadIdx.x, tx = t % 16, ty = t / 16;
    float acc[4][4] = {};
    for (int k0 = 0; k0 < K; k0 += 16) {
        { const int m = t / 4, kq = (t % 4) * 4;
#pragma unroll
          for (int i = 0; i < 4; ++i) As[kq + i][m] = fa(m0 + m, k0 + kq + i); }
        { const int k = t / 16, nq = (t % 16) * 4;
#pragma unroll
          for (int i = 0; i < 4; ++i) Bs[k][nq + i] = fb(k0 + k, n0 + nq + i); }
        __syncthreads();
#pragma unroll
        for (int kk = 0; kk < 16; ++kk) {
            float a[4], b[4];
#pragma unroll
            for (int i = 0; i < 4; ++i) { a[i] = As[kk][ty * 4 + i]; b[i] = Bs[kk][tx * 4 + i]; }
#pragma unroll
            for (int i = 0; i < 4; ++i)
#pragma unroll
                for (int j = 0; j < 4; ++j) acc[i][j] += a[i] * b[j];
        }
        __syncthreads();
    }
#pragma unroll
    for (int i = 0; i < 4; ++i)
#pragma unroll
        for (int j = 0; j < 4; ++j) fe(m0 + ty * 4 + i, n0 + tx * 4 + j, acc[i][j]);
}
struct ADense { const float* A; int lda, M; __device__ int rows() const { return M; } __device__ float operator()(int m, int k) const { return m < M ? A[(size_t)m * lda + k] : 0.f; } };
struct BDense { const float* B; int ldb, pad; __device__ float operator()(int k, int n) const { return B[(size_t)k * ldb + n]; } };
struct EStore { float* C; int ldc, M; __device__ void operator()(int m, int n, float v) const { if (m < M) C[(size_t)m * ldc + n] = v; } };
struct ESilu { float* C; int ldc, M; __device__ void operator()(int m, int n, float v) const { if (m < M) C[(size_t)m * ldc + n] = silu_f(v); } };
struct EMulInto { float* C; int ldc, M; __device__ void operator()(int m, int n, float v) const { if (m < M) C[(size_t)m * ldc + n] *= v; } };
struct EResid { Prm p; int layer, which  , row0, M;
    __device__ void operator()(int m, int n, float v) const { if (m < M) { const int r = row0 + m; const float* mod = (const float*)(p.ws + WS_MOD) + ((size_t)layer * 5 + row_b5(r)) * NMOD * DM; xrow(p, r)[n] += mod[which * DM + n] * v; } } };
struct AGather { const float* H; const int* tok; const int* cnt; int r0, rmax; __device__ int rows() const { int c = *cnt - r0; return c < rmax ? c : rmax; }
    __device__ float operator()(int m, int k) const { return m < rows() ? H[(size_t)tok[r0 + m] * DM + k] : 0.f; } };
struct ADenseCnt { const float* A; const int* cnt; int lda, r0, rmax, pad; __device__ int rows() const { int c = *cnt - r0; return c < rmax ? c : rmax; }
    __device__ float operator()(int m, int k) const { return m < rows() ? A[(size_t)m * lda + k] : 0.f; } };
struct ESiluCnt { float* C; const int* cnt; int ldc, r0, rmax, pad; __device__ void operator()(int m, int n, float v) const { int c = *cnt - r0; c = c < rmax ? c : rmax; if (m < c) C[(size_t)m * ldc + n] = silu_f(v); } };
struct EMulCnt { float* C; const int* cnt; int ldc, r0, rmax, pad; __device__ void operator()(int m, int n, float v) const { int c = *cnt - r0; c = c < rmax ? c : rmax; if (m < c) C[(size_t)m * ldc + n] *= v; } };
struct EScatterY { float* Y0; float* Y1; const int* tok; const float* w; const int* kk; const int* cnt; int r0, rmax;
    __device__ void operator()(int m, int n, float v) const { int c = *cnt - r0; c = c < rmax ? c : rmax; if (m < c) { const int i = r0 + m; (kk[i] ? Y1 : Y0)[(size_t)tok[i] * DM + n] = w[i] * v; } } };

__global__ void nk_fft_s1(const float* H, int b, float2* Y1) {
    const size_t idx = (size_t)blockIdx.x * blockDim.x + threadIdx.x;
    const int ch = idx % DM, n2 = (idx / DM) % FN2, k1 = idx / ((size_t)DM * FN2);
    float re = 0.f, im = 0.f;
    for (int n1 = 0; n1 < FN1; ++n1) {
        const float v = H[((size_t)b * SEQ + n1 * FN2 + n2) * DM + ch];
        const int ph = (n1 * k1) % FN1; double s, c; sincospi(-2.0 * ph / FN1, &s, &c);
        re += v * (float)c; im += v * (float)s;
    }
    double s, c; sincospi(-2.0 * (double)(n2 * k1) / (FN1 * FN2), &s, &c);
    Y1[idx] = make_float2(re * (float)c - im * (float)s, re * (float)s + im * (float)c);
}
__global__ void nk_fft_s2(const float2* Y1, int b, float2* Z) {
    const size_t idx = (size_t)blockIdx.x * blockDim.x + threadIdx.x;
    const int ch = idx % DM, k1 = (idx / DM) % FN1, k2 = idx / ((size_t)DM * FN1);
    float re = 0.f, im = 0.f;
    for (int n2 = 0; n2 < FN2; ++n2) {
        const float2 v = Y1[((size_t)k1 * FN2 + n2) * DM + ch];
        const int ph = (n2 * k2) % FN2; double s, c; sincospi(-2.0 * ph / FN2, &s, &c);
        re += v.x * (float)c - v.y * (float)s; im += v.x * (float)s + v.y * (float)c;
    }
    Z[((size_t)b * SEQ + k1 + FN1 * k2) * DM + ch] = make_float2(re, im);
}
__global__ void nk_dft_ctx(const float* H, float2* Z) {
    const size_t idx = (size_t)blockIdx.x * blockDim.x + threadIdx.x;
    const int ch = idx % DM, k = (idx / DM) % CTXL, b = idx / ((size_t)DM * CTXL);
    float re = 0.f, im = 0.f;
    for (int n = 0; n < CTXL; ++n) {
        const float v = H[((size_t)TL + b * CTXL + n) * DM + ch];
        const int ph = (n * k) % CTXL; double s, c; sincospi(-2.0 * ph / CTXL, &s, &c);
        re += v * (float)c; im += v * (float)s;
    }
    Z[((size_t)TL + b * CTXL + k) * DM + ch] = make_float2(re, im);
}
__global__ void nk_chan_dft(const float2* Z, float* R) {
    const size_t idx = (size_t)blockIdx.x * blockDim.x + threadIdx.x;
    const int col = idx % DM, row = idx / DM, g = col / 256, q = col % 256;
    float acc = 0.f;
    for (int pp = 0; pp < 256; ++pp) {
        const float2 v = Z[(size_t)row * DM + g * 256 + pp];
        const int ph = (pp * q) % 256; double s, c; sincospi(2.0 * ph / 256, &s, &c);
        acc += v.x * (float)c + v.y * (float)s;
    }
    const float scale = row < TL ? 1.f / sqrtf((float)SEQ * 256.f) : 1.f / sqrtf((float)CTXL * 256.f);
    R[idx] = acc * scale;
}
__global__ void nk_rope_apply(Prm p, float* QKV) {
    const size_t idx = (size_t)blockIdx.x * blockDim.x + threadIdx.x;
    const int f = idx % 16, a = (idx / 16) % 2, hh = (idx / 32) % 20; const size_t row = idx / 640;
    if (row >= TL) return;
    const int t = row % SEQ, pos = a ? (t % 64) : (t / 64);
    const float2 cs = ((const float2*)(p.ws + WS_ROPE))[pos * 16 + f];
    float* base = QKV + row * QKVD + hh * 64 + a * 32;
    const float x1 = base[f], x2 = base[16 + f];
    base[f] = x1 * cs.x - x2 * cs.y; base[16 + f] = x2 * cs.x + x1 * cs.y;
}
__global__ void __launch_bounds__(64) nk_attn(Prm p, const float* QKV, const float* sinks, float* O, int nrows) {
    const size_t idx = (size_t)blockIdx.x * blockDim.x + threadIdx.x;
    const int h = idx % NH; const size_t row = idx / NH;
    if (row >= (size_t)nrows) return;
    const int kv = h / 4;
    float q[64], o[64];
#pragma unroll
    for (int d = 0; d < 64; ++d) { q[d] = QKV[row * QKVD + h * 64 + d] * 0.125f; o[d] = 0.f; }
    float m = sinks[h], l = 1.f;
    const bool lat = row < TL; const int b = lat ? row / SEQ : (row - TL) / CTXL; const int t = lat ? row % SEQ : 0;
    const int j0 = lat ? (t - 128 < 0 ? 0 : t - 128) : 0, j1 = lat ? (t + 128 > SEQ - 1 ? SEQ - 1 : t + 128) : -1;
    const int nlat = j1 - j0 + 1;
    for (int jj = 0; jj < nlat + CTXL; ++jj) {
        const size_t krow = jj < nlat ? (size_t)b * SEQ + j0 + jj : (size_t)TL + b * CTXL + (jj - nlat);
        const float* kp = QKV + krow * QKVD + 1024 + kv * 64; const float* vp = kp + 256;
        float s = 0.f;
#pragma unroll
        for (int d = 0; d < 64; ++d) s += q[d] * kp[d];
        if (s > m) { const float f = expf(m - s); l *= f;
#pragma unroll
            for (int d = 0; d < 64; ++d) o[d] *= f;
            m = s; }
        const float pe = expf(s - m); l += pe;
#pragma unroll
        for (int d = 0; d < 64; ++d) o[d] += pe * vp[d];
    }
    const float il = 1.f / l;
#pragma unroll
    for (int d = 0; d < 64; ++d) O[row * DM + h * 64 + d] = o[d] * il;
}
__global__ void nk_router(Prm p, const float* H, const float* wr, int nrows, int* cnt, int* ltok, float* lw, int* lk) {
    const int r = blockIdx.x * blockDim.x + threadIdx.x; if (r >= nrows) return;
    float lg[NEXP] = {};
    for (int k = 0; k < DM; ++k) { const float hv = H[(size_t)r * DM + k];
#pragma unroll
        for (int e = 0; e < NEXP; ++e) lg[e] += hv * wr[k * NEXP + e]; }
    int e0 = 0; float v0 = lg[0];
#pragma unroll
    for (int e = 1; e < NEXP; ++e) if (lg[e] > v0) { v0 = lg[e]; e0 = e; }
    int e1 = -1; float v1 = -INFINITY;
#pragma unroll
    for (int e = 0; e < NEXP; ++e) if (e != e0 && lg[e] > v1) { v1 = lg[e]; e1 = e; }
    const float g1 = 1.f / (1.f + expf(v0 - v1)), g0 = 1.f - g1;
    int i0 = atomicAdd(&cnt[e0], 1); ltok[e0 * TT + i0] = r; lw[e0 * TT + i0] = g0; lk[e0 * TT + i0] = 0;
    int i1 = atomicAdd(&cnt[e1], 1); ltok[e1 * TT + i1] = r; lw[e1 * TT + i1] = g1; lk[e1 * TT + i1] = 1;
}
__global__ void nk_moe_combine(Prm p, const float* Y0, const float* Y1, int layer, int nrows) {
    const size_t idx = (size_t)blockIdx.x * blockDim.x + threadIdx.x; const int n = idx % DM; const size_t r = idx / DM;
    if (r >= (size_t)nrows) return;
    const float* mod = (const float*)(p.ws + WS_MOD) + ((size_t)layer * 5 + row_b5((int)r)) * NMOD * DM;
    xrow(p, (int)r)[n] += mod[5 * DM + n] * (Y0[idx] + Y1[idx]);
}


#define GAS __attribute__((address_space(1)))
#define LAS __attribute__((address_space(3)))
typedef unsigned short bf16_t;
typedef short bf16x8 __attribute__((ext_vector_type(8)));
typedef short s16x4 __attribute__((ext_vector_type(4)));
typedef float f32x4 __attribute__((ext_vector_type(4)));
typedef float f32x16 __attribute__((ext_vector_type(16)));
typedef unsigned u32x4 __attribute__((ext_vector_type(4)));
typedef unsigned u32x2 __attribute__((ext_vector_type(2)));
typedef float f32x2 __attribute__((ext_vector_type(2)));

constexpr size_t WS_TAB = 13 * MiB;
constexpr size_t TAB_F1 = 0, TAB_F2 = 65536, TAB_TW = 131072, TAB_TWC = 196608;
constexpr size_t WS_W = 16 * MiB;
constexpr size_t WE_STRIDE = 25 * MiB, WE_F = 0, WE_GU = 4 * MiB, WE_D = 18 * MiB;
constexpr size_t WO_BASE = 50 * MiB, WO_STRIDE = 173 * MiB, WO_QKV = 0, WO_O = 3 * MiB, WO_EXP = 5 * MiB, WX_STRIDE = 21 * MiB, WX_GU = 0, WX_D = 14 * MiB;
constexpr size_t WS_MS = 416 * MiB;
constexpr size_t MS_HB = 0;
constexpr size_t MS_BIG = 66 * MiB;
constexpr size_t BIG_ACT = 0;
constexpr size_t BIG_Y1 = 0, BIG_Y1C = 128 * MiB, BIG_PQ = 136 * MiB;
constexpr size_t BIG_Q = 0, BIG_K = 66 * MiB, BIG_V = 83 * MiB, BIG_O = 100 * MiB;
constexpr size_t WS_MEGA_END = WS_MS + MS_BIG + 490 * MiB;
constexpr size_t WS_YS = WS_W + WO_BASE;
constexpr size_t WS_TOKSLOT = WS_ROUTE + 4352 * 1024;
constexpr int MAXBLK = 280;
constexpr int CW_BAR = 4096;
constexpr int CW_CNT = 1024;
constexpr int CW_CNTW = 65536;
constexpr int CW_SKF = 32768;
constexpr int CW_MCNT = 2048;
constexpr int LDS_BYTES = 147456;
constexpr int LDS_MISC = 146944;
constexpr float LOG2E = 1.4426950408889634f;

struct Args { Prm p; int ph_lo, ph_hi; };

__device__ __forceinline__ unsigned f2bf(float f) { unsigned u = __builtin_bit_cast(unsigned, f); return (u + 0x7fffu + ((u >> 16) & 1u)) >> 16; }
__device__ __forceinline__ unsigned pk2(float lo, float hi) { typedef float f2 __attribute__((ext_vector_type(2))); typedef __bf16 b2 __attribute__((ext_vector_type(2))); f2 v = {lo, hi}; b2 b = __builtin_convertvector(v, b2); return __builtin_bit_cast(unsigned, b); }
#define SWZ_XOR(v, m) __builtin_bit_cast(float, __builtin_amdgcn_ds_swizzle(__builtin_bit_cast(int, (v)), ((m) << 10) | 0x1f))
__device__ __forceinline__ float xor32(float v, bool lower) { unsigned a = __builtin_bit_cast(unsigned, v), b = a; asm volatile("" : "+v"(b));
    auto rr = __builtin_amdgcn_permlane32_swap(a, b, false, false); return __builtin_bit_cast(float, lower ? rr[1] : rr[0]); }
__device__ __forceinline__ float wave_sum(float v) {
    v += SWZ_XOR(v, 1); v += SWZ_XOR(v, 2); v += SWZ_XOR(v, 4); v += SWZ_XOR(v, 8); v += SWZ_XOR(v, 16);
    return __builtin_bit_cast(float, __builtin_amdgcn_readlane(__builtin_bit_cast(int, v), 0)) + __builtin_bit_cast(float, __builtin_amdgcn_readlane(__builtin_bit_cast(int, v), 32));
}
__device__ __forceinline__ float fast_silu(float v) { return v * __builtin_amdgcn_rcpf(1.f + __builtin_amdgcn_exp2f(-v * LOG2E)); }

#define XB_TMO      128
#define XB_XCNT(j)  (256  + 64 * (j))
#define XB_XSUB(j)  (1280 + 64 * (j))
#define XB_XGEN(j)  (2304 + 64 * (j))
#define XB_TOP      3328
#define XB_TOPGEN   3392
#define XCD_BAR_WORDS 3456
#define XB_SPIN_CAP (1u << 18)
__device__ __forceinline__ unsigned xb_ld(unsigned* p)              { return __hip_atomic_load(p, __ATOMIC_RELAXED, __HIP_MEMORY_SCOPE_AGENT); }
__device__ __forceinline__ unsigned xb_add(unsigned* p, unsigned v) { return __hip_atomic_fetch_add(p, v, __ATOMIC_RELAXED, __HIP_MEMORY_SCOPE_AGENT); }
__device__ __forceinline__ unsigned xb_xcc_id() { return (unsigned)__builtin_amdgcn_s_getreg((3 << 11) | 20) & 0xFu; }
#define XB_SPIN(cond, bar) do { unsigned _sp = 0; while (cond) { __builtin_amdgcn_s_sleep(1); \
    if ((++_sp & 255u) == 0u) { if (xb_ld(&(bar)[XB_TMO])) break; if (_sp > XB_SPIN_CAP) { atomicAdd(&(bar)[XB_TMO], 1u); break; } } } } while (0)
struct XcdBarrier { unsigned* bar; unsigned x; volatile LAS unsigned* st; };
__device__ __forceinline__ XcdBarrier xcd_barrier_post(unsigned* bar, volatile LAS unsigned* st) {
    XcdBarrier b; b.bar = bar; b.x = xb_xcc_id(); b.st = st;
    if (threadIdx.x == 0) (void)xb_add(&bar[XB_XCNT(b.x)], 1u);
    return b;
}
__device__ __forceinline__ void xcd_barrier_complete(unsigned* bar, unsigned x, unsigned& nloc, unsigned& nx) {
    const unsigned G = gridDim.x * gridDim.y * gridDim.z;
    unsigned sum, cnt, mine, sp = 0u;
    for (;;) {
        sum = 0u; cnt = 0u; mine = 0u;
#pragma unroll
        for (unsigned j = 0; j < 16; ++j) { const unsigned c = xb_ld(&bar[XB_XCNT(j)]); sum += c; cnt += (c > 0u) ? 1u : 0u; mine = (j == x) ? c : mine; }
        if (sum == G) break;
        __builtin_amdgcn_s_sleep(1);
        if ((++sp & 255u) == 0u) { if (xb_ld(&bar[XB_TMO])) break; if (sp > XB_SPIN_CAP) { atomicAdd(&bar[XB_TMO], 1u); break; } }
    }
    nloc = mine > 0u ? mine : 1u; nx = cnt > 0u ? cnt : 1u;
}
__device__ __forceinline__ void xcd_barrier(const XcdBarrier& b) {
    asm volatile("s_waitcnt vmcnt(0)" ::: "memory");
    __syncthreads();
    if (threadIdx.x == 0) {
        unsigned* bar = b.bar;
        __builtin_amdgcn_s_waitcnt(0);
        unsigned nloc = b.st[0], nx = b.st[1];
        if (nloc == 0u) { xcd_barrier_complete(bar, b.x, nloc, nx); b.st[0] = nloc; b.st[1] = nx; }
        const unsigned old = xb_add(&bar[XB_XSUB(b.x)], 1u);
        const unsigned gen = old / nloc;
        if (old + 1u == (gen + 1u) * nloc) {
            __builtin_amdgcn_fence(__ATOMIC_RELEASE, "agent");
            asm volatile("s_waitcnt vmcnt(0)" ::: "memory");
            const unsigned og = xb_add(&bar[XB_TOP], 1u);
            const unsigned tg = og / nx;
            if (og + 1u == (tg + 1u) * nx) xb_add(&bar[XB_TOPGEN], 1u);
            else XB_SPIN(xb_ld(&bar[XB_TOPGEN]) == tg, bar);
            __builtin_amdgcn_fence(__ATOMIC_ACQUIRE, "agent");
            xb_add(&bar[XB_XGEN(b.x)], 1u);
            asm volatile("s_waitcnt vmcnt(0)" ::: "memory");
        } else {
            XB_SPIN(xb_ld(&bar[XB_XGEN(b.x)]) == gen, bar);
            __builtin_amdgcn_fence(__ATOMIC_ACQUIRE, "agent");
            asm volatile("s_waitcnt vmcnt(0)" ::: "memory");
        }
    }
    __syncthreads();
}

namespace pg8 {
constexpr int BM = 256, BK = 64, HALF = 128, HTB = HALF * BK * 2, STAGE_BYTES = 8 * HTB, NXCD = 8, WGM = 4;
__device__ __forceinline__ int lds_byte(int r, int c) { const int st = (r >> 4) * 2 + (c >> 5), rr = r & 15, cc = c & 31, ob = rr * 64 + cc * 2; return st * 1024 + (ob ^ (((ob >> 9) & 1) << 5)); }
__device__ __forceinline__ void stage_rc(int b, int& R, int& C) { const int st = b / 1024, sb = b % 1024, swz = sb ^ (((sb >> 9) & 1) << 5); R = (st >> 1) * 16 + swz / 64; C = (st & 1) * 32 + (swz % 64) / 2; }
__device__ __forceinline__ int perm32(int rho) { const int n = rho >> 4, i = rho & 15; return 8 * (i >> 2) + 4 * n + (i & 3); }
struct Unit { int pm, pn, g, first, cnt, kofs, nt, flags, np, part, qmask; };
__device__ __forceinline__ bool static_next(int nM, int nN, int G, int c, int i, Unit& u) {
    const int nwg = nM * nN; const long L = (long)i * G + c; const bool ok = L < nwg;
    int wgid = ok ? (int)L : nwg - 1; { const int q = nwg / NXCD, r = nwg % NXCD, xcd = wgid % NXCD, off = wgid / NXCD; wgid = (xcd < r ? xcd * (q + 1) : r * (q + 1) + (xcd - r) * q) + off; }
    const int nig = WGM * nN, gid = wgid / nig, fm = gid * WGM, gsz = (nM - fm) < WGM ? (nM - fm) : WGM;
    u.pm = fm + ((wgid % nig) % gsz); u.pn = (wgid % nig) / gsz; return ok;
}
__device__ __forceinline__ bool sk_next(int nM, int nN, int nt2, int G, int c, int i, int pmax, Unit& u) {
    const int nwg = nM * nN, nfull = nwg / G, R = nwg - nfull * G;
    int P = 1; if (R > 0) { if (R * 8 <= G && pmax >= 8) P = 8; else if (R * 4 <= G && pmax >= 4) P = 4; else if (R * 2 <= G && pmax >= 2) P = 2; }
    const bool tail = (i >= nfull);
    const int x = c % NXCD, rho = c / NXCD, jj = rho / P, p = rho % P, j = jj * NXCD + x;
    const long L = tail ? (long)nfull * G + (j < R ? j : 0) : (long)i * G + c;
    int wgid = (int)(L < nwg ? L : nwg - 1); { const int q = nwg / NXCD, r = nwg % NXCD, xcd = wgid % NXCD, off = wgid / NXCD; wgid = (xcd < r ? xcd * (q + 1) : r * (q + 1) + (xcd - r) * q) + off; }
    const int nig = WGM * nN, gid = wgid / nig, fm = gid * WGM, gsz = (nM - fm) < WGM ? (nM - fm) : WGM;
    u.pm = fm + ((wgid % nig) % gsz); u.pn = (wgid % nig) / gsz;
    const int lo = tail ? p * nt2 / P : 0, hi = tail ? (p + 1) * nt2 / P : nt2;
    u.kofs = lo * 2 * BK * 2; u.nt = (hi - lo) * 2; u.flags = (tail && P > 1) ? 1 : 0; u.np = P; u.part = p;
    u.qmask = (tail && P > 1) ? (P == 4 ? (1 << p) : P == 2 ? (5 << p) : 0xF) : 0xF;
    return tail ? (i == nfull && j < R) : true;
}
struct SkCtl { f32x4* slots; unsigned* flag; unsigned* tmo; unsigned epoch; int c, G; };
template <class Epi, class Sched, bool GATHER>
__device__ __forceinline__ void gemm_phase(LAS unsigned char* lds, const int tid_in, const bf16_t* Aptr, const int K, const Sched& S, const Epi& E, const SkCtl sk = SkCtl{}) {
    int tid = tid_in; asm volatile("" : "+v"(tid));
    const int wid = __builtin_amdgcn_readfirstlane(tid >> 6), lane = tid & 63, wr = wid >> 2, wc = wid & 3, fr = lane & 15, fq = lane >> 4;
    int RA[2], CA[2]; unsigned voffA[2], voffB[2];
#pragma unroll
    for (int i = 0; i < 2; ++i) { int R, C; stage_rc(tid * 16 + i * 8192, R, C); const int Rb = Epi::PERM ? ((R & ~31) + perm32(R & 31)) : R; RA[i] = R; CA[i] = C; voffA[i] = (unsigned)(R * K + C) * 2u; voffB[i] = (unsigned)(Rb * K + C) * 2u; }
    const size_t kstep = (size_t)(BK * 2);
    const size_t hstep = (size_t)HALF * K * 2;
    const unsigned ldsw = (unsigned)wid * 1024u;
    const int aoff = lds_byte(wr * 64 + fr, fq * 8), boff = lds_byte(wc * 32 + fr, fq * 8);
    const char* const cAb = (const char*)Aptr;
#define PG8_SA(b, h) (((b) * 2 + (h)) * HTB)
#define PG8_SB(b, h) ((4 + (b) * 2 + (h)) * HTB)
#define PG8_STAGE(bufoff, gbase, voff) do { _Pragma("unroll") for (int _i = 0; _i < 2; ++_i) \
        __builtin_amdgcn_global_load_lds((const unsigned*)((const char*)(gbase) + (voff)[_i]), (LAS unsigned*)(lds + (bufoff) + ldsw + _i * 8192), 16, 0, 0); } while (0)
#define PG8_STAGEA(bufoff, vo, h, kb) do { _Pragma("unroll") for (int _i = 0; _i < 2; ++_i) { \
        if constexpr (GATHER) __builtin_amdgcn_global_load_lds((const unsigned*)(cAb + (size_t)(vo)[h][_i] + (size_t)(kb)), (LAS unsigned*)(lds + (bufoff) + ldsw + _i * 8192), 16, 0, 0); \
        else __builtin_amdgcn_global_load_lds((const unsigned*)(cAb + s##vo + (size_t)(h) * hstep + (size_t)(kb) + voffA[_i]), (LAS unsigned*)(lds + (bufoff) + ldsw + _i * 8192), 16, 0, 0); } } while (0)
#define PG8_LDA(dst, b, h) do { _Pragma("unroll") for (int m = 0; m < 4; ++m) _Pragma("unroll") for (int k = 0; k < 2; ++k) dst[m][k] = *(const LAS bf16x8*)(lds + PG8_SA(b, h) + aoff + m * 2048 + k * 1024); } while (0)
#define PG8_LDB(dst, b, h) do { _Pragma("unroll") for (int n = 0; n < 2; ++n) _Pragma("unroll") for (int k = 0; k < 2; ++k) dst[n][k] = *(const LAS bf16x8*)(lds + PG8_SB(b, h) + boff + n * 2048 + k * 1024); } while (0)
#define PG8_MMA(ai, bj, At, Bt) do { __builtin_amdgcn_s_setprio(1); _Pragma("unroll") for (int m = 0; m < 4; ++m) _Pragma("unroll") for (int n = 0; n < 2; ++n) _Pragma("unroll") for (int k = 0; k < 2; ++k) \
        acc[ai][bj][m][n] = __builtin_amdgcn_mfma_f32_16x16x32_bf16(Bt[n][k], At[m][k], acc[ai][bj][m][n], 0, 0, 0); __builtin_amdgcn_s_setprio(0); } while (0)
#define PG8_WAIT_V(n) asm volatile("s_waitcnt vmcnt(" #n ")" ::: "memory")
#define PG8_WAIT_L(n) asm volatile("s_waitcnt lgkmcnt(" #n ")" ::: "memory")
#define PG8_BAR __builtin_amdgcn_s_barrier()
#define PG8_SCHED __builtin_amdgcn_sched_barrier(0)
#define PG8_AOFFS(vo, u) do { if constexpr (GATHER) { _Pragma("unroll") for (int _h = 0; _h < 2; ++_h) _Pragma("unroll") for (int _i = 0; _i < 2; ++_i) \
        (vo)[_h][_i] = (unsigned)(((size_t)S.a_row(u, _h * HALF + RA[_i]) * (size_t)K + (size_t)CA[_i]) * 2u) + (unsigned)(u).kofs; } else { s##vo = (size_t)S.a_row(u, 0) * (size_t)K * 2u + (size_t)(u).kofs; } } while (0)
    Unit cur, nxt; int ui = 0;
    if (!S.next(0, cur)) return;
    f32x4 acc[2][2][4][2];
#pragma unroll
    for (int a = 0; a < 2; ++a)
#pragma unroll
        for (int b = 0; b < 2; ++b)
#pragma unroll
            for (int m = 0; m < 4; ++m)
#pragma unroll
                for (int n = 0; n < 2; ++n) acc[a][b][m][n] = (f32x4){0.f, 0.f, 0.f, 0.f};
    bf16x8 At[4][2], B0[2][2], B1[2][2];
    unsigned vA[2][2], vN[2][2];
    size_t svA = 0, svN = 0;
    PG8_AOFFS(vA, cur);
    const char* cB = S.b_ptr(cur) + cur.kofs;
    PG8_STAGE(PG8_SB(0, 0), cB, voffB); PG8_STAGE(PG8_SB(0, 1), cB + hstep, voffB); PG8_STAGEA(PG8_SA(0, 0), vA, 0, 0); PG8_STAGEA(PG8_SA(0, 1), vA, 1, 0);
    if (wr == 1) PG8_BAR;
    PG8_WAIT_V(2); PG8_BAR;
    PG8_STAGE(PG8_SB(1, 0), cB + kstep, voffB); PG8_STAGEA(PG8_SA(1, 0), vA, 0, kstep); PG8_STAGE(PG8_SB(1, 1), cB + hstep + kstep, voffB);
    PG8_WAIT_V(6); PG8_BAR;
    for (;;) {
        const bool has_next = S.next(ui + 1, nxt);
        const char* nB = has_next ? S.b_ptr(nxt) + nxt.kofs : cB;
        const int nt = cur.nt;
        if (has_next) { PG8_AOFFS(vN, nxt); } else { svN = svA;
#pragma unroll
            for (int _h = 0; _h < 2; ++_h)
#pragma unroll
                for (int _i = 0; _i < 2; ++_i) vN[_h][_i] = vA[_h][_i]; }
        if constexpr (GATHER) { *(LAS u32x4*)(lds + STAGE_BYTES + tid * 16) = (u32x4){vN[0][0], vN[0][1], vN[1][0], vN[1][1]}; }
        for (int t = 0; t < nt; t += 2) {
            const bool last = (t == nt - 2);
            const size_t k1 = (size_t)(t + 1) * kstep;
            const size_t k2 = last ? 0 : (size_t)(t + 2) * kstep, k3 = k2 + kstep;
            const char* b2 = last ? nB : cB + (size_t)(t + 2) * kstep; const char* b3 = b2 + kstep;
            unsigned v2[2][2]; const size_t sv2 = last ? svN : svA;
            if constexpr (GATHER) {
#pragma unroll
                for (int _h = 0; _h < 2; ++_h)
#pragma unroll
                    for (int _i = 0; _i < 2; ++_i) v2[_h][_i] = vA[_h][_i];
                if (last) { const u32x4 q = *(const LAS u32x4*)(lds + STAGE_BYTES + tid * 16); v2[0][0] = q.x; v2[0][1] = q.y; v2[1][0] = q.z; v2[1][1] = q.w; } }
            PG8_LDB(B0, 0, 0); PG8_LDB(B1, 0, 1); PG8_SCHED; PG8_LDA(At, 0, 0); PG8_STAGEA(PG8_SA(1, 1), vA, 1, k1);
            PG8_WAIT_V(8); PG8_WAIT_L(0); PG8_BAR; PG8_MMA(0, 0, At, B0); PG8_MMA(0, 1, At, B1); PG8_BAR; PG8_SCHED;
            PG8_LDA(At, 0, 1); PG8_STAGE(PG8_SB(0, 0), b2, voffB); PG8_STAGE(PG8_SB(0, 1), b2 + hstep, voffB); PG8_STAGEA(PG8_SA(0, 0), v2, 0, k2);
            PG8_WAIT_V(8); PG8_WAIT_L(0); PG8_BAR; PG8_MMA(1, 0, At, B0); PG8_MMA(1, 1, At, B1); PG8_BAR; PG8_SCHED;
            PG8_LDB(B0, 1, 0); PG8_LDB(B1, 1, 1); PG8_SCHED; PG8_LDA(At, 1, 0); PG8_STAGEA(PG8_SA(0, 1), v2, 1, k2);
            PG8_WAIT_V(8); PG8_WAIT_L(0); PG8_BAR; PG8_MMA(0, 0, At, B0); PG8_MMA(0, 1, At, B1); PG8_BAR; PG8_SCHED;
            PG8_LDA(At, 1, 1); PG8_STAGE(PG8_SB(1, 0), b3, voffB); PG8_STAGE(PG8_SB(1, 1), b3 + hstep, voffB); PG8_STAGEA(PG8_SA(1, 0), v2, 0, k3);
            PG8_WAIT_V(8); PG8_WAIT_L(0); PG8_BAR; PG8_MMA(1, 0, At, B0); PG8_MMA(1, 1, At, B1); PG8_BAR; PG8_SCHED;
        }
        if (wr == 0) PG8_BAR;
        if (cur.flags & 1) {
            const int P = cur.np, p = cur.part, c0 = sk.c - NXCD * p;
            int tl; asm volatile("v_mbcnt_lo_u32_b32 %0, -1, 0\n\tv_mbcnt_hi_u32_b32 %0, -1, %0" : "=v"(tl));
            const int tid = wid * 64 + tl;
            const __amdgpu_buffer_rsrc_t rs = __builtin_amdgcn_make_buffer_rsrc((void*)sk.slots, 0, (int)(sk.G * 32 * 512 * 16), 0x00020000);
            const unsigned so = (unsigned)((sk.c * (32 * 512) + tid) * 16);
#pragma unroll
            for (int a = 0; a < 2; ++a)
#pragma unroll
                for (int b = 0; b < 2; ++b) if (!((cur.qmask >> (a * 2 + b)) & 1)) {
#pragma unroll
                    for (int m = 0; m < 4; ++m)
#pragma unroll
                        for (int n = 0; n < 2; ++n) __builtin_amdgcn_raw_buffer_store_b128(__builtin_bit_cast(u32x4, acc[a][b][m][n]), rs, so + (unsigned)((((a * 2 + b) * 4 + m) * 2 + n) * 512 * 16), 0, 16); }
            PG8_WAIT_V(0); PG8_BAR; asm volatile("" ::: "memory");
            if (tid == 0) __hip_atomic_store(sk.flag + 64 * sk.c, sk.epoch, __ATOMIC_RELAXED, __HIP_MEMORY_SCOPE_AGENT);
            if (tid < 64) {
                for (int q = 0; q < P; ++q) if (q != p) { const int pc = c0 + NXCD * q; unsigned sp = 0;
                    while ((unsigned)__builtin_amdgcn_readfirstlane(__hip_atomic_load(sk.flag + 64 * pc, __ATOMIC_RELAXED, __HIP_MEMORY_SCOPE_AGENT)) != sk.epoch) { __builtin_amdgcn_s_sleep(1);
                        if ((++sp & 255u) == 0u) { if (__hip_atomic_load(sk.tmo, __ATOMIC_RELAXED, __HIP_MEMORY_SCOPE_AGENT)) break; if (sp > (1u << 20)) { if (tid == 0) atomicAdd(sk.tmo, 1u); break; } } } }
                __builtin_amdgcn_fence(__ATOMIC_ACQUIRE, "agent"); PG8_WAIT_V(0); }
            asm volatile("" ::: "memory"); PG8_BAR; asm volatile("" ::: "memory");
#pragma unroll
            for (int a = 0; a < 2; ++a)
#pragma unroll
                for (int b = 0; b < 2; ++b) if ((cur.qmask >> (a * 2 + b)) & 1) {
                    for (int q = 0; q < P; ++q) if (q != p) {
                        const GAS f32x4* sl = (const GAS f32x4*)sk.slots + (size_t)(c0 + NXCD * q) * (32 * 512) + (size_t)((a * 2 + b) * 8) * 512 + tid;
#pragma unroll
                        for (int h4 = 0; h4 < 2; ++h4) { f32x4 pv[4];
#pragma unroll
                            for (int v4 = 0; v4 < 4; ++v4) pv[v4] = sl[(h4 * 4 + v4) * 512];
#pragma unroll
                            for (int v4 = 0; v4 < 4; ++v4) acc[a][b][h4 * 2 + (v4 >> 1)][v4 & 1] += pv[v4]; } } }
        }
        { int fr_ = fr, fq_ = fq; asm volatile("" : "+v"(fr_), "+v"(fq_));
          E(acc, cur, wr, wc, fr_, fq_); }
        if (!has_next) break;
#pragma unroll
        for (int a = 0; a < 2; ++a)
#pragma unroll
            for (int b = 0; b < 2; ++b)
#pragma unroll
                for (int m = 0; m < 4; ++m)
#pragma unroll
                    for (int n = 0; n < 2; ++n) acc[a][b][m][n] = (f32x4){0.f, 0.f, 0.f, 0.f};
        cur = nxt; cB = nB; ++ui; svA = svN;
        if constexpr (GATHER) { const u32x4 q = *(const LAS u32x4*)(lds + STAGE_BYTES + tid * 16); vA[0][0] = q.x; vA[0][1] = q.y; vA[1][0] = q.z; vA[1][1] = q.w; }
        if (wr == 1) PG8_BAR;
    }
    PG8_WAIT_V(0);
    PG8_BAR;
#undef PG8_SA
#undef PG8_SB
#undef PG8_STAGE
#undef PG8_STAGEA
#undef PG8_LDA
#undef PG8_LDB
#undef PG8_MMA
#undef PG8_WAIT_V
#undef PG8_WAIT_L
#undef PG8_BAR
#undef PG8_SCHED
#undef PG8_AOFFS
}
}


template <bool SK>
struct SchedDense {
    const bf16_t* Bt; int nM, nN, G, c, K;
    __device__ __forceinline__ bool next(int i, pg8::Unit& u) const { u.g = 0; u.first = 0; u.cnt = 0;
        if constexpr (SK) return pg8::sk_next(nM, nN, K / 128, G, c, i, 4, u);
        else { u.kofs = 0; u.nt = K / 64; u.flags = 0; u.np = 1; u.part = 0; u.qmask = 0xF; return pg8::static_next(nM, nN, G, c, i, u); } }
    __device__ __forceinline__ const char* b_ptr(const pg8::Unit& u) const { return (const char*)Bt + (size_t)u.pn * 256 * K * 2; }
    __device__ __forceinline__ int a_row(const pg8::Unit& u, int r) const { return u.pm * 256 + r; }
};
struct MoeTab { volatile LAS unsigned* T;
    __device__ __forceinline__ int group_of(int blk) const { int g = 0;
#pragma unroll
        for (int j = 1; j < 16; ++j) g += (blk >= (int)T[16 + j]) ? 1 : 0; return g; }
};
template <bool GATHER, bool SK>
struct SchedMoe {
    const bf16_t* Wbase; size_t wx_stride; int nN, G, c, K, blk0, nblk; MoeTab tab; const int* ltok;
    __device__ __forceinline__ bool next(int i, pg8::Unit& u) const { bool ok;
        if constexpr (SK) ok = pg8::sk_next(nblk, nN, K / 128, G, c, i, 4, u); else { u.kofs = 0; u.nt = K / 64; u.flags = 0; u.np = 1; u.part = 0; u.qmask = 0xF; ok = pg8::static_next(nblk, nN, G, c, i, u); }
        u.pm += blk0;
        const int g = __builtin_amdgcn_readfirstlane(tab.group_of(u.pm)); u.g = g; u.first = __builtin_amdgcn_readfirstlane((int)tab.T[16 + g]); u.cnt = __builtin_amdgcn_readfirstlane((int)tab.T[32 + g]); return ok; }
    __device__ __forceinline__ const char* b_ptr(const pg8::Unit& u) const { return (const char*)Wbase + (size_t)(u.g & 7) * wx_stride + (size_t)u.pn * 256 * K * 2; }
    __device__ __forceinline__ int a_row(const pg8::Unit& u, int r) const {
        if (!GATHER) return u.pm * 256 + r;
        const int local = (u.pm - u.first) * 256 + r;
        return ltok[(size_t)u.g * TT + (local < u.cnt ? local : u.cnt - 1)]; }
};

struct EpiResid {
    static constexpr bool PERM = false;
    const float* xin_l; const float* xin_c; float* xout_l; float* xout_c; const float* mod; int which; float rs;
    __device__ __forceinline__ void operator()(const f32x4 (&acc)[2][2][4][2], const pg8::Unit& u, int wr, int wc, int fr, int fq) const {
        const bool lat = u.pm < TL / 256; const int b5 = lat ? u.pm / 32 : 4;
        const size_t rbase = (size_t)(lat ? u.pm : u.pm - TL / 256) * 256 + wr * 64 + fr;
        const float* xi = (lat ? xin_l : xin_c); float* xo = (lat ? xout_l : xout_c);
        const int col0 = u.pn * 256 + wc * 32 + 4 * fq;
        const float* gp = mod + (size_t)b5 * NMOD * DM + which * DM + col0;
        f32x4 gv[2][2];
#pragma unroll
        for (int bj = 0; bj < 2; ++bj)
#pragma unroll
            for (int n = 0; n < 2; ++n) gv[bj][n] = *(const f32x4*)(gp + bj * 128 + n * 16) * rs;
#pragma unroll
        for (int ai = 0; ai < 2; ++ai) { const size_t off0 = (rbase + ai * 128) * DM + col0;
            if (u.qmask == 0xF) { f32x4 xv[4][2][2];
#pragma unroll
                for (int m = 0; m < 4; ++m)
#pragma unroll
                    for (int bj = 0; bj < 2; ++bj)
#pragma unroll
                        for (int n = 0; n < 2; ++n) xv[m][bj][n] = *(const f32x4*)(xi + off0 + (size_t)m * 16 * DM + bj * 128 + n * 16);
#pragma unroll
                for (int m = 0; m < 4; ++m)
#pragma unroll
                    for (int bj = 0; bj < 2; ++bj)
#pragma unroll
                        for (int n = 0; n < 2; ++n) *(f32x4*)(xo + off0 + (size_t)m * 16 * DM + bj * 128 + n * 16) = xv[m][bj][n] + gv[bj][n] * acc[ai][bj][m][n];
            } else {
#pragma unroll
                for (int bj = 0; bj < 2; ++bj) if ((u.qmask >> (ai * 2 + bj)) & 1) { f32x4 xv[4][2];
#pragma unroll
                    for (int m = 0; m < 4; ++m)
#pragma unroll
                        for (int n = 0; n < 2; ++n) xv[m][n] = *(const f32x4*)(xi + off0 + (size_t)m * 16 * DM + bj * 128 + n * 16);
#pragma unroll
                    for (int m = 0; m < 4; ++m)
#pragma unroll
                        for (int n = 0; n < 2; ++n) *(f32x4*)(xo + off0 + (size_t)m * 16 * DM + bj * 128 + n * 16) = xv[m][n] + gv[bj][n] * acc[ai][bj][m][n]; } }
            asm volatile("" ::: "memory"); }
    }
};
struct EpiSwiglu {
    static constexpr bool PERM = true;
    bf16_t* act;
    __device__ __forceinline__ void operator()(const f32x4 (&acc)[2][2][4][2], const pg8::Unit& u, int wr, int wc, int fr, int fq) const {
        const size_t row0 = (size_t)u.pm * 256 + wr * 64 + fr; const int col0 = u.pn * 128 + wc * 32 + 8 * fq;
#pragma unroll
        for (int ai = 0; ai < 2; ++ai)
#pragma unroll
            for (int m = 0; m < 4; ++m) {
                const f32x4 g0 = acc[ai][0][m][0], g1 = acc[ai][0][m][1], u0 = acc[ai][1][m][0], u1 = acc[ai][1][m][1];
                u32x4 w;
                w.x = pk2(fast_silu(g0[0]) * u0[0], fast_silu(g0[1]) * u0[1]); w.y = pk2(fast_silu(g0[2]) * u0[2], fast_silu(g0[3]) * u0[3]);
                w.z = pk2(fast_silu(g1[0]) * u1[0], fast_silu(g1[1]) * u1[1]); w.w = pk2(fast_silu(g1[2]) * u1[2], fast_silu(g1[3]) * u1[3]);
                *(u32x4*)(act + (row0 + ai * 128 + m * 16) * DFF + col0) = w; }
    }
};
struct EpiQKV {
    static constexpr bool PERM = true;
    bf16_t *QB, *KB, *VB; const float2* rope;
    __device__ __forceinline__ void operator()(const f32x4 (&acc)[2][2][4][2], const pg8::Unit& u, int wr, int wc, int fr, int fq) const {
        const bool lat = u.pm < TL / 256; const int row0 = u.pm * 256 + wr * 64 + fr;
        const bool dorope = lat && u.pn < 5; const float qs = u.pn < 4 ? 0.125f * LOG2E : 1.f;
        const size_t doff = u.pn < 4 ? (size_t)0 : (u.pn == 4 ? (size_t)((BIG_K - BIG_Q) / 2) : (size_t)((BIG_V - BIG_Q) / 2));
        bf16_t* dst = QB + doff; const int ld = u.pn < 4 ? DM : 256, colt = u.pn < 4 ? u.pn * 256 : 0;
        const int a = wc & 1, f0 = 8 * (fq & 1); const float sg = (fq < 2) ? -1.f : 1.f;
#pragma unroll
        for (int ai = 0; ai < 2; ++ai) { f32x4 cs[4][4];
            if (dorope) {
#pragma unroll
                for (int m = 0; m < 4; ++m) { const int r = row0 + ai * 128 + m * 16; const int t = r & (SEQ - 1); const int pos = a ? (t & 63) : (t >> 6);
                    const f32x4* csp = (const f32x4*)(rope + pos * 16 + f0);
#pragma unroll
                    for (int q4 = 0; q4 < 4; ++q4) cs[m][q4] = csp[q4]; } }
#pragma unroll
            for (int m = 0; m < 4; ++m) { const int r = row0 + ai * 128 + m * 16;
#pragma unroll
                for (int bj = 0; bj < 2; ++bj) if ((u.qmask >> (ai * 2 + bj)) & 1) { f32x4 v[2];
#pragma unroll
                    for (int n = 0; n < 2; ++n) { v[n] = acc[ai][bj][m][n];
                        if (dorope) { const f32x4 c01 = cs[m][2 * n], c23 = cs[m][2 * n + 1];
#pragma unroll
                            for (int j = 0; j < 4; ++j) { const float pr = xor32(v[n][j], fq < 2); const float c = (j < 2 ? c01 : c23)[2 * (j & 1)], sn = (j < 2 ? c01 : c23)[2 * (j & 1) + 1]; v[n][j] = v[n][j] * c + sg * pr * sn; } }
                        v[n] = v[n] * qs; }
                    u32x4 w; w.x = pk2(v[0][0], v[0][1]); w.y = pk2(v[0][2], v[0][3]); w.z = pk2(v[1][0], v[1][1]); w.w = pk2(v[1][2], v[1][3]);
                    *(u32x4*)(dst + (size_t)r * ld + colt + bj * 128 + wc * 32 + 8 * fq) = w; } }
            asm volatile("" ::: "memory"); }
    }
};
struct EpiMoeDown {
    static constexpr bool PERM = false;
    float* xl; float* xc; const float* mod; const int* ltok; const float* lw; float rs;
    __device__ __forceinline__ void operator()(const f32x4 (&acc)[2][2][4][2], const pg8::Unit& u, int wr, int wc, int fr, int fq) const {
        const int g = u.g; const int lbase = (u.pm - u.first) * 256 + wr * 64 + fr; const int cnt = u.cnt;
        const int col0 = u.pn * 256 + wc * 32 + 4 * fq;
        int tokv[2][4]; float wv[2][4];
#pragma unroll
        for (int ai = 0; ai < 2; ++ai)
#pragma unroll
            for (int m = 0; m < 4; ++m) { const int local = lbase + ai * 128 + m * 16, li = local < cnt ? local : cnt - 1; tokv[ai][m] = ltok[(size_t)g * TT + li]; wv[ai][m] = lw[(size_t)g * TT + li] * rs; }
        const int b50 = tokv[0][0] < TL ? tokv[0][0] / SEQ : 4;
        f32x4 gv[2][2];
#pragma unroll
        for (int bj = 0; bj < 2; ++bj)
#pragma unroll
            for (int n = 0; n < 2; ++n) gv[bj][n] = *(const f32x4*)(mod + (size_t)b50 * NMOD * DM + 5 * DM + col0 + bj * 128 + n * 16);
#pragma unroll
        for (int am = 0; am < 4; ++am) { const int ai = am >> 1; f32x4 xv[2][2][2];
#pragma unroll
            for (int mm = 0; mm < 2; ++mm) { const int m = (am & 1) * 2 + mm; const int local = lbase + ai * 128 + m * 16;
                if (local < cnt) { const int tok = tokv[ai][m]; const float* xr = (tok < TL ? xl + (size_t)tok * DM : xc + (size_t)(tok - TL) * DM) + col0;
#pragma unroll
                    for (int bj = 0; bj < 2; ++bj) if ((u.qmask >> (ai * 2 + bj)) & 1) {
#pragma unroll
                        for (int n = 0; n < 2; ++n) xv[mm][bj][n] = *(const f32x4*)(xr + bj * 128 + n * 16); } } }
#pragma unroll
            for (int mm = 0; mm < 2; ++mm) { const int m = (am & 1) * 2 + mm; const int local = lbase + ai * 128 + m * 16;
                if (local < cnt) { const int tok = tokv[ai][m]; const float w = wv[ai][m];
                    const bool lat = tok < TL; const int b5 = lat ? tok / SEQ : 4; float* xr = (lat ? xl + (size_t)tok * DM : xc + (size_t)(tok - TL) * DM) + col0;
                    if (b5 == b50) {
#pragma unroll
                        for (int bj = 0; bj < 2; ++bj) if ((u.qmask >> (ai * 2 + bj)) & 1) {
#pragma unroll
                            for (int n = 0; n < 2; ++n) *(f32x4*)(xr + bj * 128 + n * 16) = xv[mm][bj][n] + gv[bj][n] * (w * acc[ai][bj][m][n]); }
                    } else { const float* gp = mod + (size_t)b5 * NMOD * DM + 5 * DM + col0;
#pragma unroll
                        for (int bj = 0; bj < 2; ++bj) if ((u.qmask >> (ai * 2 + bj)) & 1) {
#pragma unroll
                            for (int n = 0; n < 2; ++n) { const f32x4 gr = *(const f32x4*)(gp + bj * 128 + n * 16); *(f32x4*)(xr + bj * 128 + n * 16) = xv[mm][bj][n] + gr * (w * acc[ai][bj][m][n]); } } } } }
            asm volatile("" ::: "memory"); }
    }
};
struct EpiMoeY {
    static constexpr bool PERM = true;
    bf16_t* ys; const float* mod; const int* ltok; const float* lw;
    __device__ __forceinline__ void operator()(const f32x4 (&acc)[2][2][4][2], const pg8::Unit& u, int wr, int wc, int fr, int fq) const {
        const int g = u.g; const int lbase = (u.pm - u.first) * 256 + wr * 64 + fr; const int cnt = u.cnt;
        const int col0 = u.pn * 256 + wc * 32 + 8 * fq;
        int tokv[2][4]; float wv[2][4];
#pragma unroll
        for (int ai = 0; ai < 2; ++ai)
#pragma unroll
            for (int m = 0; m < 4; ++m) { const int local = lbase + ai * 128 + m * 16, li = local < cnt ? local : cnt - 1; tokv[ai][m] = ltok[(size_t)g * TT + li]; wv[ai][m] = lw[(size_t)g * TT + li]; }
        const int b50 = tokv[0][0] < TL ? tokv[0][0] / SEQ : 4;
        f32x4 gv[2][2];
#pragma unroll
        for (int bj = 0; bj < 2; ++bj)
#pragma unroll
            for (int n = 0; n < 2; ++n) gv[bj][n] = *(const f32x4*)(mod + (size_t)b50 * NMOD * DM + 5 * DM + col0 + bj * 128 + n * 4);
#pragma unroll
        for (int ai = 0; ai < 2; ++ai)
#pragma unroll
            for (int m = 0; m < 4; ++m) { const int local = lbase + ai * 128 + m * 16;
                if (local < cnt) { const int tok = tokv[ai][m]; const float w = wv[ai][m]; const int b5 = tok < TL ? tok / SEQ : 4;
                    bf16_t* yr = ys + ((size_t)u.pm * 256 + wr * 64 + fr + ai * 128 + m * 16) * DM + col0;
                    if (b5 == b50) {
#pragma unroll
                        for (int bj = 0; bj < 2; ++bj) if ((u.qmask >> (ai * 2 + bj)) & 1) {
                            const f32x4 v0 = gv[bj][0] * (w * acc[ai][bj][m][0]), v1 = gv[bj][1] * (w * acc[ai][bj][m][1]);
                            u32x4 o; o.x = pk2(v0[0], v0[1]); o.y = pk2(v0[2], v0[3]); o.z = pk2(v1[0], v1[1]); o.w = pk2(v1[2], v1[3]);
                            *(u32x4*)(yr + bj * 128) = o; }
                    } else { const float* gp = mod + (size_t)b5 * NMOD * DM + 5 * DM + col0;
#pragma unroll
                        for (int bj = 0; bj < 2; ++bj) if ((u.qmask >> (ai * 2 + bj)) & 1) { const f32x4 g0 = *(const f32x4*)(gp + bj * 128), g1 = *(const f32x4*)(gp + bj * 128 + 4);
                            const f32x4 v0 = g0 * (w * acc[ai][bj][m][0]), v1 = g1 * (w * acc[ai][bj][m][1]);
                            u32x4 o; o.x = pk2(v0[0], v0[1]); o.y = pk2(v0[2], v0[3]); o.z = pk2(v1[0], v1[1]); o.w = pk2(v1[2], v1[3]);
                            *(u32x4*)(yr + bj * 128) = o; } } } }
    }
};
struct Frame { LAS unsigned char* lds; volatile LAS unsigned* MISC; int tid, lane, wave, vcu, G; };

__device__ __forceinline__ void p0_transpose_item(const float* W, int K, int N, bf16_t* WT, int k0, int n0, int drow0, LAS float* scr, int lane) {
    f32x4 v[16];
#pragma unroll
    for (int i = 0; i < 16; ++i) v[i] = __builtin_nontemporal_load((const f32x4*)(W + (size_t)(k0 + 4 * i + (lane >> 4)) * N + n0 + 4 * (lane & 15)));
#pragma unroll
    for (int i = 0; i < 16; ++i) { LAS float* d = scr + (4 * i + (lane >> 4)) * 65 + 4 * (lane & 15); d[0] = v[i][0]; d[1] = v[i][1]; d[2] = v[i][2]; d[3] = v[i][3]; }
    asm volatile("s_waitcnt lgkmcnt(0)" ::: "memory");
    const int c = lane & 7;
#pragma unroll
    for (int j = 0; j < 8; ++j) { const int n = (lane >> 3) + 8 * j; const LAS float* sp = scr + (8 * c) * 65 + n;
        u32x4 o; o.x = pk2(sp[0 * 65], sp[1 * 65]); o.y = pk2(sp[2 * 65], sp[3 * 65]); o.z = pk2(sp[4 * 65], sp[5 * 65]); o.w = pk2(sp[6 * 65], sp[7 * 65]);
        *(u32x4*)(WT + (size_t)(drow0 + n) * K + k0 + 8 * c) = o; }
    asm volatile("s_waitcnt lgkmcnt(0)" ::: "memory");
}
__device__ __forceinline__ void p0_ffn_matrix(const Prm& p, int m, int r, LAS float* scr, int lane) {
    unsigned char* ws = p.ws; const float* src; bf16_t* dst; int t;
    if (m < 6) { const int j = m / 3; t = m % 3; src = (t == 0 ? p.fg : t == 1 ? p.fu : p.fd) + (size_t)j * DM * DFF; dst = (bf16_t*)(ws + WS_W + j * WE_STRIDE + (t == 2 ? WE_D : WE_GU)); }
    else { const int q = m - 6, j = q / 24, e = (q % 24) / 3; t = q % 3; src = (t == 0 ? p.mg : t == 1 ? p.mu : p.md) + ((size_t)j * NEXP + e) * DM * DFF; dst = (bf16_t*)(ws + WS_W + WO_BASE + j * WO_STRIDE + WO_EXP + e * WX_STRIDE + (t == 2 ? WX_D : WX_GU)); }
    if (t == 2) { const int nblk = DM / 64, q8 = r >> 3, w8 = r & 7, ngx = nblk / 2, kb = 4 * (q8 / ngx) + (w8 >> 1), nb = 2 * (q8 % ngx) + (w8 & 1); p0_transpose_item(src, DFF, DM, dst, 64 * kb, 64 * nb, 64 * nb, scr, lane); }
    else { const int nblk = DFF / 64, q8 = r >> 3, w8 = r & 7, ngx = nblk / 2, kb = 4 * (q8 / ngx) + (w8 >> 1), nb = 2 * (q8 % ngx) + (w8 & 1), n0 = 64 * nb; p0_transpose_item(src, DM, DFF, dst, 64 * kb, n0, (n0 / 128) * 256 + (n0 % 128) + (t == 1 ? 128 : 0), scr, lane); }
}
__device__ __forceinline__ void p0_fold(const Prm& p, Frame& F);
__device__ __forceinline__ void p0_prologue(const Prm& p, Frame& F) {
    unsigned char* ws = p.ws;
    { const int gt = F.vcu * 512 + F.tid, NT = F.G * 512;
      bf16_t* F1 = (bf16_t*)(ws + WS_TAB + TAB_F1); bf16_t* F2 = (bf16_t*)(ws + WS_TAB + TAB_F2); float2* TW = (float2*)(ws + WS_TAB + TAB_TW); float2* TWC = (float2*)(ws + WS_TAB + TAB_TWC);
      for (int i = gt; i < 256 * 128; i += NT) { const int row = i / 128, n1 = i % 128, k1 = row >> 1, c = row & 1; float sn, cs; sincospif(2.f * (float)((n1 * k1) & 127) / 128.f, &sn, &cs);
          F1[i] = (bf16_t)f2bf((c ? -sn : cs) * 0.08838834764831845f); }
      for (int i = gt; i < 128 * 128; i += NT) { const int row = i / 128, col = i % 128, k2 = row >> 1, cp = row & 1, n2 = col >> 1, c = col & 1; float sn, cs; sincospif(2.f * (float)((n2 * k2) & 63) / 64.f, &sn, &cs);
          const float v = cp == 0 ? (c == 0 ? cs : sn) : (c == 0 ? -sn : cs); F2[i] = (bf16_t)f2bf(v * 0.125f); }
      for (int i = gt; i < 64 * 128; i += NT) { const int n2 = i / 128, k1 = i % 128; float sn, cs; sincospif(2.f * (float)(n2 * k1) / 8192.f, &sn, &cs); TW[i] = make_float2(cs, -sn); }
      for (int i = gt; i < 2 * 128; i += NT) { const int n2 = i / 128, k1 = i % 128; float sn, cs; sincospif(2.f * (float)(n2 * k1) / 256.f, &sn, &cs); TWC[i] = make_float2(cs, -sn); }
      for (int i = gt; i < 128 * 16; i += NT) { const int pos = i / 16, f = i % 16; const float inv = powf(10000.f, -(float)f / 16.f); const float ang = (float)pos * inv;
          ((float2*)(ws + WS_ROPE))[i] = make_float2((float)cos((double)ang), (float)sin((double)ang)); }
    }
    { LAS float* sc = (LAS float*)(F.lds);
      LAS float* part = (LAS float*)(F.lds + 32768);
      for (int i = F.tid; i < 5 * DM; i += 512) { const int r = i / DM, k = i % DM; const float v = r < 4 ? p.c[r * DM + k] : p.c_ctx[k]; sc[i] = v / (1.f + expf(-v)); }
      __syncthreads();
      for (int it = F.vcu; it < DEPTH * 96; it += F.G) { const int l = it / 96, n = (it % 96) * 64 + F.lane;
          const float* w = p.ada_w + (size_t)l * DM * NMOD * DM + n; float a[5] = {0.f, 0.f, 0.f, 0.f, 0.f};
          for (int kb = 0; kb < 128; kb += 32) { float wv[32];
#pragma unroll
              for (int kk = 0; kk < 32; ++kk) wv[kk] = w[(size_t)(F.wave * 128 + kb + kk) * NMOD * DM];
#pragma unroll
              for (int kk = 0; kk < 32; ++kk) { const int k = F.wave * 128 + kb + kk;
#pragma unroll
                  for (int r = 0; r < 5; ++r) a[r] += sc[r * DM + k] * wv[kk]; } }
#pragma unroll
          for (int r = 0; r < 5; ++r) part[(F.wave * 5 + r) * 64 + F.lane] = a[r];
          __syncthreads();
          if (F.tid < 320) { const int r = F.tid / 64, ln = F.tid % 64; float sum = 0.f;
#pragma unroll
              for (int wv = 0; wv < 8; ++wv) sum += part[(wv * 5 + r) * 64 + ln];
              ((float*)(ws + WS_MOD))[((size_t)l * 5 + r) * NMOD * DM + (it % 96) * 64 + ln] = sum + p.ada_b[l * NMOD * DM + (it % 96) * 64 + ln]; }
          __syncthreads(); }
    }
    p0_fold(p, F);
    { LAS float* scr = (LAS float*)(F.lds + F.wave * 16640);
      const int gw = F.vcu * 8 + F.wave, NGW = F.G * 8;
      constexpr int I_FFN = 54 * 896, I_QKV = 2 * 384, I_O = 2 * 256;
      for (int it = gw; it < I_FFN + I_QKV + I_O; it += NGW) {
          if (it < I_FFN) { p0_ffn_matrix(p, it / 896, it % 896, scr, F.lane); continue; }
          int r = it - I_FFN;
          if (r < I_QKV) { const int j = r / 384, q = r % 384, nblk = QKVD / 64, kb = q / nblk, nb = q % nblk;
              p0_transpose_item(p.wqkv + (size_t)j * DM * QKVD, DM, QKVD, (bf16_t*)(ws + WS_W + WO_BASE + j * WO_STRIDE + WO_QKV), 64 * kb, 64 * nb, 64 * nb, scr, F.lane); continue; }
          r -= I_QKV;
          { const int j = r / 256, q = r % 256, nblk = DM / 64, kb = q / nblk, nb = q % nblk;
              p0_transpose_item(p.wo + (size_t)j * DM * DM, DM, DM, (bf16_t*)(ws + WS_W + WO_BASE + j * WO_STRIDE + WO_O), 64 * kb, 64 * nb, 64 * nb, scr, F.lane); }
      }
    }
}

template <bool ROUTER>
__device__ __forceinline__ void norm_phase(const Prm& p, Frame& F, const float* xl, const float* xc, const float* g, const float* mod  , int which, bf16_t* HB, int nrows,
                                            const float* wr, unsigned* mcnt, int* ltok, float* lw) {
    const int lane = F.lane;
    f32x4 gv[4];
#pragma unroll
    for (int j = 0; j < 4; ++j) gv[j] = *(const f32x4*)(g + 4 * (lane + 64 * j));
    float wreg[ROUTER ? 128 : 1];
    if (ROUTER) {
#pragma unroll
        for (int j = 0; j < 4; ++j)
#pragma unroll
            for (int i = 0; i < 4; ++i) { const int c = 4 * (lane + 64 * j) + i; const f32x4 w0 = *(const f32x4*)(wr + c * 8), w1 = *(const f32x4*)(wr + c * 8 + 4);
#pragma unroll
                for (int e = 0; e < 4; ++e) { wreg[(j * 4 + i) * 8 + e] = w0[e]; wreg[(j * 4 + i) * 8 + 4 + e] = w1[e]; } }
    }
    const int rpb = (nrows + F.G - 1) / F.G;
    const int r0 = ROUTER ? F.vcu * rpb : F.vcu * 8 + F.wave, r1 = ROUTER ? (r0 + rpb < nrows ? r0 + rpb : nrows) : nrows, rstep = ROUTER ? 8 : F.G * 8;
    LAS unsigned* ech = (LAS unsigned*)F.lds; LAS float* gch = (LAS float*)(F.lds + 4096);
    if (ROUTER) __syncthreads();
    for (int rr = ROUTER ? r0 + F.wave : r0; rr < r1; rr += 2 * rstep) {
        f32x4 v[2][4]; float ss[2];
#pragma unroll
        for (int q = 0; q < 2; ++q) { const int r = rr + q * rstep; ss[q] = 0.f;
            if (r < r1) { const float* xr = (r < TL) ? xl + (size_t)r * DM : xc + (size_t)(r - TL) * DM;
#pragma unroll
                for (int j = 0; j < 4; ++j) v[q][j] = *(const f32x4*)(xr + 4 * (lane + 64 * j)); } }
#pragma unroll
        for (int q = 0; q < 2; ++q) { const int r = rr + q * rstep;
            if (r < r1) {
#pragma unroll
                for (int j = 0; j < 4; ++j) ss[q] += (v[q][j][0] * v[q][j][0] + v[q][j][1] * v[q][j][1]) + (v[q][j][2] * v[q][j][2] + v[q][j][3] * v[q][j][3]); } }
#pragma unroll
        for (int q = 0; q < 2; ++q) { const int r = rr + q * rstep;
          if (r < r1) {
            const int b5 = (r < TL) ? r / SEQ : 4; const float* mp = mod + (size_t)b5 * NMOD * DM + which * DM;
            const float rstd = rsqrtf(wave_sum(ss[q]) * (1.f / DM) + EPS);
            float lg[8] = {};
#pragma unroll
            for (int j = 0; j < 4; ++j) { const f32x4 sh = *(const f32x4*)(mp + 4 * (lane + 64 * j)), sc = *(const f32x4*)(mp + DM + 4 * (lane + 64 * j));
                f32x4 h = v[q][j] * rstd * gv[j] * (sc + 1.f) + sh;
                u32x2 o; o.x = pk2(h[0], h[1]); o.y = pk2(h[2], h[3]); *(u32x2*)(HB + (size_t)r * DM + 4 * (lane + 64 * j)) = o;
                if (ROUTER) {
#pragma unroll
                    for (int i = 0; i < 4; ++i)
#pragma unroll
                        for (int e = 0; e < 8; ++e) lg[e] += h[i] * wreg[(j * 4 + i) * 8 + e]; } }
            if (ROUTER) {
                float a4[4], b2[2], c1;
#pragma unroll
                for (int t = 0; t < 4; ++t) { const float snd = (lane & 1) ? lg[t] : lg[t + 4], kp = (lane & 1) ? lg[t + 4] : lg[t]; a4[t] = kp + SWZ_XOR(snd, 1); }
#pragma unroll
                for (int t = 0; t < 2; ++t) { const float snd = (lane & 2) ? a4[t] : a4[t + 2], kp = (lane & 2) ? a4[t + 2] : a4[t]; b2[t] = kp + SWZ_XOR(snd, 2); }
                { const float snd = (lane & 4) ? b2[0] : b2[1], kp = (lane & 4) ? b2[1] : b2[0]; c1 = kp + SWZ_XOR(snd, 4); }
                c1 += SWZ_XOR(c1, 8); c1 += SWZ_XOR(c1, 16);
                const int cb = __builtin_bit_cast(int, c1);
#pragma unroll
                for (int e = 0; e < 8; ++e) { const int l = ((e >> 2) & 1) | (((e >> 1) & 1) << 1) | ((e & 1) << 2);
                    lg[e] = __builtin_bit_cast(float, __builtin_amdgcn_readlane(cb, l)) + __builtin_bit_cast(float, __builtin_amdgcn_readlane(cb, l + 32)); }
                int e0 = 0; float v0 = lg[0];
#pragma unroll
                for (int e = 1; e < 8; ++e) if (lg[e] > v0) { v0 = lg[e]; e0 = e; }
                int e1 = -1; float v1 = -INFINITY;
#pragma unroll
                for (int e = 0; e < 8; ++e) if (e != e0 && lg[e] > v1) { v1 = lg[e]; e1 = e; }
                const float g1 = 1.f / (1.f + expf(v0 - v1)), g0 = 1.f - g1;
                if (lane == 0) { ech[r - r0] = (unsigned)e0 | ((unsigned)e1 << 8); gch[2 * (r - r0)] = g0; gch[2 * (r - r0) + 1] = g1; }
            }
          } }
    }
    if (ROUTER) {
        __syncthreads();
        if (F.tid < 16) { const int grp = F.tid, k = grp >> 3, e = grp & 7, n = r1 - r0; int cnt = 0;
            for (int i = 0; i < n; ++i) cnt += (int)(((ech[i] >> (8 * k)) & 0xffu) == (unsigned)e);
            mcnt[(size_t)F.vcu * 16 + grp] = (unsigned)cnt; }
    }
}
__device__ __forceinline__ void moe_lists(Frame& F, const unsigned* cntw, unsigned* mcnt, int* ltok, float* lw, int nrows, int* tokslot) {
    const int rpb = (nrows + F.G - 1) / F.G; const int r0 = F.vcu * rpb, r1 = (r0 + rpb < nrows ? r0 + rpb : nrows);
    LAS unsigned* ech = (LAS unsigned*)F.lds; LAS float* gch = (LAS float*)(F.lds + 4096);
    unsigned pos = 0u, tot = 0u; const int grp = F.tid & 15, k = grp >> 3, e = grp & 7, n = r1 - r0;
    if (F.tid < 16) {
        for (int w = 0; w < F.G; ++w) { const unsigned c = cntw[(size_t)w * 16 + grp]; tot += c; pos += (w < F.vcu) ? c : 0u; }
        if (F.vcu == 0) mcnt[grp] = tot;
        F.MISC[64 + grp] = (tot + 255u) / 256u; }
    __syncthreads();
    if (F.tid < 16) { unsigned first = 0u;
        for (int g2 = 0; g2 < grp; ++g2) first += F.MISC[64 + g2];
        for (int i = 0; i < n; ++i) if (((ech[i] >> (8 * k)) & 0xffu) == (unsigned)e) { ltok[(size_t)grp * TT + pos] = r0 + i; lw[(size_t)grp * TT + pos] = gch[2 * i + k];
            if (tokslot) tokslot[(size_t)(r0 + i) * 2 + k] = (int)(first * 256u + pos); ++pos; } }
}
__device__ __forceinline__ void final_norm_phase(const Prm& p, Frame& F, const bf16_t* ys, const int* tokslot) {
    const int gw = F.vcu * 8 + F.wave, NGW = F.G * 8, lane = F.lane;
    f32x4 gv[4];
#pragma unroll
    for (int j = 0; j < 4; ++j) gv[j] = *(const f32x4*)(p.fng + 4 * (lane + 64 * j));
    for (int rr = gw; rr < TL; rr += 2 * NGW) { f32x4 v[2][4];
#pragma unroll
        for (int q = 0; q < 2; ++q) { const int r = rr + q * NGW; if (r < TL) {
#pragma unroll
            for (int j = 0; j < 4; ++j) v[q][j] = *(const f32x4*)(p.out + (size_t)r * DM + 4 * (lane + 64 * j));
            const int s0 = tokslot[2 * r], s1 = tokslot[2 * r + 1];
#pragma unroll
            for (int j = 0; j < 4; ++j) { const u32x2 a = *(const u32x2*)(ys + (size_t)s0 * DM + 4 * (lane + 64 * j)), b = *(const u32x2*)(ys + (size_t)s1 * DM + 4 * (lane + 64 * j));
                v[q][j][0] += __uint_as_float(a.x << 16) + __uint_as_float(b.x << 16); v[q][j][1] += __uint_as_float(a.x & 0xffff0000u) + __uint_as_float(b.x & 0xffff0000u);
                v[q][j][2] += __uint_as_float(a.y << 16) + __uint_as_float(b.y << 16); v[q][j][3] += __uint_as_float(a.y & 0xffff0000u) + __uint_as_float(b.y & 0xffff0000u); } } }
#pragma unroll
        for (int q = 0; q < 2; ++q) { const int r = rr + q * NGW; if (r < TL) { float s = 0.f;
#pragma unroll
            for (int j = 0; j < 4; ++j) s += (v[q][j][0] * v[q][j][0] + v[q][j][1] * v[q][j][1]) + (v[q][j][2] * v[q][j][2] + v[q][j][3] * v[q][j][3]);
            const float rstd = rsqrtf(wave_sum(s) * (1.f / DM) + EPS);
#pragma unroll
            for (int j = 0; j < 4; ++j) *(f32x4*)(p.out + (size_t)r * DM + 4 * (lane + 64 * j)) = v[q][j] * rstd * gv[j]; } } }
}
__device__ __forceinline__ void moe_tables(Frame& F, const unsigned* mcnt) {
    __syncthreads();
    if (F.tid == 0) { unsigned first = 0u, nb0 = 0u;
        for (int g = 0; g < 16; ++g) { const unsigned c = __hip_atomic_load(mcnt + g, __ATOMIC_RELAXED, __HIP_MEMORY_SCOPE_AGENT); F.MISC[16 + g] = first; F.MISC[32 + g] = c; first += (c + 255u) / 256u; if (g == 7) nb0 = first; }
        F.MISC[48] = nb0; F.MISC[49] = first; }
    __syncthreads();
}


__device__ __forceinline__ int fresh_tid(int wave) { int tl; asm volatile("v_mbcnt_lo_u32_b32 %0, -1, 0\n\tv_mbcnt_hi_u32_b32 %0, -1, %0" : "=v"(tl)); return wave * 64 + tl; }
typedef short v4i16_t __attribute__((ext_vector_type(4)));
__device__ __forceinline__ unsigned off_b(unsigned row, unsigned ch) { return 256u * row + 16u * (ch ^ (((row & 3u) << 2) | ((row >> 2) & 3u))); }
__device__ __forceinline__ int crow(int r, int hi) { return (r & 3) + 8 * (r >> 2) + 4 * hi; }
__device__ __forceinline__ s16x4 trrd(const LAS unsigned char* p) { return __builtin_bit_cast(s16x4, __builtin_amdgcn_ds_read_tr16_b64_v4i16((LAS v4i16_t*)p)); }
template <int MB>
__device__ __forceinline__ void dft_mma(const LAS unsigned char* Aimg, const LAS unsigned char* Bimg, int wave, int lane, f32x16 (&acc)[MB]) {
    const int r32 = lane & 31, hi = lane >> 5;
    const unsigned X = ((r32 & 3) << 2) | ((r32 >> 2) & 3);
    const LAS unsigned char* bbase = Bimg + (wave >> 2) * 32768;
    const unsigned blk = (lane >> 4) & 1, q = (lane & 15) >> 2, pp = lane & 3, c = wave & 3;
    unsigned tra[2];
#pragma unroll
    for (int t = 0; t < 2; ++t) tra[t] = off_b(8 * hi + 4 * t + q, 4 * c + 2 * blk + (pp >> 1)) + 8 * (pp & 1);
#pragma unroll
    for (int ks = 0; ks < 8; ++ks) {
        const s16x4 lo = trrd(bbase + tra[0] + ks * 4096), hh = trrd(bbase + tra[1] + ks * 4096);
        const bf16x8 bf = (bf16x8){lo[0], lo[1], lo[2], lo[3], hh[0], hh[1], hh[2], hh[3]};
        const unsigned achunk = ((2 * ks + hi) ^ X) * 16;
#pragma unroll
        for (int mb = 0; mb < MB; ++mb) { const bf16x8 af = *(const LAS bf16x8*)(Aimg + 256 * (32 * mb + r32) + achunk);
            acc[mb] = __builtin_amdgcn_mfma_f32_32x32x16_bf16(af, bf, acc[mb], 0, 0, 0); }
    }
}
__device__ __forceinline__ void p0_fold(const Prm& p, Frame& F) {
    LAS unsigned char* Aimg = F.lds; LAS unsigned char* Bimg = F.lds + 65536; LAS f32x2* cs256 = (LAS f32x2*)(F.lds + 131072);
    const int tid = F.tid, lane = F.lane, wave = F.wave, r32 = lane & 31, hi = lane >> 5;
    __syncthreads();
    for (int i = tid; i < 256; i += 512) { float sn, cs; sincospif(2.f * (float)i / 256.f, &sn, &cs); cs256[i] = (f32x2){cs * 0.0625f, sn * 0.0625f}; }
    const int wi = F.vcu - F.G / 2;
    if (wi >= 0 && (wi & 1) == 0)
    for (int it = wi >> 1; it < 64; it += (F.G - F.G / 2 + 1) >> 1) {
        const int j = it >> 5, g = (it >> 3) & 3, type = (it >> 2) & 1, nt = it & 3;
        const float* w = p.fw + (size_t)j * DM * DM + (size_t)(g * 256) * DM + nt * 256;
        f32x16 acc[8];
#pragma unroll
        for (int mb = 0; mb < 8; ++mb) acc[mb] = (f32x16){};
        for (int ch = 0; ch < 2; ++ch) {
            __syncthreads();
            for (int qq = tid; qq < 256 * 16; qq += 512) { const int row = qq >> 4, c8 = qq & 15, q0 = 128 * ch + 8 * c8; float v[8];
#pragma unroll
                for (int e = 0; e < 8; ++e) { const f32x2 t = cs256[(row * (q0 + e)) & 255]; v[e] = type ? t.y : t.x; }
                u32x4 o; o.x = pk2(v[0], v[1]); o.y = pk2(v[2], v[3]); o.z = pk2(v[4], v[5]); o.w = pk2(v[6], v[7]);
                *(LAS u32x4*)(Aimg + off_b(row, c8)) = o; }
            { const int tt = fresh_tid(wave); const int cols4 = tt & 63, rb = tt >> 6;
              f32x4 xv[16];
#pragma unroll
              for (int i = 0; i < 16; ++i) xv[i] = *(const f32x4*)(w + (size_t)(128 * ch + rb + 8 * i) * DM + 4 * cols4);
              LAS unsigned char* bw = Bimg + (cols4 >> 5) * 32768 + 8 * (cols4 & 1);
#pragma unroll
              for (int i = 0; i < 16; ++i) { const int n1 = rb + 8 * i; u32x2 o; o.x = pk2(xv[i][0], xv[i][1]); o.y = pk2(xv[i][2], xv[i][3]);
                  *(LAS u32x2*)(bw + off_b(n1, (cols4 & 31) >> 1)) = o; } }
            __syncthreads();
            dft_mma<8>(Aimg, Bimg, wave, lane, acc);
        }
        bf16_t* out = (bf16_t*)(p.ws + WS_W + j * WE_STRIDE + WE_F) + (size_t)(nt * 256 + 32 * wave + r32) * 2048 + type * 1024 + g * 256 + 4 * hi;
#pragma unroll
        for (int mb = 0; mb < 8; ++mb)
#pragma unroll
            for (int rg = 0; rg < 4; ++rg) { u32x2 o; o.x = pk2(acc[mb][4 * rg], acc[mb][4 * rg + 1]); o.y = pk2(acc[mb][4 * rg + 2], acc[mb][4 * rg + 3]);
                *(u32x2*)(out + 32 * mb + 8 * rg) = o; }
    }
    __syncthreads();
}
__device__ __forceinline__ void s1_phase(const Prm& p, Frame& F, const float* xl, const float* xc, const float* g, const float* mod, bf16_t* Y1, bf16_t* Y1C) {
    LAS unsigned char* Aimg = F.lds; LAS unsigned char* Bimg = F.lds + 65536;
    LAS float* rstd = (LAS float*)(F.lds + 131072); LAS f32x2* tw = (LAS f32x2*)(F.lds + 131584); LAS float* gm = (LAS float*)(F.lds + 132608); LAS float* shv = (LAS float*)(F.lds + 136704);
    const bf16_t* F1 = (const bf16_t*)(p.ws + WS_TAB + TAB_F1); const float2* TW = (const float2*)(p.ws + WS_TAB + TAB_TW); const float2* TWC = (const float2*)(p.ws + WS_TAB + TAB_TWC);
    const int tid = F.tid, lane = F.lane, wave = F.wave, r32 = lane & 31, hi = lane >> 5;
    __syncthreads();
    for (int qq = tid; qq < 256 * 16; qq += 512) { const int row = qq >> 4, ch = qq & 15; *(LAS u32x4*)(Aimg + off_b(row, ch)) = *(const u32x4*)(F1 + row * 128 + ch * 8); }
    for (int w = F.vcu; w < 288; w += F.G) {
        const int u = w < 256 ? w : 256 + ((w - 256) >> 2), c_lo = w < 256 ? 0 : (w - 256) & 3, c_hi = w < 256 ? 4 : c_lo + 1;
        const bool lat = u < 256; const int b = lat ? u >> 6 : (u - 256) >> 1, n2 = lat ? u & 63 : (u - 256) & 1;
        const float* xs = lat ? xl + ((size_t)b * SEQ + n2) * DM : xc + ((size_t)b * CTXL + n2) * DM; const size_t rstride = (size_t)(lat ? 64 : 2) * DM;
        const float* mp = mod + (size_t)(lat ? b : 4) * NMOD * DM;
        __syncthreads();
        for (int c = tid; c < DM; c += 512) { gm[c] = g[c] * (1.f + mp[DM + c]); shv[c] = mp[c]; }
        if (tid < 128) { const float2 t = lat ? TW[n2 * 128 + tid] : TWC[n2 * 128 + tid]; tw[tid] = (f32x2){t.x, t.y}; }
#pragma unroll 4
        for (int i = 0; i < 16; ++i) { const int n1 = 16 * wave + i; const float* xr = xs + n1 * rstride; float sq = 0.f;
#pragma unroll
            for (int j = 0; j < 4; ++j) { const f32x4 v = *(const f32x4*)(xr + 4 * (lane + 64 * j)); sq += (v[0] * v[0] + v[1] * v[1]) + (v[2] * v[2] + v[3] * v[3]); }
            sq = wave_sum(sq); if (lane == 0) rstd[n1] = rsqrtf(sq * (1.f / DM) + EPS); }
        __syncthreads();
        for (int cc = c_lo; cc < c_hi; ++cc) {
            { const int tt = fresh_tid(wave); const int cols4 = tt & 63, rb = tt >> 6, c0 = 256 * cc + 4 * cols4;
              f32x4 xv[16];
#pragma unroll
              for (int i = 0; i < 16; ++i) xv[i] = *(const f32x4*)(xs + (size_t)(rb + 8 * i) * rstride + c0);
              const f32x4 gv = *(const LAS f32x4*)(gm + c0), sv = *(const LAS f32x4*)(shv + c0);
              LAS unsigned char* bw = Bimg + (cols4 >> 5) * 32768 + 8 * (cols4 & 1);
#pragma unroll
              for (int i = 0; i < 16; ++i) { const int n1 = rb + 8 * i; const f32x4 h = xv[i] * rstd[n1] * gv + sv; u32x2 o; o.x = pk2(h[0], h[1]); o.y = pk2(h[2], h[3]);
                  *(LAS u32x2*)(bw + off_b(n1, (cols4 & 31) >> 1)) = o; } }
            __syncthreads();
            f32x16 acc[8];
#pragma unroll
            for (int mb = 0; mb < 8; ++mb) acc[mb] = (f32x16){};
            dft_mma<8>(Aimg, Bimg, wave, lane, acc);
            __syncthreads();
            bf16_t* Y = lat ? Y1 : Y1C; const size_t k1stride = (size_t)(lat ? 128 : 4) * DM;
            const size_t ybase = (lat ? ((size_t)b * 128 * 64 + n2) * 2 : ((size_t)b * 128 * 2 + n2) * 2) * DM + 256 * cc;
            LAS bf16_t* ost = (LAS bf16_t*)Bimg + (4 * hi) * 256 + 32 * wave + r32;
#pragma unroll
            for (int hf = 0; hf < 2; ++hf) {
#pragma unroll
                for (int mb = 0; mb < 4; ++mb)
#pragma unroll
                    for (int r = 0; r < 16; r += 2) { const int k1 = (32 * (4 * hf + mb) + crow(r, hi)) >> 1; const f32x2 t = tw[k1]; const float re = acc[4 * hf + mb][r], im = acc[4 * hf + mb][r + 1];
                        ost[(32 * mb + (r & 3) + 8 * (r >> 2)) * 256] = (bf16_t)f2bf(re * t.x - im * t.y); ost[(32 * mb + (r & 3) + 8 * (r >> 2) + 1) * 256] = (bf16_t)f2bf(re * t.y + im * t.x);
                        if ((r & 7) == 6) asm volatile("" ::: "memory"); }
                __syncthreads();
                const int t2 = fresh_tid(wave);
#pragma unroll
                for (int i = 0; i < 8; ++i) { const int qq = t2 + 512 * i, row = qq >> 5, ch = qq & 31;
                    const u32x4 v = *(const LAS u32x4*)((const LAS unsigned char*)Bimg + row * 512 + ch * 16);
                    const int k1 = 64 * hf + (row >> 1);
                    *(u32x4*)(Y + ybase + (size_t)k1 * k1stride + (size_t)(row & 1) * DM + ch * 8) = v; }
                __syncthreads();
            }
        }
    }
}
__device__ __forceinline__ void s2_phase(const Prm& p, Frame& F, const bf16_t* Y1, const bf16_t* Y1C, bf16_t* PQ) {
    LAS unsigned char* Aimg = F.lds; LAS unsigned char* Bimg = F.lds + 65536;
    const bf16_t* F2 = (const bf16_t*)(p.ws + WS_TAB + TAB_F2);
    const int tid = F.tid, lane = F.lane, wave = F.wave, r32 = lane & 31, hi = lane >> 5;
    __syncthreads();
    for (int qq = tid; qq < 128 * 16; qq += 512) { const int row = qq >> 4, ch = qq & 15; *(LAS u32x4*)(Aimg + off_b(row, ch)) = *(const u32x4*)(F2 + row * 128 + ch * 8); }
    u32x4 v[8];
    { const int u = F.vcu; if (u < 2048) { const int cc = u & 3, k1 = (u >> 2) & 127, b = u >> 9; const bf16_t* src = Y1 + ((size_t)b * 128 + k1) * 128 * DM + 256 * cc;
#pragma unroll
        for (int i = 0; i < 8; ++i) { const int qq = tid + 512 * i; v[i] = *(const u32x4*)(src + (size_t)(qq >> 5) * DM + (qq & 31) * 8); } } }
    for (int u = F.vcu; u < 2048; u += F.G) {
        const int cc = u & 3, k1 = (u >> 2) & 127, b = u >> 9;
        __syncthreads();
#pragma unroll
        for (int i = 0; i < 8; ++i) { const int qq = tid + 512 * i, row = qq >> 5, ch32 = qq & 31; *(LAS u32x4*)(Bimg + (ch32 >> 4) * 32768 + off_b(row, ch32 & 15)) = v[i]; }
        __syncthreads();
        { const int un = u + F.G; if (un < 2048) { const int ccn = un & 3, k1n = (un >> 2) & 127, bn = un >> 9; const bf16_t* src = Y1 + ((size_t)bn * 128 + k1n) * 128 * DM + 256 * ccn;
#pragma unroll
            for (int i = 0; i < 8; ++i) { const int qq = tid + 512 * i; v[i] = *(const u32x4*)(src + (size_t)(qq >> 5) * DM + (qq & 31) * 8); } } }
        f32x16 acc[4];
#pragma unroll
        for (int mb = 0; mb < 4; ++mb) acc[mb] = (f32x16){};
        dft_mma<4>(Aimg, Bimg, wave, lane, acc);
        __syncthreads();
        { LAS bf16_t* ost = (LAS bf16_t*)Bimg + (4 * hi) * 256 + 32 * wave + r32;
#pragma unroll
          for (int mb = 0; mb < 4; ++mb)
#pragma unroll
              for (int r = 0; r < 16; ++r) ost[(32 * mb + (r & 3) + 8 * (r >> 2)) * 256] = (bf16_t)f2bf(acc[mb][r]); }
        __syncthreads();
        { const int t2 = fresh_tid(wave);
#pragma unroll
          for (int i = 0; i < 8; ++i) { const int qq = t2 + 512 * i, row = qq >> 5, ch = qq & 31, k2 = row >> 1, cp = row & 1;
              const u32x4 o = *(const LAS u32x4*)((const LAS unsigned char*)Bimg + row * 512 + ch * 16);
              *(u32x4*)(PQ + ((size_t)b * SEQ + k1 + 128 * k2) * 2048 + cp * DM + 256 * cc + ch * 8) = o; } }
    }
    { const int gt = F.vcu * 512 + fresh_tid(wave), NT = F.G * 512; const float sc = 0.70710678118654752f;
      for (int i = gt; i < NB * 128 * DM; i += NT) { const int ch = i & (DM - 1), k1 = (i >> 10) & 127, b = i >> 17;
          const bf16_t* y = Y1C + ((size_t)b * 128 + k1) * 4 * DM + ch;
          const float y0r = __uint_as_float((unsigned)y[0] << 16), y0i = __uint_as_float((unsigned)y[DM] << 16), y1r = __uint_as_float((unsigned)y[2 * DM] << 16), y1i = __uint_as_float((unsigned)y[3 * DM] << 16);
          bf16_t* o0 = PQ + ((size_t)TL + b * CTXL + k1) * 2048 + ch; bf16_t* o1 = o0 + (size_t)128 * 2048;
          o0[0] = (bf16_t)f2bf((y0r + y1r) * sc); o0[DM] = (bf16_t)f2bf((y0i + y1i) * sc); o1[0] = (bf16_t)f2bf((y0r - y1r) * sc); o1[DM] = (bf16_t)f2bf((y0i - y1i) * sc); } }
}

__device__ __forceinline__ void attn_phase(const Prm& p, Frame& F, const bf16_t* QB, const bf16_t* KB, const bf16_t* VB, bf16_t* OB, const float* sinks, int nunits) {
    LAS unsigned char* Ks = F.lds; LAS unsigned char* Vs = F.lds + 8192; LAS float* wsf = (LAS float*)(F.lds + 32768) + F.wave * 64; LAS bf16_t* stg = (LAS bf16_t*)(F.lds + 34816 + F.wave * 4096);
    const int lane = F.lane, wave = F.wave, r32 = lane & 31, hi = lane >> 5;
    for (int u = F.vcu; u < nunits; u += F.G) {
        const bool isctx = u >= 2048; const int uu = isctx ? u - 2048 : u;
        const int pb = isctx ? (uu & 3) : (uu & 127), kv = isctx ? ((uu >> 2) & 3) : ((uu >> 7) & 3), b = isctx ? (uu >> 4) : (uu >> 9);
        const int h = kv * 4 + (wave >> 1); const int qq = 32 * (wave & 1) + r32;
        const size_t qrow0 = (size_t)(isctx ? TL + b * CTXL : b * SEQ) + 64 * pb + 32 * (wave & 1);
        bf16x8 qr[4];
#pragma unroll
        for (int d0 = 0; d0 < 4; ++d0) qr[d0] = *(const bf16x8*)(QB + (qrow0 + r32) * DM + h * 64 + d0 * 16 + hi * 8);
        float m = sinks[h] * LOG2E, l = hi ? 0.f : 1.f; f32x16 o[2]; o[0] = (f32x16){}; o[1] = (f32x16){};
        const int ntl = isctx ? 0 : 5;
        const int t_first = isctx ? 0 : (pb < 2 ? 2 - pb : 0), t_lastl = isctx ? -1 : (pb > 125 ? 129 - pb : 4);
        const bf16_t* kbase = KB + (size_t)lane * 256 + kv * 64 + wave * 8;
        const bf16_t* vbase = VB + (size_t)(16 * (wave & 3) + (lane >> 2)) * 256 + kv * 64 + (wave >> 2) * 32 + (lane & 3) * 8;
        auto tile_row0 = [&](int ti) -> size_t { return ti < ntl ? (size_t)b * SEQ + 64 * (pb - 2 + ti) : (size_t)TL + b * CTXL + 64 * (ti - ntl); };
        int ti = isctx ? 0 : t_first; int slot = 0;
        u32x4 kreg = *(const u32x4*)(kbase + tile_row0(ti) * 256), vreg = *(const u32x4*)(vbase + tile_row0(ti) * 256);
        __syncthreads();
        *(LAS u32x4*)(Ks + wave * 1024 + lane * 16) = kreg; *(LAS u32x4*)(Vs + wave * 1024 + lane * 16) = vreg;
        { int tn0 = ti + 1; if (tn0 > t_lastl && tn0 < ntl) tn0 = ntl; kreg = *(const u32x4*)(kbase + tile_row0(tn0) * 256); vreg = *(const u32x4*)(vbase + tile_row0(tn0) * 256); }
        __syncthreads();
        while (ti < ntl + 4) {
            const int mode = (ti < ntl) ? ((ti == 0) ? 1 : (ti == 4) ? 2 : 0) : 0;
            int tn = ti + 1; if (tn > t_lastl && tn < ntl) tn = ntl;
            int tnn = tn + 1; if (tnn > t_lastl && tnn < ntl) tnn = ntl;
            const LAS unsigned char* kb = Ks + slot * 16384 + hi * 1024 + r32 * 16;
            const LAS unsigned char* vp = Vs + slot * 16384 + ((lane >> 4) & 1) * 32 + (lane & 3) * 8 + (4 * hi + ((lane & 15) >> 2)) * 64;
            f32x16 p0 = (f32x16){}, p1 = (f32x16){};
#pragma unroll
            for (int d0 = 0; d0 < 4; ++d0) { const bf16x8 b0 = *(const LAS bf16x8*)(kb + d0 * 2048), b1 = *(const LAS bf16x8*)(kb + d0 * 2048 + 512);
                p0 = __builtin_amdgcn_mfma_f32_32x32x16_bf16(b0, qr[d0], p0, 0, 0, 0); p1 = __builtin_amdgcn_mfma_f32_32x32x16_bf16(b1, qr[d0], p1, 0, 0, 0); }
            if (mode) {
#pragma unroll
                for (int r = 0; r < 16; ++r) { const int kk = crow(r, hi); const bool m0 = (mode == 1) ? (kk < qq) : (kk > qq), m1 = (mode == 1) ? (kk + 32 < qq) : (kk + 32 > qq);
                    if (m0) p0[r] = -INFINITY; if (m1) p1[r] = -INFINITY; } }
            float rm = fmaxf(p0[0], p1[0]);
#pragma unroll
            for (int r = 1; r < 16; ++r) rm = fmaxf(rm, fmaxf(p0[r], p1[r]));
            { auto rr = __builtin_amdgcn_permlane32_swap(__float_as_uint(rm), __float_as_uint(rm), false, false); rm = fmaxf(__uint_as_float(rr[0]), __uint_as_float(rr[1])); }
            const float mnew = fmaxf(m, rm), alpha = __builtin_amdgcn_exp2f(m - mnew); m = mnew;
            float ps = 0.f;
#pragma unroll
            for (int r = 0; r < 16; ++r) { p0[r] = __builtin_amdgcn_exp2f(p0[r] - m); p1[r] = __builtin_amdgcn_exp2f(p1[r] - m); ps += p0[r] + p1[r]; }
            l = l * alpha + ps;
            if (hi == 0) wsf[r32] = alpha;
#pragma unroll
            for (int r = 0; r < 16; ++r) { const float a = wsf[crow(r, hi)]; o[0][r] *= a; o[1][r] *= a; }
            u32x4 pw[4];
            pw[0] = (u32x4){pk2(p0[0], p0[1]), pk2(p0[2], p0[3]), pk2(p0[4], p0[5]), pk2(p0[6], p0[7])};
            pw[1] = (u32x4){pk2(p0[8], p0[9]), pk2(p0[10], p0[11]), pk2(p0[12], p0[13]), pk2(p0[14], p0[15])};
            pw[2] = (u32x4){pk2(p1[0], p1[1]), pk2(p1[2], p1[3]), pk2(p1[4], p1[5]), pk2(p1[6], p1[7])};
            pw[3] = (u32x4){pk2(p1[8], p1[9]), pk2(p1[10], p1[11]), pk2(p1[12], p1[13]), pk2(p1[14], p1[15])};
#pragma unroll
            for (int d0 = 0; d0 < 2; ++d0)
#pragma unroll
                for (int ks = 0; ks < 4; ++ks) { const s16x4 lo = trrd(vp + d0 * 4096 + ks * 1024), hh = trrd(vp + d0 * 4096 + ks * 1024 + 512);
                    const bf16x8 vf = (bf16x8){lo[0], lo[1], lo[2], lo[3], hh[0], hh[1], hh[2], hh[3]};
                    o[d0] = __builtin_amdgcn_mfma_f32_32x32x16_bf16(__builtin_bit_cast(bf16x8, pw[ks]), vf, o[d0], 0, 0, 0); }
            if (tn < ntl + 4) {
                *(LAS u32x4*)(Ks + (slot ^ 1) * 16384 + wave * 1024 + lane * 16) = kreg; *(LAS u32x4*)(Vs + (slot ^ 1) * 16384 + wave * 1024 + lane * 16) = vreg;
                if (tnn < ntl + 4) { kreg = *(const u32x4*)(kbase + tile_row0(tnn) * 256); vreg = *(const u32x4*)(vbase + tile_row0(tnn) * 256); }
                __syncthreads(); }
            ti = tn; slot ^= 1;
        }
        { auto rr = __builtin_amdgcn_permlane32_swap(__float_as_uint(l), __float_as_uint(l), false, false); l = __uint_as_float(rr[0]) + __uint_as_float(rr[1]); }
        if (hi == 0) wsf[32 + r32] = l;
#pragma unroll
        for (int r = 0; r < 16; ++r) { const int orow = crow(r, hi); const float rl = __builtin_amdgcn_rcpf(wsf[32 + orow]);
            stg[orow * 64 + r32] = (bf16_t)f2bf(o[0][r] * rl); stg[orow * 64 + 32 + r32] = (bf16_t)f2bf(o[1][r] * rl); }
#pragma unroll
        for (int i = 0; i < 4; ++i) { const int row = i * 8 + (lane >> 3), ch = lane & 7; const u32x4 v = *(const LAS u32x4*)(stg + row * 64 + ch * 8);
            *(u32x4*)(OB + (qrow0 + row) * DM + h * 64 + ch * 8) = v; }
    }
}


__device__ __forceinline__ int next_real(int ph) { int q = ph + 1; if (q >= 1 && q <= 32) { const int i = (q - 1) >> 3, o = (q - 1) & 7; if ((i & 1) == 0 && o >= 6) q = 1 + 8 * (i + 1); } return q; }
__global__ void __launch_bounds__(512, 2) mk_fwd(Args a) {
    extern __shared__ __attribute__((aligned(16))) unsigned char lds_raw[];
    Frame F; F.lds = (LAS unsigned char*)lds_raw; F.MISC = (volatile LAS unsigned*)(F.lds + LDS_MISC);
    F.tid = threadIdx.x; F.lane = F.tid & 63; F.wave = __builtin_amdgcn_readfirstlane(F.tid >> 6);
    F.G = gridDim.x; { const int bx = blockIdx.x; F.vcu = (F.G % 8 == 0) ? (bx % 8) * (F.G / 8) + bx / 8 : bx; }
    const Prm& p = a.p; GAS unsigned char* ws = (GAS unsigned char*)a.p.ws;
    for (int u = F.tid; u < 128; u += 512) F.MISC[u] = 0u;
    __syncthreads();
    unsigned* ctl = (unsigned*)(ws + WS_CTL);
    XcdBarrier bar = xcd_barrier_post(ctl + CW_BAR, F.MISC + 8);
    const int lo = a.ph_lo, hi = a.ph_hi;
    const int wave0 = __builtin_amdgcn_readfirstlane((int)threadIdx.x >> 6);
#ifndef ONLY
#define ONLY -1
#endif
#ifndef PROBE_KIND
#define PROBE_KIND -1
#endif
#ifndef PROBE_GEMMS
#define PROBE_GEMMS 0
#endif
#define NREP(k) (((k) == PROBE_KIND) || (PROBE_GEMMS && ((k) == 3 || (k) == 5 || (k) == 6 || (k) == 7 || (k) == 9 || (k) == 11 || (k) == 12)) ? 2 : 1)
#define EN(k) (ONLY == -1 || ONLY == (k))
#define RUN(ph) (lo <= (ph) && (ph) < hi)
#define SEAM(ph) do { if (next_real(ph) < hi) xcd_barrier(bar); } while (0)
#define FRESH() do { const int t_ = fresh_tid(wave0);     F.tid = t_; F.lane = t_ & 63; F.wave = __builtin_amdgcn_readfirstlane(t_ >> 6); asm volatile("" : "+s"(ws)); } while (0)
    const int cblk = (int)blockIdx.x;
#define WSP(T, off) ((T*)(GAS T*)(ws + (off)))
#define SKCTL(slots_off, ph) pg8::SkCtl{WSP(f32x4, slots_off), WSP(unsigned, WS_CTL) + CW_SKF, WSP(unsigned, WS_CTL) + CW_BAR + XB_TMO, (unsigned)((ph) * 4 + rep + 1), cblk, F.G}
    for (int rep = 0; rep < NREP(0); ++rep) if (EN(0) && RUN(0)) { FRESH(); p0_prologue(p, F); SEAM(0); }

    for (int lp = 0; lp < 2; ++lp) {
        const int ie = 2 * lp, io = 2 * lp + 1, j = lp;
        { const int base = 1 + 8 * ie;
          for (int rep = 0; rep < NREP(1); ++rep) if (EN(1) && RUN(base + 0)) { FRESH(); s1_phase(p, F, ie == 0 ? p.x : p.out, ie == 0 ? p.ctx : WSP(const float, WS_XC), p.nmg + ie * DM, WSP(const float, WS_MOD) + (size_t)ie * 5 * NMOD * DM,
                                                  WSP(bf16_t, WS_MS + MS_BIG + BIG_Y1), WSP(bf16_t, WS_MS + MS_BIG + BIG_Y1C)); SEAM(base + 0); }
          for (int rep = 0; rep < NREP(2); ++rep) if (EN(2) && RUN(base + 1)) { FRESH(); s2_phase(p, F, WSP(const bf16_t, WS_MS + MS_BIG + BIG_Y1), WSP(const bf16_t, WS_MS + MS_BIG + BIG_Y1C), WSP(bf16_t, WS_MS + MS_BIG + BIG_PQ)); SEAM(base + 1); }
          for (int rep = 0; rep < NREP(3); ++rep) if (EN(3) && RUN(base + 2)) { FRESH(); SchedDense<true> S{WSP(const bf16_t, WS_W + j * WE_STRIDE + WE_F), TT / 256, DM / 256, F.G, cblk, 2048};
              EpiResid E{ie == 0 ? p.x : p.out, ie == 0 ? p.ctx : WSP(const float, WS_XC), p.out, WSP(float, WS_XC), WSP(const float, WS_MOD) + (size_t)ie * 5 * NMOD * DM, 2, rep ? 0.f : 1.f};
              pg8::gemm_phase<EpiResid, SchedDense<true>, false>(F.lds, F.tid, WSP(const bf16_t, WS_MS + MS_BIG + BIG_PQ), 2048, S, E, SKCTL(WS_MS + MS_HB, base + 2)); SEAM(base + 2); }
          for (int rep = 0; rep < NREP(4); ++rep) if (EN(4) && RUN(base + 3)) { FRESH(); norm_phase<false>(p, F, p.out, WSP(const float, WS_XC), p.nfg + ie * DM, WSP(const float, WS_MOD) + (size_t)ie * 5 * NMOD * DM, 3, WSP(bf16_t, WS_MS + MS_HB), TT, nullptr, nullptr, nullptr, nullptr); SEAM(base + 3); }
          for (int rep = 0; rep < NREP(5); ++rep) if (EN(5) && RUN(base + 4)) { FRESH(); SchedDense<false> S{WSP(const bf16_t, WS_W + j * WE_STRIDE + WE_GU), TT / 256, 2 * DFF / 256, F.G, cblk, DM}; EpiSwiglu E{WSP(bf16_t, WS_MS + MS_BIG + BIG_ACT)};
              pg8::gemm_phase<EpiSwiglu, SchedDense<false>, false>(F.lds, F.tid, WSP(const bf16_t, WS_MS + MS_HB), DM, S, E); SEAM(base + 4); }
          for (int rep = 0; rep < NREP(6); ++rep) if (EN(6) && RUN(base + 5)) { FRESH(); SchedDense<true> S{WSP(const bf16_t, WS_W + j * WE_STRIDE + WE_D), TT / 256, DM / 256, F.G, cblk, DFF};
              EpiResid E{p.out, WSP(const float, WS_XC), p.out, WSP(float, WS_XC), WSP(const float, WS_MOD) + (size_t)ie * 5 * NMOD * DM, 5, rep ? 0.f : 1.f};
              pg8::gemm_phase<EpiResid, SchedDense<true>, false>(F.lds, F.tid, WSP(const bf16_t, WS_MS + MS_BIG + BIG_ACT), DFF, S, E, SKCTL(WS_MS + MS_HB, base + 5)); SEAM(base + 5); }
        }
        { const int base = 1 + 8 * io; const bool last = (io == DEPTH - 1); const int nrows = last ? TL : TT;
          const size_t wo = WS_W + WO_BASE + j * WO_STRIDE;
          for (int rep = 0; rep < NREP(4); ++rep) if (EN(4) && RUN(base + 0)) { FRESH(); norm_phase<false>(p, F, p.out, WSP(const float, WS_XC), p.nmg + io * DM, WSP(const float, WS_MOD) + (size_t)io * 5 * NMOD * DM, 0, WSP(bf16_t, WS_MS + MS_HB), TT, nullptr, nullptr, nullptr, nullptr); SEAM(base + 0); }
          for (int rep = 0; rep < NREP(7); ++rep) if (EN(7) && RUN(base + 1)) { FRESH(); SchedDense<true> S{WSP(const bf16_t, wo + WO_QKV), TT / 256, QKVD / 256, F.G, cblk, DM};
              EpiQKV E{WSP(bf16_t, WS_MS + MS_BIG + BIG_Q), WSP(bf16_t, WS_MS + MS_BIG + BIG_K), WSP(bf16_t, WS_MS + MS_BIG + BIG_V), WSP(const float2, WS_ROPE)};
              pg8::gemm_phase<EpiQKV, SchedDense<true>, false>(F.lds, F.tid, WSP(const bf16_t, WS_MS + MS_HB), DM, S, E, SKCTL(WS_MS + MS_BIG + 300 * MiB, base + 1)); SEAM(base + 1); }
          for (int rep = 0; rep < NREP(8); ++rep) if (EN(8) && RUN(base + 2)) { FRESH(); attn_phase(p, F, WSP(const bf16_t, WS_MS + MS_BIG + BIG_Q), WSP(const bf16_t, WS_MS + MS_BIG + BIG_K), WSP(const bf16_t, WS_MS + MS_BIG + BIG_V), WSP(bf16_t, WS_MS + MS_BIG + BIG_O), p.sinks + j * NH, last ? 2048 : 2048 + 64); SEAM(base + 2); }
          for (int rep = 0; rep < NREP(9); ++rep) if (EN(9) && RUN(base + 3)) { FRESH(); SchedDense<true> S{WSP(const bf16_t, wo + WO_O), nrows / 256, DM / 256, F.G, cblk, DM};
              EpiResid E{p.out, WSP(const float, WS_XC), p.out, WSP(float, WS_XC), WSP(const float, WS_MOD) + (size_t)io * 5 * NMOD * DM, 2, rep ? 0.f : 1.f};
              pg8::gemm_phase<EpiResid, SchedDense<true>, false>(F.lds, F.tid, WSP(const bf16_t, WS_MS + MS_BIG + BIG_O), DM, S, E, SKCTL(WS_MS + MS_HB, base + 3)); SEAM(base + 3); }
          for (int rep = 0; rep < NREP(10); ++rep) if (EN(10) && RUN(base + 4)) { FRESH(); norm_phase<true>(p, F, p.out, WSP(const float, WS_XC), p.nfg + io * DM, WSP(const float, WS_MOD) + (size_t)io * 5 * NMOD * DM, 3, WSP(bf16_t, WS_MS + MS_HB), nrows,
                                                       p.mr + (size_t)j * DM * NEXP, WSP(unsigned, WS_CTL) + CW_CNTW + 4096 * j, WSP(int, WS_ROUTE), WSP(float, WS_ROUTE) + 16 * TT); SEAM(base + 4); }
          for (int rep = 0; rep < NREP(11); ++rep) if (EN(11) && RUN(base + 5)) { FRESH(); if (rep == 0) { moe_lists(F, WSP(const unsigned, WS_CTL) + CW_CNTW + 4096 * j, WSP(unsigned, WS_CTL) + CW_MCNT + 64 * j, WSP(int, WS_ROUTE), WSP(float, WS_ROUTE) + 16 * TT, nrows, last ? WSP(int, WS_TOKSLOT) : (int*)nullptr); xcd_barrier(bar); }
              FRESH(); moe_tables(F, WSP(unsigned, WS_CTL) + CW_MCNT + 64 * j); MoeTab tab{F.MISC};
              SchedMoe<true, false> S{WSP(const bf16_t, wo + WO_EXP + WX_GU), WX_STRIDE, 2 * DFF / 256, F.G, cblk, DM, 0, (int)F.MISC[49], tab, WSP(const int, WS_ROUTE)}; EpiSwiglu E{WSP(bf16_t, WS_MS + MS_BIG + BIG_ACT)};
              pg8::gemm_phase<EpiSwiglu, SchedMoe<true, false>, true>(F.lds, F.tid, WSP(const bf16_t, WS_MS + MS_HB), DM, S, E); SEAM(base + 5); }
#pragma unroll
          for (int k = 0; k < 2; ++k)
          for (int rep = 0; rep < NREP(12); ++rep) if (EN(12) && RUN(base + 6 + k) && !last) { FRESH(); moe_tables(F, WSP(unsigned, WS_CTL) + CW_MCNT + 64 * j); MoeTab tab{F.MISC};
              const int nb0 = (int)F.MISC[48], nba = (int)F.MISC[49];
              SchedMoe<false, true> S{WSP(const bf16_t, wo + WO_EXP + WX_D), WX_STRIDE, DM / 256, F.G, cblk, DFF, k ? nb0 : 0, k ? nba - nb0 : nb0, tab, WSP(const int, WS_ROUTE)};
              EpiMoeDown E{p.out, WSP(float, WS_XC), WSP(const float, WS_MOD) + (size_t)io * 5 * NMOD * DM, WSP(const int, WS_ROUTE), WSP(const float, WS_ROUTE) + 16 * TT, rep ? 0.f : 1.f};
              pg8::gemm_phase<EpiMoeDown, SchedMoe<false, true>, false>(F.lds, F.tid, WSP(const bf16_t, WS_MS + MS_BIG + BIG_ACT), DFF, S, E, SKCTL(WS_MS + MS_HB, base + 6 + k)); SEAM(base + 6 + k); }
          for (int rep = 0; rep < NREP(14); ++rep) if (EN(12) && RUN(base + 6) && last) { FRESH(); moe_tables(F, WSP(unsigned, WS_CTL) + CW_MCNT + 64 * j); MoeTab tab{F.MISC};
              SchedMoe<false, true> S{WSP(const bf16_t, wo + WO_EXP + WX_D), WX_STRIDE, DM / 256, F.G, cblk, DFF, 0, (int)F.MISC[49], tab, WSP(const int, WS_ROUTE)};
              EpiMoeY E{WSP(bf16_t, WS_YS), WSP(const float, WS_MOD) + (size_t)io * 5 * NMOD * DM, WSP(const int, WS_ROUTE), WSP(const float, WS_ROUTE) + 16 * TT};
              pg8::gemm_phase<EpiMoeY, SchedMoe<false, true>, false>(F.lds, F.tid, WSP(const bf16_t, WS_MS + MS_BIG + BIG_ACT), DFF, S, E, SKCTL(WS_MS + MS_HB, base + 6)); SEAM(base + 7); }
        }
    }
    if (EN(13) && RUN(33)) { FRESH(); final_norm_phase(p, F, WSP(const bf16_t, WS_YS), WSP(const int, WS_TOKSLOT)); }
#undef WSP
#undef RUN
#undef SEAM
}

static int g_grid = 0;
static void mega_launch(const Prm& p, int lo, int hi, hipStream_t st) {
    if (g_grid == 0) {
        int dev = 0, cus = 0; hipGetDevice(&dev); hipDeviceGetAttribute(&cus, hipDeviceAttributeMultiprocessorCount, dev);
        if (hipFuncSetAttribute((const void*)mk_fwd, hipFuncAttributeMaxDynamicSharedMemorySize, LDS_BYTES) != hipSuccess) { fprintf(stderr, "hipFuncSetAttribute failed\n"); g_grid = -1; return; }
        int per_cu = 0; if (hipOccupancyMaxActiveBlocksPerMultiprocessor(&per_cu, (const void*)mk_fwd, 512, LDS_BYTES) != hipSuccess || per_cu < 1) fprintf(stderr, "occupancy query: %d\n", per_cu);
        (void)hipGetLastError();
        g_grid = cus & ~7;
    }
    if (g_grid < 0) return;
    hipMemsetAsync(p.ws + WS_CTL + CW_BAR * 4, 0, XCD_BAR_WORDS * 4, st);
    Args a{}; a.p = p; a.ph_lo = lo; a.ph_hi = hi;
    hipLaunchKernelGGL(mk_fwd, dim3(g_grid), dim3(512), LDS_BYTES, st, a);
}

template <class FA, class FB, class FE> static void ngemm(hipStream_t st, int Mmax, int N, int K, FA fa, FB fb, FE fe) {
    hipLaunchKernelGGL((nk_gemm<FA, FB, FE>), dim3(N / 64, (Mmax + 63) / 64), dim3(256), 0, st, Mmax, N, K, fa, fb, fe);
}

#ifndef MEGA_MASK
#define MEGA_MASK 0xFF
#endif
static void naive_forward(const Prm& p, hipStream_t st) {
    unsigned char* ws = p.ws;
    hipMemsetAsync(ws + WS_CTL, 0, 1 * MiB, st);
    if (MEGA_MASK) mega_launch(p, 0, 1, st);
    if (!(MEGA_MASK & 0x20)) {
    hipLaunchKernelGGL(nk_adaln, dim3((DEPTH * 5 * NMOD * DM + 255) / 256), dim3(256), 0, st, p);
    hipLaunchKernelGGL(nk_rope, dim3(8), dim3(256), 0, st, p); }
    hipMemcpyAsync(p.out, p.x, (size_t)TL * DM * 4, hipMemcpyDeviceToDevice, st);
    hipMemcpyAsync(ws + WS_XC, p.ctx, (size_t)TC * DM * 4, hipMemcpyDeviceToDevice, st);
    float* H = (float*)(ws + WS_S);
    unsigned char* S2 = ws + WS_S + 136 * MiB;
    for (int i = 0; i < DEPTH; ++i) {
        const int j = i / 2; const bool last = (i == DEPTH - 1);
        const int nrows = last ? TL : TT;
        const int pbase = 1 + 8 * i;
        if ((i % 2 == 0) && (MEGA_MASK & 0x08)) mega_launch(p, pbase + 0, pbase + 3, st);
        else if ((i % 2 == 1) && (MEGA_MASK & 0x04)) mega_launch(p, pbase + 0, pbase + 4, st);
        else {
        hipLaunchKernelGGL(nk_norm_mod, dim3(TT), dim3(256), 0, st, p, p.nmg + i * DM, i, 0, H, TT);
        if (i % 2 == 0) {
            float2* Y1 = (float2*)S2;
            float2* Z = (float2*)(S2 + 64 * MiB);
            for (int b = 0; b < NB; ++b) {
                hipLaunchKernelGGL(nk_fft_s1, dim3(SEQ * DM / 256), dim3(256), 0, st, H, b, Y1);
                hipLaunchKernelGGL(nk_fft_s2, dim3(SEQ * DM / 256), dim3(256), 0, st, Y1, b, Z);
            }
            hipLaunchKernelGGL(nk_dft_ctx, dim3(TC * DM / 256), dim3(256), 0, st, H, Z);
            hipLaunchKernelGGL(nk_chan_dft, dim3(TT * (DM / 256)), dim3(256), 0, st, Z, H);
            ngemm(st, nrows, DM, DM, ADense{H, DM, nrows}, BDense{p.fw + (size_t)j * DM * DM, DM, 0}, EResid{p, i, 2, 0, nrows});
        } else {
            float* QKV = (float*)S2;
            ngemm(st, TT, QKVD, DM, ADense{H, DM, TT}, BDense{p.wqkv + (size_t)j * DM * QKVD, QKVD, 0}, EStore{QKV, QKVD, TT});
            hipLaunchKernelGGL(nk_rope_apply, dim3((unsigned)(((size_t)TL * 640 + 255) / 256)), dim3(256), 0, st, p, QKV);
            hipLaunchKernelGGL(nk_attn, dim3((unsigned)(((size_t)nrows * NH + 63) / 64)), dim3(64), 0, st, p, QKV, p.sinks + j * NH, H, nrows);
            ngemm(st, nrows, DM, DM, ADense{H, DM, nrows}, BDense{p.wo + (size_t)j * DM * DM, DM, 0}, EResid{p, i, 2, 0, nrows});
        } }
        if ((i % 2 == 0) && (MEGA_MASK & 0x01)) { mega_launch(p, pbase + 3, pbase + 6, st); continue; }
        if ((i % 2 == 1) && (MEGA_MASK & 0x02)) { mega_launch(p, pbase + 4, pbase + 8, st); continue; }
        hipLaunchKernelGGL(nk_norm_mod, dim3(nrows), dim3(256), 0, st, p, p.nfg + i * DM, i, 3, H, nrows);
        constexpr int CH = 8448;
        float* ACT = (float*)S2;
        if (i % 2 == 0) {
            for (int r0 = 0; r0 < nrows; r0 += CH) {
                const int m = nrows - r0 < CH ? nrows - r0 : CH;
                ngemm(st, m, DFF, DM, ADense{H + (size_t)r0 * DM, DM, m}, BDense{p.fg + (size_t)j * DM * DFF, DFF, 0}, ESilu{ACT, DFF, m});
                ngemm(st, m, DFF, DM, ADense{H + (size_t)r0 * DM, DM, m}, BDense{p.fu + (size_t)j * DM * DFF, DFF, 0}, EMulInto{ACT, DFF, m});
                ngemm(st, m, DM, DFF, ADense{ACT, DFF, m}, BDense{p.fd + (size_t)j * DFF * DM, DM, 0}, EResid{p, i, 5, r0, m});
            }
        } else {
            int* cnt = (int*)(ws + WS_CTL) + 1024 + 64 * i;
            int* ltok = (int*)(ws + WS_ROUTE); float* lw = (float*)(ltok + NEXP * TT); int* lk = (int*)(lw + NEXP * TT);
            float* Y0 = (float*)(S2 + 120 * MiB); float* Y1 = Y0 + (size_t)TT * DM;
            hipLaunchKernelGGL(nk_router, dim3((nrows + 255) / 256), dim3(256), 0, st, p, H, p.mr + (size_t)j * DM * NEXP, nrows, cnt, ltok, lw, lk);
            for (int e = 0; e < NEXP; ++e) {
                const size_t we = ((size_t)j * NEXP + e) * DM * DFF;
                for (int r0 = 0; r0 < nrows; r0 += CH) {
                    ngemm(st, CH, DFF, DM, AGather{H, ltok + e * TT, cnt + e, r0, CH}, BDense{p.mg + we, DFF, 0}, ESiluCnt{ACT, cnt + e, DFF, r0, CH, 0});
                    ngemm(st, CH, DFF, DM, AGather{H, ltok + e * TT, cnt + e, r0, CH}, BDense{p.mu + we, DFF, 0}, EMulCnt{ACT, cnt + e, DFF, r0, CH, 0});
                    ngemm(st, CH, DM, DFF, ADenseCnt{ACT, cnt + e, DFF, r0, CH, 0}, BDense{p.md + we, DM, 0}, EScatterY{Y0, Y1, ltok + e * TT, lw + e * TT, lk + e * TT, cnt + e, r0, CH});
                }
            }
            hipLaunchKernelGGL(nk_moe_combine, dim3((unsigned)(((size_t)nrows * DM + 255) / 256)), dim3(256), 0, st, p, Y0, Y1, i, nrows);
        }
    }
    if (MEGA_MASK & 0x10) mega_launch(p, 33, 34, st); else hipLaunchKernelGGL(nk_final_norm, dim3(TL), dim3(256), 0, st, p);
}

extern "C" void kernel_launch(void* const* d_in, const int* in_sizes, int n_in, void* d_out, int out_size, void* d_ws, size_t ws_size, hipStream_t stream) {
    if (n_in != 20 || out_size != TL * DM || ws_size < WS_MEGA_END) { fprintf(stderr, "kernel_launch: unexpected shapes n_in %d out %d ws %zu\n", n_in, out_size, ws_size); return; }
    Prm p{};
    const float** f = (const float**)&p;
    for (int i = 0; i < 20; ++i) f[i] = (const float*)d_in[i];
    p.out = (float*)d_out; p.ws = (unsigned char*)d_ws;
    if (MEGA_MASK == 0xFF) {
        hipMemsetAsync(p.ws + WS_CTL, 0, 1 * MiB, stream);
        mega_launch(p, 0, 34, stream);
    } else naive_forward(p, stream);
}
```

```cpp
#include <hip/hip_runtime.h>
#include <cstdio>
#include <cstdint>
#include <cmath>

constexpr int DM = 1024, NB = 4, SEQ = 8192, DEPTH = 4, CTXL = 256;
constexpr int TL = NB * SEQ;
constexpr int TC = NB * CTXL;
constexpr int TT = TL + TC;
constexpr int NMOD = 6, DFF = 3584, NEXP = 8, QKVD = 1536, NH = 16, NKV = 4, HD = 64;
constexpr int FN1 = 128, FN2 = 64;
constexpr float EPS = 1e-6f;

constexpr size_t MiB = 1ull << 20;
constexpr size_t WS_CTL = 0;
constexpr size_t WS_MOD = 1 * MiB;
constexpr size_t WS_ROPE = 2 * MiB;
constexpr size_t WS_XC = 3 * MiB;
constexpr size_t WS_ROUTE = 8 * MiB;
constexpr size_t WS_S = 416 * MiB;

struct Prm {
    const float *x, *c, *ctx, *c_ctx, *ada_w, *ada_b, *nmg, *nfg, *fw, *wqkv, *wo, *sinks, *fg, *fu, *fd, *mr, *mg, *mu, *md, *fng;
    float* out; unsigned char* ws;
};

__device__ __forceinline__ float silu_f(float v) { return v / (1.f + expf(-v)); }
__device__ __forceinline__ int row_b5(int r) { return r < TL ? r / SEQ : 4; }
__device__ __forceinline__ float* xrow(const Prm& p, int r) { return r < TL ? p.out + (size_t)r * DM : (float*)(p.ws + WS_XC) + (size_t)(r - TL) * DM; }

__global__ void nk_adaln(Prm p) {
    const int idx = blockIdx.x * blockDim.x + threadIdx.x;
    if (idx >= DEPTH * 5 * NMOD * DM) return;
    const int n = idx % (NMOD * DM), r = (idx / (NMOD * DM)) % 5, l = idx / (5 * NMOD * DM);
    const float* cv = r < 4 ? p.c + r * DM : p.c_ctx;
    const float* w = p.ada_w + (size_t)l * DM * NMOD * DM;
    float acc = 0.f;
    for (int k = 0; k < DM; ++k) acc += silu_f(cv[k]) * w[(size_t)k * NMOD * DM + n];
    ((float*)(p.ws + WS_MOD))[idx] = acc + p.ada_b[l * NMOD * DM + n];
}
__global__ void nk_rope(Prm p) {
    const int idx = blockIdx.x * blockDim.x + threadIdx.x;
    if (idx >= 128 * 16) return;
    const int pos = idx / 16, f = idx % 16;
    const float inv = powf(10000.f, -(float)f / 16.f);
    const float ang = (float)pos * inv;
    ((float2*)(p.ws + WS_ROPE))[idx] = make_float2((float)cos((double)ang), (float)sin((double)ang));
}
__global__ void nk_norm_mod(Prm p, const float* g, int layer, int which  , float* H, int nrows) {
    const int r = blockIdx.x; if (r >= nrows) return;
    const float* xr = xrow(p, r);
    __shared__ float red[256];
    float s = 0.f;
    for (int c = threadIdx.x; c < DM; c += 256) { const float v = xr[c]; s += v * v; }
    red[threadIdx.x] = s; __syncthreads();
    for (int o = 128; o > 0; o >>= 1) { if (threadIdx.x < o) red[threadIdx.x] += red[threadIdx.x + o]; __syncthreads(); }
    const float rstd = rsqrtf(red[0] / DM + EPS);
    const float* mod = (const float*)(p.ws + WS_MOD) + ((size_t)layer * 5 + row_b5(r)) * NMOD * DM;
    for (int c = threadIdx.x; c < DM; c += 256) H[(size_t)r * DM + c] = xr[c] * rstd * g[c] * (1.f + mod[(which + 1) * DM + c]) + mod[which * DM + c];
}
__global__ void nk_final_norm(Prm p) {
    const int r = blockIdx.x;
    float* xr = p.out + (size_t)r * DM;
    __shared__ float red[256];
    float s = 0.f;
    for (int c = threadIdx.x; c < DM; c += 256) { const float v = xr[c]; s += v * v; }
    red[threadIdx.x] = s; __syncthreads();
    for (int o = 128; o > 0; o >>= 1) { if (threadIdx.x < o) red[threadIdx.x] += red[threadIdx.x + o]; __syncthreads(); }
    const float rstd = rsqrtf(red[0] / DM + EPS);
    for (int c = threadIdx.x; c < DM; c += 256) xr[c] = xr[c] * rstd * p.fng[c];
}
template <class FA, class FB, class FE>
__global__ void __launch_bounds__(256) nk_gemm(int M, int N, int K, FA fa, FB fb, FE fe) {
    __shared__ float As[16][68], Bs[16][68];
    const int m0 = blockIdx.y * 64, n0 = blockIdx.x * 64;
    if (m0 >= fa.rows()) return;
    const int t = threadIdx.x, tx = t % 16, ty = t / 16;
    float acc[4][4] = {};
    for (int k0 = 0; k0 < K; k0 += 16) {
        { const int m = t / 4, kq = (t % 4) * 4;
#pragma unroll
          for (int i = 0; i < 4; ++i) As[kq + i][m] = fa(m0 + m, k0 + kq + i); }
        { const int k = t / 16, nq = (t % 16) * 4;
#pragma unroll
          for (int i = 0; i < 4; ++i) Bs[k][nq + i] = fb(k0 + k, n0 + nq + i); }
        __syncthreads();
#pragma unroll
        for (int kk = 0; kk < 16; ++kk) {
            float a[4], b[4];
#pragma unroll
            for (int i = 0; i < 4; ++i) { a[i] = As[kk][ty * 4 + i]; b[i] = Bs[kk][tx * 4 + i]; }
#pragma unroll
            for (int i = 0; i < 4; ++i)
#pragma unroll
                for (int j = 0; j < 4; ++j) acc[i][j] += a[i] * b[j];
        }
        __syncthreads();
    }
#pragma unroll
    for (int i = 0; i < 4; ++i)
#pragma unroll
        for (int j = 0; j < 4; ++j) fe(m0 + ty * 4 + i, n0 + tx * 4 + j, acc[i][j]);
}
struct ADense { const float* A; int lda, M; __device__ int rows() const { return M; } __device__ float operator()(int m, int k) const { return m < M ? A[(size_t)m * lda + k] : 0.f; } };
struct BDense { const float* B; int ldb, pad; __device__ float operator()(int k, int n) const { return B[(size_t)k * ldb + n]; } };
struct EStore { float* C; int ldc, M; __device__ void operator()(int m, int n, float v) const { if (m < M) C[(size_t)m * ldc + n] = v; } };
struct ESilu { float* C; int ldc, M; __device__ void operator()(int m, int n, float v) const { if (m < M) C[(size_t)m * ldc + n] = silu_f(v); } };
struct EMulInto { float* C; int ldc, M; __device__ void operator()(int m, int n, float v) const { if (m < M) C[(size_t)m * ldc + n] *= v; } };
struct EResid { Prm p; int layer, which  , row0, M;
    __device__ void operator()(int m, int n, float v) const { if (m < M) { const int r = row0 + m; const float* mod = (const float*)(p.ws + WS_MOD) + ((size_t)layer * 5 + row_b5(r)) * NMOD * DM; xrow(p, r)[n] += mod[which * DM + n] * v; } } };
struct AGather { const float* H; const int* tok; const int* cnt; int r0, rmax; __device__ int rows() const { int c = *cnt - r0; return c < rmax ? c : rmax; }
    __device__ float operator()(int m, int k) const { return m < rows() ? H[(size_t)tok[r0 + m] * DM + k] : 0.f; } };
struct ADenseCnt { const float* A; const int* cnt; int lda, r0, rmax, pad; __device__ int rows() const { int c = *cnt - r0; return c < rmax ? c : rmax; }
    __device__ float operator()(int m, int k) const { return m < rows() ? A[(size_t)m * lda + k] : 0.f; } };
struct ESiluCnt { float* C; const int* cnt; int ldc, r0, rmax, pad; __device__ void operator()(int m, int n, float v) const { int c = *cnt - r0; c = c < rmax ? c : rmax; if (m < c) C[(size_t)m * ldc + n] = silu_f(v); } };
struct EMulCnt { float* C; const int* cnt; int ldc, r0, rmax, pad; __device__ void operator()(int m, int n, float v) const { int c = *cnt - r0; c = c < rmax ? c : rmax; if (m < c) C[(size_t)m * ldc + n] *= v; } };
struct EScatterY { float* Y0; float* Y1; const int* tok; const float* w; const int* kk; const int* cnt; int r0, rmax;
    __device__ void operator()(int m, int n, float v) const { int c = *cnt - r0; c = c < rmax ? c : rmax; if (m < c) { const int i = r0 + m; (kk[i] ? Y1 : Y0)[(size_t)tok[i] * DM + n] = w[i] * v; } } };

__global__ void nk_fft_s1(const float* H, int b, float2* Y1) {
    const size_t idx = (size_t)blockIdx.x * blockDim.x + threadIdx.x;
    const int ch = idx % DM, n2 = (idx / DM) % FN2, k1 = idx / ((size_t)DM * FN2);
    float re = 0.f, im = 0.f;
    for (int n1 = 0; n1 < FN1; ++n1) {
        const float v = H[((size_t)b * SEQ + n1 * FN2 + n2) * DM + ch];
        const int ph = (n1 * k1) % FN1; double s, c; sincospi(-2.0 * ph / FN1, &s, &c);
        re += v * (float)c; im += v * (float)s;
    }
    double s, c; sincospi(-2.0 * (double)(n2 * k1) / (FN1 * FN2), &s, &c);
    Y1[idx] = make_float2(re * (float)c - im * (float)s, re * (float)s + im * (float)c);
}
__global__ void nk_fft_s2(const float2* Y1, int b, float2* Z) {
    const size_t idx = (size_t)blockIdx.x * blockDim.x + threadIdx.x;
    const int ch = idx % DM, k1 = (idx / DM) % FN1, k2 = idx / ((size_t)DM * FN1);
    float re = 0.f, im = 0.f;
    for (int n2 = 0; n2 < FN2; ++n2) {
        const float2 v = Y1[((size_t)k1 * FN2 + n2) * DM + ch];
        const int ph = (n2 * k2) % FN2; double s, c; sincospi(-2.0 * ph / FN2, &s, &c);
        re += v.x * (float)c - v.y * (float)s; im += v.x * (float)s + v.y * (float)c;
    }
    Z[((size_t)b * SEQ + k1 + FN1 * k2) * DM + ch] = make_float2(re, im);
}
__global__ void nk_dft_ctx(const float* H, float2* Z) {
    const size_t idx = (size_t)blockIdx.x * blockDim.x + threadIdx.x;
    const int ch = idx % DM, k = (idx / DM) % CTXL, b = idx / ((size_t)DM * CTXL);
    float re = 0.f, im = 0.f;
    for (int n = 0; n < CTXL; ++n) {
        const float v = H[((size_t)TL + b * CTXL + n) * DM + ch];
        const int ph = (n * k) % CTXL; double s, c; sincospi(-2.0 * ph / CTXL, &s, &c);
        re += v * (float)c; im += v * (float)s;
    }
    Z[((size_t)TL + b * CTXL + k) * DM + ch] = make_float2(re, im);
}
__global__ void nk_chan_dft(const float2* Z, float* R) {
    const size_t idx = (size_t)blockIdx.x * blockDim.x + threadIdx.x;
    const int col = idx % DM, row = idx / DM, g = col / 256, q = col % 256;
    float acc = 0.f;
    for (int pp = 0; pp < 256; ++pp) {
        const float2 v = Z[(size_t)row * DM + g * 256 + pp];
        const int ph = (pp * q) % 256; double s, c; sincospi(2.0 * ph / 256, &s, &c);
        acc += v.x * (float)c + v.y * (float)s;
    }
    const float scale = row < TL ? 1.f / sqrtf((float)SEQ * 256.f) : 1.f / sqrtf((float)CTXL * 256.f);
    R[idx] = acc * scale;
}
__global__ void nk_rope_apply(Prm p, float* QKV) {
    const size_t idx = (size_t)blockIdx.x * blockDim.x + threadIdx.x;
    const int f = idx % 16, a = (idx / 16) % 2, hh = (idx / 32) % 20; const size_t row = idx / 640;
    if (row >= TL) return;
    const int t = row % SEQ, pos = a ? (t % 64) : (t / 64);
    const float2 cs = ((const float2*)(p.ws + WS_ROPE))[pos * 16 + f];
    float* base = QKV + row * QKVD + hh * 64 + a * 32;
    const float x1 = base[f], x2 = base[16 + f];
    base[f] = x1 * cs.x - x2 * cs.y; base[16 + f] = x2 * cs.x + x1 * cs.y;
}
__global__ void __launch_bounds__(64) nk_attn(Prm p, const float* QKV, const float* sinks, float* O, int nrows) {
    const size_t idx = (size_t)blockIdx.x * blockDim.x + threadIdx.x;
    const int h = idx % NH; const size_t row = idx / NH;
    if (row >= (size_t)nrows) return;
    const int kv = h / 4;
    float q[64], o[64];
#pragma unroll
    for (int d = 0; d < 64; ++d) { q[d] = QKV[row * QKVD + h * 64 + d] * 0.125f; o[d] = 0.f; }
    float m = sinks[h], l = 1.f;
    const bool lat = row < TL; const int b = lat ? row / SEQ : (row - TL) / CTXL; const int t = lat ? row % SEQ : 0;
    const int j0 = lat ? (t - 128 < 0 ? 0 : t - 128) : 0, j1 = lat ? (t + 128 > SEQ - 1 ? SEQ - 1 : t + 128) : -1;
    const int nlat = j1 - j0 + 1;
    for (int jj = 0; jj < nlat + CTXL; ++jj) {
        const size_t krow = jj < nlat ? (size_t)b * SEQ + j0 + jj : (size_t)TL + b * CTXL + (jj - nlat);
        const float* kp = QKV + krow * QKVD + 1024 + kv * 64; const float* vp = kp + 256;
        float s = 0.f;
#pragma unroll
        for (int d = 0; d < 64; ++d) s += q[d] * kp[d];
        if (s > m) { const float f = expf(m - s); l *= f;
#pragma unroll
            for (int d = 0; d < 64; ++d) o[d] *= f;
            m = s; }
        const float pe = expf(s - m); l += pe;
#pragma unroll
        for (int d = 0; d < 64; ++d) o[d] += pe * vp[d];
    }
    const float il = 1.f / l;
#pragma unroll
    for (int d = 0; d < 64; ++d) O[row * DM + h * 64 + d] = o[d] * il;
}
__global__ void nk_router(Prm p, const float* H, const float* wr, int nrows, int* cnt, int* ltok, float* lw, int* lk) {
    const int r = blockIdx.x * blockDim.x + threadIdx.x; if (r >= nrows) return;
    float lg[NEXP] = {};
    for (int k = 0; k < DM; ++k) { const float hv = H[(size_t)r * DM + k];
#pragma unroll
        for (int e = 0; e < NEXP; ++e) lg[e] += hv * wr[k * NEXP + e]; }
    int e0 = 0; float v0 = lg[0];
#pragma unroll
    for (int e = 1; e < NEXP; ++e) if (lg[e] > v0) { v0 = lg[e]; e0 = e; }
    int e1 = -1; float v1 = -INFINITY;
#pragma unroll
    for (int e = 0; e < NEXP; ++e) if (e != e0 && lg[e] > v1) { v1 = lg[e]; e1 = e; }
    const float g1 = 1.f / (1.f + expf(v0 - v1)), g0 = 1.f - g1;
    int i0 = atomicAdd(&cnt[e0], 1); ltok[e0 * TT + i0] = r; lw[e0 * TT + i0] = g0; lk[e0 * TT + i0] = 0;
    int i1 = atomicAdd(&cnt[e1], 1); ltok[e1 * TT + i1] = r; lw[e1 * TT + i1] = g1; lk[e1 * TT + i1] = 1;
}
__global__ void nk_moe_combine(Prm p, const float* Y0, const float* Y1, int layer, int nrows) {
    const size_t idx = (size_t)blockIdx.x * blockDim.x + threadIdx.x; const int n = idx % DM; const size_t r = idx / DM;
    if (r >= (size_t)nrows) return;
    const float* mod = (const float*)(p.ws + WS_MOD) + ((size_t)layer * 5 + row_b5((int)r)) * NMOD * DM;
    xrow(p, (int)r)[n] += mod[5 * DM + n] * (Y0[idx] + Y1[idx]);
}


#define GAS __attribute__((address_space(1)))
#define LAS __attribute__((address_space(3)))
typedef unsigned short bf16_t;
typedef short bf16x8 __attribute__((ext_vector_type(8)));
typedef short s16x4 __attribute__((ext_vector_type(4)));
typedef float f32x4 __attribute__((ext_vector_type(4)));
typedef float f32x16 __attribute__((ext_vector_type(16)));
typedef unsigned u32x4 __attribute__((ext_vector_type(4)));
typedef unsigned u32x2 __attribute__((ext_vector_type(2)));
typedef float f32x2 __attribute__((ext_vector_type(2)));

constexpr size_t WS_TAB = 13 * MiB;
constexpr size_t TAB_F1 = 0, TAB_F2 = 65536, TAB_TW = 131072, TAB_TWC = 196608;
constexpr size_t WS_W = 16 * MiB;
constexpr size_t WE_STRIDE = 25 * MiB, WE_F = 0, WE_GU = 4 * MiB, WE_D = 18 * MiB;
constexpr size_t WO_BASE = 50 * MiB, WO_STRIDE = 173 * MiB, WO_QKV = 0, WO_O = 3 * MiB, WO_EXP = 5 * MiB, WX_STRIDE = 21 * MiB, WX_GU = 0, WX_D = 14 * MiB;
constexpr size_t WS_MS = 416 * MiB;
constexpr size_t MS_HB = 0;
constexpr size_t MS_BIG = 66 * MiB;
constexpr size_t BIG_ACT = 0;
constexpr size_t BIG_Y1 = 0, BIG_Y1C = 128 * MiB, BIG_PQ = 136 * MiB;
constexpr size_t BIG_Q = 0, BIG_K = 66 * MiB, BIG_V = 83 * MiB, BIG_O = 100 * MiB;
constexpr size_t WS_MEGA_END = WS_MS + MS_BIG + 490 * MiB;
constexpr size_t WS_YS = WS_W + WO_BASE;
constexpr size_t WS_TOKSLOT = WS_ROUTE + 4352 * 1024;
constexpr int MAXBLK = 280;
constexpr int CW_BAR = 4096;
constexpr int CW_CNT = 1024;
constexpr int CW_CNTW = 65536;
constexpr int CW_SKF = 32768;
constexpr int CW_MCNT = 2048;
constexpr int LDS_BYTES = 147456;
constexpr int LDS_MISC = 146944;
constexpr float LOG2E = 1.4426950408889634f;

struct Args { Prm p; int ph_lo, ph_hi; };

__device__ __forceinline__ unsigned f2bf(float f) { unsigned u = __builtin_bit_cast(unsigned, f); return (u + 0x7fffu + ((u >> 16) & 1u)) >> 16; }
__device__ __forceinline__ unsigned pk2(float lo, float hi) { typedef float f2 __attribute__((ext_vector_type(2))); typedef __bf16 b2 __attribute__((ext_vector_type(2))); f2 v = {lo, hi}; b2 b = __builtin_convertvector(v, b2); return __builtin_bit_cast(unsigned, b); }
#define SWZ_XOR(v, m) __builtin_bit_cast(float, __builtin_amdgcn_ds_swizzle(__builtin_bit_cast(int, (v)), ((m) << 10) | 0x1f))
__device__ __forceinline__ float xor32(float v, bool lower) { unsigned a = __builtin_bit_cast(unsigned, v), b = a; asm volatile("" : "+v"(b));
    auto rr = __builtin_amdgcn_permlane32_swap(a, b, false, false); return __builtin_bit_cast(float, lower ? rr[1] : rr[0]); }
__device__ __forceinline__ float wave_sum(float v) {
    v += SWZ_XOR(v, 1); v += SWZ_XOR(v, 2); v += SWZ_XOR(v, 4); v += SWZ_XOR(v, 8); v += SWZ_XOR(v, 16);
    return __builtin_bit_cast(float, __builtin_amdgcn_readlane(__builtin_bit_cast(int, v), 0)) + __builtin_bit_cast(float, __builtin_amdgcn_readlane(__builtin_bit_cast(int, v), 32));
}
__device__ __forceinline__ float fast_silu(float v) { return v * __builtin_amdgcn_rcpf(1.f + __builtin_amdgcn_exp2f(-v * LOG2E)); }

#define XB_TMO      128
#define XB_XCNT(j)  (256  + 64 * (j))
#define XB_XSUB(j)  (1280 + 64 * (j))
#define XB_XGEN(j)  (2304 + 64 * (j))
#define XB_TOP      3328
#define XB_TOPGEN   3392
#define XCD_BAR_WORDS 3456
#define XB_SPIN_CAP (1u << 18)
__device__ __forceinline__ unsigned xb_ld(unsigned* p)              { return __hip_atomic_load(p, __ATOMIC_RELAXED, __HIP_MEMORY_SCOPE_AGENT); }
__device__ __forceinline__ unsigned xb_add(unsigned* p, unsigned v) { return __hip_atomic_fetch_add(p, v, __ATOMIC_RELAXED, __HIP_MEMORY_SCOPE_AGENT); }
__device__ __forceinline__ unsigned xb_xcc_id() { return (unsigned)__builtin_amdgcn_s_getreg((3 << 11) | 20) & 0xFu; }
#define XB_SPIN(cond, bar) do { unsigned _sp = 0; while (cond) { __builtin_amdgcn_s_sleep(1); \
    if ((++_sp & 255u) == 0u) { if (xb_ld(&(bar)[XB_TMO])) break; if (_sp > XB_SPIN_CAP) { atomicAdd(&(bar)[XB_TMO], 1u); break; } } } } while (0)
struct XcdBarrier { unsigned* bar; unsigned x; volatile LAS unsigned* st; };
__device__ __forceinline__ XcdBarrier xcd_barrier_post(unsigned* bar, volatile LAS unsigned* st) {
    XcdBarrier b; b.bar = bar; b.x = xb_xcc_id(); b.st = st;
    if (threadIdx.x == 0) (void)xb_add(&bar[XB_XCNT(b.x)], 1u);
    return b;
}
__device__ __forceinline__ void xcd_barrier_complete(unsigned* bar, unsigned x, unsigned& nloc, unsigned& nx) {
    const unsigned G = gridDim.x * gridDim.y * gridDim.z;
    unsigned sum, cnt, mine, sp = 0u;
    for (;;) {
        sum = 0u; cnt = 0u; mine = 0u;
#pragma unroll
        for (unsigned j = 0; j < 16; ++j) { const unsigned c = xb_ld(&bar[XB_XCNT(j)]); sum += c; cnt += (c > 0u) ? 1u : 0u; mine = (j == x) ? c : mine; }
        if (sum == G) break;
        __builtin_amdgcn_s_sleep(1);
        if ((++sp & 255u) == 0u) { if (xb_ld(&bar[XB_TMO])) break; if (sp > XB_SPIN_CAP) { atomicAdd(&bar[XB_TMO], 1u); break; } }
    }
    nloc = mine > 0u ? mine : 1u; nx = cnt > 0u ? cnt : 1u;
}
__device__ __forceinline__ void xcd_barrier(const XcdBarrier& b) {
    asm volatile("s_waitcnt vmcnt(0)" ::: "memory");
    __syncthreads();
    if (threadIdx.x == 0) {
        unsigned* bar = b.bar;
        __builtin_amdgcn_s_waitcnt(0);
        unsigned nloc = b.st[0], nx = b.st[1];
        if (nloc == 0u) { xcd_barrier_complete(bar, b.x, nloc, nx); b.st[0] = nloc; b.st[1] = nx; }
        const unsigned old = xb_add(&bar[XB_XSUB(b.x)], 1u);
        const unsigned gen = old / nloc;
        if (old + 1u == (gen + 1u) * nloc) {
            __builtin_amdgcn_fence(__ATOMIC_RELEASE, "agent");
            asm volatile("s_waitcnt vmcnt(0)" ::: "memory");
            const unsigned og = xb_add(&bar[XB_TOP], 1u);
            const unsigned tg = og / nx;
            if (og + 1u == (tg + 1u) * nx) xb_add(&bar[XB_TOPGEN], 1u);
            else XB_SPIN(xb_ld(&bar[XB_TOPGEN]) == tg, bar);
            __builtin_amdgcn_fence(__ATOMIC_ACQUIRE, "agent");
            xb_add(&bar[XB_XGEN(b.x)], 1u);
            asm volatile("s_waitcnt vmcnt(0)" ::: "memory");
        } else {
            XB_SPIN(xb_ld(&bar[XB_XGEN(b.x)]) == gen, bar);
            __builtin_amdgcn_fence(__ATOMIC_ACQUIRE, "agent");
            asm volatile("s_waitcnt vmcnt(0)" ::: "memory");
        }
    }
    __syncthreads();
}

namespace pg8 {
constexpr int BM = 256, BK = 64, HALF = 128, HTB = HALF * BK * 2, STAGE_BYTES = 8 * HTB, NXCD = 8, WGM = 4;
__device__ __forceinline__ int lds_byte(int r, int c) { const int st = (r >> 4) * 2 + (c >> 5), rr = r & 15, cc = c & 31, ob = rr * 64 + cc * 2; return st * 1024 + (ob ^ (((ob >> 9) & 1) << 5)); }
__device__ __forceinline__ void stage_rc(int b, int& R, int& C) { const int st = b / 1024, sb = b % 1024, swz = sb ^ (((sb >> 9) & 1) << 5); R = (st >> 1) * 16 + swz / 64; C = (st & 1) * 32 + (swz % 64) / 2; }
__device__ __forceinline__ int perm32(int rho) { const int n = rho >> 4, i = rho & 15; return 8 * (i >> 2) + 4 * n + (i & 3); }
struct Unit { int pm, pn, g, first, cnt, kofs, nt, flags, np, part, qmask; };
__device__ __forceinline__ bool static_next(int nM, int nN, int G, int c, int i, Unit& u) {
    const int nwg = nM * nN; const long L = (long)i * G + c; const bool ok = L < nwg;
    int wgid = ok ? (int)L : nwg - 1; { const int q = nwg / NXCD, r = nwg % NXCD, xcd = wgid % NXCD, off = wgid / NXCD; wgid = (xcd < r ? xcd * (q + 1) : r * (q + 1) + (xcd - r) * q) + off; }
    const int nig = WGM * nN, gid = wgid / nig, fm = gid * WGM, gsz = (nM - fm) < WGM ? (nM - fm) : WGM;
    u.pm = fm + ((wgid % nig) % gsz); u.pn = (wgid % nig) / gsz; return ok;
}
__device__ __forceinline__ bool sk_next(int nM, int nN, int nt2, int G, int c, int i, int pmax, Unit& u) {
    const int nwg = nM * nN, nfull = nwg / G, R = nwg - nfull * G;
    int P = 1; if (R > 0) { if (R * 8 <= G && pmax >= 8) P = 8; else if (R * 4 <= G && pmax >= 4) P = 4; else if (R * 2 <= G && pmax >= 2) P = 2; }
    const bool tail = (i >= nfull);
    const int x = c % NXCD, rho = c / NXCD, jj = rho / P, p = rho % P, j = jj * NXCD + x;
    const long L = tail ? (long)nfull * G + (j < R ? j : 0) : (long)i * G + c;
    int wgid = (int)(L < nwg ? L : nwg - 1); { const int q = nwg / NXCD, r = nwg % NXCD, xcd = wgid % NXCD, off = wgid / NXCD; wgid = (xcd < r ? xcd * (q + 1) : r * (q + 1) + (xcd - r) * q) + off; }
    const int nig = WGM * nN, gid = wgid / nig, fm = gid * WGM, gsz = (nM - fm) < WGM ? (nM - fm) : WGM;
    u.pm = fm + ((wgid % nig) % gsz); u.pn = (wgid % nig) / gsz;
    const int lo = tail ? p * nt2 / P : 0, hi = tail ? (p + 1) * nt2 / P : nt2;
    u.kofs = lo * 2 * BK * 2; u.nt = (hi - lo) * 2; u.flags = (tail && P > 1) ? 1 : 0; u.np = P; u.part = p;
    u.qmask = (tail && P > 1) ? (P == 4 ? (1 << p) : P == 2 ? (5 << p) : 0xF) : 0xF;
    return tail ? (i == nfull && j < R) : true;
}
struct SkCtl { f32x4* slots; unsigned* flag; unsigned* tmo; unsigned epoch; int c, G; };
template <class Epi, class Sched, bool GATHER>
__device__ __forceinline__ void gemm_phase(LAS unsigned char* lds, const int tid_in, const bf16_t* Aptr, const int K, const Sched& S, const Epi& E, const SkCtl sk = SkCtl{}) {
    int tid = tid_in; asm volatile("" : "+v"(tid));
    const int wid = __builtin_amdgcn_readfirstlane(tid >> 6), lane = tid & 63, wr = wid >> 2, wc = wid & 3, fr = lane & 15, fq = lane >> 4;
    int RA[2], CA[2]; unsigned voffA[2], voffB[2];
#pragma unroll
    for (int i = 0; i < 2; ++i) { int R, C; stage_rc(tid * 16 + i * 8192, R, C); const int Rb = Epi::PERM ? ((R & ~31) + perm32(R & 31)) : R; RA[i] = R; CA[i] = C; voffA[i] = (unsigned)(R * K + C) * 2u; voffB[i] = (unsigned)(Rb * K + C) * 2u; }
    const size_t kstep = (size_t)(BK * 2);
    const size_t hstep = (size_t)HALF * K * 2;
    const unsigned ldsw = (unsigned)wid * 1024u;
    const int aoff = lds_byte(wr * 64 + fr, fq * 8), boff = lds_byte(wc * 32 + fr, fq * 8);
    const char* const cAb = (const char*)Aptr;
#define PG8_SA(b, h) (((b) * 2 + (h)) * HTB)
#define PG8_SB(b, h) ((4 + (b) * 2 + (h)) * HTB)
#define PG8_STAGE(bufoff, gbase, voff) do { _Pragma("unroll") for (int _i = 0; _i < 2; ++_i) \
        __builtin_amdgcn_global_load_lds((const unsigned*)((const char*)(gbase) + (voff)[_i]), (LAS unsigned*)(lds + (bufoff) + ldsw + _i * 8192), 16, 0, 0); } while (0)
#define PG8_STAGEA(bufoff, vo, h, kb) do { _Pragma("unroll") for (int _i = 0; _i < 2; ++_i) { \
        if constexpr (GATHER) __builtin_amdgcn_global_load_lds((const unsigned*)(cAb + (size_t)(vo)[h][_i] + (size_t)(kb)), (LAS unsigned*)(lds + (bufoff) + ldsw + _i * 8192), 16, 0, 0); \
        else __builtin_amdgcn_global_load_lds((const unsigned*)(cAb + s##vo + (size_t)(h) * hstep + (size_t)(kb) + voffA[_i]), (LAS unsigned*)(lds + (bufoff) + ldsw + _i * 8192), 16, 0, 0); } } while (0)
#define PG8_LDA(dst, b, h) do { _Pragma("unroll") for (int m = 0; m < 4; ++m) _Pragma("unroll") for (int k = 0; k < 2; ++k) dst[m][k] = *(const LAS bf16x8*)(lds + PG8_SA(b, h) + aoff + m * 2048 + k * 1024); } while (0)
#define PG8_LDB(dst, b, h) do { _Pragma("unroll") for (int n = 0; n < 2; ++n) _Pragma("unroll") for (int k = 0; k < 2; ++k) dst[n][k] = *(const LAS bf16x8*)(lds + PG8_SB(b, h) + boff + n * 2048 + k * 1024); } while (0)
#define PG8_MMA(ai, bj, At, Bt) do { __builtin_amdgcn_s_setprio(1); _Pragma("unroll") for (int m = 0; m < 4; ++m) _Pragma("unroll") for (int n = 0; n < 2; ++n) _Pragma("unroll") for (int k = 0; k < 2; ++k) \
        acc[ai][bj][m][n] = __builtin_amdgcn_mfma_f32_16x16x32_bf16(Bt[n][k], At[m][k], acc[ai][bj][m][n], 0, 0, 0); __builtin_amdgcn_s_setprio(0); } while (0)
#define PG8_WAIT_V(n) asm volatile("s_waitcnt vmcnt(" #n ")" ::: "memory")
#define PG8_WAIT_L(n) asm volatile("s_waitcnt lgkmcnt(" #n ")" ::: "memory")
#define PG8_BAR __builtin_amdgcn_s_barrier()
#define PG8_SCHED __builtin_amdgcn_sched_barrier(0)
#define PG8_AOFFS(vo, u) do { if constexpr (GATHER) { _Pragma("unroll") for (int _h = 0; _h < 2; ++_h) _Pragma("unroll") for (int _i = 0; _i < 2; ++_i) \
        (vo)[_h][_i] = (unsigned)(((size_t)S.a_row(u, _h * HALF + RA[_i]) * (size_t)K + (size_t)CA[_i]) * 2u) + (unsigned)(u).kofs; } else { s##vo = (size_t)S.a_row(u, 0) * (size_t)K * 2u + (size_t)(u).kofs; } } while (0)
    Unit cur, nxt; int ui = 0;
    if (!S.next(0, cur)) return;
    f32x4 acc[2][2][4][2];
#pragma unroll
    for (int a = 0; a < 2; ++a)
#pragma unroll
        for (int b = 0; b < 2; ++b)
#pragma unroll
            for (int m = 0; m < 4; ++m)
#pragma unroll
                for (int n = 0; n < 2; ++n) acc[a][b][m][n] = (f32x4){0.f, 0.f, 0.f, 0.f};
    bf16x8 At[4][2], B0[2][2], B1[2][2];
    unsigned vA[2][2], vN[2][2];
    size_t svA = 0, svN = 0;
    PG8_AOFFS(vA, cur);
    const char* cB = S.b_ptr(cur) + cur.kofs;
    PG8_STAGE(PG8_SB(0, 0), cB, voffB); PG8_STAGE(PG8_SB(0, 1), cB + hstep, voffB); PG8_STAGEA(PG8_SA(0, 0), vA, 0, 0); PG8_STAGEA(PG8_SA(0, 1), vA, 1, 0);
    if (wr == 1) PG8_BAR;
    PG8_WAIT_V(2); PG8_BAR;
    PG8_STAGE(PG8_SB(1, 0), cB + kstep, voffB); PG8_STAGEA(PG8_SA(1, 0), vA, 0, kstep); PG8_STAGE(PG8_SB(1, 1), cB + hstep + kstep, voffB);
    PG8_WAIT_V(6); PG8_BAR;
    for (;;) {
        const bool has_next = S.next(ui + 1, nxt);
        const char* nB = has_next ? S.b_ptr(nxt) + nxt.kofs : cB;
        const int nt = cur.nt;
        if (has_next) { PG8_AOFFS(vN, nxt); } else { svN = svA;
#pragma unroll
            for (int _h = 0; _h < 2; ++_h)
#pragma unroll
                for (int _i = 0; _i < 2; ++_i) vN[_h][_i] = vA[_h][_i]; }
        if constexpr (GATHER) { *(LAS u32x4*)(lds + STAGE_BYTES + tid * 16) = (u32x4){vN[0][0], vN[0][1], vN[1][0], vN[1][1]}; }
        for (int t = 0; t < nt; t += 2) {
            const bool last = (t == nt - 2);
            const size_t k1 = (size_t)(t + 1) * kstep;
            const size_t k2 = last ? 0 : (size_t)(t + 2) * kstep, k3 = k2 + kstep;
            const char* b2 = last ? nB : cB + (size_t)(t + 2) * kstep; const char* b3 = b2 + kstep;
            unsigned v2[2][2]; const size_t sv2 = last ? svN : svA;
            if constexpr (GATHER) {
#pragma unroll
                for (int _h = 0; _h < 2; ++_h)
#pragma unroll
                    for (int _i = 0; _i < 2; ++_i) v2[_h][_i] = vA[_h][_i];
                if (last) { const u32x4 q = *(const LAS u32x4*)(lds + STAGE_BYTES + tid * 16); v2[0][0] = q.x; v2[0][1] = q.y; v2[1][0] = q.z; v2[1][1] = q.w; } }
            PG8_LDB(B0, 0, 0); PG8_LDB(B1, 0, 1); PG8_SCHED; PG8_LDA(At, 0, 0); PG8_STAGEA(PG8_SA(1, 1), vA, 1, k1);
            PG8_WAIT_V(8); PG8_WAIT_L(0); PG8_BAR; PG8_MMA(0, 0, At, B0); PG8_MMA(0, 1, At, B1); PG8_BAR; PG8_SCHED;
            PG8_LDA(At, 0, 1); PG8_STAGE(PG8_SB(0, 0), b2, voffB); PG8_STAGE(PG8_SB(0, 1), b2 + hstep, voffB); PG8_STAGEA(PG8_SA(0, 0), v2, 0, k2);
            PG8_WAIT_V(8); PG8_WAIT_L(0); PG8_BAR; PG8_MMA(1, 0, At, B0); PG8_MMA(1, 1, At, B1); PG8_BAR; PG8_SCHED;
            PG8_LDB(B0, 1, 0); PG8_LDB(B1, 1, 1); PG8_SCHED; PG8_LDA(At, 1, 0); PG8_STAGEA(PG8_SA(0, 1), v2, 1, k2);
            PG8_WAIT_V(8); PG8_WAIT_L(0); PG8_BAR; PG8_MMA(0, 0, At, B0); PG8_MMA(0, 1, At, B1); PG8_BAR; PG8_SCHED;
            PG8_LDA(At, 1, 1); PG8_STAGE(PG8_SB(1, 0), b3, voffB); PG8_STAGE(PG8_SB(1, 1), b3 + hstep, voffB); PG8_STAGEA(PG8_SA(1, 0), v2, 0, k3);
            PG8_WAIT_V(8); PG8_WAIT_L(0); PG8_BAR; PG8_MMA(1, 0, At, B0); PG8_MMA(1, 1, At, B1); PG8_BAR; PG8_SCHED;
        }
        if (wr == 0) PG8_BAR;
        if (cur.flags & 1) {
            const int P = cur.np, p = cur.part, c0 = sk.c - NXCD * p;
            int tl; asm volatile("v_mbcnt_lo_u32_b32 %0, -1, 0\n\tv_mbcnt_hi_u32_b32 %0, -1, %0" : "=v"(tl));
            const int tid = wid * 64 + tl;
            const __amdgpu_buffer_rsrc_t rs = __builtin_amdgcn_make_buffer_rsrc((void*)sk.slots, 0, (int)(sk.G * 32 * 512 * 16), 0x00020000);
            const unsigned so = (unsigned)((sk.c * (32 * 512) + tid) * 16);
#pragma unroll
            for (int a = 0; a < 2; ++a)
#pragma unroll
                for (int b = 0; b < 2; ++b) if (!((cur.qmask >> (a * 2 + b)) & 1)) {
#pragma unroll
                    for (int m = 0; m < 4; ++m)
#pragma unroll
                        for (int n = 0; n < 2; ++n) __builtin_amdgcn_raw_buffer_store_b128(__builtin_bit_cast(u32x4, acc[a][b][m][n]), rs, so + (unsigned)((((a * 2 + b) * 4 + m) * 2 + n) * 512 * 16), 0, 16); }
            PG8_WAIT_V(0); PG8_BAR; asm volatile("" ::: "memory");
            if (tid == 0) __hip_atomic_store(sk.flag + 64 * sk.c, sk.epoch, __ATOMIC_RELAXED, __HIP_MEMORY_SCOPE_AGENT);
            if (tid < 64) {
                for (int q = 0; q < P; ++q) if (q != p) { const int pc = c0 + NXCD * q; unsigned sp = 0;
                    while ((unsigned)__builtin_amdgcn_readfirstlane(__hip_atomic_load(sk.flag + 64 * pc, __ATOMIC_RELAXED, __HIP_MEMORY_SCOPE_AGENT)) != sk.epoch) { __builtin_amdgcn_s_sleep(1);
                        if ((++sp & 255u) == 0u) { if (__hip_atomic_load(sk.tmo, __ATOMIC_RELAXED, __HIP_MEMORY_SCOPE_AGENT)) break; if (sp > (1u << 20)) { if (tid == 0) atomicAdd(sk.tmo, 1u); break; } } } }
                __builtin_amdgcn_fence(__ATOMIC_ACQUIRE, "agent"); PG8_WAIT_V(0); }
            asm volatile("" ::: "memory"); PG8_BAR; asm volatile("" ::: "memory");
#pragma unroll
            for (int a = 0; a < 2; ++a)
#pragma unroll
                for (int b = 0; b < 2; ++b) if ((cur.qmask >> (a * 2 + b)) & 1) {
                    for (int q = 0; q < P; ++q) if (q != p) {
                        const GAS f32x4* sl = (const GAS f32x4*)sk.slots + (size_t)(c0 + NXCD * q) * (32 * 512) + (size_t)((a * 2 + b) * 8) * 512 + tid;
#pragma unroll
                        for (int h4 = 0; h4 < 2; ++h4) { f32x4 pv[4];
#pragma unroll
                            for (int v4 = 0; v4 < 4; ++v4) pv[v4] = sl[(h4 * 4 + v4) * 512];
#pragma unroll
                            for (int v4 = 0; v4 < 4; ++v4) acc[a][b][h4 * 2 + (v4 >> 1)][v4 & 1] += pv[v4]; } } }
        }
        { int fr_ = fr, fq_ = fq; asm volatile("" : "+v"(fr_), "+v"(fq_));
          E(acc, cur, wr, wc, fr_, fq_); }
        if (!has_next) break;
#pragma unroll
        for (int a = 0; a < 2; ++a)
#pragma unroll
            for (int b = 0; b < 2; ++b)
#pragma unroll
                for (int m = 0; m < 4; ++m)
#pragma unroll
                    for (int n = 0; n < 2; ++n) acc[a][b][m][n] = (f32x4){0.f, 0.f, 0.f, 0.f};
        cur = nxt; cB = nB; ++ui; svA = svN;
        if constexpr (GATHER) { const u32x4 q = *(const LAS u32x4*)(lds + STAGE_BYTES + tid * 16); vA[0][0] = q.x; vA[0][1] = q.y; vA[1][0] = q.z; vA[1][1] = q.w; }
        if (wr == 1) PG8_BAR;
    }
    PG8_WAIT_V(0);
    PG8_BAR;
#undef PG8_SA
#undef PG8_SB
#undef PG8_STAGE
#undef PG8_STAGEA
#undef PG8_LDA
#undef PG8_LDB
#undef PG8_MMA
#undef PG8_WAIT_V
#undef PG8_WAIT_L
#undef PG8_BAR
#undef PG8_SCHED
#undef PG8_AOFFS
}
}


template <bool SK>
struct SchedDense {
    const bf16_t* Bt; int nM, nN, G, c, K;
    __device__ __forceinline__ bool next(int i, pg8::Unit& u) const { u.g = 0; u.first = 0; u.cnt = 0;
        if constexpr (SK) return pg8::sk_next(nM, nN, K / 128, G, c, i, 4, u);
        else { u.kofs = 0; u.nt = K / 64; u.flags = 0; u.np = 1; u.part = 0; u.qmask = 0xF; return pg8::static_next(nM, nN, G, c, i, u); } }
    __device__ __forceinline__ const char* b_ptr(const pg8::Unit& u) const { return (const char*)Bt + (size_t)u.pn * 256 * K * 2; }
    __device__ __forceinline__ int a_row(const pg8::Unit& u, int r) const { return u.pm * 256 + r; }
};
struct MoeTab { volatile LAS unsigned* T;
    __device__ __forceinline__ int group_of(int blk) const { int g = 0;
#pragma unroll
        for (int j = 1; j < 16; ++j) g += (blk >= (int)T[16 + j]) ? 1 : 0; return g; }
};
template <bool GATHER, bool SK>
struct SchedMoe {
    const bf16_t* Wbase; size_t wx_stride; int nN, G, c, K, blk0, nblk; MoeTab tab; const int* ltok;
    __device__ __forceinline__ bool next(int i, pg8::Unit& u) const { bool ok;
        if constexpr (SK) ok = pg8::sk_next(nblk, nN, K / 128, G, c, i, 4, u); else { u.kofs = 0; u.nt = K / 64; u.flags = 0; u.np = 1; u.part = 0; u.qmask = 0xF; ok = pg8::static_next(nblk, nN, G, c, i, u); }
        u.pm += blk0;
        const int g = __builtin_amdgcn_readfirstlane(tab.group_of(u.pm)); u.g = g; u.first = __builtin_amdgcn_readfirstlane((int)tab.T[16 + g]); u.cnt = __builtin_amdgcn_readfirstlane((int)tab.T[32 + g]); return ok; }
    __device__ __forceinline__ const char* b_ptr(const pg8::Unit& u) const { return (const char*)Wbase + (size_t)(u.g & 7) * wx_stride + (size_t)u.pn * 256 * K * 2; }
    __device__ __forceinline__ int a_row(const pg8::Unit& u, int r) const {
        if (!GATHER) return u.pm * 256 + r;
        const int local = (u.pm - u.first) * 256 + r;
        return ltok[(size_t)u.g * TT + (local < u.cnt ? local : u.cnt - 1)]; }
};

struct EpiResid {
    static constexpr bool PERM = false;
    const float* xin_l; const float* xin_c; float* xout_l; float* xout_c; const float* mod; int which; float rs;
    __device__ __forceinline__ void operator()(const f32x4 (&acc)[2][2][4][2], const pg8::Unit& u, int wr, int wc, int fr, int fq) const {
        const bool lat = u.pm < TL / 256; const int b5 = lat ? u.pm / 32 : 4;
        const size_t rbase = (size_t)(lat ? u.pm : u.pm - TL / 256) * 256 + wr * 64 + fr;
        const float* xi = (lat ? xin_l : xin_c); float* xo = (lat ? xout_l : xout_c);
        const int col0 = u.pn * 256 + wc * 32 + 4 * fq;
        const float* gp = mod + (size_t)b5 * NMOD * DM + which * DM + col0;
        f32x4 gv[2][2];
#pragma unroll
        for (int bj = 0; bj < 2; ++bj)
#pragma unroll
            for (int n = 0; n < 2; ++n) gv[bj][n] = *(const f32x4*)(gp + bj * 128 + n * 16) * rs;
#pragma unroll
        for (int ai = 0; ai < 2; ++ai) { const size_t off0 = (rbase + ai * 128) * DM + col0;
            if (u.qmask == 0xF) { f32x4 xv[4][2][2];
#pragma unroll
                for (int m = 0; m < 4; ++m)
#pragma unroll
                    for (int bj = 0; bj < 2; ++bj)
#pragma unroll
                        for (int n = 0; n < 2; ++n) xv[m][bj][n] = *(const f32x4*)(xi + off0 + (size_t)m * 16 * DM + bj * 128 + n * 16);
#pragma unroll
                for (int m = 0; m < 4; ++m)
#pragma unroll
                    for (int bj = 0; bj < 2; ++bj)
#pragma unroll
                        for (int n = 0; n < 2; ++n) *(f32x4*)(xo + off0 + (size_t)m * 16 * DM + bj * 128 + n * 16) = xv[m][bj][n] + gv[bj][n] * acc[ai][bj][m][n];
            } else {
#pragma unroll
                for (int bj = 0; bj < 2; ++bj) if ((u.qmask >> (ai * 2 + bj)) & 1) { f32x4 xv[4][2];
#pragma unroll
                    for (int m = 0; m < 4; ++m)
#pragma unroll
                        for (int n = 0; n < 2; ++n) xv[m][n] = *(const f32x4*)(xi + off0 + (size_t)m * 16 * DM + bj * 128 + n * 16);
#pragma unroll
                    for (int m = 0; m < 4; ++m)
#pragma unroll
                        for (int n = 0; n < 2; ++n) *(f32x4*)(xo + off0 + (size_t)m * 16 * DM + bj * 128 + n * 16) = xv[m][n] + gv[bj][n] * acc[ai][bj][m][n]; } }
            asm volatile("" ::: "memory"); }
    }
};
struct EpiSwiglu {
    static constexpr bool PERM = true;
    bf16_t* act;
    __device__ __forceinline__ void operator()(const f32x4 (&acc)[2][2][4][2], const pg8::Unit& u, int wr, int wc, int fr, int fq) const {
        const size_t row0 = (size_t)u.pm * 256 + wr * 64 + fr; const int col0 = u.pn * 128 + wc * 32 + 8 * fq;
#pragma unroll
        for (int ai = 0; ai < 2; ++ai)
#pragma unroll
            for (int m = 0; m < 4; ++m) {
                const f32x4 g0 = acc[ai][0][m][0], g1 = acc[ai][0][m][1], u0 = acc[ai][1][m][0], u1 = acc[ai][1][m][1];
                u32x4 w;
                w.x = pk2(fast_silu(g0[0]) * u0[0], fast_silu(g0[1]) * u0[1]); w.y = pk2(fast_silu(g0[2]) * u0[2], fast_silu(g0[3]) * u0[3]);
                w.z = pk2(fast_silu(g1[0]) * u1[0], fast_silu(g1[1]) * u1[1]); w.w = pk2(fast_silu(g1[2]) * u1[2], fast_silu(g1[3]) * u1[3]);
                *(u32x4*)(act + (row0 + ai * 128 + m * 16) * DFF + col0) = w; }
    }
};
struct EpiQKV {
    static constexpr bool PERM = true;
    bf16_t *QB, *KB, *VB; const float2* rope;
    __device__ __forceinline__ void operator()(const f32x4 (&acc)[2][2][4][2], const pg8::Unit& u, int wr, int wc, int fr, int fq) const {
        const bool lat = u.pm < TL / 256; const int row0 = u.pm * 256 + wr * 64 + fr;
        const bool dorope = lat && u.pn < 5; const float qs = u.pn < 4 ? 0.125f * LOG2E : 1.f;
        const size_t doff = u.pn < 4 ? (size_t)0 : (u.pn == 4 ? (size_t)((BIG_K - BIG_Q) / 2) : (size_t)((BIG_V - BIG_Q) / 2));
        bf16_t* dst = QB + doff; const int ld = u.pn < 4 ? DM : 256, colt = u.pn < 4 ? u.pn * 256 : 0;
        const int a = wc & 1, f0 = 8 * (fq & 1); const float sg = (fq < 2) ? -1.f : 1.f;
#pragma unroll
        for (int ai = 0; ai < 2; ++ai) { f32x4 cs[4][4];
            if (dorope) {
#pragma unroll
                for (int m = 0; m < 4; ++m) { const int r = row0 + ai * 128 + m * 16; const int t = r & (SEQ - 1); const int pos = a ? (t & 63) : (t >> 6);
                    const f32x4* csp = (const f32x4*)(rope + pos * 16 + f0);
#pragma unroll
                    for (int q4 = 0; q4 < 4; ++q4) cs[m][q4] = csp[q4]; } }
#pragma unroll
            for (int m = 0; m < 4; ++m) { const int r = row0 + ai * 128 + m * 16;
#pragma unroll
                for (int bj = 0; bj < 2; ++bj) if ((u.qmask >> (ai * 2 + bj)) & 1) { f32x4 v[2];
#pragma unroll
                    for (int n = 0; n < 2; ++n) { v[n] = acc[ai][bj][m][n];
                        if (dorope) { const f32x4 c01 = cs[m][2 * n], c23 = cs[m][2 * n + 1];
#pragma unroll
                            for (int j = 0; j < 4; ++j) { const float pr = xor32(v[n][j], fq < 2); const float c = (j < 2 ? c01 : c23)[2 * (j & 1)], sn = (j < 2 ? c01 : c23)[2 * (j & 1) + 1]; v[n][j] = v[n][j] * c + sg * pr * sn; } }
                        v[n] = v[n] * qs; }
                    u32x4 w; w.x = pk2(v[0][0], v[0][1]); w.y = pk2(v[0][2], v[0][3]); w.z = pk2(v[1][0], v[1][1]); w.w = pk2(v[1][2], v[1][3]);
                    *(u32x4*)(dst + (size_t)r * ld + colt + bj * 128 + wc * 32 + 8 * fq) = w; } }
            asm volatile("" ::: "memory"); }
    }
};
struct EpiMoeDown {
    static constexpr bool PERM = false;
    float* xl; float* xc; const float* mod; const int* ltok; const float* lw; float rs;
    __device__ __forceinline__ void operator()(const f32x4 (&acc)[2][2][4][2], const pg8::Unit& u, int wr, int wc, int fr, int fq) const {
        const int g = u.g; const int lbase = (u.pm - u.first) * 256 + wr * 64 + fr; const int cnt = u.cnt;
        const int col0 = u.pn * 256 + wc * 32 + 4 * fq;
        int tokv[2][4]; float wv[2][4];
#pragma unroll
        for (int ai = 0; ai < 2; ++ai)
#pragma unroll
            for (int m = 0; m < 4; ++m) { const int local = lbase + ai * 128 + m * 16, li = local < cnt ? local : cnt - 1; tokv[ai][m] = ltok[(size_t)g * TT + li]; wv[ai][m] = lw[(size_t)g * TT + li] * rs; }
        const int b50 = tokv[0][0] < TL ? tokv[0][0] / SEQ : 4;
        f32x4 gv[2][2];
#pragma unroll
        for (int bj = 0; bj < 2; ++bj)
#pragma unroll
            for (int n = 0; n < 2; ++n) gv[bj][n] = *(const f32x4*)(mod + (size_t)b50 * NMOD * DM + 5 * DM + col0 + bj * 128 + n * 16);
#pragma unroll
        for (int am = 0; am < 4; ++am) { const int ai = am >> 1; f32x4 xv[2][2][2];
#pragma unroll
            for (int mm = 0; mm < 2; ++mm) { const int m = (am & 1) * 2 + mm; const int local = lbase + ai * 128 + m * 16;
                if (local < cnt) { const int tok = tokv[ai][m]; const float* xr = (tok < TL ? xl + (size_t)tok * DM : xc + (size_t)(tok - TL) * DM) + col0;
#pragma unroll
                    for (int bj = 0; bj < 2; ++bj) if ((u.qmask >> (ai * 2 + bj)) & 1) {
#pragma unroll
                        for (int n = 0; n < 2; ++n) xv[mm][bj][n] = *(const f32x4*)(xr + bj * 128 + n * 16); } } }
#pragma unroll
            for (int mm = 0; mm < 2; ++mm) { const int m = (am & 1) * 2 + mm; const int local = lbase + ai * 128 + m * 16;
                if (local < cnt) { const int tok = tokv[ai][m]; const float w = wv[ai][m];
                    const bool lat = tok < TL; const int b5 = lat ? tok / SEQ : 4; float* xr = (lat ? xl + (size_t)tok * DM : xc + (size_t)(tok - TL) * DM) + col0;
                    if (b5 == b50) {
#pragma unroll
                        for (int bj = 0; bj < 2; ++bj) if ((u.qmask >> (ai * 2 + bj)) & 1) {
#pragma unroll
                            for (int n = 0; n < 2; ++n) *(f32x4*)(xr + bj * 128 + n * 16) = xv[mm][bj][n] + gv[bj][n] * (w * acc[ai][bj][m][n]); }
                    } else { const float* gp = mod + (size_t)b5 * NMOD * DM + 5 * DM + col0;
#pragma unroll
                        for (int bj = 0; bj < 2; ++bj) if ((u.qmask >> (ai * 2 + bj)) & 1) {
#pragma unroll
                            for (int n = 0; n < 2; ++n) { const f32x4 gr = *(const f32x4*)(gp + bj * 128 + n * 16); *(f32x4*)(xr + bj * 128 + n * 16) = xv[mm][bj][n] + gr * (w * acc[ai][bj][m][n]); } } } } }
            asm volatile("" ::: "memory"); }
    }
};
struct EpiMoeY {
    static constexpr bool PERM = true;
    bf16_t* ys; const float* mod; const int* ltok; const float* lw;
    __device__ __forceinline__ void operator()(const f32x4 (&acc)[2][2][4][2], const pg8::Unit& u, int wr, int wc, int fr, int fq) const {
        const int g = u.g; const int lbase = (u.pm - u.first) * 256 + wr * 64 + fr; const int cnt = u.cnt;
        const int col0 = u.pn * 256 + wc * 32 + 8 * fq;
        int tokv[2][4]; float wv[2][4];
#pragma unroll
        for (int ai = 0; ai < 2; ++ai)
#pragma unroll
            for (int m = 0; m < 4; ++m) { const int local = lbase + ai * 128 + m * 16, li = local < cnt ? local : cnt - 1; tokv[ai][m] = ltok[(size_t)g * TT + li]; wv[ai][m] = lw[(size_t)g * TT + li]; }
        const int b50 = tokv[0][0] < TL ? tokv[0][0] / SEQ : 4;
        f32x4 gv[2][2];
#pragma unroll
        for (int bj = 0; bj < 2; ++bj)
#pragma unroll
            for (int n = 0; n < 2; ++n) gv[bj][n] = *(const f32x4*)(mod + (size_t)b50 * NMOD * DM + 5 * DM + col0 + bj * 128 + n * 4);
#pragma unroll
        for (int ai = 0; ai < 2; ++ai)
#pragma unroll
            for (int m = 0; m < 4; ++m) { const int local = lbase + ai * 128 + m * 16;
                if (local < cnt) { const int tok = tokv[ai][m]; const float w = wv[ai][m]; const int b5 = tok < TL ? tok / SEQ : 4;
                    bf16_t* yr = ys + ((size_t)u.pm * 256 + wr * 64 + fr + ai * 128 + m * 16) * DM + col0;
                    if (b5 == b50) {
#pragma unroll
                        for (int bj = 0; bj < 2; ++bj) if ((u.qmask >> (ai * 2 + bj)) & 1) {
                            const f32x4 v0 = gv[bj][0] * (w * acc[ai][bj][m][0]), v1 = gv[bj][1] * (w * acc[ai][bj][m][1]);
                            u32x4 o; o.x = pk2(v0[0], v0[1]); o.y = pk2(v0[2], v0[3]); o.z = pk2(v1[0], v1[1]); o.w = pk2(v1[2], v1[3]);
                            *(u32x4*)(yr + bj * 128) = o; }
                    } else { const float* gp = mod + (size_t)b5 * NMOD * DM + 5 * DM + col0;
#pragma unroll
                        for (int bj = 0; bj < 2; ++bj) if ((u.qmask >> (ai * 2 + bj)) & 1) { const f32x4 g0 = *(const f32x4*)(gp + bj * 128), g1 = *(const f32x4*)(gp + bj * 128 + 4);
                            const f32x4 v0 = g0 * (w * acc[ai][bj][m][0]), v1 = g1 * (w * acc[ai][bj][m][1]);
                            u32x4 o; o.x = pk2(v0[0], v0[1]); o.y = pk2(v0[2], v0[3]); o.z = pk2(v1[0], v1[1]); o.w = pk2(v1[2], v1[3]);
                            *(u32x4*)(yr + bj * 128) = o; } } } }
    }
};
struct Frame { LAS unsigned char* lds; volatile LAS unsigned* MISC; int tid, lane, wave, vcu, G; };

__device__ __forceinline__ void p0_transpose_item(const float* W, int K, int N, bf16_t* WT, int k0, int n0, int drow0, LAS float* scr, int lane) {
    f32x4 v[16];
#pragma unroll
    for (int i = 0; i < 16; ++i) v[i] = __builtin_nontemporal_load((const f32x4*)(W + (size_t)(k0 + 4 * i + (lane >> 4)) * N + n0 + 4 * (lane & 15)));
#pragma unroll
    for (int i = 0; i < 16; ++i) { LAS float* d = scr + (4 * i + (lane >> 4)) * 65 + 4 * (lane & 15); d[0] = v[i][0]; d[1] = v[i][1]; d[2] = v[i][2]; d[3] = v[i][3]; }
    asm volatile("s_waitcnt lgkmcnt(0)" ::: "memory");
    const int c = lane & 7;
#pragma unroll
    for (int j = 0; j < 8; ++j) { const int n = (lane >> 3) + 8 * j; const LAS float* sp = scr + (8 * c) * 65 + n;
        u32x4 o; o.x = pk2(sp[0 * 65], sp[1 * 65]); o.y = pk2(sp[2 * 65], sp[3 * 65]); o.z = pk2(sp[4 * 65], sp[5 * 65]); o.w = pk2(sp[6 * 65], sp[7 * 65]);
        *(u32x4*)(WT + (size_t)(drow0 + n) * K + k0 + 8 * c) = o; }
    asm volatile("s_waitcnt lgkmcnt(0)" ::: "memory");
}
__device__ __forceinline__ void p0_ffn_matrix(const Prm& p, int m, int r, LAS float* scr, int lane) {
    unsigned char* ws = p.ws; const float* src; bf16_t* dst; int t;
    if (m < 6) { const int j = m / 3; t = m % 3; src = (t == 0 ? p.fg : t == 1 ? p.fu : p.fd) + (size_t)j * DM * DFF; dst = (bf16_t*)(ws + WS_W + j * WE_STRIDE + (t == 2 ? WE_D : WE_GU)); }
    else { const int q = m - 6, j = q / 24, e = (q % 24) / 3; t = q % 3; src = (t == 0 ? p.mg : t == 1 ? p.mu : p.md) + ((size_t)j * NEXP + e) * DM * DFF; dst = (bf16_t*)(ws + WS_W + WO_BASE + j * WO_STRIDE + WO_EXP + e * WX_STRIDE + (t == 2 ? WX_D : WX_GU)); }
    if (t == 2) { const int nblk = DM / 64, q8 = r >> 3, w8 = r & 7, ngx = nblk / 2, kb = 4 * (q8 / ngx) + (w8 >> 1), nb = 2 * (q8 % ngx) + (w8 & 1); p0_transpose_item(src, DFF, DM, dst, 64 * kb, 64 * nb, 64 * nb, scr, lane); }
    else { const int nblk = DFF / 64, q8 = r >> 3, w8 = r & 7, ngx = nblk / 2, kb = 4 * (q8 / ngx) + (w8 >> 1), nb = 2 * (q8 % ngx) + (w8 & 1), n0 = 64 * nb; p0_transpose_item(src, DM, DFF, dst, 64 * kb, n0, (n0 / 128) * 256 + (n0 % 128) + (t == 1 ? 128 : 0), scr, lane); }
}
__device__ __forceinline__ void p0_fold(const Prm& p, Frame& F);
__device__ __forceinline__ void p0_prologue(const Prm& p, Frame& F) {
    unsigned char* ws = p.ws;
    { const int gt = F.vcu * 512 + F.tid, NT = F.G * 512;
      bf16_t* F1 = (bf16_t*)(ws + WS_TAB + TAB_F1); bf16_t* F2 = (bf16_t*)(ws + WS_TAB + TAB_F2); float2* TW = (float2*)(ws + WS_TAB + TAB_TW); float2* TWC = (float2*)(ws + WS_TAB + TAB_TWC);
      for (int i = gt; i < 256 * 128; i += NT) { const int row = i / 128, n1 = i % 128, k1 = row >> 1, c = row & 1; float sn, cs; sincospif(2.f * (float)((n1 * k1) & 127) / 128.f, &sn, &cs);
          F1[i] = (bf16_t)f2bf((c ? -sn : cs) * 0.08838834764831845f); }
      for (int i = gt; i < 128 * 128; i += NT) { const int row = i / 128, col = i % 128, k2 = row >> 1, cp = row & 1, n2 = col >> 1, c = col & 1; float sn, cs; sincospif(2.f * (float)((n2 * k2) & 63) / 64.f, &sn, &cs);
          const float v = cp == 0 ? (c == 0 ? cs : sn) : (c == 0 ? -sn : cs); F2[i] = (bf16_t)f2bf(v * 0.125f); }
      for (int i = gt; i < 64 * 128; i += NT) { const int n2 = i / 128, k1 = i % 128; float sn, cs; sincospif(2.f * (float)(n2 * k1) / 8192.f, &sn, &cs); TW[i] = make_float2(cs, -sn); }
      for (int i = gt; i < 2 * 128; i += NT) { const int n2 = i / 128, k1 = i % 128; float sn, cs; sincospif(2.f * (float)(n2 * k1) / 256.f, &sn, &cs); TWC[i] = make_float2(cs, -sn); }
      for (int i = gt; i < 128 * 16; i += NT) { const int pos = i / 16, f = i % 16; const float inv = powf(10000.f, -(float)f / 16.f); const float ang = (float)pos * inv;
          ((float2*)(ws + WS_ROPE))[i] = make_float2((float)cos((double)ang), (float)sin((double)ang)); }
    }
    { LAS float* sc = (LAS float*)(F.lds);
      LAS float* part = (LAS float*)(F.lds + 32768);
      for (int i = F.tid; i < 5 * DM; i += 512) { const int r = i / DM, k = i % DM; const float v = r < 4 ? p.c[r * DM + k] : p.c_ctx[k]; sc[i] = v / (1.f + expf(-v)); }
      __syncthreads();
      for (int it = F.vcu; it < DEPTH * 96; it += F.G) { const int l = it / 96, n = (it % 96) * 64 + F.lane;
          const float* w = p.ada_w + (size_t)l * DM * NMOD * DM + n; float a[5] = {0.f, 0.f, 0.f, 0.f, 0.f};
          for (int kb = 0; kb < 128; kb += 32) { float wv[32];
#pragma unroll
              for (int kk = 0; kk < 32; ++kk) wv[kk] = w[(size_t)(F.wave * 128 + kb + kk) * NMOD * DM];
#pragma unroll
              for (int kk = 0; kk < 32; ++kk) { const int k = F.wave * 128 + kb + kk;
#pragma unroll
                  for (int r = 0; r < 5; ++r) a[r] += sc[r * DM + k] * wv[kk]; } }
#pragma unroll
          for (int r = 0; r < 5; ++r) part[(F.wave * 5 + r) * 64 + F.lane] = a[r];
          __syncthreads();
          if (F.tid < 320) { const int r = F.tid / 64, ln = F.tid % 64; float sum = 0.f;
#pragma unroll
              for (int wv = 0; wv < 8; ++wv) sum += part[(wv * 5 + r) * 64 + ln];
              ((float*)(ws + WS_MOD))[((size_t)l * 5 + r) * NMOD * DM + (it % 96) * 64 + ln] = sum + p.ada_b[l * NMOD * DM + (it % 96) * 64 + ln]; }
          __syncthreads(); }
    }
    p0_fold(p, F);
    { LAS float* scr = (LAS float*)(F.lds + F.wave * 16640);
      const int gw = F.vcu * 8 + F.wave, NGW = F.G * 8;
      constexpr int I_FFN = 54 * 896, I_QKV = 2 * 384, I_O = 2 * 256;
      for (int it = gw; it < I_FFN + I_QKV + I_O; it += NGW) {
          if (it < I_FFN) { p0_ffn_matrix(p, it / 896, it % 896, scr, F.lane); continue; }
          int r = it - I_FFN;
          if (r < I_QKV) { const int j = r / 384, q = r % 384, nblk = QKVD / 64, kb = q / nblk, nb = q % nblk;
              p0_transpose_item(p.wqkv + (size_t)j * DM * QKVD, DM, QKVD, (bf16_t*)(ws + WS_W + WO_BASE + j * WO_STRIDE + WO_QKV), 64 * kb, 64 * nb, 64 * nb, scr, F.lane); continue; }
          r -= I_QKV;
          { const int j = r / 256, q = r % 256, nblk = DM / 64, kb = q / nblk, nb = q % nblk;
              p0_transpose_item(p.wo + (size_t)j * DM * DM, DM, DM, (bf16_t*)(ws + WS_W + WO_BASE + j * WO_STRIDE + WO_O), 64 * kb, 64 * nb, 64 * nb, scr, F.lane); }
      }
    }
}

template <bool ROUTER>
__device__ __forceinline__ void norm_phase(const Prm& p, Frame& F, const float* xl, const float* xc, const float* g, const float* mod  , int which, bf16_t* HB, int nrows,
                                            const float* wr, unsigned* mcnt, int* ltok, float* lw) {
    const int lane = F.lane;
    f32x4 gv[4];
#pragma unroll
    for (int j = 0; j < 4; ++j) gv[j] = *(const f32x4*)(g + 4 * (lane + 64 * j));
    float wreg[ROUTER ? 128 : 1];
    if (ROUTER) {
#pragma unroll
        for (int j = 0; j < 4; ++j)
#pragma unroll
            for (int i = 0; i < 4; ++i) { const int c = 4 * (lane + 64 * j) + i; const f32x4 w0 = *(const f32x4*)(wr + c * 8), w1 = *(const f32x4*)(wr + c * 8 + 4);
#pragma unroll
                for (int e = 0; e < 4; ++e) { wreg[(j * 4 + i) * 8 + e] = w0[e]; wreg[(j * 4 + i) * 8 + 4 + e] = w1[e]; } }
    }
    const int rpb = (nrows + F.G - 1) / F.G;
    const int r0 = ROUTER ? F.vcu * rpb : F.vcu * 8 + F.wave, r1 = ROUTER ? (r0 + rpb < nrows ? r0 + rpb : nrows) : nrows, rstep = ROUTER ? 8 : F.G * 8;
    LAS unsigned* ech = (LAS unsigned*)F.lds; LAS float* gch = (LAS float*)(F.lds + 4096);
    if (ROUTER) __syncthreads();
    for (int rr = ROUTER ? r0 + F.wave : r0; rr < r1; rr += 2 * rstep) {
        f32x4 v[2][4]; float ss[2];
#pragma unroll
        for (int q = 0; q < 2; ++q) { const int r = rr + q * rstep; ss[q] = 0.f;
            if (r < r1) { const float* xr = (r < TL) ? xl + (size_t)r * DM : xc + (size_t)(r - TL) * DM;
#pragma unroll
                for (int j = 0; j < 4; ++j) v[q][j] = *(const f32x4*)(xr + 4 * (lane + 64 * j)); } }
#pragma unroll
        for (int q = 0; q < 2; ++q) { const int r = rr + q * rstep;
            if (r < r1) {
#pragma unroll
                for (int j = 0; j < 4; ++j) ss[q] += (v[q][j][0] * v[q][j][0] + v[q][j][1] * v[q][j][1]) + (v[q][j][2] * v[q][j][2] + v[q][j][3] * v[q][j][3]); } }
#pragma unroll
        for (int q = 0; q < 2; ++q) { const int r = rr + q * rstep;
          if (r < r1) {
            const int b5 = (r < TL) ? r / SEQ : 4; const float* mp = mod + (size_t)b5 * NMOD * DM + which * DM;
            const float rstd = rsqrtf(wave_sum(ss[q]) * (1.f / DM) + EPS);
            float lg[8] = {};
#pragma unroll
            for (int j = 0; j < 4; ++j) { const f32x4 sh = *(const f32x4*)(mp + 4 * (lane + 64 * j)), sc = *(const f32x4*)(mp + DM + 4 * (lane + 64 * j));
                f32x4 h = v[q][j] * rstd * gv[j] * (sc + 1.f) + sh;
                u32x2 o; o.x = pk2(h[0], h[1]); o.y = pk2(h[2], h[3]); *(u32x2*)(HB + (size_t)r * DM + 4 * (lane + 64 * j)) = o;
                if (ROUTER) {
#pragma unroll
                    for (int i = 0; i < 4; ++i)
#pragma unroll
                        for (int e = 0; e < 8; ++e) lg[e] += h[i] * wreg[(j * 4 + i) * 8 + e]; } }
            if (ROUTER) {
                float a4[4], b2[2], c1;
#pragma unroll
                for (int t = 0; t < 4; ++t) { const float snd = (lane & 1) ? lg[t] : lg[t + 4], kp = (lane & 1) ? lg[t + 4] : lg[t]; a4[t] = kp + SWZ_XOR(snd, 1); }
#pragma unroll
                for (int t = 0; t < 2; ++t) { const float snd = (lane & 2) ? a4[t] : a4[t + 2], kp = (lane & 2) ? a4[t + 2] : a4[t]; b2[t] = kp + SWZ_XOR(snd, 2); }
                { const float snd = (lane & 4) ? b2[0] : b2[1], kp = (lane & 4) ? b2[1] : b2[0]; c1 = kp + SWZ_XOR(snd, 4); }
                c1 += SWZ_XOR(c1, 8); c1 += SWZ_XOR(c1, 16);
                const int cb = __builtin_bit_cast(int, c1);
#pragma unroll
                for (int e = 0; e < 8; ++e) { const int l = ((e >> 2) & 1) | (((e >> 1) & 1) << 1) | ((e & 1) << 2);
                    lg[e] = __builtin_bit_cast(float, __builtin_amdgcn_readlane(cb, l)) + __builtin_bit_cast(float, __builtin_amdgcn_readlane(cb, l + 32)); }
                int e0 = 0; float v0 = lg[0];
#pragma unroll
                for (int e = 1; e < 8; ++e) if (lg[e] > v0) { v0 = lg[e]; e0 = e; }
                int e1 = -1; float v1 = -INFINITY;
#pragma unroll
                for (int e = 0; e < 8; ++e) if (e != e0 && lg[e] > v1) { v1 = lg[e]; e1 = e; }
                const float g1 = 1.f / (1.f + expf(v0 - v1)), g0 = 1.f - g1;
                if (lane == 0) { ech[r - r0] = (unsigned)e0 | ((unsigned)e1 << 8); gch[2 * (r - r0)] = g0; gch[2 * (r - r0) + 1] = g1; }
            }
          } }
    }
    if (ROUTER) {
        __syncthreads();
        if (F.tid < 16) { const int grp = F.tid, k = grp >> 3, e = grp & 7, n = r1 - r0; int cnt = 0;
            for (int i = 0; i < n; ++i) cnt += (int)(((ech[i] >> (8 * k)) & 0xffu) == (unsigned)e);
            mcnt[(size_t)F.vcu * 16 + grp] = (unsigned)cnt; }
    }
}
__device__ __forceinline__ void moe_lists(Frame& F, const unsigned* cntw, unsigned* mcnt, int* ltok, float* lw, int nrows, int* tokslot) {
    const int rpb = (nrows + F.G - 1) / F.G; const int r0 = F.vcu * rpb, r1 = (r0 + rpb < nrows ? r0 + rpb : nrows);
    LAS unsigned* ech = (LAS unsigned*)F.lds; LAS float* gch = (LAS float*)(F.lds + 4096);
    unsigned pos = 0u, tot = 0u; const int grp = F.tid & 15, k = grp >> 3, e = grp & 7, n = r1 - r0;
    { LAS unsigned* red = (LAS unsigned*)(F.lds + 8192); const int sub = F.tid >> 4; unsigned tp = 0u, pp = 0u;
      for (int w0 = 0; w0 < F.G; w0 += 256) { unsigned c[8];
#pragma unroll
          for (int q = 0; q < 8; ++q) { const int w = w0 + sub + 32 * q; c[q] = w < F.G ? cntw[(size_t)w * 16 + grp] : 0u; }
#pragma unroll
          for (int q = 0; q < 8; ++q) { const int w = w0 + sub + 32 * q; tp += c[q]; pp += (w < F.vcu) ? c[q] : 0u; } }
      red[F.tid] = tp; red[512 + F.tid] = pp; }
    __syncthreads();
    if (F.tid < 16) { LAS unsigned* red = (LAS unsigned*)(F.lds + 8192);
        for (int q = 0; q < 32; ++q) { tot += red[q * 16 + grp]; pos += red[512 + q * 16 + grp]; }
        if (F.vcu == 0) mcnt[grp] = tot;
        F.MISC[64 + grp] = (tot + 255u) / 256u; }
    __syncthreads();
    if (F.tid < 16) { unsigned first = 0u;
        for (int g2 = 0; g2 < grp; ++g2) first += F.MISC[64 + g2];
        for (int i = 0; i < n; ++i) if (((ech[i] >> (8 * k)) & 0xffu) == (unsigned)e) { ltok[(size_t)grp * TT + pos] = r0 + i; lw[(size_t)grp * TT + pos] = gch[2 * i + k];
            if (tokslot) tokslot[(size_t)(r0 + i) * 2 + k] = (int)(first * 256u + pos); ++pos; } }
}
__device__ __forceinline__ void final_norm_phase(const Prm& p, Frame& F, const bf16_t* ys, const int* tokslot) {
    const int gw = F.vcu * 8 + F.wave, NGW = F.G * 8, lane = F.lane;
    f32x4 gv[4];
#pragma unroll
    for (int j = 0; j < 4; ++j) gv[j] = *(const f32x4*)(p.fng + 4 * (lane + 64 * j));
    for (int rr = gw; rr < TL; rr += 2 * NGW) { f32x4 v[2][4];
#pragma unroll
        for (int q = 0; q < 2; ++q) { const int r = rr + q * NGW; if (r < TL) {
#pragma unroll
            for (int j = 0; j < 4; ++j) v[q][j] = *(const f32x4*)(p.out + (size_t)r * DM + 4 * (lane + 64 * j));
            const int s0 = tokslot[2 * r], s1 = tokslot[2 * r + 1];
#pragma unroll
            for (int j = 0; j < 4; ++j) { const u32x2 a = *(const u32x2*)(ys + (size_t)s0 * DM + 4 * (lane + 64 * j)), b = *(const u32x2*)(ys + (size_t)s1 * DM + 4 * (lane + 64 * j));
                v[q][j][0] += __uint_as_float(a.x << 16) + __uint_as_float(b.x << 16); v[q][j][1] += __uint_as_float(a.x & 0xffff0000u) + __uint_as_float(b.x & 0xffff0000u);
                v[q][j][2] += __uint_as_float(a.y << 16) + __uint_as_float(b.y << 16); v[q][j][3] += __uint_as_float(a.y & 0xffff0000u) + __uint_as_float(b.y & 0xffff0000u); } } }
#pragma unroll
        for (int q = 0; q < 2; ++q) { const int r = rr + q * NGW; if (r < TL) { float s = 0.f;
#pragma unroll
            for (int j = 0; j < 4; ++j) s += (v[q][j][0] * v[q][j][0] + v[q][j][1] * v[q][j][1]) + (v[q][j][2] * v[q][j][2] + v[q][j][3] * v[q][j][3]);
            const float rstd = rsqrtf(wave_sum(s) * (1.f / DM) + EPS);
#pragma unroll
            for (int j = 0; j < 4; ++j) *(f32x4*)(p.out + (size_t)r * DM + 4 * (lane + 64 * j)) = v[q][j] * rstd * gv[j]; } } }
}
__device__ __forceinline__ void moe_tables(Frame& F, const unsigned* mcnt) {
    __syncthreads();
    if (F.tid < 16) F.MISC[32 + F.tid] = __hip_atomic_load(mcnt + F.tid, __ATOMIC_RELAXED, __HIP_MEMORY_SCOPE_AGENT);
    __syncthreads();
    if (F.tid == 0) { unsigned first = 0u, nb0 = 0u;
        for (int g = 0; g < 16; ++g) { const unsigned c = F.MISC[32 + g]; F.MISC[16 + g] = first; first += (c + 255u) / 256u; if (g == 7) nb0 = first; }
        F.MISC[48] = nb0; F.MISC[49] = first; }
    __syncthreads();
}


__device__ __forceinline__ int fresh_tid(int wave) { int tl; asm volatile("v_mbcnt_lo_u32_b32 %0, -1, 0\n\tv_mbcnt_hi_u32_b32 %0, -1, %0" : "=v"(tl)); return wave * 64 + tl; }
typedef short v4i16_t __attribute__((ext_vector_type(4)));
__device__ __forceinline__ unsigned off_b(unsigned row, unsigned ch) { return 256u * row + 16u * (ch ^ (((row & 3u) << 2) | ((row >> 2) & 3u))); }
__device__ __forceinline__ int crow(int r, int hi) { return (r & 3) + 8 * (r >> 2) + 4 * hi; }
__device__ __forceinline__ s16x4 trrd(const LAS unsigned char* p) { return __builtin_bit_cast(s16x4, __builtin_amdgcn_ds_read_tr16_b64_v4i16((LAS v4i16_t*)p)); }
template <int MB>
__device__ __forceinline__ void dft_mma(const LAS unsigned char* Aimg, const LAS unsigned char* Bimg, int wave, int lane, f32x16 (&acc)[MB]) {
    const int r32 = lane & 31, hi = lane >> 5;
    const unsigned X = ((r32 & 3) << 2) | ((r32 >> 2) & 3);
    const LAS unsigned char* bbase = Bimg + (wave >> 2) * 32768;
    const unsigned blk = (lane >> 4) & 1, q = (lane & 15) >> 2, pp = lane & 3, c = wave & 3;
    unsigned tra[2];
#pragma unroll
    for (int t = 0; t < 2; ++t) tra[t] = off_b(8 * hi + 4 * t + q, 4 * c + 2 * blk + (pp >> 1)) + 8 * (pp & 1);
#pragma unroll
    for (int ks = 0; ks < 8; ++ks) {
        const s16x4 lo = trrd(bbase + tra[0] + ks * 4096), hh = trrd(bbase + tra[1] + ks * 4096);
        const bf16x8 bf = (bf16x8){lo[0], lo[1], lo[2], lo[3], hh[0], hh[1], hh[2], hh[3]};
        const unsigned achunk = ((2 * ks + hi) ^ X) * 16;
#pragma unroll
        for (int mb = 0; mb < MB; ++mb) { const bf16x8 af = *(const LAS bf16x8*)(Aimg + 256 * (32 * mb + r32) + achunk);
            acc[mb] = __builtin_amdgcn_mfma_f32_32x32x16_bf16(af, bf, acc[mb], 0, 0, 0); }
    }
}
__device__ __forceinline__ void p0_fold(const Prm& p, Frame& F) {
    LAS unsigned char* Aimg = F.lds; LAS unsigned char* Bimg = F.lds + 65536; LAS f32x2* cs256 = (LAS f32x2*)(F.lds + 131072);
    const int tid = F.tid, lane = F.lane, wave = F.wave, r32 = lane & 31, hi = lane >> 5;
    __syncthreads();
    for (int i = tid; i < 256; i += 512) { float sn, cs; sincospif(2.f * (float)i / 256.f, &sn, &cs); cs256[i] = (f32x2){cs * 0.0625f, sn * 0.0625f}; }
    const int wi = F.vcu - F.G / 2;
    if (wi >= 0 && (wi & 1) == 0)
    for (int it = wi >> 1; it < 64; it += (F.G - F.G / 2 + 1) >> 1) {
        const int j = it >> 5, g = (it >> 3) & 3, type = (it >> 2) & 1, nt = it & 3;
        const float* w = p.fw + (size_t)j * DM * DM + (size_t)(g * 256) * DM + nt * 256;
        f32x16 acc[8];
#pragma unroll
        for (int mb = 0; mb < 8; ++mb) acc[mb] = (f32x16){};
        for (int ch = 0; ch < 2; ++ch) {
            __syncthreads();
            for (int qq = tid; qq < 256 * 16; qq += 512) { const int row = qq >> 4, c8 = qq & 15, q0 = 128 * ch + 8 * c8; float v[8];
#pragma unroll
                for (int e = 0; e < 8; ++e) { const f32x2 t = cs256[(row * (q0 + e)) & 255]; v[e] = type ? t.y : t.x; }
                u32x4 o; o.x = pk2(v[0], v[1]); o.y = pk2(v[2], v[3]); o.z = pk2(v[4], v[5]); o.w = pk2(v[6], v[7]);
                *(LAS u32x4*)(Aimg + off_b(row, c8)) = o; }
            { const int tt = fresh_tid(wave); const int cols4 = tt & 63, rb = tt >> 6;
              f32x4 xv[16];
#pragma unroll
              for (int i = 0; i < 16; ++i) xv[i] = *(const f32x4*)(w + (size_t)(128 * ch + rb + 8 * i) * DM + 4 * cols4);
              LAS unsigned char* bw = Bimg + (cols4 >> 5) * 32768 + 8 * (cols4 & 1);
#pragma unroll
              for (int i = 0; i < 16; ++i) { const int n1 = rb + 8 * i; u32x2 o; o.x = pk2(xv[i][0], xv[i][1]); o.y = pk2(xv[i][2], xv[i][3]);
                  *(LAS u32x2*)(bw + off_b(n1, (cols4 & 31) >> 1)) = o; } }
            __syncthreads();
            dft_mma<8>(Aimg, Bimg, wave, lane, acc);
        }
        bf16_t* out = (bf16_t*)(p.ws + WS_W + j * WE_STRIDE + WE_F) + (size_t)(nt * 256 + 32 * wave + r32) * 2048 + type * 1024 + g * 256 + 4 * hi;
#pragma unroll
        for (int mb = 0; mb < 8; ++mb)
#pragma unroll
            for (int rg = 0; rg < 4; ++rg) { u32x2 o; o.x = pk2(acc[mb][4 * rg], acc[mb][4 * rg + 1]); o.y = pk2(acc[mb][4 * rg + 2], acc[mb][4 * rg + 3]);
                *(u32x2*)(out + 32 * mb + 8 * rg) = o; }
    }
    __syncthreads();
}
__device__ __forceinline__ void s1_phase(const Prm& p, Frame& F, const float* xl, const float* xc, const float* g, const float* mod, bf16_t* Y1, bf16_t* Y1C) {
    LAS unsigned char* Aimg = F.lds; LAS unsigned char* Bimg = F.lds + 65536;
    LAS float* rstd = (LAS float*)(F.lds + 131072); LAS f32x2* tw = (LAS f32x2*)(F.lds + 131584); LAS float* gm = (LAS float*)(F.lds + 132608); LAS float* shv = (LAS float*)(F.lds + 136704);
    const bf16_t* F1 = (const bf16_t*)(p.ws + WS_TAB + TAB_F1); const float2* TW = (const float2*)(p.ws + WS_TAB + TAB_TW); const float2* TWC = (const float2*)(p.ws + WS_TAB + TAB_TWC);
    const int tid = F.tid, lane = F.lane, wave = F.wave, r32 = lane & 31, hi = lane >> 5;
    __syncthreads();
    for (int qq = tid; qq < 256 * 16; qq += 512) { const int row = qq >> 4, ch = qq & 15; *(LAS u32x4*)(Aimg + off_b(row, ch)) = *(const u32x4*)(F1 + row * 128 + ch * 8); }
    for (int w = F.vcu; w < 288; w += F.G) {
        const int u = w < 256 ? w : 256 + ((w - 256) >> 2), c_lo = w < 256 ? 0 : (w - 256) & 3, c_hi = w < 256 ? 4 : c_lo + 1;
        const bool lat = u < 256; const int b = lat ? u >> 6 : (u - 256) >> 1, n2 = lat ? u & 63 : (u - 256) & 1;
        const float* xs = lat ? xl + ((size_t)b * SEQ + n2) * DM : xc + ((size_t)b * CTXL + n2) * DM; const size_t rstride = (size_t)(lat ? 64 : 2) * DM;
        const float* mp = mod + (size_t)(lat ? b : 4) * NMOD * DM;
        __syncthreads();
        for (int c = tid; c < DM; c += 512) { gm[c] = g[c] * (1.f + mp[DM + c]); shv[c] = mp[c]; }
        if (tid < 128) { const float2 t = lat ? TW[n2 * 128 + tid] : TWC[n2 * 128 + tid]; tw[tid] = (f32x2){t.x, t.y}; }
#pragma unroll 4
        for (int i = 0; i < 16; ++i) { const int n1 = 16 * wave + i; const float* xr = xs + n1 * rstride; float sq = 0.f;
#pragma unroll
            for (int j = 0; j < 4; ++j) { const f32x4 v = *(const f32x4*)(xr + 4 * (lane + 64 * j)); sq += (v[0] * v[0] + v[1] * v[1]) + (v[2] * v[2] + v[3] * v[3]); }
            sq = wave_sum(sq); if (lane == 0) rstd[n1] = rsqrtf(sq * (1.f / DM) + EPS); }
        __syncthreads();
        for (int cc = c_lo; cc < c_hi; ++cc) {
            { const int tt = fresh_tid(wave); const int cols4 = tt & 63, rb = tt >> 6, c0 = 256 * cc + 4 * cols4;
              f32x4 xv[16];
#pragma unroll
              for (int i = 0; i < 16; ++i) xv[i] = *(const f32x4*)(xs + (size_t)(rb + 8 * i) * rstride + c0);
              const f32x4 gv = *(const LAS f32x4*)(gm + c0), sv = *(const LAS f32x4*)(shv + c0);
              LAS unsigned char* bw = Bimg + (cols4 >> 5) * 32768 + 8 * (cols4 & 1);
#pragma unroll
              for (int i = 0; i < 16; ++i) { const int n1 = rb + 8 * i; const f32x4 h = xv[i] * rstd[n1] * gv + sv; u32x2 o; o.x = pk2(h[0], h[1]); o.y = pk2(h[2], h[3]);
                  *(LAS u32x2*)(bw + off_b(n1, (cols4 & 31) >> 1)) = o; } }
            __syncthreads();
            f32x16 acc[8];
#pragma unroll
            for (int mb = 0; mb < 8; ++mb) acc[mb] = (f32x16){};
            dft_mma<8>(Aimg, Bimg, wave, lane, acc);
            __syncthreads();
            bf16_t* Y = lat ? Y1 : Y1C; const size_t k1stride = (size_t)(lat ? 128 : 4) * DM;
            const size_t ybase = (lat ? ((size_t)b * 128 * 64 + n2) * 2 : ((size_t)b * 128 * 2 + n2) * 2) * DM + 256 * cc;
            LAS bf16_t* ost = (LAS bf16_t*)Bimg + (4 * hi) * 256 + 32 * wave + r32;
#pragma unroll
            for (int hf = 0; hf < 2; ++hf) {
#pragma unroll
                for (int mb = 0; mb < 4; ++mb)
#pragma unroll
                    for (int r = 0; r < 16; r += 2) { const int k1 = (32 * (4 * hf + mb) + crow(r, hi)) >> 1; const f32x2 t = tw[k1]; const float re = acc[4 * hf + mb][r], im = acc[4 * hf + mb][r + 1];
                        ost[(32 * mb + (r & 3) + 8 * (r >> 2)) * 256] = (bf16_t)f2bf(re * t.x - im * t.y); ost[(32 * mb + (r & 3) + 8 * (r >> 2) + 1) * 256] = (bf16_t)f2bf(re * t.y + im * t.x);
                        if ((r & 7) == 6) asm volatile("" ::: "memory"); }
                __syncthreads();
                const int t2 = fresh_tid(wave);
#pragma unroll
                for (int i = 0; i < 8; ++i) { const int qq = t2 + 512 * i, row = qq >> 5, ch = qq & 31;
                    const u32x4 v = *(const LAS u32x4*)((const LAS unsigned char*)Bimg + row * 512 + ch * 16);
                    const int k1 = 64 * hf + (row >> 1);
                    *(u32x4*)(Y + ybase + (size_t)k1 * k1stride + (size_t)(row & 1) * DM + ch * 8) = v; }
                __syncthreads();
            }
        }
    }
}
__device__ __forceinline__ void s2_phase(const Prm& p, Frame& F, const bf16_t* Y1, const bf16_t* Y1C, bf16_t* PQ) {
    LAS unsigned char* Aimg = F.lds; LAS unsigned char* Bimg = F.lds + 65536;
    const bf16_t* F2 = (const bf16_t*)(p.ws + WS_TAB + TAB_F2);
    const int tid = F.tid, lane = F.lane, wave = F.wave, r32 = lane & 31, hi = lane >> 5;
    __syncthreads();
    for (int qq = tid; qq < 128 * 16; qq += 512) { const int row = qq >> 4, ch = qq & 15; *(LAS u32x4*)(Aimg + off_b(row, ch)) = *(const u32x4*)(F2 + row * 128 + ch * 8); }
    u32x4 v[8];
    { const int u = F.vcu; if (u < 2048) { const int cc = u & 3, k1 = (u >> 2) & 127, b = u >> 9; const bf16_t* src = Y1 + ((size_t)b * 128 + k1) * 128 * DM + 256 * cc;
#pragma unroll
        for (int i = 0; i < 8; ++i) { const int qq = tid + 512 * i; v[i] = *(const u32x4*)(src + (size_t)(qq >> 5) * DM + (qq & 31) * 8); } } }
    for (int u = F.vcu; u < 2048; u += F.G) {
        const int cc = u & 3, k1 = (u >> 2) & 127, b = u >> 9;
        __syncthreads();
#pragma unroll
        for (int i = 0; i < 8; ++i) { const int qq = tid + 512 * i, row = qq >> 5, ch32 = qq & 31; *(LAS u32x4*)(Bimg + (ch32 >> 4) * 32768 + off_b(row, ch32 & 15)) = v[i]; }
        __syncthreads();
        { const int un = u + F.G; if (un < 2048) { const int ccn = un & 3, k1n = (un >> 2) & 127, bn = un >> 9; const bf16_t* src = Y1 + ((size_t)bn * 128 + k1n) * 128 * DM + 256 * ccn;
#pragma unroll
            for (int i = 0; i < 8; ++i) { const int qq = tid + 512 * i; v[i] = *(const u32x4*)(src + (size_t)(qq >> 5) * DM + (qq & 31) * 8); } } }
        f32x16 acc[4];
#pragma unroll
        for (int mb = 0; mb < 4; ++mb) acc[mb] = (f32x16){};
        dft_mma<4>(Aimg, Bimg, wave, lane, acc);
        __syncthreads();
        { LAS bf16_t* ost = (LAS bf16_t*)Bimg + (4 * hi) * 256 + 32 * wave + r32;
#pragma unroll
          for (int mb = 0; mb < 4; ++mb)
#pragma unroll
              for (int r = 0; r < 16; ++r) ost[(32 * mb + (r & 3) + 8 * (r >> 2)) * 256] = (bf16_t)f2bf(acc[mb][r]); }
        __syncthreads();
        { const int t2 = fresh_tid(wave);
#pragma unroll
          for (int i = 0; i < 8; ++i) { const int qq = t2 + 512 * i, row = qq >> 5, ch = qq & 31, k2 = row >> 1, cp = row & 1;
              const u32x4 o = *(const LAS u32x4*)((const LAS unsigned char*)Bimg + row * 512 + ch * 16);
              *(u32x4*)(PQ + ((size_t)b * SEQ + k1 + 128 * k2) * 2048 + cp * DM + 256 * cc + ch * 8) = o; } }
    }
    { const int gt = F.vcu * 512 + fresh_tid(wave), NT = F.G * 512; const float sc = 0.70710678118654752f;
      for (int i = gt; i < NB * 128 * DM; i += NT) { const int ch = i & (DM - 1), k1 = (i >> 10) & 127, b = i >> 17;
          const bf16_t* y = Y1C + ((size_t)b * 128 + k1) * 4 * DM + ch;
          const float y0r = __uint_as_float((unsigned)y[0] << 16), y0i = __uint_as_float((unsigned)y[DM] << 16), y1r = __uint_as_float((unsigned)y[2 * DM] << 16), y1i = __uint_as_float((unsigned)y[3 * DM] << 16);
          bf16_t* o0 = PQ + ((size_t)TL + b * CTXL + k1) * 2048 + ch; bf16_t* o1 = o0 + (size_t)128 * 2048;
          o0[0] = (bf16_t)f2bf((y0r + y1r) * sc); o0[DM] = (bf16_t)f2bf((y0i + y1i) * sc); o1[0] = (bf16_t)f2bf((y0r - y1r) * sc); o1[DM] = (bf16_t)f2bf((y0i - y1i) * sc); } }
}

__device__ __forceinline__ void attn_phase(const Prm& p, Frame& F, const bf16_t* QB, const bf16_t* KB, const bf16_t* VB, bf16_t* OB, const float* sinks, int nunits) {
    LAS unsigned char* Ks = F.lds; LAS unsigned char* Vs = F.lds + 8192; LAS float* wsf = (LAS float*)(F.lds + 32768) + F.wave * 64; LAS bf16_t* stg = (LAS bf16_t*)(F.lds + 34816 + F.wave * 4096);
    const int lane = F.lane, wave = F.wave, r32 = lane & 31, hi = lane >> 5;
    for (int u = F.vcu; u < nunits; u += F.G) {
        const bool isctx = u >= 2048; const int uu = isctx ? u - 2048 : u;
        const int pb = isctx ? (uu & 3) : (uu & 127), kv = isctx ? ((uu >> 2) & 3) : ((uu >> 7) & 3), b = isctx ? (uu >> 4) : (uu >> 9);
        const int h = kv * 4 + (wave >> 1); const int qq = 32 * (wave & 1) + r32;
        const size_t qrow0 = (size_t)(isctx ? TL + b * CTXL : b * SEQ) + 64 * pb + 32 * (wave & 1);
        bf16x8 qr[4];
#pragma unroll
        for (int d0 = 0; d0 < 4; ++d0) qr[d0] = *(const bf16x8*)(QB + (qrow0 + r32) * DM + h * 64 + d0 * 16 + hi * 8);
        float m = sinks[h] * LOG2E, l = hi ? 0.f : 1.f; f32x16 o[2]; o[0] = (f32x16){}; o[1] = (f32x16){};
        const int ntl = isctx ? 0 : 5;
        const int t_first = isctx ? 0 : (pb < 2 ? 2 - pb : 0), t_lastl = isctx ? -1 : (pb > 125 ? 129 - pb : 4);
        const bf16_t* kbase = KB + (size_t)lane * 256 + kv * 64 + wave * 8;
        const bf16_t* vbase = VB + (size_t)(16 * (wave & 3) + (lane >> 2)) * 256 + kv * 64 + (wave >> 2) * 32 + (lane & 3) * 8;
        auto tile_row0 = [&](int ti) -> size_t { return ti < ntl ? (size_t)b * SEQ + 64 * (pb - 2 + ti) : (size_t)TL + b * CTXL + 64 * (ti - ntl); };
        int ti = isctx ? 0 : t_first; int slot = 0;
        u32x4 kreg = *(const u32x4*)(kbase + tile_row0(ti) * 256), vreg = *(const u32x4*)(vbase + tile_row0(ti) * 256);
        __syncthreads();
        *(LAS u32x4*)(Ks + wave * 1024 + lane * 16) = kreg; *(LAS u32x4*)(Vs + wave * 1024 + lane * 16) = vreg;
        { int tn0 = ti + 1; if (tn0 > t_lastl && tn0 < ntl) tn0 = ntl; kreg = *(const u32x4*)(kbase + tile_row0(tn0) * 256); vreg = *(const u32x4*)(vbase + tile_row0(tn0) * 256); }
        __syncthreads();
        while (ti < ntl + 4) {
            const int mode = (ti < ntl) ? ((ti == 0) ? 1 : (ti == 4) ? 2 : 0) : 0;
            int tn = ti + 1; if (tn > t_lastl && tn < ntl) tn = ntl;
            int tnn = tn + 1; if (tnn > t_lastl && tnn < ntl) tnn = ntl;
            const LAS unsigned char* kb = Ks + slot * 16384 + hi * 1024 + r32 * 16;
            const LAS unsigned char* vp = Vs + slot * 16384 + ((lane >> 4) & 1) * 32 + (lane & 3) * 8 + (4 * hi + ((lane & 15) >> 2)) * 64;
            f32x16 p0 = (f32x16){}, p1 = (f32x16){};
#pragma unroll
            for (int d0 = 0; d0 < 4; ++d0) { const bf16x8 b0 = *(const LAS bf16x8*)(kb + d0 * 2048), b1 = *(const LAS bf16x8*)(kb + d0 * 2048 + 512);
                p0 = __builtin_amdgcn_mfma_f32_32x32x16_bf16(b0, qr[d0], p0, 0, 0, 0); p1 = __builtin_amdgcn_mfma_f32_32x32x16_bf16(b1, qr[d0], p1, 0, 0, 0); }
            if (mode) {
#pragma unroll
                for (int r = 0; r < 16; ++r) { const int kk = crow(r, hi); const bool m0 = (mode == 1) ? (kk < qq) : (kk > qq), m1 = (mode == 1) ? (kk + 32 < qq) : (kk + 32 > qq);
                    if (m0) p0[r] = -INFINITY; if (m1) p1[r] = -INFINITY; } }
            float rm = fmaxf(p0[0], p1[0]);
#pragma unroll
            for (int r = 1; r < 16; ++r) rm = fmaxf(rm, fmaxf(p0[r], p1[r]));
            { auto rr = __builtin_amdgcn_permlane32_swap(__float_as_uint(rm), __float_as_uint(rm), false, false); rm = fmaxf(__uint_as_float(rr[0]), __uint_as_float(rr[1])); }
            const float mnew = fmaxf(m, rm), alpha = __builtin_amdgcn_exp2f(m - mnew); m = mnew;
            float ps = 0.f;
#pragma unroll
            for (int r = 0; r < 16; ++r) { p0[r] = __builtin_amdgcn_exp2f(p0[r] - m); p1[r] = __builtin_amdgcn_exp2f(p1[r] - m); ps += p0[r] + p1[r]; }
            l = l * alpha + ps;
            if (hi == 0) wsf[r32] = alpha;
#pragma unroll
            for (int r = 0; r < 16; ++r) { const float a = wsf[crow(r, hi)]; o[0][r] *= a; o[1][r] *= a; }
            u32x4 pw[4];
            pw[0] = (u32x4){pk2(p0[0], p0[1]), pk2(p0[2], p0[3]), pk2(p0[4], p0[5]), pk2(p0[6], p0[7])};
            pw[1] = (u32x4){pk2(p0[8], p0[9]), pk2(p0[10], p0[11]), pk2(p0[12], p0[13]), pk2(p0[14], p0[15])};
            pw[2] = (u32x4){pk2(p1[0], p1[1]), pk2(p1[2], p1[3]), pk2(p1[4], p1[5]), pk2(p1[6], p1[7])};
            pw[3] = (u32x4){pk2(p1[8], p1[9]), pk2(p1[10], p1[11]), pk2(p1[12], p1[13]), pk2(p1[14], p1[15])};
#pragma unroll
            for (int d0 = 0; d0 < 2; ++d0)
#pragma unroll
                for (int ks = 0; ks < 4; ++ks) { const s16x4 lo = trrd(vp + d0 * 4096 + ks * 1024), hh = trrd(vp + d0 * 4096 + ks * 1024 + 512);
                    const bf16x8 vf = (bf16x8){lo[0], lo[1], lo[2], lo[3], hh[0], hh[1], hh[2], hh[3]};
                    o[d0] = __builtin_amdgcn_mfma_f32_32x32x16_bf16(__builtin_bit_cast(bf16x8, pw[ks]), vf, o[d0], 0, 0, 0); }
            if (tn < ntl + 4) {
                *(LAS u32x4*)(Ks + (slot ^ 1) * 16384 + wave * 1024 + lane * 16) = kreg; *(LAS u32x4*)(Vs + (slot ^ 1) * 16384 + wave * 1024 + lane * 16) = vreg;
                if (tnn < ntl + 4) { kreg = *(const u32x4*)(kbase + tile_row0(tnn) * 256); vreg = *(const u32x4*)(vbase + tile_row0(tnn) * 256); }
                __syncthreads(); }
            ti = tn; slot ^= 1;
        }
        { auto rr = __builtin_amdgcn_permlane32_swap(__float_as_uint(l), __float_as_uint(l), false, false); l = __uint_as_float(rr[0]) + __uint_as_float(rr[1]); }
        if (hi == 0) wsf[32 + r32] = l;
#pragma unroll
        for (int r = 0; r < 16; ++r) { const int orow = crow(r, hi); const float rl = __builtin_amdgcn_rcpf(wsf[32 + orow]);
            stg[orow * 64 + r32] = (bf16_t)f2bf(o[0][r] * rl); stg[orow * 64 + 32 + r32] = (bf16_t)f2bf(o[1][r] * rl); }
#pragma unroll
        for (int i = 0; i < 4; ++i) { const int row = i * 8 + (lane >> 3), ch = lane & 7; const u32x4 v = *(const LAS u32x4*)(stg + row * 64 + ch * 8);
            *(u32x4*)(OB + (qrow0 + row) * DM + h * 64 + ch * 8) = v; }
    }
}


__device__ __forceinline__ int next_real(int ph) { int q = ph + 1; if (q >= 1 && q <= 32) { const int i = (q - 1) >> 3, o = (q - 1) & 7; if ((i & 1) == 0 && o >= 6) q = 1 + 8 * (i + 1); } return q; }
__global__ void __launch_bounds__(512, 2) mk_fwd(Args a) {
    extern __shared__ __attribute__((aligned(16))) unsigned char lds_raw[];
    Frame F; F.lds = (LAS unsigned char*)lds_raw; F.MISC = (volatile LAS unsigned*)(F.lds + LDS_MISC);
    F.tid = threadIdx.x; F.lane = F.tid & 63; F.wave = __builtin_amdgcn_readfirstlane(F.tid >> 6);
    F.G = gridDim.x; { const int bx = blockIdx.x; F.vcu = (F.G % 8 == 0) ? (bx % 8) * (F.G / 8) + bx / 8 : bx; }
    const Prm& p = a.p; GAS unsigned char* ws = (GAS unsigned char*)a.p.ws;
    for (int u = F.tid; u < 128; u += 512) F.MISC[u] = 0u;
    __syncthreads();
    unsigned* ctl = (unsigned*)(ws + WS_CTL);
    XcdBarrier bar = xcd_barrier_post(ctl + CW_BAR, F.MISC + 8);
    const int lo = a.ph_lo, hi = a.ph_hi;
    const int wave0 = __builtin_amdgcn_readfirstlane((int)threadIdx.x >> 6);
#ifndef ONLY
#define ONLY -1
#endif
#ifndef PROBE_KIND
#define PROBE_KIND -1
#endif
#ifndef PROBE_GEMMS
#define PROBE_GEMMS 0
#endif
#define NREP(k) (((k) == PROBE_KIND) || (PROBE_GEMMS && ((k) == 3 || (k) == 5 || (k) == 6 || (k) == 7 || (k) == 9 || (k) == 11 || (k) == 12)) ? 2 : 1)
#define EN(k) (ONLY == -1 || ONLY == (k))
#define RUN(ph) (lo <= (ph) && (ph) < hi)
#define SEAM(ph) do { if (next_real(ph) < hi) xcd_barrier(bar); } while (0)
#define FRESH() do { const int t_ = fresh_tid(wave0);     F.tid = t_; F.lane = t_ & 63; F.wave = __builtin_amdgcn_readfirstlane(t_ >> 6); asm volatile("" : "+s"(ws)); } while (0)
    const int cblk = (int)blockIdx.x;
#define WSP(T, off) ((T*)(GAS T*)(ws + (off)))
#define SKCTL(slots_off, ph) pg8::SkCtl{WSP(f32x4, slots_off), WSP(unsigned, WS_CTL) + CW_SKF, WSP(unsigned, WS_CTL) + CW_BAR + XB_TMO, (unsigned)((ph) * 4 + rep + 1), cblk, F.G}
    for (int rep = 0; rep < NREP(0); ++rep) if (EN(0) && RUN(0)) { FRESH(); p0_prologue(p, F); SEAM(0); }

    for (int lp = 0; lp < 2; ++lp) {
        const int ie = 2 * lp, io = 2 * lp + 1, j = lp;
        { const int base = 1 + 8 * ie;
          for (int rep = 0; rep < NREP(1); ++rep) if (EN(1) && RUN(base + 0)) { FRESH(); s1_phase(p, F, ie == 0 ? p.x : p.out, ie == 0 ? p.ctx : WSP(const float, WS_XC), p.nmg + ie * DM, WSP(const float, WS_MOD) + (size_t)ie * 5 * NMOD * DM,
                                                  WSP(bf16_t, WS_MS + MS_BIG + BIG_Y1), WSP(bf16_t, WS_MS + MS_BIG + BIG_Y1C)); SEAM(base + 0); }
          for (int rep = 0; rep < NREP(2); ++rep) if (EN(2) && RUN(base + 1)) { FRESH(); s2_phase(p, F, WSP(const bf16_t, WS_MS + MS_BIG + BIG_Y1), WSP(const bf16_t, WS_MS + MS_BIG + BIG_Y1C), WSP(bf16_t, WS_MS + MS_BIG + BIG_PQ)); SEAM(base + 1); }
          for (int rep = 0; rep < NREP(3); ++rep) if (EN(3) && RUN(base + 2)) { FRESH(); SchedDense<true> S{WSP(const bf16_t, WS_W + j * WE_STRIDE + WE_F), TT / 256, DM / 256, F.G, cblk, 2048};
              EpiResid E{ie == 0 ? p.x : p.out, ie == 0 ? p.ctx : WSP(const float, WS_XC), p.out, WSP(float, WS_XC), WSP(const float, WS_MOD) + (size_t)ie * 5 * NMOD * DM, 2, rep ? 0.f : 1.f};
              pg8::gemm_phase<EpiResid, SchedDense<true>, false>(F.lds, F.tid, WSP(const bf16_t, WS_MS + MS_BIG + BIG_PQ), 2048, S, E, SKCTL(WS_MS + MS_HB, base + 2)); SEAM(base + 2); }
          for (int rep = 0; rep < NREP(4); ++rep) if (EN(4) && RUN(base + 3)) { FRESH(); norm_phase<false>(p, F, p.out, WSP(const float, WS_XC), p.nfg + ie * DM, WSP(const float, WS_MOD) + (size_t)ie * 5 * NMOD * DM, 3, WSP(bf16_t, WS_MS + MS_HB), TT, nullptr, nullptr, nullptr, nullptr); SEAM(base + 3); }
          for (int rep = 0; rep < NREP(5); ++rep) if (EN(5) && RUN(base + 4)) { FRESH(); SchedDense<false> S{WSP(const bf16_t, WS_W + j * WE_STRIDE + WE_GU), TT / 256, 2 * DFF / 256, F.G, cblk, DM}; EpiSwiglu E{WSP(bf16_t, WS_MS + MS_BIG + BIG_ACT)};
              pg8::gemm_phase<EpiSwiglu, SchedDense<false>, false>(F.lds, F.tid, WSP(const bf16_t, WS_MS + MS_HB), DM, S, E); SEAM(base + 4); }
          for (int rep = 0; rep < NREP(6); ++rep) if (EN(6) && RUN(base + 5)) { FRESH(); SchedDense<true> S{WSP(const bf16_t, WS_W + j * WE_STRIDE + WE_D), TT / 256, DM / 256, F.G, cblk, DFF};
              EpiResid E{p.out, WSP(const float, WS_XC), p.out, WSP(float, WS_XC), WSP(const float, WS_MOD) + (size_t)ie * 5 * NMOD * DM, 5, rep ? 0.f : 1.f};
              pg8::gemm_phase<EpiResid, SchedDense<true>, false>(F.lds, F.tid, WSP(const bf16_t, WS_MS + MS_BIG + BIG_ACT), DFF, S, E, SKCTL(WS_MS + MS_HB, base + 5)); SEAM(base + 5); }
        }
        { const int base = 1 + 8 * io; const bool last = (io == DEPTH - 1); const int nrows = last ? TL : TT;
          const size_t wo = WS_W + WO_BASE + j * WO_STRIDE;
          for (int rep = 0; rep < NREP(4); ++rep) if (EN(4) && RUN(base + 0)) { FRESH(); norm_phase<false>(p, F, p.out, WSP(const float, WS_XC), p.nmg + io * DM, WSP(const float, WS_MOD) + (size_t)io * 5 * NMOD * DM, 0, WSP(bf16_t, WS_MS + MS_HB), TT, nullptr, nullptr, nullptr, nullptr); SEAM(base + 0); }
          for (int rep = 0; rep < NREP(7); ++rep) if (EN(7) && RUN(base + 1)) { FRESH(); SchedDense<true> S{WSP(const bf16_t, wo + WO_QKV), TT / 256, QKVD / 256, F.G, cblk, DM};
              EpiQKV E{WSP(bf16_t, WS_MS + MS_BIG + BIG_Q), WSP(bf16_t, WS_MS + MS_BIG + BIG_K), WSP(bf16_t, WS_MS + MS_BIG + BIG_V), WSP(const float2, WS_ROPE)};
              pg8::gemm_phase<EpiQKV, SchedDense<true>, false>(F.lds, F.tid, WSP(const bf16_t, WS_MS + MS_HB), DM, S, E, SKCTL(WS_MS + MS_BIG + 300 * MiB, base + 1)); SEAM(base + 1); }
          for (int rep = 0; rep < NREP(8); ++rep) if (EN(8) && RUN(base + 2)) { FRESH(); attn_phase(p, F, WSP(const bf16_t, WS_MS + MS_BIG + BIG_Q), WSP(const bf16_t, WS_MS + MS_BIG + BIG_K), WSP(const bf16_t, WS_MS + MS_BIG + BIG_V), WSP(bf16_t, WS_MS + MS_BIG + BIG_O), p.sinks + j * NH, last ? 2048 : 2048 + 64); SEAM(base + 2); }
          for (int rep = 0; rep < NREP(9); ++rep) if (EN(9) && RUN(base + 3)) { FRESH(); SchedDense<true> S{WSP(const bf16_t, wo + WO_O), nrows / 256, DM / 256, F.G, cblk, DM};
              EpiResid E{p.out, WSP(const float, WS_XC), p.out, WSP(float, WS_XC), WSP(const float, WS_MOD) + (size_t)io * 5 * NMOD * DM, 2, rep ? 0.f : 1.f};
              pg8::gemm_phase<EpiResid, SchedDense<true>, false>(F.lds, F.tid, WSP(const bf16_t, WS_MS + MS_BIG + BIG_O), DM, S, E, SKCTL(WS_MS + MS_HB, base + 3)); SEAM(base + 3); }
          for (int rep = 0; rep < NREP(10); ++rep) if (EN(10) && RUN(base + 4)) { FRESH(); norm_phase<true>(p, F, p.out, WSP(const float, WS_XC), p.nfg + io * DM, WSP(const float, WS_MOD) + (size_t)io * 5 * NMOD * DM, 3, WSP(bf16_t, WS_MS + MS_HB), nrows,
                                                       p.mr + (size_t)j * DM * NEXP, WSP(unsigned, WS_CTL) + CW_CNTW + 4096 * j, WSP(int, WS_ROUTE), WSP(float, WS_ROUTE) + 16 * TT); SEAM(base + 4); }
          for (int rep = 0; rep < NREP(11); ++rep) if (EN(11) && RUN(base + 5)) { FRESH(); if (rep == 0) { moe_lists(F, WSP(const unsigned, WS_CTL) + CW_CNTW + 4096 * j, WSP(unsigned, WS_CTL) + CW_MCNT + 64 * j, WSP(int, WS_ROUTE), WSP(float, WS_ROUTE) + 16 * TT, nrows, last ? WSP(int, WS_TOKSLOT) : (int*)nullptr); xcd_barrier(bar); }
              FRESH(); moe_tables(F, WSP(unsigned, WS_CTL) + CW_MCNT + 64 * j); MoeTab tab{F.MISC};
              SchedMoe<true, false> S{WSP(const bf16_t, wo + WO_EXP + WX_GU), WX_STRIDE, 2 * DFF / 256, F.G, cblk, DM, 0, (int)F.MISC[49], tab, WSP(const int, WS_ROUTE)}; EpiSwiglu E{WSP(bf16_t, WS_MS + MS_BIG + BIG_ACT)};
              pg8::gemm_phase<EpiSwiglu, SchedMoe<true, false>, true>(F.lds, F.tid, WSP(const bf16_t, WS_MS + MS_HB), DM, S, E); SEAM(base + 5); }
#pragma unroll
          for (int k = 0; k < 2; ++k)
          for (int rep = 0; rep < NREP(12); ++rep) if (EN(12) && RUN(base + 6 + k) && !last) { FRESH(); moe_tables(F, WSP(unsigned, WS_CTL) + CW_MCNT + 64 * j); MoeTab tab{F.MISC};
              const int nb0 = (int)F.MISC[48], nba = (int)F.MISC[49];
              SchedMoe<false, true> S{WSP(const bf16_t, wo + WO_EXP + WX_D), WX_STRIDE, DM / 256, F.G, cblk, DFF, k ? nb0 : 0, k ? nba - nb0 : nb0, tab, WSP(const int, WS_ROUTE)};
              EpiMoeDown E{p.out, WSP(float, WS_XC), WSP(const float, WS_MOD) + (size_t)io * 5 * NMOD * DM, WSP(const int, WS_ROUTE), WSP(const float, WS_ROUTE) + 16 * TT, rep ? 0.f : 1.f};
              pg8::gemm_phase<EpiMoeDown, SchedMoe<false, true>, false>(F.lds, F.tid, WSP(const bf16_t, WS_MS + MS_BIG + BIG_ACT), DFF, S, E, SKCTL(WS_MS + MS_HB, base + 6 + k)); SEAM(base + 6 + k); }
          for (int rep = 0; rep < NREP(14); ++rep) if (EN(12) && RUN(base + 6) && last) { FRESH(); moe_tables(F, WSP(unsigned, WS_CTL) + CW_MCNT + 64 * j); MoeTab tab{F.MISC};
              SchedMoe<false, true> S{WSP(const bf16_t, wo + WO_EXP + WX_D), WX_STRIDE, DM / 256, F.G, cblk, DFF, 0, (int)F.MISC[49], tab, WSP(const int, WS_ROUTE)};
              EpiMoeY E{WSP(bf16_t, WS_YS), WSP(const float, WS_MOD) + (size_t)io * 5 * NMOD * DM, WSP(const int, WS_ROUTE), WSP(const float, WS_ROUTE) + 16 * TT};
              pg8::gemm_phase<EpiMoeY, SchedMoe<false, true>, false>(F.lds, F.tid, WSP(const bf16_t, WS_MS + MS_BIG + BIG_ACT), DFF, S, E, SKCTL(WS_MS + MS_HB, base + 6)); SEAM(base + 7); }
        }
    }
    if (EN(13) && RUN(33)) { FRESH(); final_norm_phase(p, F, WSP(const bf16_t, WS_YS), WSP(const int, WS_TOKSLOT)); }
#undef WSP
#undef RUN
#undef SEAM
}

static int g_grid = 0;
static void mega_launch(const Prm& p, int lo, int hi, hipStream_t st) {
    if (g_grid == 0) {
        int dev = 0, cus = 0; hipGetDevice(&dev); hipDeviceGetAttribute(&cus, hipDeviceAttributeMultiprocessorCount, dev);
        if (hipFuncSetAttribute((const void*)mk_fwd, hipFuncAttributeMaxDynamicSharedMemorySize, LDS_BYTES) != hipSuccess) { fprintf(stderr, "hipFuncSetAttribute failed\n"); g_grid = -1; return; }
        int per_cu = 0; if (hipOccupancyMaxActiveBlocksPerMultiprocessor(&per_cu, (const void*)mk_fwd, 512, LDS_BYTES) != hipSuccess || per_cu < 1) fprintf(stderr, "occupancy query: %d\n", per_cu);
        (void)hipGetLastError();
        g_grid = cus & ~7;
    }
    if (g_grid < 0) return;
    hipMemsetAsync(p.ws + WS_CTL + CW_BAR * 4, 0, XCD_BAR_WORDS * 4, st);
    Args a{}; a.p = p; a.ph_lo = lo; a.ph_hi = hi;
    hipLaunchKernelGGL(mk_fwd, dim3(g_grid), dim3(512), LDS_BYTES, st, a);
}

template <class FA, class FB, class FE> static void ngemm(hipStream_t st, int Mmax, int N, int K, FA fa, FB fb, FE fe) {
    hipLaunchKernelGGL((nk_gemm<FA, FB, FE>), dim3(N / 64, (Mmax + 63) / 64), dim3(256), 0, st, Mmax, N, K, fa, fb, fe);
}

#ifndef MEGA_MASK
#define MEGA_MASK 0xFF
#endif
static void naive_forward(const Prm& p, hipStream_t st) {
    unsigned char* ws = p.ws;
    hipMemsetAsync(ws + WS_CTL, 0, 1 * MiB, st);
    if (MEGA_MASK) mega_launch(p, 0, 1, st);
    if (!(MEGA_MASK & 0x20)) {
    hipLaunchKernelGGL(nk_adaln, dim3((DEPTH * 5 * NMOD * DM + 255) / 256), dim3(256), 0, st, p);
    hipLaunchKernelGGL(nk_rope, dim3(8), dim3(256), 0, st, p); }
    hipMemcpyAsync(p.out, p.x, (size_t)TL * DM * 4, hipMemcpyDeviceToDevice, st);
    hipMemcpyAsync(ws + WS_XC, p.ctx, (size_t)TC * DM * 4, hipMemcpyDeviceToDevice, st);
    float* H = (float*)(ws + WS_S);
    unsigned char* S2 = ws + WS_S + 136 * MiB;
    for (int i = 0; i < DEPTH; ++i) {
        const int j = i / 2; const bool last = (i == DEPTH - 1);
        const int nrows = last ? TL : TT;
        const int pbase = 1 + 8 * i;
        if ((i % 2 == 0) && (MEGA_MASK & 0x08)) mega_launch(p, pbase + 0, pbase + 3, st);
        else if ((i % 2 == 1) && (MEGA_MASK & 0x04)) mega_launch(p, pbase + 0, pbase + 4, st);
        else {
        hipLaunchKernelGGL(nk_norm_mod, dim3(TT), dim3(256), 0, st, p, p.nmg + i * DM, i, 0, H, TT);
        if (i % 2 == 0) {
            float2* Y1 = (float2*)S2;
            float2* Z = (float2*)(S2 + 64 * MiB);
            for (int b = 0; b < NB; ++b) {
                hipLaunchKernelGGL(nk_fft_s1, dim3(SEQ * DM / 256), dim3(256), 0, st, H, b, Y1);
                hipLaunchKernelGGL(nk_fft_s2, dim3(SEQ * DM / 256), dim3(256), 0, st, Y1, b, Z);
            }
            hipLaunchKernelGGL(nk_dft_ctx, dim3(TC * DM / 256), dim3(256), 0, st, H, Z);
            hipLaunchKernelGGL(nk_chan_dft, dim3(TT * (DM / 256)), dim3(256), 0, st, Z, H);
            ngemm(st, nrows, DM, DM, ADense{H, DM, nrows}, BDense{p.fw + (size_t)j * DM * DM, DM, 0}, EResid{p, i, 2, 0, nrows});
        } else {
            float* QKV = (float*)S2;
            ngemm(st, TT, QKVD, DM, ADense{H, DM, TT}, BDense{p.wqkv + (size_t)j * DM * QKVD, QKVD, 0}, EStore{QKV, QKVD, TT});
            hipLaunchKernelGGL(nk_rope_apply, dim3((unsigned)(((size_t)TL * 640 + 255) / 256)), dim3(256), 0, st, p, QKV);
            hipLaunchKernelGGL(nk_attn, dim3((unsigned)(((size_t)nrows * NH + 63) / 64)), dim3(64), 0, st, p, QKV, p.sinks + j * NH, H, nrows);
            ngemm(st, nrows, DM, DM, ADense{H, DM, nrows}, BDense{p.wo + (size_t)j * DM * DM, DM, 0}, EResid{p, i, 2, 0, nrows});
        } }
        if ((i % 2 == 0) && (MEGA_MASK & 0x01)) { mega_launch(p, pbase + 3, pbase + 6, st); continue; }
        if ((i % 2 == 1) && (MEGA_MASK & 0x02)) { mega_launch(p, pbase + 4, pbase + 8, st); continue; }
        hipLaunchKernelGGL(nk_norm_mod, dim3(nrows), dim3(256), 0, st, p, p.nfg + i * DM, i, 3, H, nrows);
        constexpr int CH = 8448;
        float* ACT = (float*)S2;
        if (i % 2 == 0) {
            for (int r0 = 0; r0 < nrows; r0 += CH) {
                const int m = nrows - r0 < CH ? nrows - r0 : CH;
                ngemm(st, m, DFF, DM, ADense{H + (size_t)r0 * DM, DM, m}, BDense{p.fg + (size_t)j * DM * DFF, DFF, 0}, ESilu{ACT, DFF, m});
                ngemm(st, m, DFF, DM, ADense{H + (size_t)r0 * DM, DM, m}, BDense{p.fu + (size_t)j * DM * DFF, DFF, 0}, EMulInto{ACT, DFF, m});
                ngemm(st, m, DM, DFF, ADense{ACT, DFF, m}, BDense{p.fd + (size_t)j * DFF * DM, DM, 0}, EResid{p, i, 5, r0, m});
            }
        } else {
            int* cnt = (int*)(ws + WS_CTL) + 1024 + 64 * i;
            int* ltok = (int*)(ws + WS_ROUTE); float* lw = (float*)(ltok + NEXP * TT); int* lk = (int*)(lw + NEXP * TT);
            float* Y0 = (float*)(S2 + 120 * MiB); float* Y1 = Y0 + (size_t)TT * DM;
            hipLaunchKernelGGL(nk_router, dim3((nrows + 255) / 256), dim3(256), 0, st, p, H, p.mr + (size_t)j * DM * NEXP, nrows, cnt, ltok, lw, lk);
            for (int e = 0; e < NEXP; ++e) {
                const size_t we = ((size_t)j * NEXP + e) * DM * DFF;
                for (int r0 = 0; r0 < nrows; r0 += CH) {
                    ngemm(st, CH, DFF, DM, AGather{H, ltok + e * TT, cnt + e, r0, CH}, BDense{p.mg + we, DFF, 0}, ESiluCnt{ACT, cnt + e, DFF, r0, CH, 0});
                    ngemm(st, CH, DFF, DM, AGather{H, ltok + e * TT, cnt + e, r0, CH}, BDense{p.mu + we, DFF, 0}, EMulCnt{ACT, cnt + e, DFF, r0, CH, 0});
                    ngemm(st, CH, DM, DFF, ADenseCnt{ACT, cnt + e, DFF, r0, CH, 0}, BDense{p.md + we, DM, 0}, EScatterY{Y0, Y1, ltok + e * TT, lw + e * TT, lk + e * TT, cnt + e, r0, CH});
                }
            }
            hipLaunchKernelGGL(nk_moe_combine, dim3((unsigned)(((size_t)nrows * DM + 255) / 256)), dim3(256), 0, st, p, Y0, Y1, i, nrows);
        }
    }
    if (MEGA_MASK & 0x10) mega_launch(p, 33, 34, st); else hipLaunchKernelGGL(nk_final_norm, dim3(TL), dim3(256), 0, st, p);
}

extern "C" void kernel_launch(void* const* d_in, const int* in_sizes, int n_in, void* d_out, int out_size, void* d_ws, size_t ws_size, hipStream_t stream) {
    if (n_in != 20 || out_size != TL * DM || ws_size < WS_MEGA_END) { fprintf(stderr, "kernel_launch: unexpected shapes n_in %d out %d ws %zu\n", n_in, out_size, ws_size); return; }
    Prm p{};
    const float** f = (const float**)&p;
    for (int i = 0; i < 20; ++i) f[i] = (const float*)d_in[i];
    p.out = (float*)d_out; p.ws = (unsigned char*)d_ws;
    if (MEGA_MASK == 0xFF) {
        hipMemsetAsync(p.ws + WS_CTL, 0, 1 * MiB, stream);
        mega_launch(p, 0, 34, stream);
    } else naive_forward(p, stream);
}
```

```cpp
#include <hip/hip_runtime.h>
#include <cstdio>
#include <cstdint>
#include <cmath>

constexpr int DM = 1024, NB = 4, SEQ = 8192, DEPTH = 4, CTXL = 256;
constexpr int TL = NB * SEQ;
constexpr int TC = NB * CTXL;
constexpr int TT = TL + TC;
constexpr int NMOD = 6, DFF = 3584, NEXP = 8, QKVD = 1536, NH = 16, NKV = 4, HD = 64;
constexpr int FN1 = 128, FN2 = 64;
constexpr float EPS = 1e-6f;

constexpr size_t MiB = 1ull << 20;
constexpr size_t WS_CTL = 0;
constexpr size_t WS_MOD = 1 * MiB;
constexpr size_t WS_ROPE = 2 * MiB;
constexpr size_t WS_XC = 3 * MiB;
constexpr size_t WS_ROUTE = 8 * MiB;
constexpr size_t WS_S = 416 * MiB;

struct Prm {
    const float *x, *c, *ctx, *c_ctx, *ada_w, *ada_b, *nmg, *nfg, *fw, *wqkv, *wo, *sinks, *fg, *fu, *fd, *mr, *mg, *mu, *md, *fng;
    float* out; unsigned char* ws;
};

__device__ __forceinline__ float silu_f(float v) { return v / (1.f + expf(-v)); }
__device__ __forceinline__ int row_b5(int r) { return r < TL ? r / SEQ : 4; }
__device__ __forceinline__ float* xrow(const Prm& p, int r) { return r < TL ? p.out + (size_t)r * DM : (float*)(p.ws + WS_XC) + (size_t)(r - TL) * DM; }

__global__ void nk_adaln(Prm p) {
    const int idx = blockIdx.x * blockDim.x + threadIdx.x;
    if (idx >= DEPTH * 5 * NMOD * DM) return;
    const int n = idx % (NMOD * DM), r = (idx / (NMOD * DM)) % 5, l = idx / (5 * NMOD * DM);
    const float* cv = r < 4 ? p.c + r * DM : p.c_ctx;
    const float* w = p.ada_w + (size_t)l * DM * NMOD * DM;
    float acc = 0.f;
    for (int k = 0; k < DM; ++k) acc += silu_f(cv[k]) * w[(size_t)k * NMOD * DM + n];
    ((float*)(p.ws + WS_MOD))[idx] = acc + p.ada_b[l * NMOD * DM + n];
}
__global__ void nk_rope(Prm p) {
    const int idx = blockIdx.x * blockDim.x + threadIdx.x;
    if (idx >= 128 * 16) return;
    const int pos = idx / 16, f = idx % 16;
    const float inv = powf(10000.f, -(float)f / 16.f);
    const float ang = (float)pos * inv;
    ((float2*)(p.ws + WS_ROPE))[idx] = make_float2((float)cos((double)ang), (float)sin((double)ang));
}
__global__ void nk_norm_mod(Prm p, const float* g, int layer, int which  , float* H, int nrows) {
    const int r = blockIdx.x; if (r >= nrows) return;
    const float* xr = xrow(p, r);
    __shared__ float red[256];
    float s = 0.f;
    for (int c = threadIdx.x; c < DM; c += 256) { const float v = xr[c]; s += v * v; }
    red[threadIdx.x] = s; __syncthreads();
    for (int o = 128; o > 0; o >>= 1) { if (threadIdx.x < o) red[threadIdx.x] += red[threadIdx.x + o]; __syncthreads(); }
    const float rstd = rsqrtf(red[0] / DM + EPS);
    const float* mod = (const float*)(p.ws + WS_MOD) + ((size_t)layer * 5 + row_b5(r)) * NMOD * DM;
    for (int c = threadIdx.x; c < DM; c += 256) H[(size_t)r * DM + c] = xr[c] * rstd * g[c] * (1.f + mod[(which + 1) * DM + c]) + mod[which * DM + c];
}
__global__ void nk_final_norm(Prm p) {
    const int r = blockIdx.x;
    float* xr = p.out + (size_t)r * DM;
    __shared__ float red[256];
    float s = 0.f;
    for (int c = threadIdx.x; c < DM; c += 256) { const float v = xr[c]; s += v * v; }
    red[threadIdx.x] = s; __syncthreads();
    for (int o = 128; o > 0; o >>= 1) { if (threadIdx.x < o) red[threadIdx.x] += red[threadIdx.x + o]; __syncthreads(); }
    const float rstd = rsqrtf(red[0] / DM + EPS);
    for (int c = threadIdx.x; c < DM; c += 256) xr[c] = xr[c] * rstd * p.fng[c];
}
template <class FA, class FB, class FE>
__global__ void __launch_bounds__(256) nk_gemm(int M, int N, int K, FA fa, FB fb, FE fe) {
    __shared__ float As[16][68], Bs[16][68];
    const int m0 = blockIdx.y * 64, n0 = blockIdx.x * 64;
    if (m0 >= fa.rows()) return;
    const int t = threadIdx.x, tx = t % 16, ty = t / 16;
    float acc[4][4] = {};
    for (int k0 = 0; k0 < K; k0 += 16) {
        { const int m = t / 4, kq = (t % 4) * 4;
#pragma unroll
          for (int i = 0; i < 4; ++i) As[kq + i][m] = fa(m0 + m, k0 + kq + i); }
        { const int k = t / 16, nq = (t % 16) * 4;
#pragma unroll
          for (int i = 0; i < 4; ++i) Bs[k][nq + i] = fb(k0 + k, n0 + nq + i); }
        __syncthreads();
#pragma unroll
        for (int kk = 0; kk < 16; ++kk) {
            float a[4], b[4];
#pragma unroll
            for (int i = 0; i < 4; ++i) { a[i] = As[kk][ty * 4 + i]; b[i] = Bs[kk][tx * 4 + i]; }
#pragma unroll
            for (int i = 0; i < 4; ++i)
#pragma unroll
                for (int j = 0; j < 4; ++j) acc[i][j] += a[i] * b[j];
        }
        __syncthreads();
    }
#pragma unroll
    for (int i = 0; i < 4; ++i)
#pragma unroll
        for (int j = 0; j < 4; ++j) fe(m0 + ty * 4 + i, n0 + tx * 4 + j, acc[i][j]);
}
struct ADense { const float* A; int lda, M; __device__ int rows() const { return M; } __device__ float operator()(int m, int k) const { return m < M ? A[(size_t)m * lda + k] : 0.f; } };
struct BDense { const float* B; int ldb, pad; __device__ float operator()(int k, int n) const { return B[(size_t)k * ldb + n]; } };
struct EStore { float* C; int ldc, M; __device__ void operator()(int m, int n, float v) const { if (m < M) C[(size_t)m * ldc + n] = v; } };
struct ESilu { float* C; int ldc, M; __device__ void operator()(int m, int n, float v) const { if (m < M) C[(size_t)m * ldc + n] = silu_f(v); } };
struct EMulInto { float* C; int ldc, M; __device__ void operator()(int m, int n, float v) const { if (m < M) C[(size_t)m * ldc + n] *= v; } };
struct EResid { Prm p; int layer, which  , row0, M;
    __device__ void operator()(int m, int n, float v) const { if (m < M) { const int r = row0 + m; const float* mod = (const float*)(p.ws + WS_MOD) + ((size_t)layer * 5 + row_b5(r)) * NMOD * DM; xrow(p, r)[n] += mod[which * DM + n] * v; } } };
struct AGather { const float* H; const int* tok; const int* cnt; int r0, rmax; __device__ int rows() const { int c = *cnt - r0; return c < rmax ? c : rmax; }
    __device__ float operator()(int m, int k) const { return m < rows() ? H[(size_t)tok[r0 + m] * DM + k] : 0.f; } };
struct ADenseCnt { const float* A; const int* cnt; int lda, r0, rmax, pad; __device__ int rows() const { int c = *cnt - r0; return c < rmax ? c : rmax; }
    __device__ float operator()(int m, int k) const { return m < rows() ? A[(size_t)m * lda + k] : 0.f; } };
struct ESiluCnt { float* C; const int* cnt; int ldc, r0, rmax, pad; __device__ void operator()(int m, int n, float v) const { int c = *cnt - r0; c = c < rmax ? c : rmax; if (m < c) C[(size_t)m * ldc + n] = silu_f(v); } };
struct EMulCnt { float* C; const int* cnt; int ldc, r0, rmax, pad; __device__ void operator()(int m, int n, float v) const { int c = *cnt - r0; c = c < rmax ? c : rmax; if (m < c) C[(size_t)m * ldc + n] *= v; } };
struct EScatterY { float* Y0; float* Y1; const int* tok; const float* w; const int* kk; const int* cnt; int r0, rmax;
    __device__ void operator()(int m, int n, float v) const { int c = *cnt - r0; c = c < rmax ? c : rmax; if (m < c) { const int i = r0 + m; (kk[i] ? Y1 : Y0)[(size_t)tok[i] * DM + n] = w[i] * v; } } };

__global__ void nk_fft_s1(const float* H, int b, float2* Y1) {
    const size_t idx = (size_t)blockIdx.x * blockDim.x + threadIdx.x;
    const int ch = idx % DM, n2 = (idx / DM) % FN2, k1 = idx / ((size_t)DM * FN2);
    float re = 0.f, im = 0.f;
    for (int n1 = 0; n1 < FN1; ++n1) {
        const float v = H[((size_t)b * SEQ + n1 * FN2 + n2) * DM + ch];
        const int ph = (n1 * k1) % FN1; double s, c; sincospi(-2.0 * ph / FN1, &s, &c);
        re += v * (float)c; im += v * (float)s;
    }
    double s, c; sincospi(-2.0 * (double)(n2 * k1) / (FN1 * FN2), &s, &c);
    Y1[idx] = make_float2(re * (float)c - im * (float)s, re * (float)s + im * (float)c);
}
__global__ void nk_fft_s2(const float2* Y1, int b, float2* Z) {
    const size_t idx = (size_t)blockIdx.x * blockDim.x + threadIdx.x;
    const int ch = idx % DM, k1 = (idx / DM) % FN1, k2 = idx / ((size_t)DM * FN1);
    float re = 0.f, im = 0.f;
    for (int n2 = 0; n2 < FN2; ++n2) {
        const float2 v = Y1[((size_t)k1 * FN2 + n2) * DM + ch];
        const int ph = (n2 * k2) % FN2; double s, c; sincospi(-2.0 * ph / FN2, &s, &c);
        re += v.x * (float)c - v.y * (float)s; im += v.x * (float)s + v.y * (float)c;
    }
    Z[((size_t)b * SEQ + k1 + FN1 * k2) * DM + ch] = make_float2(re, im);
}
__global__ void nk_dft_ctx(const float* H, float2* Z) {
    const size_t idx = (size_t)blockIdx.x * blockDim.x + threadIdx.x;
    const int ch = idx % DM, k = (idx / DM) % CTXL, b = idx / ((size_t)DM * CTXL);
    float re = 0.f, im = 0.f;
    for (int n = 0; n < CTXL; ++n) {
        const float v = H[((size_t)TL + b * CTXL + n) * DM + ch];
        const int ph = (n * k) % CTXL; double s, c; sincospi(-2.0 * ph / CTXL, &s, &c);
        re += v * (float)c; im += v * (float)s;
    }
    Z[((size_t)TL + b * CTXL + k) * DM + ch] = make_float2(re, im);
}
__global__ void nk_chan_dft(const float2* Z, float* R) {
    const size_t idx = (size_t)blockIdx.x * blockDim.x + threadIdx.x;
    const int col = idx % DM, row = idx / DM, g = col / 256, q = col % 256;
    float acc = 0.f;
    for (int pp = 0; pp < 256; ++pp) {
        const float2 v = Z[(size_t)row * DM + g * 256 + pp];
        const int ph = (pp * q) % 256; double s, c; sincospi(2.0 * ph / 256, &s, &c);
        acc += v.x * (float)c + v.y * (float)s;
    }
    const float scale = row < TL ? 1.f / sqrtf((float)SEQ * 256.f) : 1.f / sqrtf((float)CTXL * 256.f);
    R[idx] = acc * scale;
}
__global__ void nk_rope_apply(Prm p, float* QKV) {
    const size_t idx = (size_t)blockIdx.x * blockDim.x + threadIdx.x;
    const int f = idx % 16, a = (idx / 16) % 2, hh = (idx / 32) % 20; const size_t row = idx / 640;
    if (row >= TL) return;
    const int t = row % SEQ, pos = a ? (t % 64) : (t / 64);
    const float2 cs = ((const float2*)(p.ws + WS_ROPE))[pos * 16 + f];
    float* base = QKV + row * QKVD + hh * 64 + a * 32;
    const float x1 = base[f], x2 = base[16 + f];
    base[f] = x1 * cs.x - x2 * cs.y; base[16 + f] = x2 * cs.x + x1 * cs.y;
}
__global__ void __launch_bounds__(64) nk_attn(Prm p, const float* QKV, const float* sinks, float* O, int nrows) {
    const size_t idx = (size_t)blockIdx.x * blockDim.x + threadIdx.x;
    const int h = idx % NH; const size_t row = idx / NH;
    if (row >= (size_t)nrows) return;
    const int kv = h / 4;
    float q[64], o[64];
#pragma unroll
    for (int d = 0; d < 64; ++d) { q[d] = QKV[row * QKVD + h * 64 + d] * 0.125f; o[d] = 0.f; }
    float m = sinks[h], l = 1.f;
    const bool lat = row < TL; const int b = lat ? row / SEQ : (row - TL) / CTXL; const int t = lat ? row % SEQ : 0;
    const int j0 = lat ? (t - 128 < 0 ? 0 : t - 128) : 0, j1 = lat ? (t + 128 > SEQ - 1 ? SEQ - 1 : t + 128) : -1;
    const int nlat = j1 - j0 + 1;
    for (int jj = 0; jj < nlat + CTXL; ++jj) {
        const size_t krow = jj < nlat ? (size_t)b * SEQ + j0 + jj : (size_t)TL + b * CTXL + (jj - nlat);
        const float* kp = QKV + krow * QKVD + 1024 + kv * 64; const float* vp = kp + 256;
        float s = 0.f;
#pragma unroll
        for (int d = 0; d < 64; ++d) s += q[d] * kp[d];
        if (s > m) { const float f = expf(m - s); l *= f;
#pragma unroll
            for (int d = 0; d < 64; ++d) o[d] *= f;
            m = s; }
        const float pe = expf(s - m); l += pe;
#pragma unroll
        for (int d = 0; d < 64; ++d) o[d] += pe * vp[d];
    }
    const float il = 1.f / l;
#pragma unroll
    for (int d = 0; d < 64; ++d) O[row * DM + h * 64 + d] = o[d] * il;
}
__global__ void nk_router(Prm p, const float* H, const float* wr, int nrows, int* cnt, int* ltok, float* lw, int* lk) {
    const int r = blockIdx.x * blockDim.x + threadIdx.x; if (r >= nrows) return;
    float lg[NEXP] = {};
    for (int k = 0; k < DM; ++k) { const float hv = H[(size_t)r * DM + k];
#pragma unroll
        for (int e = 0; e < NEXP; ++e) lg[e] += hv * wr[k * NEXP + e]; }
    int e0 = 0; float v0 = lg[0];
#pragma unroll
    for (int e = 1; e < NEXP; ++e) if (lg[e] > v0) { v0 = lg[e]; e0 = e; }
    int e1 = -1; float v1 = -INFINITY;
#pragma unroll
    for (int e = 0; e < NEXP; ++e) if (e != e0 && lg[e] > v1) { v1 = lg[e]; e1 = e; }
    const float g1 = 1.f / (1.f + expf(v0 - v1)), g0 = 1.f - g1;
    int i0 = atomicAdd(&cnt[e0], 1); ltok[e0 * TT + i0] = r; lw[e0 * TT + i0] = g0; lk[e0 * TT + i0] = 0;
    int i1 = atomicAdd(&cnt[e1], 1); ltok[e1 * TT + i1] = r; lw[e1 * TT + i1] = g1; lk[e1 * TT + i1] = 1;
}
__global__ void nk_moe_combine(Prm p, const float* Y0, const float* Y1, int layer, int nrows) {
    const size_t idx = (size_t)blockIdx.x * blockDim.x + threadIdx.x; const int n = idx % DM; const size_t r = idx / DM;
    if (r >= (size_t)nrows) return;
    const float* mod = (const float*)(p.ws + WS_MOD) + ((size_t)layer * 5 + row_b5((int)r)) * NMOD * DM;
    xrow(p, (int)r)[n] += mod[5 * DM + n] * (Y0[idx] + Y1[idx]);
}


#define GAS __attribute__((address_space(1)))
#define LAS __attribute__((address_space(3)))
typedef unsigned short bf16_t;
typedef short bf16x8 __attribute__((ext_vector_type(8)));
typedef short s16x4 __attribute__((ext_vector_type(4)));
typedef float f32x4 __attribute__((ext_vector_type(4)));
typedef float f32x16 __attribute__((ext_vector_type(16)));
typedef unsigned u32x4 __attribute__((ext_vector_type(4)));
typedef unsigned u32x2 __attribute__((ext_vector_type(2)));
typedef float f32x2 __attribute__((ext_vector_type(2)));

constexpr size_t WS_TAB = 13 * MiB;
constexpr size_t TAB_F1 = 0, TAB_F2 = 65536, TAB_TW = 131072, TAB_TWC = 196608;
constexpr size_t WS_W = 16 * MiB;
constexpr size_t WE_STRIDE = 25 * MiB, WE_F = 0, WE_GU = 4 * MiB, WE_D = 18 * MiB;
constexpr size_t WO_BASE = 50 * MiB, WO_STRIDE = 173 * MiB, WO_QKV = 0, WO_O = 3 * MiB, WO_EXP = 5 * MiB, WX_STRIDE = 21 * MiB, WX_GU = 0, WX_D = 14 * MiB;
constexpr size_t WS_MS = 416 * MiB;
constexpr size_t MS_HB = 0;
constexpr size_t MS_BIG = 66 * MiB;
constexpr size_t BIG_ACT = 0;
constexpr size_t BIG_Y1 = 0, BIG_Y1C = 128 * MiB, BIG_PQ = 136 * MiB;
constexpr size_t BIG_Q = 0, BIG_K = 66 * MiB, BIG_V = 83 * MiB, BIG_O = 100 * MiB;
constexpr size_t WS_MEGA_END = WS_MS + MS_BIG + 490 * MiB;
constexpr size_t WS_YS = WS_W + WO_BASE;
constexpr size_t WS_TOKSLOT = WS_ROUTE + 4352 * 1024;
constexpr int MAXBLK = 280;
constexpr int CW_BAR = 4096;
constexpr int CW_CNT = 1024;
constexpr int CW_CNTW = 65536;
constexpr int CW_SKF = 32768;
constexpr int CW_MCNT = 2048;
constexpr int LDS_BYTES = 147456;
constexpr int LDS_MISC = 146944;
constexpr float LOG2E = 1.4426950408889634f;

struct Args { Prm p; int ph_lo, ph_hi; };

__device__ __forceinline__ unsigned f2bf(float f) { unsigned u = __builtin_bit_cast(unsigned, f); return (u + 0x7fffu + ((u >> 16) & 1u)) >> 16; }
__device__ __forceinline__ unsigned pk2(float lo, float hi) { typedef float f2 __attribute__((ext_vector_type(2))); typedef __bf16 b2 __attribute__((ext_vector_type(2))); f2 v = {lo, hi}; b2 b = __builtin_convertvector(v, b2); return __builtin_bit_cast(unsigned, b); }
#define SWZ_XOR(v, m) __builtin_bit_cast(float, __builtin_amdgcn_ds_swizzle(__builtin_bit_cast(int, (v)), ((m) << 10) | 0x1f))
__device__ __forceinline__ float xor32(float v, bool lower) { unsigned a = __builtin_bit_cast(unsigned, v), b = a; asm volatile("" : "+v"(b));
    auto rr = __builtin_amdgcn_permlane32_swap(a, b, false, false); return __builtin_bit_cast(float, lower ? rr[1] : rr[0]); }
__device__ __forceinline__ float wave_sum(float v) {
    v += SWZ_XOR(v, 1); v += SWZ_XOR(v, 2); v += SWZ_XOR(v, 4); v += SWZ_XOR(v, 8); v += SWZ_XOR(v, 16);
    return __builtin_bit_cast(float, __builtin_amdgcn_readlane(__builtin_bit_cast(int, v), 0)) + __builtin_bit_cast(float, __builtin_amdgcn_readlane(__builtin_bit_cast(int, v), 32));
}
__device__ __forceinline__ float fast_silu(float v) { return v * __builtin_amdgcn_rcpf(1.f + __builtin_amdgcn_exp2f(-v * LOG2E)); }

#define XB_TMO      128
#define XB_XCNT(j)  (256  + 64 * (j))
#define XB_XSUB(j)  (1280 + 64 * (j))
#define XB_XGEN(j)  (2304 + 64 * (j))
#define XB_TOP      3328
#define XB_TOPGEN   3392
#define XCD_BAR_WORDS 3456
#define XB_SPIN_CAP (1u << 18)
__device__ __forceinline__ unsigned xb_ld(unsigned* p)              { return __hip_atomic_load(p, __ATOMIC_RELAXED, __HIP_MEMORY_SCOPE_AGENT); }
__device__ __forceinline__ unsigned xb_add(unsigned* p, unsigned v) { return __hip_atomic_fetch_add(p, v, __ATOMIC_RELAXED, __HIP_MEMORY_SCOPE_AGENT); }
__device__ __forceinline__ unsigned xb_xcc_id() { return (unsigned)__builtin_amdgcn_s_getreg((3 << 11) | 20) & 0xFu; }
#define XB_SPIN(cond, bar) do { unsigned _sp = 0; while (cond) { __builtin_amdgcn_s_sleep(1); \
    if ((++_sp & 255u) == 0u) { if (xb_ld(&(bar)[XB_TMO])) break; if (_sp > XB_SPIN_CAP) { atomicAdd(&(bar)[XB_TMO], 1u); break; } } } } while (0)
struct XcdBarrier { unsigned* bar; unsigned x; volatile LAS unsigned* st; };
__device__ __forceinline__ XcdBarrier xcd_barrier_post(unsigned* bar, volatile LAS unsigned* st) {
    XcdBarrier b; b.bar = bar; b.x = xb_xcc_id(); b.st = st;
    if (threadIdx.x == 0) (void)xb_add(&bar[XB_XCNT(b.x)], 1u);
    return b;
}
__device__ __forceinline__ void xcd_barrier_complete(unsigned* bar, unsigned x, unsigned& nloc, unsigned& nx) {
    const unsigned G = gridDim.x * gridDim.y * gridDim.z;
    unsigned sum, cnt, mine, sp = 0u;
    for (;;) {
        sum = 0u; cnt = 0u; mine = 0u;
#pragma unroll
        for (unsigned j = 0; j < 16; ++j) { const unsigned c = xb_ld(&bar[XB_XCNT(j)]); sum += c; cnt += (c > 0u) ? 1u : 0u; mine = (j == x) ? c : mine; }
        if (sum == G) break;
        __builtin_amdgcn_s_sleep(1);
        if ((++sp & 255u) == 0u) { if (xb_ld(&bar[XB_TMO])) break; if (sp > XB_SPIN_CAP) { atomicAdd(&bar[XB_TMO], 1u); break; } }
    }
    nloc = mine > 0u ? mine : 1u; nx = cnt > 0u ? cnt : 1u;
}
__device__ __forceinline__ void xcd_barrier(const XcdBarrier& b) {
    asm volatile("s_waitcnt vmcnt(0)" ::: "memory");
    __syncthreads();
    if (threadIdx.x == 0) {
        unsigned* bar = b.bar;
        __builtin_amdgcn_s_waitcnt(0);
        unsigned nloc = b.st[0], nx = b.st[1];
        if (nloc == 0u) { xcd_barrier_complete(bar, b.x, nloc, nx); b.st[0] = nloc; b.st[1] = nx; }
        const unsigned old = xb_add(&bar[XB_XSUB(b.x)], 1u);
        const unsigned gen = old / nloc;
        if (old + 1u == (gen + 1u) * nloc) {
            __builtin_amdgcn_fence(__ATOMIC_RELEASE, "agent");
            asm volatile("s_waitcnt vmcnt(0)" ::: "memory");
            const unsigned og = xb_add(&bar[XB_TOP], 1u);
            const unsigned tg = og / nx;
            if (og + 1u == (tg + 1u) * nx) xb_add(&bar[XB_TOPGEN], 1u);
            else XB_SPIN(xb_ld(&bar[XB_TOPGEN]) == tg, bar);
            __builtin_amdgcn_fence(__ATOMIC_ACQUIRE, "agent");
            xb_add(&bar[XB_XGEN(b.x)], 1u);
            asm volatile("s_waitcnt vmcnt(0)" ::: "memory");
        } else {
            XB_SPIN(xb_ld(&bar[XB_XGEN(b.x)]) == gen, bar);
            __builtin_amdgcn_fence(__ATOMIC_ACQUIRE, "agent");
            asm volatile("s_waitcnt vmcnt(0)" ::: "memory");
        }
    }
    __syncthreads();
}

namespace pg8 {
constexpr int BM = 256, BK = 64, HALF = 128, HTB = HALF * BK * 2, STAGE_BYTES = 8 * HTB, NXCD = 8, WGM = 4;
__device__ __forceinline__ int lds_byte(int r, int c) { const int st = (r >> 4) * 2 + (c >> 5), rr = r & 15, cc = c & 31, ob = rr * 64 + cc * 2; return st * 1024 + (ob ^ (((ob >> 9) & 1) << 5)); }
__device__ __forceinline__ void stage_rc(int b, int& R, int& C) { const int st = b / 1024, sb = b % 1024, swz = sb ^ (((sb >> 9) & 1) << 5); R = (st >> 1) * 16 + swz / 64; C = (st & 1) * 32 + (swz % 64) / 2; }
__device__ __forceinline__ int perm32(int rho) { const int n = rho >> 4, i = rho & 15; return 8 * (i >> 2) + 4 * n + (i & 3); }
struct Unit { int pm, pn, g, first, cnt, kofs, nt, flags, np, part, qmask; };
__device__ __forceinline__ bool static_next(int nM, int nN, int G, int c, int i, Unit& u) {
    const int nwg = nM * nN; const long L = (long)i * G + c; const bool ok = L < nwg;
    int wgid = ok ? (int)L : nwg - 1; { const int q = nwg / NXCD, r = nwg % NXCD, xcd = wgid % NXCD, off = wgid / NXCD; wgid = (xcd < r ? xcd * (q + 1) : r * (q + 1) + (xcd - r) * q) + off; }
    const int nig = WGM * nN, gid = wgid / nig, fm = gid * WGM, gsz = (nM - fm) < WGM ? (nM - fm) : WGM;
    u.pm = fm + ((wgid % nig) % gsz); u.pn = (wgid % nig) / gsz; return ok;
}
__device__ __forceinline__ bool sk_next(int nM, int nN, int nt2, int G, int c, int i, int pmax, Unit& u) {
    const int nwg = nM * nN, nfull = nwg / G, R = nwg - nfull * G;
    int P = 1; if (R > 0) { if (R * 8 <= G && pmax >= 8) P = 8; else if (R * 4 <= G && pmax >= 4) P = 4; else if (R * 2 <= G && pmax >= 2) P = 2; }
    const bool tail = (i >= nfull);
    const int x = c % NXCD, rho = c / NXCD, jj = rho / P, p = rho % P, j = jj * NXCD + x;
    const long L = tail ? (long)nfull * G + (j < R ? j : 0) : (long)i * G + c;
    int wgid = (int)(L < nwg ? L : nwg - 1); { const int q = nwg / NXCD, r = nwg % NXCD, xcd = wgid % NXCD, off = wgid / NXCD; wgid = (xcd < r ? xcd * (q + 1) : r * (q + 1) + (xcd - r) * q) + off; }
    const int nig = WGM * nN, gid = wgid / nig, fm = gid * WGM, gsz = (nM - fm) < WGM ? (nM - fm) : WGM;
    u.pm = fm + ((wgid % nig) % gsz); u.pn = (wgid % nig) / gsz;
    const int lo = tail ? p * nt2 / P : 0, hi = tail ? (p + 1) * nt2 / P : nt2;
    u.kofs = lo * 2 * BK * 2; u.nt = (hi - lo) * 2; u.flags = (tail && P > 1) ? 1 : 0; u.np = P; u.part = p;
    u.qmask = (tail && P > 1) ? (P == 4 ? (1 << p) : P == 2 ? (5 << p) : 0xF) : 0xF;
    return tail ? (i == nfull && j < R) : true;
}
struct SkCtl { f32x4* slots; unsigned* flag; unsigned* tmo; unsigned epoch; int c, G; };
template <class Epi, class Sched, bool GATHER>
__device__ __forceinline__ void gemm_phase(LAS unsigned char* lds, const int tid_in, const bf16_t* Aptr, const int K, const Sched& S, const Epi& E, const SkCtl sk = SkCtl{}) {
    int tid = tid_in; asm volatile("" : "+v"(tid));
    const int wid = __builtin_amdgcn_readfirstlane(tid >> 6), lane = tid & 63, wr = wid >> 2, wc = wid & 3, fr = lane & 15, fq = lane >> 4;
    int RA[2], CA[2]; unsigned voffA[2], voffB[2];
#pragma unroll
    for (int i = 0; i < 2; ++i) { int R, C; stage_rc(tid * 16 + i * 8192, R, C); const int Rb = Epi::PERM ? ((R & ~31) + perm32(R & 31)) : R; RA[i] = R; CA[i] = C; voffA[i] = (unsigned)(R * K + C) * 2u; voffB[i] = (unsigned)(Rb * K + C) * 2u; }
    const size_t kstep = (size_t)(BK * 2);
    const size_t hstep = (size_t)HALF * K * 2;
    const unsigned ldsw = (unsigned)wid * 1024u;
    const int aoff = lds_byte(wr * 64 + fr, fq * 8), boff = lds_byte(wc * 32 + fr, fq * 8);
    const char* const cAb = (const char*)Aptr;
#define PG8_SA(b, h) (((b) * 2 + (h)) * HTB)
#define PG8_SB(b, h) ((4 + (b) * 2 + (h)) * HTB)
#define PG8_STAGE(bufoff, gbase, voff) do { _Pragma("unroll") for (int _i = 0; _i < 2; ++_i) \
        __builtin_amdgcn_global_load_lds((const unsigned*)((const char*)(gbase) + (voff)[_i]), (LAS unsigned*)(lds + (bufoff) + ldsw + _i * 8192), 16, 0, 0); } while (0)
#define PG8_STAGEA(bufoff, vo, h, kb) do { _Pragma("unroll") for (int _i = 0; _i < 2; ++_i) { \
        if constexpr (GATHER) __builtin_amdgcn_global_load_lds((const unsigned*)(cAb + (size_t)(vo)[h][_i] + (size_t)(kb)), (LAS unsigned*)(lds + (bufoff) + ldsw + _i * 8192), 16, 0, 0); \
        else __builtin_amdgcn_global_load_lds((const unsigned*)(cAb + s##vo + (size_t)(h) * hstep + (size_t)(kb) + voffA[_i]), (LAS unsigned*)(lds + (bufoff) + ldsw + _i * 8192), 16, 0, 0); } } while (0)
#define PG8_LDA(dst, b, h) do { _Pragma("unroll") for (int m = 0; m < 4; ++m) _Pragma("unroll") for (int k = 0; k < 2; ++k) dst[m][k] = *(const LAS bf16x8*)(lds + PG8_SA(b, h) + aoff + m * 2048 + k * 1024); } while (0)
#define PG8_LDB(dst, b, h) do { _Pragma("unroll") for (int n = 0; n < 2; ++n) _Pragma("unroll") for (int k = 0; k < 2; ++k) dst[n][k] = *(const LAS bf16x8*)(lds + PG8_SB(b, h) + boff + n * 2048 + k * 1024); } while (0)
#define PG8_MMA(ai, bj, At, Bt) do { __builtin_amdgcn_s_setprio(1); _Pragma("unroll") for (int m = 0; m < 4; ++m) _Pragma("unroll") for (int n = 0; n < 2; ++n) _Pragma("unroll") for (int k = 0; k < 2; ++k) \
        acc[ai][bj][m][n] = __builtin_amdgcn_mfma_f32_16x16x32_bf16(Bt[n][k], At[m][k], acc[ai][bj][m][n], 0, 0, 0); __builtin_amdgcn_s_setprio(0); } while (0)
#define PG8_WAIT_V(n) asm volatile("s_waitcnt vmcnt(" #n ")" ::: "memory")
#define PG8_WAIT_L(n) asm volatile("s_waitcnt lgkmcnt(" #n ")" ::: "memory")
#define PG8_BAR __builtin_amdgcn_s_barrier()
#define PG8_SCHED __builtin_amdgcn_sched_barrier(0)
#define PG8_AOFFS(vo, u) do { if constexpr (GATHER) { _Pragma("unroll") for (int _h = 0; _h < 2; ++_h) _Pragma("unroll") for (int _i = 0; _i < 2; ++_i) \
        (vo)[_h][_i] = (unsigned)(((size_t)S.a_row(u, _h * HALF + RA[_i]) * (size_t)K + (size_t)CA[_i]) * 2u) + (unsigned)(u).kofs; } else { s##vo = (size_t)S.a_row(u, 0) * (size_t)K * 2u + (size_t)(u).kofs; } } while (0)
    Unit cur, nxt; int ui = 0;
    if (!S.next(0, cur)) return;
    f32x4 acc[2][2][4][2];
#pragma unroll
    for (int a = 0; a < 2; ++a)
#pragma unroll
        for (int b = 0; b < 2; ++b)
#pragma unroll
            for (int m = 0; m < 4; ++m)
#pragma unroll
                for (int n = 0; n < 2; ++n) acc[a][b][m][n] = (f32x4){0.f, 0.f, 0.f, 0.f};
    bf16x8 At[4][2], B0[2][2], B1[2][2];
    unsigned vA[2][2], vN[2][2];
    size_t svA = 0, svN = 0;
    PG8_AOFFS(vA, cur);
    const char* cB = S.b_ptr(cur) + cur.kofs;
    PG8_STAGE(PG8_SB(0, 0), cB, voffB); PG8_STAGE(PG8_SB(0, 1), cB + hstep, voffB); PG8_STAGEA(PG8_SA(0, 0), vA, 0, 0); PG8_STAGEA(PG8_SA(0, 1), vA, 1, 0);
    if (wr == 1) PG8_BAR;
    PG8_WAIT_V(2); PG8_BAR;
    PG8_STAGE(PG8_SB(1, 0), cB + kstep, voffB); PG8_STAGEA(PG8_SA(1, 0), vA, 0, kstep); PG8_STAGE(PG8_SB(1, 1), cB + hstep + kstep, voffB);
    PG8_WAIT_V(6); PG8_BAR;
    for (;;) {
        const bool has_next = S.next(ui + 1, nxt);
        const char* nB = has_next ? S.b_ptr(nxt) + nxt.kofs : cB;
        const int nt = cur.nt;
        if (has_next) { PG8_AOFFS(vN, nxt); } else { svN = svA;
#pragma unroll
            for (int _h = 0; _h < 2; ++_h)
#pragma unroll
                for (int _i = 0; _i < 2; ++_i) vN[_h][_i] = vA[_h][_i]; }
        if constexpr (GATHER) { *(LAS u32x4*)(lds + STAGE_BYTES + tid * 16) = (u32x4){vN[0][0], vN[0][1], vN[1][0], vN[1][1]}; }
        for (int t = 0; t < nt; t += 2) {
            const bool last = (t == nt - 2);
            const size_t k1 = (size_t)(t + 1) * kstep;
            const size_t k2 = last ? 0 : (size_t)(t + 2) * kstep, k3 = k2 + kstep;
            const char* b2 = last ? nB : cB + (size_t)(t + 2) * kstep; const char* b3 = b2 + kstep;
            unsigned v2[2][2]; const size_t sv2 = last ? svN : svA;
            if constexpr (GATHER) {
#pragma unroll
                for (int _h = 0; _h < 2; ++_h)
#pragma unroll
                    for (int _i = 0; _i < 2; ++_i) v2[_h][_i] = vA[_h][_i];
                if (last) { const u32x4 q = *(const LAS u32x4*)(lds + STAGE_BYTES + tid * 16); v2[0][0] = q.x; v2[0][1] = q.y; v2[1][0] = q.z; v2[1][1] = q.w; } }
            PG8_LDB(B0, 0, 0); PG8_LDB(B1, 0, 1); PG8_SCHED; PG8_LDA(At, 0, 0); PG8_STAGEA(PG8_SA(1, 1), vA, 1, k1);
            PG8_WAIT_V(8); PG8_WAIT_L(0); PG8_BAR; PG8_MMA(0, 0, At, B0); PG8_MMA(0, 1, At, B1); PG8_BAR; PG8_SCHED;
            PG8_LDA(At, 0, 1); PG8_STAGE(PG8_SB(0, 0), b2, voffB); PG8_STAGE(PG8_SB(0, 1), b2 + hstep, voffB); PG8_STAGEA(PG8_SA(0, 0), v2, 0, k2);
            PG8_WAIT_V(8); PG8_WAIT_L(0); PG8_BAR; PG8_MMA(1, 0, At, B0); PG8_MMA(1, 1, At, B1); PG8_BAR; PG8_SCHED;
            PG8_LDB(B0, 1, 0); PG8_LDB(B1, 1, 1); PG8_SCHED; PG8_LDA(At, 1, 0); PG8_STAGEA(PG8_SA(0, 1), v2, 1, k2);
            PG8_WAIT_V(8); PG8_WAIT_L(0); PG8_BAR; PG8_MMA(0, 0, At, B0); PG8_MMA(0, 1, At, B1); PG8_BAR; PG8_SCHED;
            PG8_LDA(At, 1, 1); PG8_STAGE(PG8_SB(1, 0), b3, voffB); PG8_STAGE(PG8_SB(1, 1), b3 + hstep, voffB); PG8_STAGEA(PG8_SA(1, 0), v2, 0, k3);
            PG8_WAIT_V(8); PG8_WAIT_L(0); PG8_BAR; PG8_MMA(1, 0, At, B0); PG8_MMA(1, 1, At, B1); PG8_BAR; PG8_SCHED;
        }
        if (wr == 0) PG8_BAR;
        if (cur.flags & 1) {
            const int P = cur.np, p = cur.part, c0 = sk.c - NXCD * p;
            int tl; asm volatile("v_mbcnt_lo_u32_b32 %0, -1, 0\n\tv_mbcnt_hi_u32_b32 %0, -1, %0" : "=v"(tl));
            const int tid = wid * 64 + tl;
            const __amdgpu_buffer_rsrc_t rs = __builtin_amdgcn_make_buffer_rsrc((void*)sk.slots, 0, (int)(sk.G * 32 * 512 * 16), 0x00020000);
            const unsigned so = (unsigned)((sk.c * (32 * 512) + tid) * 16);
#pragma unroll
            for (int a = 0; a < 2; ++a)
#pragma unroll
                for (int b = 0; b < 2; ++b) if (!((cur.qmask >> (a * 2 + b)) & 1)) {
#pragma unroll
                    for (int m = 0; m < 4; ++m)
#pragma unroll
                        for (int n = 0; n < 2; ++n) __builtin_amdgcn_raw_buffer_store_b128(__builtin_bit_cast(u32x4, acc[a][b][m][n]), rs, so + (unsigned)((((a * 2 + b) * 4 + m) * 2 + n) * 512 * 16), 0, 16); }
            PG8_WAIT_V(0); PG8_BAR; asm volatile("" ::: "memory");
            if (tid == 0) __hip_atomic_store(sk.flag + 64 * sk.c, sk.epoch, __ATOMIC_RELAXED, __HIP_MEMORY_SCOPE_AGENT);
            if (tid < 64) {
                for (int q = 0; q < P; ++q) if (q != p) { const int pc = c0 + NXCD * q; unsigned sp = 0;
                    while ((unsigned)__builtin_amdgcn_readfirstlane(__hip_atomic_load(sk.flag + 64 * pc, __ATOMIC_RELAXED, __HIP_MEMORY_SCOPE_AGENT)) != sk.epoch) { __builtin_amdgcn_s_sleep(1);
                        if ((++sp & 255u) == 0u) { if (__hip_atomic_load(sk.tmo, __ATOMIC_RELAXED, __HIP_MEMORY_SCOPE_AGENT)) break; if (sp > (1u << 20)) { if (tid == 0) atomicAdd(sk.tmo, 1u); break; } } } }
                __builtin_amdgcn_fence(__ATOMIC_ACQUIRE, "agent"); PG8_WAIT_V(0); }
            asm volatile("" ::: "memory"); PG8_BAR; asm volatile("" ::: "memory");
#pragma unroll
            for (int a = 0; a < 2; ++a)
#pragma unroll
                for (int b = 0; b < 2; ++b) if ((cur.qmask >> (a * 2 + b)) & 1) {
                    for (int q = 0; q < P; ++q) if (q != p) {
                        const GAS f32x4* sl = (const GAS f32x4*)sk.slots + (size_t)(c0 + NXCD * q) * (32 * 512) + (size_t)((a * 2 + b) * 8) * 512 + tid;
#pragma unroll
                        for (int h4 = 0; h4 < 2; ++h4) { f32x4 pv[4];
#pragma unroll
                            for (int v4 = 0; v4 < 4; ++v4) pv[v4] = sl[(h4 * 4 + v4) * 512];
#pragma unroll
                            for (int v4 = 0; v4 < 4; ++v4) acc[a][b][h4 * 2 + (v4 >> 1)][v4 & 1] += pv[v4]; } } }
        }
        { int fr_ = fr, fq_ = fq; asm volatile("" : "+v"(fr_), "+v"(fq_));
          E(acc, cur, wr, wc, fr_, fq_); }
        if (!has_next) break;
#pragma unroll
        for (int a = 0; a < 2; ++a)
#pragma unroll
            for (int b = 0; b < 2; ++b)
#pragma unroll
                for (int m = 0; m < 4; ++m)
#pragma unroll
                    for (int n = 0; n < 2; ++n) acc[a][b][m][n] = (f32x4){0.f, 0.f, 0.f, 0.f};
        cur = nxt; cB = nB; ++ui; svA = svN;
        if constexpr (GATHER) { const u32x4 q = *(const LAS u32x4*)(lds + STAGE_BYTES + tid * 16); vA[0][0] = q.x; vA[0][1] = q.y; vA[1][0] = q.z; vA[1][1] = q.w; }
        if (wr == 1) PG8_BAR;
    }
    PG8_WAIT_V(0);
    PG8_BAR;
#undef PG8_SA
#undef PG8_SB
#undef PG8_STAGE
#undef PG8_STAGEA
#undef PG8_LDA
#undef PG8_LDB
#undef PG8_MMA
#undef PG8_WAIT_V
#undef PG8_WAIT_L
#undef PG8_BAR
#undef PG8_SCHED
#undef PG8_AOFFS
}
}


template <bool SK>
struct SchedDense {
    const bf16_t* Bt; int nM, nN, G, c, K;
    __device__ __forceinline__ bool next(int i, pg8::Unit& u) const { u.g = 0; u.first = 0; u.cnt = 0;
        if constexpr (SK) return pg8::sk_next(nM, nN, K / 128, G, c, i, 4, u);
        else { u.kofs = 0; u.nt = K / 64; u.flags = 0; u.np = 1; u.part = 0; u.qmask = 0xF; return pg8::static_next(nM, nN, G, c, i, u); } }
    __device__ __forceinline__ const char* b_ptr(const pg8::Unit& u) const { return (const char*)Bt + (size_t)u.pn * 256 * K * 2; }
    __device__ __forceinline__ int a_row(const pg8::Unit& u, int r) const { return u.pm * 256 + r; }
};
struct MoeTab { volatile LAS unsigned* T;
    __device__ __forceinline__ int group_of(int blk) const { int g = 0;
#pragma unroll
        for (int j = 1; j < 16; ++j) g += (blk >= (int)T[16 + j]) ? 1 : 0; return g; }
};
template <bool GATHER, bool SK>
struct SchedMoe {
    const bf16_t* Wbase; size_t wx_stride; int nN, G, c, K, blk0, nblk; MoeTab tab; const int* ltok;
    __device__ __forceinline__ bool next(int i, pg8::Unit& u) const { bool ok;
        if constexpr (SK) ok = pg8::sk_next(nblk, nN, K / 128, G, c, i, 4, u); else { u.kofs = 0; u.nt = K / 64; u.flags = 0; u.np = 1; u.part = 0; u.qmask = 0xF; ok = pg8::static_next(nblk, nN, G, c, i, u); }
        u.pm += blk0;
        const int g = __builtin_amdgcn_readfirstlane(tab.group_of(u.pm)); u.g = g; u.first = __builtin_amdgcn_readfirstlane((int)tab.T[16 + g]); u.cnt = __builtin_amdgcn_readfirstlane((int)tab.T[32 + g]); return ok; }
    __device__ __forceinline__ const char* b_ptr(const pg8::Unit& u) const { return (const char*)Wbase + (size_t)(u.g & 7) * wx_stride + (size_t)u.pn * 256 * K * 2; }
    __device__ __forceinline__ int a_row(const pg8::Unit& u, int r) const {
        if (!GATHER) return u.pm * 256 + r;
        const int local = (u.pm - u.first) * 256 + r;
        return ltok[(size_t)u.g * TT + (local < u.cnt ? local : u.cnt - 1)]; }
};

struct EpiResid {
    static constexpr bool PERM = false;
    const float* xin_l; const float* xin_c; float* xout_l; float* xout_c; const float* mod; int which; float rs;
    __device__ __forceinline__ void operator()(const f32x4 (&acc)[2][2][4][2], const pg8::Unit& u, int wr, int wc, int fr, int fq) const {
        const bool lat = u.pm < TL / 256; const int b5 = lat ? u.pm / 32 : 4;
        const size_t rbase = (size_t)(lat ? u.pm : u.pm - TL / 256) * 256 + wr * 64 + fr;
        const float* xi = (lat ? xin_l : xin_c); float* xo = (lat ? xout_l : xout_c);
        const int col0 = u.pn * 256 + wc * 32 + 4 * fq;
        const float* gp = mod + (size_t)b5 * NMOD * DM + which * DM + col0;
        f32x4 gv[2][2];
#pragma unroll
        for (int bj = 0; bj < 2; ++bj)
#pragma unroll
            for (int n = 0; n < 2; ++n) gv[bj][n] = *(const f32x4*)(gp + bj * 128 + n * 16) * rs;
#pragma unroll
        for (int ai = 0; ai < 2; ++ai) { const size_t off0 = (rbase + ai * 128) * DM + col0;
            if (u.qmask == 0xF) { f32x4 xv[4][2][2];
#pragma unroll
                for (int m = 0; m < 4; ++m)
#pragma unroll
                    for (int bj = 0; bj < 2; ++bj)
#pragma unroll
                        for (int n = 0; n < 2; ++n) xv[m][bj][n] = *(const f32x4*)(xi + off0 + (size_t)m * 16 * DM + bj * 128 + n * 16);
#pragma unroll
                for (int m = 0; m < 4; ++m)
#pragma unroll
                    for (int bj = 0; bj < 2; ++bj)
#pragma unroll
                        for (int n = 0; n < 2; ++n) *(f32x4*)(xo + off0 + (size_t)m * 16 * DM + bj * 128 + n * 16) = xv[m][bj][n] + gv[bj][n] * acc[ai][bj][m][n];
            } else {
#pragma unroll
                for (int bj = 0; bj < 2; ++bj) if ((u.qmask >> (ai * 2 + bj)) & 1) { f32x4 xv[4][2];
#pragma unroll
                    for (int m = 0; m < 4; ++m)
#pragma unroll
                        for (int n = 0; n < 2; ++n) xv[m][n] = *(const f32x4*)(xi + off0 + (size_t)m * 16 * DM + bj * 128 + n * 16);
#pragma unroll
                    for (int m = 0; m < 4; ++m)
#pragma unroll
                        for (int n = 0; n < 2; ++n) *(f32x4*)(xo + off0 + (size_t)m * 16 * DM + bj * 128 + n * 16) = xv[m][n] + gv[bj][n] * acc[ai][bj][m][n]; } }
            asm volatile("" ::: "memory"); }
    }
};
struct EpiSwiglu {
    static constexpr bool PERM = true;
    bf16_t* act;
    __device__ __forceinline__ void operator()(const f32x4 (&acc)[2][2][4][2], const pg8::Unit& u, int wr, int wc, int fr, int fq) const {
        const size_t row0 = (size_t)u.pm * 256 + wr * 64 + fr; const int col0 = u.pn * 128 + wc * 32 + 8 * fq;
#pragma unroll
        for (int ai = 0; ai < 2; ++ai)
#pragma unroll
            for (int m = 0; m < 4; ++m) {
                const f32x4 g0 = acc[ai][0][m][0], g1 = acc[ai][0][m][1], u0 = acc[ai][1][m][0], u1 = acc[ai][1][m][1];
                u32x4 w;
                w.x = pk2(fast_silu(g0[0]) * u0[0], fast_silu(g0[1]) * u0[1]); w.y = pk2(fast_silu(g0[2]) * u0[2], fast_silu(g0[3]) * u0[3]);
                w.z = pk2(fast_silu(g1[0]) * u1[0], fast_silu(g1[1]) * u1[1]); w.w = pk2(fast_silu(g1[2]) * u1[2], fast_silu(g1[3]) * u1[3]);
                *(u32x4*)(act + (row0 + ai * 128 + m * 16) * DFF + col0) = w; }
    }
};
struct EpiQKV {
    static constexpr bool PERM = true;
    bf16_t *QB, *KB, *VB; const float2* rope;
    __device__ __forceinline__ void operator()(const f32x4 (&acc)[2][2][4][2], const pg8::Unit& u, int wr, int wc, int fr, int fq) const {
        const bool lat = u.pm < TL / 256; const int row0 = u.pm * 256 + wr * 64 + fr;
        const bool dorope = lat && u.pn < 5; const float qs = u.pn < 4 ? 0.125f * LOG2E : 1.f;
        const size_t doff = u.pn < 4 ? (size_t)0 : (u.pn == 4 ? (size_t)((BIG_K - BIG_Q) / 2) : (size_t)((BIG_V - BIG_Q) / 2));
        bf16_t* dst = QB + doff; const int ld = u.pn < 4 ? DM : 256, colt = u.pn < 4 ? u.pn * 256 : 0;
        const int a = wc & 1, f0 = 8 * (fq & 1); const float sg = (fq < 2) ? -1.f : 1.f;
#pragma unroll
        for (int ai = 0; ai < 2; ++ai) { f32x4 cs[4][4];
            if (dorope) {
#pragma unroll
                for (int m = 0; m < 4; ++m) { const int r = row0 + ai * 128 + m * 16; const int t = r & (SEQ - 1); const int pos = a ? (t & 63) : (t >> 6);
                    const f32x4* csp = (const f32x4*)(rope + pos * 16 + f0);
#pragma unroll
                    for (int q4 = 0; q4 < 4; ++q4) cs[m][q4] = csp[q4]; } }
#pragma unroll
            for (int m = 0; m < 4; ++m) { const int r = row0 + ai * 128 + m * 16;
#pragma unroll
                for (int bj = 0; bj < 2; ++bj) if ((u.qmask >> (ai * 2 + bj)) & 1) { f32x4 v[2];
#pragma unroll
                    for (int n = 0; n < 2; ++n) { v[n] = acc[ai][bj][m][n];
                        if (dorope) { const f32x4 c01 = cs[m][2 * n], c23 = cs[m][2 * n + 1];
#pragma unroll
                            for (int j = 0; j < 4; ++j) { const float pr = xor32(v[n][j], fq < 2); const float c = (j < 2 ? c01 : c23)[2 * (j & 1)], sn = (j < 2 ? c01 : c23)[2 * (j & 1) + 1]; v[n][j] = v[n][j] * c + sg * pr * sn; } }
                        v[n] = v[n] * qs; }
                    u32x4 w; w.x = pk2(v[0][0], v[0][1]); w.y = pk2(v[0][2], v[0][3]); w.z = pk2(v[1][0], v[1][1]); w.w = pk2(v[1][2], v[1][3]);
                    *(u32x4*)(dst + (size_t)r * ld + colt + bj * 128 + wc * 32 + 8 * fq) = w; } }
            asm volatile("" ::: "memory"); }
    }
};
struct EpiMoeDown {
    static constexpr bool PERM = false;
    float* xl; float* xc; const float* mod; const int* ltok; const float* lw; float rs;
    __device__ __forceinline__ void operator()(const f32x4 (&acc)[2][2][4][2], const pg8::Unit& u, int wr, int wc, int fr, int fq) const {
        const int g = u.g; const int lbase = (u.pm - u.first) * 256 + wr * 64 + fr; const int cnt = u.cnt;
        const int col0 = u.pn * 256 + wc * 32 + 4 * fq;
        int tokv[2][4]; float wv[2][4];
#pragma unroll
        for (int ai = 0; ai < 2; ++ai)
#pragma unroll
            for (int m = 0; m < 4; ++m) { const int local = lbase + ai * 128 + m * 16, li = local < cnt ? local : cnt - 1; tokv[ai][m] = ltok[(size_t)g * TT + li]; wv[ai][m] = lw[(size_t)g * TT + li] * rs; }
        const int b50 = tokv[0][0] < TL ? tokv[0][0] / SEQ : 4;
        f32x4 gv[2][2];
#pragma unroll
        for (int bj = 0; bj < 2; ++bj)
#pragma unroll
            for (int n = 0; n < 2; ++n) gv[bj][n] = *(const f32x4*)(mod + (size_t)b50 * NMOD * DM + 5 * DM + col0 + bj * 128 + n * 16);
#pragma unroll
        for (int am = 0; am < 4; ++am) { const int ai = am >> 1; f32x4 xv[2][2][2];
#pragma unroll
            for (int mm = 0; mm < 2; ++mm) { const int m = (am & 1) * 2 + mm; const int local = lbase + ai * 128 + m * 16;
                if (local < cnt) { const int tok = tokv[ai][m]; const float* xr = (tok < TL ? xl + (size_t)tok * DM : xc + (size_t)(tok - TL) * DM) + col0;
#pragma unroll
                    for (int bj = 0; bj < 2; ++bj) if ((u.qmask >> (ai * 2 + bj)) & 1) {
#pragma unroll
                        for (int n = 0; n < 2; ++n) xv[mm][bj][n] = *(const f32x4*)(xr + bj * 128 + n * 16); } } }
#pragma unroll
            for (int mm = 0; mm < 2; ++mm) { const int m = (am & 1) * 2 + mm; const int local = lbase + ai * 128 + m * 16;
                if (local < cnt) { const int tok = tokv[ai][m]; const float w = wv[ai][m];
                    const bool lat = tok < TL; const int b5 = lat ? tok / SEQ : 4; float* xr = (lat ? xl + (size_t)tok * DM : xc + (size_t)(tok - TL) * DM) + col0;
                    if (b5 == b50) {
#pragma unroll
                        for (int bj = 0; bj < 2; ++bj) if ((u.qmask >> (ai * 2 + bj)) & 1) {
#pragma unroll
                            for (int n = 0; n < 2; ++n) *(f32x4*)(xr + bj * 128 + n * 16) = xv[mm][bj][n] + gv[bj][n] * (w * acc[ai][bj][m][n]); }
                    } else { const float* gp = mod + (size_t)b5 * NMOD * DM + 5 * DM + col0;
#pragma unroll
                        for (int bj = 0; bj < 2; ++bj) if ((u.qmask >> (ai * 2 + bj)) & 1) {
#pragma unroll
                            for (int n = 0; n < 2; ++n) { const f32x4 gr = *(const f32x4*)(gp + bj * 128 + n * 16); *(f32x4*)(xr + bj * 128 + n * 16) = xv[mm][bj][n] + gr * (w * acc[ai][bj][m][n]); } } } } }
            asm volatile("" ::: "memory"); }
    }
};
struct EpiMoeY {
    static constexpr bool PERM = true;
    bf16_t* ys; const float* mod; const int* ltok; const float* lw;
    __device__ __forceinline__ void operator()(const f32x4 (&acc)[2][2][4][2], const pg8::Unit& u, int wr, int wc, int fr, int fq) const {
        const int g = u.g; const int lbase = (u.pm - u.first) * 256 + wr * 64 + fr; const int cnt = u.cnt;
        const int col0 = u.pn * 256 + wc * 32 + 8 * fq;
        int tokv[2][4]; float wv[2][4];
#pragma unroll
        for (int ai = 0; ai < 2; ++ai)
#pragma unroll
            for (int m = 0; m < 4; ++m) { const int local = lbase + ai * 128 + m * 16, li = local < cnt ? local : cnt - 1; tokv[ai][m] = ltok[(size_t)g * TT + li]; wv[ai][m] = lw[(size_t)g * TT + li]; }
        const int b50 = tokv[0][0] < TL ? tokv[0][0] / SEQ : 4;
        f32x4 gv[2][2];
#pragma unroll
        for (int bj = 0; bj < 2; ++bj)
#pragma unroll
            for (int n = 0; n < 2; ++n) gv[bj][n] = *(const f32x4*)(mod + (size_t)b50 * NMOD * DM + 5 * DM + col0 + bj * 128 + n * 4);
#pragma unroll
        for (int ai = 0; ai < 2; ++ai)
#pragma unroll
            for (int m = 0; m < 4; ++m) { const int local = lbase + ai * 128 + m * 16;
                if (local < cnt) { const int tok = tokv[ai][m]; const float w = wv[ai][m]; const int b5 = tok < TL ? tok / SEQ : 4;
                    bf16_t* yr = ys + ((size_t)u.pm * 256 + wr * 64 + fr + ai * 128 + m * 16) * DM + col0;
                    if (b5 == b50) {
#pragma unroll
                        for (int bj = 0; bj < 2; ++bj) if ((u.qmask >> (ai * 2 + bj)) & 1) {
                            const f32x4 v0 = gv[bj][0] * (w * acc[ai][bj][m][0]), v1 = gv[bj][1] * (w * acc[ai][bj][m][1]);
                            u32x4 o; o.x = pk2(v0[0], v0[1]); o.y = pk2(v0[2], v0[3]); o.z = pk2(v1[0], v1[1]); o.w = pk2(v1[2], v1[3]);
                            *(u32x4*)(yr + bj * 128) = o; }
                    } else { const float* gp = mod + (size_t)b5 * NMOD * DM + 5 * DM + col0;
#pragma unroll
                        for (int bj = 0; bj < 2; ++bj) if ((u.qmask >> (ai * 2 + bj)) & 1) { const f32x4 g0 = *(const f32x4*)(gp + bj * 128), g1 = *(const f32x4*)(gp + bj * 128 + 4);
                            const f32x4 v0 = g0 * (w * acc[ai][bj][m][0]), v1 = g1 * (w * acc[ai][bj][m][1]);
                            u32x4 o; o.x = pk2(v0[0], v0[1]); o.y = pk2(v0[2], v0[3]); o.z = pk2(v1[0], v1[1]); o.w = pk2(v1[2], v1[3]);
                            *(u32x4*)(yr + bj * 128) = o; } } } }
    }
};
struct Frame { LAS unsigned char* lds; volatile LAS unsigned* MISC; int tid, lane, wave, vcu, G; };

__device__ __forceinline__ void p0_transpose_item(const float* W, int K, int N, bf16_t* WT, int k0, int n0, int drow0, LAS float* scr, int lane) {
    f32x4 v[16];
#pragma unroll
    for (int i = 0; i < 16; ++i) v[i] = __builtin_nontemporal_load((const f32x4*)(W + (size_t)(k0 + 4 * i + (lane >> 4)) * N + n0 + 4 * (lane & 15)));
#pragma unroll
    for (int i = 0; i < 16; ++i) { LAS float* d = scr + (4 * i + (lane >> 4)) * 65 + 4 * (lane & 15); d[0] = v[i][0]; d[1] = v[i][1]; d[2] = v[i][2]; d[3] = v[i][3]; }
    asm volatile("s_waitcnt lgkmcnt(0)" ::: "memory");
    const int c = lane & 7;
#pragma unroll
    for (int j = 0; j < 8; ++j) { const int n = (lane >> 3) + 8 * j; const LAS float* sp = scr + (8 * c) * 65 + n;
        u32x4 o; o.x = pk2(sp[0 * 65], sp[1 * 65]); o.y = pk2(sp[2 * 65], sp[3 * 65]); o.z = pk2(sp[4 * 65], sp[5 * 65]); o.w = pk2(sp[6 * 65], sp[7 * 65]);
        *(u32x4*)(WT + (size_t)(drow0 + n) * K + k0 + 8 * c) = o; }
    asm volatile("s_waitcnt lgkmcnt(0)" ::: "memory");
}
__device__ __forceinline__ void p0_ffn_matrix(const Prm& p, int m, int r, LAS float* scr, int lane) {
    unsigned char* ws = p.ws; const float* src; bf16_t* dst; int t;
    if (m < 6) { const int j = m / 3; t = m % 3; src = (t == 0 ? p.fg : t == 1 ? p.fu : p.fd) + (size_t)j * DM * DFF; dst = (bf16_t*)(ws + WS_W + j * WE_STRIDE + (t == 2 ? WE_D : WE_GU)); }
    else { const int q = m - 6, j = q / 24, e = (q % 24) / 3; t = q % 3; src = (t == 0 ? p.mg : t == 1 ? p.mu : p.md) + ((size_t)j * NEXP + e) * DM * DFF; dst = (bf16_t*)(ws + WS_W + WO_BASE + j * WO_STRIDE + WO_EXP + e * WX_STRIDE + (t == 2 ? WX_D : WX_GU)); }
    if (t == 2) { const int nblk = DM / 64, q8 = r >> 3, w8 = r & 7, ngx = nblk / 2, kb = 4 * (q8 / ngx) + (w8 >> 1), nb = 2 * (q8 % ngx) + (w8 & 1); p0_transpose_item(src, DFF, DM, dst, 64 * kb, 64 * nb, 64 * nb, scr, lane); }
    else { const int nblk = DFF / 64, q8 = r >> 3, w8 = r & 7, ngx = nblk / 2, kb = 4 * (q8 / ngx) + (w8 >> 1), nb = 2 * (q8 % ngx) + (w8 & 1), n0 = 64 * nb; p0_transpose_item(src, DM, DFF, dst, 64 * kb, n0, (n0 / 128) * 256 + (n0 % 128) + (t == 1 ? 128 : 0), scr, lane); }
}
__device__ __forceinline__ void p0_fold(const Prm& p, Frame& F);
__device__ __forceinline__ void p0_prologue(const Prm& p, Frame& F) {
    unsigned char* ws = p.ws;
    { const int gt = F.vcu * 512 + F.tid, NT = F.G * 512;
      bf16_t* F1 = (bf16_t*)(ws + WS_TAB + TAB_F1); bf16_t* F2 = (bf16_t*)(ws + WS_TAB + TAB_F2); float2* TW = (float2*)(ws + WS_TAB + TAB_TW); float2* TWC = (float2*)(ws + WS_TAB + TAB_TWC);
      for (int i = gt; i < 256 * 128; i += NT) { const int row = i / 128, n1 = i % 128, k1 = row >> 1, c = row & 1; float sn, cs; sincospif(2.f * (float)((n1 * k1) & 127) / 128.f, &sn, &cs);
          F1[i] = (bf16_t)f2bf((c ? -sn : cs) * 0.08838834764831845f); }
      for (int i = gt; i < 128 * 128; i += NT) { const int row = i / 128, col = i % 128, k2 = row >> 1, cp = row & 1, n2 = col >> 1, c = col & 1; float sn, cs; sincospif(2.f * (float)((n2 * k2) & 63) / 64.f, &sn, &cs);
          const float v = cp == 0 ? (c == 0 ? cs : sn) : (c == 0 ? -sn : cs); F2[i] = (bf16_t)f2bf(v * 0.125f); }
      for (int i = gt; i < 64 * 128; i += NT) { const int n2 = i / 128, k1 = i % 128; float sn, cs; sincospif(2.f * (float)(n2 * k1) / 8192.f, &sn, &cs); TW[i] = make_float2(cs, -sn); }
      for (int i = gt; i < 2 * 128; i += NT) { const int n2 = i / 128, k1 = i % 128; float sn, cs; sincospif(2.f * (float)(n2 * k1) / 256.f, &sn, &cs); TWC[i] = make_float2(cs, -sn); }
      for (int i = gt; i < 128 * 16; i += NT) { const int pos = i / 16, f = i % 16; const float inv = powf(10000.f, -(float)f / 16.f); const float ang = (float)pos * inv;
          ((float2*)(ws + WS_ROPE))[i] = make_float2((float)cos((double)ang), (float)sin((double)ang)); }
    }
    { LAS float* sc = (LAS float*)(F.lds);
      LAS float* part = (LAS float*)(F.lds + 32768);
      for (int i = F.tid; i < 5 * DM; i += 512) { const int r = i / DM, k = i % DM; const float v = r < 4 ? p.c[r * DM + k] : p.c_ctx[k]; sc[i] = v / (1.f + expf(-v)); }
      __syncthreads();
      for (int it = F.vcu; it < DEPTH * 96; it += F.G) { const int l = it / 96, n = (it % 96) * 64 + F.lane;
          const float* w = p.ada_w + (size_t)l * DM * NMOD * DM + n; float a[5] = {0.f, 0.f, 0.f, 0.f, 0.f};
          for (int kb = 0; kb < 128; kb += 32) { float wv[32];
#pragma unroll
              for (int kk = 0; kk < 32; ++kk) wv[kk] = w[(size_t)(F.wave * 128 + kb + kk) * NMOD * DM];
#pragma unroll
              for (int kk = 0; kk < 32; ++kk) { const int k = F.wave * 128 + kb + kk;
#pragma unroll
                  for (int r = 0; r < 5; ++r) a[r] += sc[r * DM + k] * wv[kk]; } }
#pragma unroll
          for (int r = 0; r < 5; ++r) part[(F.wave * 5 + r) * 64 + F.lane] = a[r];
          __syncthreads();
          if (F.tid < 320) { const int r = F.tid / 64, ln = F.tid % 64; float sum = 0.f;
#pragma unroll
              for (int wv = 0; wv < 8; ++wv) sum += part[(wv * 5 + r) * 64 + ln];
              ((float*)(ws + WS_MOD))[((size_t)l * 5 + r) * NMOD * DM + (it % 96) * 64 + ln] = sum + p.ada_b[l * NMOD * DM + (it % 96) * 64 + ln]; }
          __syncthreads(); }
    }
    p0_fold(p, F);
    { LAS float* scr = (LAS float*)(F.lds + F.wave * 16640);
      const int gw = F.vcu * 8 + F.wave, NGW = F.G * 8;
      constexpr int I_FFN = 54 * 896, I_QKV = 2 * 384, I_O = 2 * 256;
      for (int it = gw; it < I_FFN + I_QKV + I_O; it += NGW) {
          if (it < I_FFN) { p0_ffn_matrix(p, it / 896, it % 896, scr, F.lane); continue; }
          int r = it - I_FFN;
          if (r < I_QKV) { const int j = r / 384, q = r % 384, nblk = QKVD / 64, kb = q / nblk, nb = q % nblk;
              p0_transpose_item(p.wqkv + (size_t)j * DM * QKVD, DM, QKVD, (bf16_t*)(ws + WS_W + WO_BASE + j * WO_STRIDE + WO_QKV), 64 * kb, 64 * nb, 64 * nb, scr, F.lane); continue; }
          r -= I_QKV;
          { const int j = r / 256, q = r % 256, nblk = DM / 64, kb = q / nblk, nb = q % nblk;
              p0_transpose_item(p.wo + (size_t)j * DM * DM, DM, DM, (bf16_t*)(ws + WS_W + WO_BASE + j * WO_STRIDE + WO_O), 64 * kb, 64 * nb, 64 * nb, scr, F.lane); }
      }
    }
}

template <bool ROUTER>
__device__ __forceinline__ void norm_phase(const Prm& p, Frame& F, const float* xl, const float* xc, const float* g, const float* mod  , int which, bf16_t* HB, int nrows,
                                            const float* wr, unsigned* mcnt, int* ltok, float* lw) {
    const int lane = F.lane;
    f32x4 gv[4];
#pragma unroll
    for (int j = 0; j < 4; ++j) gv[j] = *(const f32x4*)(g + 4 * (lane + 64 * j));
    float wreg[ROUTER ? 128 : 1];
    if (ROUTER) {
#pragma unroll
        for (int j = 0; j < 4; ++j)
#pragma unroll
            for (int i = 0; i < 4; ++i) { const int c = 4 * (lane + 64 * j) + i; const f32x4 w0 = *(const f32x4*)(wr + c * 8), w1 = *(const f32x4*)(wr + c * 8 + 4);
#pragma unroll
                for (int e = 0; e < 4; ++e) { wreg[(j * 4 + i) * 8 + e] = w0[e]; wreg[(j * 4 + i) * 8 + 4 + e] = w1[e]; } }
    }
    const int rpb = (nrows + F.G - 1) / F.G;
    const int r0 = ROUTER ? F.vcu * rpb : F.vcu * 8 + F.wave, r1 = ROUTER ? (r0 + rpb < nrows ? r0 + rpb : nrows) : nrows, rstep = ROUTER ? 8 : F.G * 8;
    LAS unsigned* ech = (LAS unsigned*)F.lds; LAS float* gch = (LAS float*)(F.lds + 4096);
    if (ROUTER) __syncthreads();
    for (int rr = ROUTER ? r0 + F.wave : r0; rr < r1; rr += 2 * rstep) {
        f32x4 v[2][4]; float ss[2];
        f32x4 shv[ROUTER ? 1 : 2][4], scv[ROUTER ? 1 : 2][4];
#pragma unroll
        for (int q = 0; q < 2; ++q) { const int r = rr + q * rstep; ss[q] = 0.f;
            if (r < r1) { const float* xr = (r < TL) ? xl + (size_t)r * DM : xc + (size_t)(r - TL) * DM;
#pragma unroll
                for (int j = 0; j < 4; ++j) v[q][j] = *(const f32x4*)(xr + 4 * (lane + 64 * j));
                if (!ROUTER) { const int b5 = (r < TL) ? r / SEQ : 4; const float* mp = mod + (size_t)b5 * NMOD * DM + which * DM;
#pragma unroll
                    for (int j = 0; j < 4; ++j) { shv[ROUTER ? 0 : q][j] = *(const f32x4*)(mp + 4 * (lane + 64 * j)); scv[ROUTER ? 0 : q][j] = *(const f32x4*)(mp + DM + 4 * (lane + 64 * j)); } } } }
#pragma unroll
        for (int q = 0; q < 2; ++q) { const int r = rr + q * rstep;
            if (r < r1) {
#pragma unroll
                for (int j = 0; j < 4; ++j) ss[q] += (v[q][j][0] * v[q][j][0] + v[q][j][1] * v[q][j][1]) + (v[q][j][2] * v[q][j][2] + v[q][j][3] * v[q][j][3]); } }
#pragma unroll
        for (int q = 0; q < 2; ++q) { const int r = rr + q * rstep;
          if (r < r1) {
            const int b5 = (r < TL) ? r / SEQ : 4; const float* mp = mod + (size_t)b5 * NMOD * DM + which * DM;
            if (ROUTER) {
#pragma unroll
                for (int j = 0; j < 4; ++j) { shv[0][j] = *(const f32x4*)(mp + 4 * (lane + 64 * j)); scv[0][j] = *(const f32x4*)(mp + DM + 4 * (lane + 64 * j)); } }
            const float rstd = rsqrtf(wave_sum(ss[q]) * (1.f / DM) + EPS);
            float lg[8] = {};
#pragma unroll
            for (int j = 0; j < 4; ++j) { const f32x4 sh = shv[ROUTER ? 0 : q][j], sc = scv[ROUTER ? 0 : q][j];
                f32x4 h = v[q][j] * rstd * gv[j] * (sc + 1.f) + sh;
                u32x2 o; o.x = pk2(h[0], h[1]); o.y = pk2(h[2], h[3]); *(u32x2*)(HB + (size_t)r * DM + 4 * (lane + 64 * j)) = o;
                if (ROUTER) {
#pragma unroll
                    for (int i = 0; i < 4; ++i)
#pragma unroll
                        for (int e = 0; e < 8; ++e) lg[e] += h[i] * wreg[(j * 4 + i) * 8 + e]; } }
            if (ROUTER) {
                float a4[4], b2[2], c1;
#pragma unroll
                for (int t = 0; t < 4; ++t) { const float snd = (lane & 1) ? lg[t] : lg[t + 4], kp = (lane & 1) ? lg[t + 4] : lg[t]; a4[t] = kp + SWZ_XOR(snd, 1); }
#pragma unroll
                for (int t = 0; t < 2; ++t) { const float snd = (lane & 2) ? a4[t] : a4[t + 2], kp = (lane & 2) ? a4[t + 2] : a4[t]; b2[t] = kp + SWZ_XOR(snd, 2); }
                { const float snd = (lane & 4) ? b2[0] : b2[1], kp = (lane & 4) ? b2[1] : b2[0]; c1 = kp + SWZ_XOR(snd, 4); }
                c1 += SWZ_XOR(c1, 8); c1 += SWZ_XOR(c1, 16);
                const int cb = __builtin_bit_cast(int, c1);
#pragma unroll
                for (int e = 0; e < 8; ++e) { const int l = ((e >> 2) & 1) | (((e >> 1) & 1) << 1) | ((e & 1) << 2);
                    lg[e] = __builtin_bit_cast(float, __builtin_amdgcn_readlane(cb, l)) + __builtin_bit_cast(float, __builtin_amdgcn_readlane(cb, l + 32)); }
                int e0 = 0; float v0 = lg[0];
#pragma unroll
                for (int e = 1; e < 8; ++e) if (lg[e] > v0) { v0 = lg[e]; e0 = e; }
                int e1 = -1; float v1 = -INFINITY;
#pragma unroll
                for (int e = 0; e < 8; ++e) if (e != e0 && lg[e] > v1) { v1 = lg[e]; e1 = e; }
                const float g1 = 1.f / (1.f + expf(v0 - v1)), g0 = 1.f - g1;
                if (lane == 0) { ech[r - r0] = (unsigned)e0 | ((unsigned)e1 << 8); gch[2 * (r - r0)] = g0; gch[2 * (r - r0) + 1] = g1; }
            }
          } }
    }
    if (ROUTER) {
        __syncthreads();
        if (F.tid < 16) { const int grp = F.tid, k = grp >> 3, e = grp & 7, n = r1 - r0; int cnt = 0;
            for (int i = 0; i < n; ++i) cnt += (int)(((ech[i] >> (8 * k)) & 0xffu) == (unsigned)e);
            mcnt[(size_t)F.vcu * 16 + grp] = (unsigned)cnt; }
    }
}
__device__ __forceinline__ void moe_lists(Frame& F, const unsigned* cntw, unsigned* mcnt, int* ltok, float* lw, int nrows, int* tokslot) {
    const int rpb = (nrows + F.G - 1) / F.G; const int r0 = F.vcu * rpb, r1 = (r0 + rpb < nrows ? r0 + rpb : nrows);
    LAS unsigned* ech = (LAS unsigned*)F.lds; LAS float* gch = (LAS float*)(F.lds + 4096);
    unsigned pos = 0u, tot = 0u; const int grp = F.tid & 15, k = grp >> 3, e = grp & 7, n = r1 - r0;
    { LAS unsigned* red = (LAS unsigned*)(F.lds + 8192); const int sub = F.tid >> 4; unsigned tp = 0u, pp = 0u;
      for (int w0 = 0; w0 < F.G; w0 += 256) { unsigned c[8];
#pragma unroll
          for (int q = 0; q < 8; ++q) { const int w = w0 + sub + 32 * q; c[q] = w < F.G ? cntw[(size_t)w * 16 + grp] : 0u; }
#pragma unroll
          for (int q = 0; q < 8; ++q) { const int w = w0 + sub + 32 * q; tp += c[q]; pp += (w < F.vcu) ? c[q] : 0u; } }
      red[F.tid] = tp; red[512 + F.tid] = pp; }
    __syncthreads();
    if (F.tid < 16) { LAS unsigned* red = (LAS unsigned*)(F.lds + 8192);
        for (int q = 0; q < 32; ++q) { tot += red[q * 16 + grp]; pos += red[512 + q * 16 + grp]; }
        if (F.vcu == 0) mcnt[grp] = tot;
        F.MISC[64 + grp] = (tot + 255u) / 256u; }
    __syncthreads();
    if (F.tid < 16) { unsigned first = 0u;
        for (int g2 = 0; g2 < grp; ++g2) first += F.MISC[64 + g2];
        for (int i = 0; i < n; ++i) if (((ech[i] >> (8 * k)) & 0xffu) == (unsigned)e) { ltok[(size_t)grp * TT + pos] = r0 + i; lw[(size_t)grp * TT + pos] = gch[2 * i + k];
            if (tokslot) tokslot[(size_t)(r0 + i) * 2 + k] = (int)(first * 256u + pos); ++pos; } }
}
__device__ __forceinline__ void final_norm_phase(const Prm& p, Frame& F, const bf16_t* ys, const int* tokslot) {
    const int gw = F.vcu * 8 + F.wave, NGW = F.G * 8, lane = F.lane;
    f32x4 gv[4];
#pragma unroll
    for (int j = 0; j < 4; ++j) gv[j] = *(const f32x4*)(p.fng + 4 * (lane + 64 * j));
    for (int rr = gw; rr < TL; rr += 2 * NGW) { f32x4 v[2][4];
#pragma unroll
        for (int q = 0; q < 2; ++q) { const int r = rr + q * NGW; if (r < TL) {
#pragma unroll
            for (int j = 0; j < 4; ++j) v[q][j] = *(const f32x4*)(p.out + (size_t)r * DM + 4 * (lane + 64 * j));
            const int s0 = tokslot[2 * r], s1 = tokslot[2 * r + 1];
#pragma unroll
            for (int j = 0; j < 4; ++j) { const u32x2 a = *(const u32x2*)(ys + (size_t)s0 * DM + 4 * (lane + 64 * j)), b = *(const u32x2*)(ys + (size_t)s1 * DM + 4 * (lane + 64 * j));
                v[q][j][0] += __uint_as_float(a.x << 16) + __uint_as_float(b.x << 16); v[q][j][1] += __uint_as_float(a.x & 0xffff0000u) + __uint_as_float(b.x & 0xffff0000u);
                v[q][j][2] += __uint_as_float(a.y << 16) + __uint_as_float(b.y << 16); v[q][j][3] += __uint_as_float(a.y & 0xffff0000u) + __uint_as_float(b.y & 0xffff0000u); } } }
#pragma unroll
        for (int q = 0; q < 2; ++q) { const int r = rr + q * NGW; if (r < TL) { float s = 0.f;
#pragma unroll
            for (int j = 0; j < 4; ++j) s += (v[q][j][0] * v[q][j][0] + v[q][j][1] * v[q][j][1]) + (v[q][j][2] * v[q][j][2] + v[q][j][3] * v[q][j][3]);
            const float rstd = rsqrtf(wave_sum(s) * (1.f / DM) + EPS);
#pragma unroll
            for (int j = 0; j < 4; ++j) *(f32x4*)(p.out + (size_t)r * DM + 4 * (lane + 64 * j)) = v[q][j] * rstd * gv[j]; } } }
}
__device__ __forceinline__ void moe_tables(Frame& F, const unsigned* mcnt) {
    __syncthreads();
    if (F.tid < 16) F.MISC[32 + F.tid] = __hip_atomic_load(mcnt + F.tid, __ATOMIC_RELAXED, __HIP_MEMORY_SCOPE_AGENT);
    __syncthreads();
    if (F.tid == 0) { unsigned first = 0u, nb0 = 0u;
        for (int g = 0; g < 16; ++g) { const unsigned c = F.MISC[32 + g]; F.MISC[16 + g] = first; first += (c + 255u) / 256u; if (g == 7) nb0 = first; }
        F.MISC[48] = nb0; F.MISC[49] = first; }
    __syncthreads();
}


__device__ __forceinline__ int fresh_tid(int wave) { int tl; asm volatile("v_mbcnt_lo_u32_b32 %0, -1, 0\n\tv_mbcnt_hi_u32_b32 %0, -1, %0" : "=v"(tl)); return wave * 64 + tl; }
typedef short v4i16_t __attribute__((ext_vector_type(4)));
__device__ __forceinline__ unsigned off_b(unsigned row, unsigned ch) { return 256u * row + 16u * (ch ^ (((row & 3u) << 2) | ((row >> 2) & 3u))); }
__device__ __forceinline__ int crow(int r, int hi) { return (r & 3) + 8 * (r >> 2) + 4 * hi; }
__device__ __forceinline__ s16x4 trrd(const LAS unsigned char* p) { return __builtin_bit_cast(s16x4, __builtin_amdgcn_ds_read_tr16_b64_v4i16((LAS v4i16_t*)p)); }
template <int MB>
__device__ __forceinline__ void dft_mma(const LAS unsigned char* Aimg, const LAS unsigned char* Bimg, int wave, int lane, f32x16 (&acc)[MB]) {
    const int r32 = lane & 31, hi = lane >> 5;
    const unsigned X = ((r32 & 3) << 2) | ((r32 >> 2) & 3);
    const LAS unsigned char* bbase = Bimg + (wave >> 2) * 32768;
    const unsigned blk = (lane >> 4) & 1, q = (lane & 15) >> 2, pp = lane & 3, c = wave & 3;
    unsigned tra[2];
#pragma unroll
    for (int t = 0; t < 2; ++t) tra[t] = off_b(8 * hi + 4 * t + q, 4 * c + 2 * blk + (pp >> 1)) + 8 * (pp & 1);
#pragma unroll
    for (int ks = 0; ks < 8; ++ks) {
        const s16x4 lo = trrd(bbase + tra[0] + ks * 4096), hh = trrd(bbase + tra[1] + ks * 4096);
        const bf16x8 bf = (bf16x8){lo[0], lo[1], lo[2], lo[3], hh[0], hh[1], hh[2], hh[3]};
        const unsigned achunk = ((2 * ks + hi) ^ X) * 16;
#pragma unroll
        for (int mb = 0; mb < MB; ++mb) { const bf16x8 af = *(const LAS bf16x8*)(Aimg + 256 * (32 * mb + r32) + achunk);
            acc[mb] = __builtin_amdgcn_mfma_f32_32x32x16_bf16(af, bf, acc[mb], 0, 0, 0); }
    }
}
__device__ __forceinline__ void p0_fold(const Prm& p, Frame& F) {
    LAS unsigned char* Aimg = F.lds; LAS unsigned char* Bimg = F.lds + 65536; LAS f32x2* cs256 = (LAS f32x2*)(F.lds + 131072);
    const int tid = F.tid, lane = F.lane, wave = F.wave, r32 = lane & 31, hi = lane >> 5;
    __syncthreads();
    for (int i = tid; i < 256; i += 512) { float sn, cs; sincospif(2.f * (float)i / 256.f, &sn, &cs); cs256[i] = (f32x2){cs * 0.0625f, sn * 0.0625f}; }
    const int wi = F.vcu - F.G / 2;
    if (wi >= 0 && (wi & 1) == 0)
    for (int it = wi >> 1; it < 64; it += (F.G - F.G / 2 + 1) >> 1) {
        const int j = it >> 5, g = (it >> 3) & 3, type = (it >> 2) & 1, nt = it & 3;
        const float* w = p.fw + (size_t)j * DM * DM + (size_t)(g * 256) * DM + nt * 256;
        f32x16 acc[8];
#pragma unroll
        for (int mb = 0; mb < 8; ++mb) acc[mb] = (f32x16){};
        for (int ch = 0; ch < 2; ++ch) {
            __syncthreads();
            for (int qq = tid; qq < 256 * 16; qq += 512) { const int row = qq >> 4, c8 = qq & 15, q0 = 128 * ch + 8 * c8; float v[8];
#pragma unroll
                for (int e = 0; e < 8; ++e) { const f32x2 t = cs256[(row * (q0 + e)) & 255]; v[e] = type ? t.y : t.x; }
                u32x4 o; o.x = pk2(v[0], v[1]); o.y = pk2(v[2], v[3]); o.z = pk2(v[4], v[5]); o.w = pk2(v[6], v[7]);
                *(LAS u32x4*)(Aimg + off_b(row, c8)) = o; }
            { const int tt = fresh_tid(wave); const int cols4 = tt & 63, rb = tt >> 6;
              f32x4 xv[16];
#pragma unroll
              for (int i = 0; i < 16; ++i) xv[i] = *(const f32x4*)(w + (size_t)(128 * ch + rb + 8 * i) * DM + 4 * cols4);
              asm volatile("" : "+v"(xv[0]), "+v"(xv[1]), "+v"(xv[2]), "+v"(xv[3]), "+v"(xv[4]), "+v"(xv[5]), "+v"(xv[6]), "+v"(xv[7]));
              asm volatile("" : "+v"(xv[8]), "+v"(xv[9]), "+v"(xv[10]), "+v"(xv[11]), "+v"(xv[12]), "+v"(xv[13]), "+v"(xv[14]), "+v"(xv[15]));
              LAS unsigned char* bw = Bimg + (cols4 >> 5) * 32768 + 8 * (cols4 & 1);
#pragma unroll
              for (int i = 0; i < 16; ++i) { const int n1 = rb + 8 * i; u32x2 o; o.x = pk2(xv[i][0], xv[i][1]); o.y = pk2(xv[i][2], xv[i][3]);
                  *(LAS u32x2*)(bw + off_b(n1, (cols4 & 31) >> 1)) = o; } }
            __syncthreads();
            dft_mma<8>(Aimg, Bimg, wave, lane, acc);
        }
        bf16_t* out = (bf16_t*)(p.ws + WS_W + j * WE_STRIDE + WE_F) + (size_t)(nt * 256 + 32 * wave + r32) * 2048 + type * 1024 + g * 256 + 4 * hi;
#pragma unroll
        for (int mb = 0; mb < 8; ++mb)
#pragma unroll
            for (int rg = 0; rg < 4; ++rg) { u32x2 o; o.x = pk2(acc[mb][4 * rg], acc[mb][4 * rg + 1]); o.y = pk2(acc[mb][4 * rg + 2], acc[mb][4 * rg + 3]);
                *(u32x2*)(out + 32 * mb + 8 * rg) = o; }
    }
    __syncthreads();
}
__device__ __forceinline__ void s1_phase(const Prm& p, Frame& F, const float* xl, const float* xc, const float* g, const float* mod, bf16_t* Y1, bf16_t* Y1C) {
    LAS unsigned char* Aimg = F.lds; LAS unsigned char* Bimg = F.lds + 65536;
    LAS float* rstd = (LAS float*)(F.lds + 131072); LAS f32x2* tw = (LAS f32x2*)(F.lds + 131584); LAS float* gm = (LAS float*)(F.lds + 132608); LAS float* shv = (LAS float*)(F.lds + 136704);
    const bf16_t* F1 = (const bf16_t*)(p.ws + WS_TAB + TAB_F1); const float2* TW = (const float2*)(p.ws + WS_TAB + TAB_TW); const float2* TWC = (const float2*)(p.ws + WS_TAB + TAB_TWC);
    const int tid = F.tid, lane = F.lane, wave = F.wave, r32 = lane & 31, hi = lane >> 5;
    __syncthreads();
    for (int qq = tid; qq < 256 * 16; qq += 512) { const int row = qq >> 4, ch = qq & 15; *(LAS u32x4*)(Aimg + off_b(row, ch)) = *(const u32x4*)(F1 + row * 128 + ch * 8); }
    for (int w = F.vcu; w < 288; w += F.G) {
        const int u = w < 256 ? w : 256 + ((w - 256) >> 2), c_lo = w < 256 ? 0 : (w - 256) & 3, c_hi = w < 256 ? 4 : c_lo + 1;
        const bool lat = u < 256; const int b = lat ? u >> 6 : (u - 256) >> 1, n2 = lat ? u & 63 : (u - 256) & 1;
        const float* xs = lat ? xl + ((size_t)b * SEQ + n2) * DM : xc + ((size_t)b * CTXL + n2) * DM; const size_t rstride = (size_t)(lat ? 64 : 2) * DM;
        const float* mp = mod + (size_t)(lat ? b : 4) * NMOD * DM;
        __syncthreads();
        for (int c = tid; c < DM; c += 512) { gm[c] = g[c] * (1.f + mp[DM + c]); shv[c] = mp[c]; }
        if (tid < 128) { const float2 t = lat ? TW[n2 * 128 + tid] : TWC[n2 * 128 + tid]; tw[tid] = (f32x2){t.x, t.y}; }
        for (int i0 = 0; i0 < 16; i0 += 4) { f32x4 rv[4][4];
#pragma unroll
            for (int ii = 0; ii < 4; ++ii)
#pragma unroll
                for (int j = 0; j < 4; ++j) rv[ii][j] = *(const f32x4*)(xs + (size_t)(16 * wave + i0 + ii) * rstride + 4 * (lane + 64 * j));
            asm volatile("" : "+v"(rv[0][0]), "+v"(rv[0][1]), "+v"(rv[0][2]), "+v"(rv[0][3]), "+v"(rv[1][0]), "+v"(rv[1][1]), "+v"(rv[1][2]), "+v"(rv[1][3]));
            asm volatile("" : "+v"(rv[2][0]), "+v"(rv[2][1]), "+v"(rv[2][2]), "+v"(rv[2][3]), "+v"(rv[3][0]), "+v"(rv[3][1]), "+v"(rv[3][2]), "+v"(rv[3][3]));
#pragma unroll
            for (int ii = 0; ii < 4; ++ii) { float sq = 0.f;
#pragma unroll
                for (int j = 0; j < 4; ++j) { const f32x4 v = rv[ii][j]; sq += (v[0] * v[0] + v[1] * v[1]) + (v[2] * v[2] + v[3] * v[3]); }
                sq = wave_sum(sq); if (lane == 0) rstd[16 * wave + i0 + ii] = rsqrtf(sq * (1.f / DM) + EPS); } }
        __syncthreads();
        for (int cc = c_lo; cc < c_hi; ++cc) {
            { const int tt = fresh_tid(wave); const int cols4 = tt & 63, rb = tt >> 6, c0 = 256 * cc + 4 * cols4;
              f32x4 xv[16];
#pragma unroll
              for (int i = 0; i < 16; ++i) xv[i] = *(const f32x4*)(xs + (size_t)(rb + 8 * i) * rstride + c0);
              const f32x4 gv = *(const LAS f32x4*)(gm + c0), sv = *(const LAS f32x4*)(shv + c0);
              LAS unsigned char* bw = Bimg + (cols4 >> 5) * 32768 + 8 * (cols4 & 1);
#pragma unroll
              for (int i = 0; i < 16; ++i) { const int n1 = rb + 8 * i; const f32x4 h = xv[i] * rstd[n1] * gv + sv; u32x2 o; o.x = pk2(h[0], h[1]); o.y = pk2(h[2], h[3]);
                  *(LAS u32x2*)(bw + off_b(n1, (cols4 & 31) >> 1)) = o; } }
            __syncthreads();
            f32x16 acc[8];
#pragma unroll
            for (int mb = 0; mb < 8; ++mb) acc[mb] = (f32x16){};
            dft_mma<8>(Aimg, Bimg, wave, lane, acc);
            __syncthreads();
            bf16_t* Y = lat ? Y1 : Y1C; const size_t k1stride = (size_t)(lat ? 128 : 4) * DM;
            const size_t ybase = (lat ? ((size_t)b * 128 * 64 + n2) * 2 : ((size_t)b * 128 * 2 + n2) * 2) * DM + 256 * cc;
            LAS bf16_t* ost = (LAS bf16_t*)Bimg + (4 * hi) * 256 + 32 * wave + r32;
#pragma unroll
            for (int hf = 0; hf < 2; ++hf) {
#pragma unroll
                for (int mb = 0; mb < 4; ++mb)
#pragma unroll
                    for (int r = 0; r < 16; r += 2) { const int k1 = (32 * (4 * hf + mb) + crow(r, hi)) >> 1; const f32x2 t = tw[k1]; const float re = acc[4 * hf + mb][r], im = acc[4 * hf + mb][r + 1];
                        ost[(32 * mb + (r & 3) + 8 * (r >> 2)) * 256] = (bf16_t)f2bf(re * t.x - im * t.y); ost[(32 * mb + (r & 3) + 8 * (r >> 2) + 1) * 256] = (bf16_t)f2bf(re * t.y + im * t.x);
                        if ((r & 7) == 6) asm volatile("" ::: "memory"); }
                __syncthreads();
                const int t2 = fresh_tid(wave);
#pragma unroll
                for (int i = 0; i < 8; ++i) { const int qq = t2 + 512 * i, row = qq >> 5, ch = qq & 31;
                    const u32x4 v = *(const LAS u32x4*)((const LAS unsigned char*)Bimg + row * 512 + ch * 16);
                    const int k1 = 64 * hf + (row >> 1);
                    *(u32x4*)(Y + ybase + (size_t)k1 * k1stride + (size_t)(row & 1) * DM + ch * 8) = v; }
                __syncthreads();
            }
        }
    }
}
__device__ __forceinline__ void s2_phase(const Prm& p, Frame& F, const bf16_t* Y1, const bf16_t* Y1C, bf16_t* PQ) {
    LAS unsigned char* Aimg = F.lds; LAS unsigned char* Bimg = F.lds + 65536;
    const bf16_t* F2 = (const bf16_t*)(p.ws + WS_TAB + TAB_F2);
    const int tid = F.tid, lane = F.lane, wave = F.wave, r32 = lane & 31, hi = lane >> 5;
    __syncthreads();
    for (int qq = tid; qq < 128 * 16; qq += 512) { const int row = qq >> 4, ch = qq & 15; *(LAS u32x4*)(Aimg + off_b(row, ch)) = *(const u32x4*)(F2 + row * 128 + ch * 8); }
    u32x4 v[8];
    { const int u = F.vcu; if (u < 2048) { const int cc = u & 3, k1 = (u >> 2) & 127, b = u >> 9; const bf16_t* src = Y1 + ((size_t)b * 128 + k1) * 128 * DM + 256 * cc;
#pragma unroll
        for (int i = 0; i < 8; ++i) { const int qq = tid + 512 * i; v[i] = *(const u32x4*)(src + (size_t)(qq >> 5) * DM + (qq & 31) * 8); } } }
    for (int u = F.vcu; u < 2048; u += F.G) {
        const int cc = u & 3, k1 = (u >> 2) & 127, b = u >> 9;
        __syncthreads();
#pragma unroll
        for (int i = 0; i < 8; ++i) { const int qq = tid + 512 * i, row = qq >> 5, ch32 = qq & 31; *(LAS u32x4*)(Bimg + (ch32 >> 4) * 32768 + off_b(row, ch32 & 15)) = v[i]; }
        __syncthreads();
        { const int un = u + F.G; if (un < 2048) { const int ccn = un & 3, k1n = (un >> 2) & 127, bn = un >> 9; const bf16_t* src = Y1 + ((size_t)bn * 128 + k1n) * 128 * DM + 256 * ccn;
#pragma unroll
            for (int i = 0; i < 8; ++i) { const int qq = tid + 512 * i; v[i] = *(const u32x4*)(src + (size_t)(qq >> 5) * DM + (qq & 31) * 8); } } }
        f32x16 acc[4];
#pragma unroll
        for (int mb = 0; mb < 4; ++mb) acc[mb] = (f32x16){};
        dft_mma<4>(Aimg, Bimg, wave, lane, acc);
        __syncthreads();
        { LAS bf16_t* ost = (LAS bf16_t*)Bimg + (4 * hi) * 256 + 32 * wave + r32;
#pragma unroll
          for (int mb = 0; mb < 4; ++mb)
#pragma unroll
              for (int r = 0; r < 16; ++r) ost[(32 * mb + (r & 3) + 8 * (r >> 2)) * 256] = (bf16_t)f2bf(acc[mb][r]); }
        __syncthreads();
        { const int t2 = fresh_tid(wave);
#pragma unroll
          for (int i = 0; i < 8; ++i) { const int qq = t2 + 512 * i, row = qq >> 5, ch = qq & 31, k2 = row >> 1, cp = row & 1;
              const u32x4 o = *(const LAS u32x4*)((const LAS unsigned char*)Bimg + row * 512 + ch * 16);
              *(u32x4*)(PQ + ((size_t)b * SEQ + k1 + 128 * k2) * 2048 + cp * DM + 256 * cc + ch * 8) = o; } }
    }
    { const int gt = F.vcu * 512 + fresh_tid(wave), NT = F.G * 512; const float sc = 0.70710678118654752f;
      for (int i = gt; i < NB * 128 * DM; i += NT) { const int ch = i & (DM - 1), k1 = (i >> 10) & 127, b = i >> 17;
          const bf16_t* y = Y1C + ((size_t)b * 128 + k1) * 4 * DM + ch;
          const float y0r = __uint_as_float((unsigned)y[0] << 16), y0i = __uint_as_float((unsigned)y[DM] << 16), y1r = __uint_as_float((unsigned)y[2 * DM] << 16), y1i = __uint_as_float((unsigned)y[3 * DM] << 16);
          bf16_t* o0 = PQ + ((size_t)TL + b * CTXL + k1) * 2048 + ch; bf16_t* o1 = o0 + (size_t)128 * 2048;
          o0[0] = (bf16_t)f2bf((y0r + y1r) * sc); o0[DM] = (bf16_t)f2bf((y0i + y1i) * sc); o1[0] = (bf16_t)f2bf((y0r - y1r) * sc); o1[DM] = (bf16_t)f2bf((y0i - y1i) * sc); } }
}

__device__ __forceinline__ void attn_phase(const Prm& p, Frame& F, const bf16_t* QB, const bf16_t* KB, const bf16_t* VB, bf16_t* OB, const float* sinks, int nunits) {
    LAS unsigned char* Ks = F.lds; LAS unsigned char* Vs = F.lds + 8192; LAS float* wsf = (LAS float*)(F.lds + 32768) + F.wave * 64; LAS bf16_t* stg = (LAS bf16_t*)(F.lds + 34816 + F.wave * 4096);
    const int lane = F.lane, wave = F.wave, r32 = lane & 31, hi = lane >> 5;
    for (int u = F.vcu; u < nunits; u += F.G) {
        const bool isctx = u >= 2048; const int uu = isctx ? u - 2048 : u;
        const int pb = isctx ? (uu & 3) : (uu & 127), kv = isctx ? ((uu >> 2) & 3) : ((uu >> 7) & 3), b = isctx ? (uu >> 4) : (uu >> 9);
        const int h = kv * 4 + (wave >> 1); const int qq = 32 * (wave & 1) + r32;
        const size_t qrow0 = (size_t)(isctx ? TL + b * CTXL : b * SEQ) + 64 * pb + 32 * (wave & 1);
        bf16x8 qr[4];
#pragma unroll
        for (int d0 = 0; d0 < 4; ++d0) qr[d0] = *(const bf16x8*)(QB + (qrow0 + r32) * DM + h * 64 + d0 * 16 + hi * 8);
        float m = sinks[h] * LOG2E, l = hi ? 0.f : 1.f; f32x16 o[2]; o[0] = (f32x16){}; o[1] = (f32x16){};
        const int ntl = isctx ? 0 : 5;
        const int t_first = isctx ? 0 : (pb < 2 ? 2 - pb : 0), t_lastl = isctx ? -1 : (pb > 125 ? 129 - pb : 4);
        const bf16_t* kbase = KB + (size_t)lane * 256 + kv * 64 + wave * 8;
        const bf16_t* vbase = VB + (size_t)(16 * (wave & 3) + (lane >> 2)) * 256 + kv * 64 + (wave >> 2) * 32 + (lane & 3) * 8;
        auto tile_row0 = [&](int ti) -> size_t { return ti < ntl ? (size_t)b * SEQ + 64 * (pb - 2 + ti) : (size_t)TL + b * CTXL + 64 * (ti - ntl); };
        int ti = isctx ? 0 : t_first; int slot = 0;
        u32x4 kreg = *(const u32x4*)(kbase + tile_row0(ti) * 256), vreg = *(const u32x4*)(vbase + tile_row0(ti) * 256);
        __syncthreads();
        *(LAS u32x4*)(Ks + wave * 1024 + lane * 16) = kreg; *(LAS u32x4*)(Vs + wave * 1024 + lane * 16) = vreg;
        { int tn0 = ti + 1; if (tn0 > t_lastl && tn0 < ntl) tn0 = ntl; kreg = *(const u32x4*)(kbase + tile_row0(tn0) * 256); vreg = *(const u32x4*)(vbase + tile_row0(tn0) * 256); }
        __syncthreads();
        while (ti < ntl + 4) {
            const int mode = (ti < ntl) ? ((ti == 0) ? 1 : (ti == 4) ? 2 : 0) : 0;
            int tn = ti + 1; if (tn > t_lastl && tn < ntl) tn = ntl;
            int tnn = tn + 1; if (tnn > t_lastl && tnn < ntl) tnn = ntl;
            const LAS unsigned char* kb = Ks + slot * 16384 + hi * 1024 + r32 * 16;
            const LAS unsigned char* vp = Vs + slot * 16384 + ((lane >> 4) & 1) * 32 + (lane & 3) * 8 + (4 * hi + ((lane & 15) >> 2)) * 64;
            f32x16 p0 = (f32x16){}, p1 = (f32x16){};
#pragma unroll
            for (int d0 = 0; d0 < 4; ++d0) { const bf16x8 b0 = *(const LAS bf16x8*)(kb + d0 * 2048), b1 = *(const LAS bf16x8*)(kb + d0 * 2048 + 512);
                p0 = __builtin_amdgcn_mfma_f32_32x32x16_bf16(b0, qr[d0], p0, 0, 0, 0); p1 = __builtin_amdgcn_mfma_f32_32x32x16_bf16(b1, qr[d0], p1, 0, 0, 0); }
            if (mode) {
#pragma unroll
                for (int r = 0; r < 16; ++r) { const int kk = crow(r, hi); const bool m0 = (mode == 1) ? (kk < qq) : (kk > qq), m1 = (mode == 1) ? (kk + 32 < qq) : (kk + 32 > qq);
                    if (m0) p0[r] = -INFINITY; if (m1) p1[r] = -INFINITY; } }
            float rm = fmaxf(p0[0], p1[0]);
#pragma unroll
            for (int r = 1; r < 16; ++r) rm = fmaxf(rm, fmaxf(p0[r], p1[r]));
            { auto rr = __builtin_amdgcn_permlane32_swap(__float_as_uint(rm), __float_as_uint(rm), false, false); rm = fmaxf(__uint_as_float(rr[0]), __uint_as_float(rr[1])); }
            const float mnew = fmaxf(m, rm), alpha = __builtin_amdgcn_exp2f(m - mnew); m = mnew;
            float ps = 0.f;
#pragma unroll
            for (int r = 0; r < 16; ++r) { p0[r] = __builtin_amdgcn_exp2f(p0[r] - m); p1[r] = __builtin_amdgcn_exp2f(p1[r] - m); ps += p0[r] + p1[r]; }
            l = l * alpha + ps;
            if (hi == 0) wsf[r32] = alpha;
#pragma unroll
            for (int r = 0; r < 16; ++r) { const float a = wsf[crow(r, hi)]; o[0][r] *= a; o[1][r] *= a; }
            u32x4 pw[4];
            pw[0] = (u32x4){pk2(p0[0], p0[1]), pk2(p0[2], p0[3]), pk2(p0[4], p0[5]), pk2(p0[6], p0[7])};
            pw[1] = (u32x4){pk2(p0[8], p0[9]), pk2(p0[10], p0[11]), pk2(p0[12], p0[13]), pk2(p0[14], p0[15])};
            pw[2] = (u32x4){pk2(p1[0], p1[1]), pk2(p1[2], p1[3]), pk2(p1[4], p1[5]), pk2(p1[6], p1[7])};
            pw[3] = (u32x4){pk2(p1[8], p1[9]), pk2(p1[10], p1[11]), pk2(p1[12], p1[13]), pk2(p1[14], p1[15])};
#pragma unroll
            for (int d0 = 0; d0 < 2; ++d0)
#pragma unroll
                for (int ks = 0; ks < 4; ++ks) { const s16x4 lo = trrd(vp + d0 * 4096 + ks * 1024), hh = trrd(vp + d0 * 4096 + ks * 1024 + 512);
                    const bf16x8 vf = (bf16x8){lo[0], lo[1], lo[2], lo[3], hh[0], hh[1], hh[2], hh[3]};
                    o[d0] = __builtin_amdgcn_mfma_f32_32x32x16_bf16(__builtin_bit_cast(bf16x8, pw[ks]), vf, o[d0], 0, 0, 0); }
            if (tn < ntl + 4) {
                *(LAS u32x4*)(Ks + (slot ^ 1) * 16384 + wave * 1024 + lane * 16) = kreg; *(LAS u32x4*)(Vs + (slot ^ 1) * 16384 + wave * 1024 + lane * 16) = vreg;
                if (tnn < ntl + 4) { kreg = *(const u32x4*)(kbase + tile_row0(tnn) * 256); vreg = *(const u32x4*)(vbase + tile_row0(tnn) * 256); }
                __syncthreads(); }
            ti = tn; slot ^= 1;
        }
        { auto rr = __builtin_amdgcn_permlane32_swap(__float_as_uint(l), __float_as_uint(l), false, false); l = __uint_as_float(rr[0]) + __uint_as_float(rr[1]); }
        if (hi == 0) wsf[32 + r32] = l;
#pragma unroll
        for (int r = 0; r < 16; ++r) { const int orow = crow(r, hi); const float rl = __builtin_amdgcn_rcpf(wsf[32 + orow]);
            stg[orow * 64 + r32] = (bf16_t)f2bf(o[0][r] * rl); stg[orow * 64 + 32 + r32] = (bf16_t)f2bf(o[1][r] * rl); }
#pragma unroll
        for (int i = 0; i < 4; ++i) { const int row = i * 8 + (lane >> 3), ch = lane & 7; const u32x4 v = *(const LAS u32x4*)(stg + row * 64 + ch * 8);
            *(u32x4*)(OB + (qrow0 + row) * DM + h * 64 + ch * 8) = v; }
    }
}


__device__ __forceinline__ int next_real(int ph) { int q = ph + 1; if (q >= 1 && q <= 32) { const int i = (q - 1) >> 3, o = (q - 1) & 7; if ((i & 1) == 0 && o >= 6) q = 1 + 8 * (i + 1); } return q; }
__global__ void __launch_bounds__(512, 2) mk_fwd(Args a) {
    extern __shared__ __attribute__((aligned(16))) unsigned char lds_raw[];
    Frame F; F.lds = (LAS unsigned char*)lds_raw; F.MISC = (volatile LAS unsigned*)(F.lds + LDS_MISC);
    F.tid = threadIdx.x; F.lane = F.tid & 63; F.wave = __builtin_amdgcn_readfirstlane(F.tid >> 6);
    F.G = gridDim.x; { const int bx = blockIdx.x; F.vcu = (F.G % 8 == 0) ? (bx % 8) * (F.G / 8) + bx / 8 : bx; }
    const Prm& p = a.p; GAS unsigned char* ws = (GAS unsigned char*)a.p.ws;
    for (int u = F.tid; u < 128; u += 512) F.MISC[u] = 0u;
    __syncthreads();
    unsigned* ctl = (unsigned*)(ws + WS_CTL);
    XcdBarrier bar = xcd_barrier_post(ctl + CW_BAR, F.MISC + 8);
    const int lo = a.ph_lo, hi = a.ph_hi;
    const int wave0 = __builtin_amdgcn_readfirstlane((int)threadIdx.x >> 6);
#ifndef ONLY
#define ONLY -1
#endif
#ifndef PROBE_KIND
#define PROBE_KIND -1
#endif
#ifndef PROBE_GEMMS
#define PROBE_GEMMS 0
#endif
#define NREP(k) (((k) == PROBE_KIND) || (PROBE_GEMMS && ((k) == 3 || (k) == 5 || (k) == 6 || (k) == 7 || (k) == 9 || (k) == 11 || (k) == 12)) ? 2 : 1)
#define EN(k) (ONLY == -1 || ONLY == (k))
#define RUN(ph) (lo <= (ph) && (ph) < hi)
#define SEAM(ph) do { if (next_real(ph) < hi) xcd_barrier(bar); } while (0)
#define FRESH() do { const int t_ = fresh_tid(wave0);     F.tid = t_; F.lane = t_ & 63; F.wave = __builtin_amdgcn_readfirstlane(t_ >> 6); asm volatile("" : "+s"(ws)); } while (0)
    const int cblk = (int)blockIdx.x;
#define WSP(T, off) ((T*)(GAS T*)(ws + (off)))
#define SKCTL(slots_off, ph) pg8::SkCtl{WSP(f32x4, slots_off), WSP(unsigned, WS_CTL) + CW_SKF, WSP(unsigned, WS_CTL) + CW_BAR + XB_TMO, (unsigned)((ph) * 4 + rep + 1), cblk, F.G}
    for (int rep = 0; rep < NREP(0); ++rep) if (EN(0) && RUN(0)) { FRESH(); p0_prologue(p, F); SEAM(0); }

    for (int lp = 0; lp < 2; ++lp) {
        const int ie = 2 * lp, io = 2 * lp + 1, j = lp;
        { const int base = 1 + 8 * ie;
          for (int rep = 0; rep < NREP(1); ++rep) if (EN(1) && RUN(base + 0)) { FRESH(); s1_phase(p, F, ie == 0 ? p.x : p.out, ie == 0 ? p.ctx : WSP(const float, WS_XC), p.nmg + ie * DM, WSP(const float, WS_MOD) + (size_t)ie * 5 * NMOD * DM,
                                                  WSP(bf16_t, WS_MS + MS_BIG + BIG_Y1), WSP(bf16_t, WS_MS + MS_BIG + BIG_Y1C)); SEAM(base + 0); }
          for (int rep = 0; rep < NREP(2); ++rep) if (EN(2) && RUN(base + 1)) { FRESH(); s2_phase(p, F, WSP(const bf16_t, WS_MS + MS_BIG + BIG_Y1), WSP(const bf16_t, WS_MS + MS_BIG + BIG_Y1C), WSP(bf16_t, WS_MS + MS_BIG + BIG_PQ)); SEAM(base + 1); }
          for (int rep = 0; rep < NREP(3); ++rep) if (EN(3) && RUN(base + 2)) { FRESH(); SchedDense<true> S{WSP(const bf16_t, WS_W + j * WE_STRIDE + WE_F), TT / 256, DM / 256, F.G, cblk, 2048};
              EpiResid E{ie == 0 ? p.x : p.out, ie == 0 ? p.ctx : WSP(const float, WS_XC), p.out, WSP(float, WS_XC), WSP(const float, WS_MOD) + (size_t)ie * 5 * NMOD * DM, 2, rep ? 0.f : 1.f};
              pg8::gemm_phase<EpiResid, SchedDense<true>, false>(F.lds, F.tid, WSP(const bf16_t, WS_MS + MS_BIG + BIG_PQ), 2048, S, E, SKCTL(WS_MS + MS_HB, base + 2)); SEAM(base + 2); }
          for (int rep = 0; rep < NREP(4); ++rep) if (EN(4) && RUN(base + 3)) { FRESH(); norm_phase<false>(p, F, p.out, WSP(const float, WS_XC), p.nfg + ie * DM, WSP(const float, WS_MOD) + (size_t)ie * 5 * NMOD * DM, 3, WSP(bf16_t, WS_MS + MS_HB), TT, nullptr, nullptr, nullptr, nullptr); SEAM(base + 3); }
          for (int rep = 0; rep < NREP(5); ++rep) if (EN(5) && RUN(base + 4)) { FRESH(); SchedDense<false> S{WSP(const bf16_t, WS_W + j * WE_STRIDE + WE_GU), TT / 256, 2 * DFF / 256, F.G, cblk, DM}; EpiSwiglu E{WSP(bf16_t, WS_MS + MS_BIG + BIG_ACT)};
              pg8::gemm_phase<EpiSwiglu, SchedDense<false>, false>(F.lds, F.tid, WSP(const bf16_t, WS_MS + MS_HB), DM, S, E); SEAM(base + 4); }
          for (int rep = 0; rep < NREP(6); ++rep) if (EN(6) && RUN(base + 5)) { FRESH(); SchedDense<true> S{WSP(const bf16_t, WS_W + j * WE_STRIDE + WE_D), TT / 256, DM / 256, F.G, cblk, DFF};
              EpiResid E{p.out, WSP(const float, WS_XC), p.out, WSP(float, WS_XC), WSP(const float, WS_MOD) + (size_t)ie * 5 * NMOD * DM, 5, rep ? 0.f : 1.f};
              pg8::gemm_phase<EpiResid, SchedDense<true>, false>(F.lds, F.tid, WSP(const bf16_t, WS_MS + MS_BIG + BIG_ACT), DFF, S, E, SKCTL(WS_MS + MS_HB, base + 5)); SEAM(base + 5); }
        }
        { const int base = 1 + 8 * io; const bool last = (io == DEPTH - 1); const int nrows = last ? TL : TT;
          const size_t wo = WS_W + WO_BASE + j * WO_STRIDE;
          for (int rep = 0; rep < NREP(4); ++rep) if (EN(4) && RUN(base + 0)) { FRESH(); norm_phase<false>(p, F, p.out, WSP(const float, WS_XC), p.nmg + io * DM, WSP(const float, WS_MOD) + (size_t)io * 5 * NMOD * DM, 0, WSP(bf16_t, WS_MS + MS_HB), TT, nullptr, nullptr, nullptr, nullptr); SEAM(base + 0); }
          for (int rep = 0; rep < NREP(7); ++rep) if (EN(7) && RUN(base + 1)) { FRESH(); SchedDense<true> S{WSP(const bf16_t, wo + WO_QKV), TT / 256, QKVD / 256, F.G, cblk, DM};
              EpiQKV E{WSP(bf16_t, WS_MS + MS_BIG + BIG_Q), WSP(bf16_t, WS_MS + MS_BIG + BIG_K), WSP(bf16_t, WS_MS + MS_BIG + BIG_V), WSP(const float2, WS_ROPE)};
              pg8::gemm_phase<EpiQKV, SchedDense<true>, false>(F.lds, F.tid, WSP(const bf16_t, WS_MS + MS_HB), DM, S, E, SKCTL(WS_MS + MS_BIG + 300 * MiB, base + 1)); SEAM(base + 1); }
          for (int rep = 0; rep < NREP(8); ++rep) if (EN(8) && RUN(base + 2)) { FRESH(); attn_phase(p, F, WSP(const bf16_t, WS_MS + MS_BIG + BIG_Q), WSP(const bf16_t, WS_MS + MS_BIG + BIG_K), WSP(const bf16_t, WS_MS + MS_BIG + BIG_V), WSP(bf16_t, WS_MS + MS_BIG + BIG_O), p.sinks + j * NH, last ? 2048 : 2048 + 64); SEAM(base + 2); }
          for (int rep = 0; rep < NREP(9); ++rep) if (EN(9) && RUN(base + 3)) { FRESH(); SchedDense<true> S{WSP(const bf16_t, wo + WO_O), nrows / 256, DM / 256, F.G, cblk, DM};
              EpiResid E{p.out, WSP(const float, WS_XC), p.out, WSP(float, WS_XC), WSP(const float, WS_MOD) + (size_t)io * 5 * NMOD * DM, 2, rep ? 0.f : 1.f};
              pg8::gemm_phase<EpiResid, SchedDense<true>, false>(F.lds, F.tid, WSP(const bf16_t, WS_MS + MS_BIG + BIG_O), DM, S, E, SKCTL(WS_MS + MS_HB, base + 3)); SEAM(base + 3); }
          for (int rep = 0; rep < NREP(10); ++rep) if (EN(10) && RUN(base + 4)) { FRESH(); norm_phase<true>(p, F, p.out, WSP(const float, WS_XC), p.nfg + io * DM, WSP(const float, WS_MOD) + (size_t)io * 5 * NMOD * DM, 3, WSP(bf16_t, WS_MS + MS_HB), nrows,
                                                       p.mr + (size_t)j * DM * NEXP, WSP(unsigned, WS_CTL) + CW_CNTW + 4096 * j, WSP(int, WS_ROUTE), WSP(float, WS_ROUTE) + 16 * TT); SEAM(base + 4); }
          for (int rep = 0; rep < NREP(11); ++rep) if (EN(11) && RUN(base + 5)) { FRESH(); if (rep == 0) { moe_lists(F, WSP(const unsigned, WS_CTL) + CW_CNTW + 4096 * j, WSP(unsigned, WS_CTL) + CW_MCNT + 64 * j, WSP(int, WS_ROUTE), WSP(float, WS_ROUTE) + 16 * TT, nrows, last ? WSP(int, WS_TOKSLOT) : (int*)nullptr); xcd_barrier(bar); }
              FRESH(); moe_tables(F, WSP(unsigned, WS_CTL) + CW_MCNT + 64 * j); MoeTab tab{F.MISC};
              SchedMoe<true, false> S{WSP(const bf16_t, wo + WO_EXP + WX_GU), WX_STRIDE, 2 * DFF / 256, F.G, cblk, DM, 0, (int)F.MISC[49], tab, WSP(const int, WS_ROUTE)}; EpiSwiglu E{WSP(bf16_t, WS_MS + MS_BIG + BIG_ACT)};
              pg8::gemm_phase<EpiSwiglu, SchedMoe<true, false>, true>(F.lds, F.tid, WSP(const bf16_t, WS_MS + MS_HB), DM, S, E); SEAM(base + 5); }
#pragma unroll
          for (int k = 0; k < 2; ++k)
          for (int rep = 0; rep < NREP(12); ++rep) if (EN(12) && RUN(base + 6 + k) && !last) { FRESH(); moe_tables(F, WSP(unsigned, WS_CTL) + CW_MCNT + 64 * j); MoeTab tab{F.MISC};
              const int nb0 = (int)F.MISC[48], nba = (int)F.MISC[49];
              SchedMoe<false, true> S{WSP(const bf16_t, wo + WO_EXP + WX_D), WX_STRIDE, DM / 256, F.G, cblk, DFF, k ? nb0 : 0, k ? nba - nb0 : nb0, tab, WSP(const int, WS_ROUTE)};
              EpiMoeDown E{p.out, WSP(float, WS_XC), WSP(const float, WS_MOD) + (size_t)io * 5 * NMOD * DM, WSP(const int, WS_ROUTE), WSP(const float, WS_ROUTE) + 16 * TT, rep ? 0.f : 1.f};
              pg8::gemm_phase<EpiMoeDown, SchedMoe<false, true>, false>(F.lds, F.tid, WSP(const bf16_t, WS_MS + MS_BIG + BIG_ACT), DFF, S, E, SKCTL(WS_MS + MS_HB, base + 6 + k)); SEAM(base + 6 + k); }
          for (int rep = 0; rep < NREP(14); ++rep) if (EN(12) && RUN(base + 6) && last) { FRESH(); moe_tables(F, WSP(unsigned, WS_CTL) + CW_MCNT + 64 * j); MoeTab tab{F.MISC};
              SchedMoe<false, true> S{WSP(const bf16_t, wo + WO_EXP + WX_D), WX_STRIDE, DM / 256, F.G, cblk, DFF, 0, (int)F.MISC[49], tab, WSP(const int, WS_ROUTE)};
              EpiMoeY E{WSP(bf16_t, WS_YS), WSP(const float, WS_MOD) + (size_t)io * 5 * NMOD * DM, WSP(const int, WS_ROUTE), WSP(const float, WS_ROUTE) + 16 * TT};
              pg8::gemm_phase<EpiMoeY, SchedMoe<false, true>, false>(F.lds, F.tid, WSP(const bf16_t, WS_MS + MS_BIG + BIG_ACT), DFF, S, E, SKCTL(WS_MS + MS_HB, base + 6)); SEAM(base + 7); }
        }
    }
    if (EN(13) && RUN(33)) { FRESH(); final_norm_phase(p, F, WSP(const bf16_t, WS_YS), WSP(const int, WS_TOKSLOT)); }
#undef WSP
#undef RUN
#undef SEAM
}

static int g_grid = 0;
static void mega_launch(const Prm& p, int lo, int hi, hipStream_t st) {
    if (g_grid == 0) {
        int dev = 0, cus = 0; hipGetDevice(&dev); hipDeviceGetAttribute(&cus, hipDeviceAttributeMultiprocessorCount, dev);
        if (hipFuncSetAttribute((const void*)mk_fwd, hipFuncAttributeMaxDynamicSharedMemorySize, LDS_BYTES) != hipSuccess) { fprintf(stderr, "hipFuncSetAttribute failed\n"); g_grid = -1; return; }
        int per_cu = 0; if (hipOccupancyMaxActiveBlocksPerMultiprocessor(&per_cu, (const void*)mk_fwd, 512, LDS_BYTES) != hipSuccess || per_cu < 1) fprintf(stderr, "occupancy query: %d\n", per_cu);
        (void)hipGetLastError();
        g_grid = cus & ~7;
    }
    if (g_grid < 0) return;
    hipMemsetAsync(p.ws + WS_CTL + CW_BAR * 4, 0, XCD_BAR_WORDS * 4, st);
    Args a{}; a.p = p; a.ph_lo = lo; a.ph_hi = hi;
    hipLaunchKernelGGL(mk_fwd, dim3(g_grid), dim3(512), LDS_BYTES, st, a);
}

template <class FA, class FB, class FE> static void ngemm(hipStream_t st, int Mmax, int N, int K, FA fa, FB fb, FE fe) {
    hipLaunchKernelGGL((nk_gemm<FA, FB, FE>), dim3(N / 64, (Mmax + 63) / 64), dim3(256), 0, st, Mmax, N, K, fa, fb, fe);
}

#ifndef MEGA_MASK
#define MEGA_MASK 0xFF
#endif
static void naive_forward(const Prm& p, hipStream_t st) {
    unsigned char* ws = p.ws;
    hipMemsetAsync(ws + WS_CTL, 0, 1 * MiB, st);
    if (MEGA_MASK) mega_launch(p, 0, 1, st);
    if (!(MEGA_MASK & 0x20)) {
    hipLaunchKernelGGL(nk_adaln, dim3((DEPTH * 5 * NMOD * DM + 255) / 256), dim3(256), 0, st, p);
    hipLaunchKernelGGL(nk_rope, dim3(8), dim3(256), 0, st, p); }
    hipMemcpyAsync(p.out, p.x, (size_t)TL * DM * 4, hipMemcpyDeviceToDevice, st);
    hipMemcpyAsync(ws + WS_XC, p.ctx, (size_t)TC * DM * 4, hipMemcpyDeviceToDevice, st);
    float* H = (float*)(ws + WS_S);
    unsigned char* S2 = ws + WS_S + 136 * MiB;
    for (int i = 0; i < DEPTH; ++i) {
        const int j = i / 2; const bool last = (i == DEPTH - 1);
        const int nrows = last ? TL : TT;
        const int pbase = 1 + 8 * i;
        if ((i % 2 == 0) && (MEGA_MASK & 0x08)) mega_launch(p, pbase + 0, pbase + 3, st);
        else if ((i % 2 == 1) && (MEGA_MASK & 0x04)) mega_launch(p, pbase + 0, pbase + 4, st);
        else {
        hipLaunchKernelGGL(nk_norm_mod, dim3(TT), dim3(256), 0, st, p, p.nmg + i * DM, i, 0, H, TT);
        if (i % 2 == 0) {
            float2* Y1 = (float2*)S2;
            float2* Z = (float2*)(S2 + 64 * MiB);
            for (int b = 0; b < NB; ++b) {
                hipLaunchKernelGGL(nk_fft_s1, dim3(SEQ * DM / 256), dim3(256), 0, st, H, b, Y1);
                hipLaunchKernelGGL(nk_fft_s2, dim3(SEQ * DM / 256), dim3(256), 0, st, Y1, b, Z);
            }
            hipLaunchKernelGGL(nk_dft_ctx, dim3(TC * DM / 256), dim3(256), 0, st, H, Z);
            hipLaunchKernelGGL(nk_chan_dft, dim3(TT * (DM / 256)), dim3(256), 0, st, Z, H);
            ngemm(st, nrows, DM, DM, ADense{H, DM, nrows}, BDense{p.fw + (size_t)j * DM * DM, DM, 0}, EResid{p, i, 2, 0, nrows});
        } else {
            float* QKV = (float*)S2;
            ngemm(st, TT, QKVD, DM, ADense{H, DM, TT}, BDense{p.wqkv + (size_t)j * DM * QKVD, QKVD, 0}, EStore{QKV, QKVD, TT});
            hipLaunchKernelGGL(nk_rope_apply, dim3((unsigned)(((size_t)TL * 640 + 255) / 256)), dim3(256), 0, st, p, QKV);
            hipLaunchKernelGGL(nk_attn, dim3((unsigned)(((size_t)nrows * NH + 63) / 64)), dim3(64), 0, st, p, QKV, p.sinks + j * NH, H, nrows);
            ngemm(st, nrows, DM, DM, ADense{H, DM, nrows}, BDense{p.wo + (size_t)j * DM * DM, DM, 0}, EResid{p, i, 2, 0, nrows});
        } }
        if ((i % 2 == 0) && (MEGA_MASK & 0x01)) { mega_launch(p, pbase + 3, pbase + 6, st); continue; }
        if ((i % 2 == 1) && (MEGA_MASK & 0x02)) { mega_launch(p, pbase + 4, pbase + 8, st); continue; }
        hipLaunchKernelGGL(nk_norm_mod, dim3(nrows), dim3(256), 0, st, p, p.nfg + i * DM, i, 3, H, nrows);
        constexpr int CH = 8448;
        float* ACT = (float*)S2;
        if (i % 2 == 0) {
            for (int r0 = 0; r0 < nrows; r0 += CH) {
                const int m = nrows - r0 < CH ? nrows - r0 : CH;
                ngemm(st, m, DFF, DM, ADense{H + (size_t)r0 * DM, DM, m}, BDense{p.fg + (size_t)j * DM * DFF, DFF, 0}, ESilu{ACT, DFF, m});
                ngemm(st, m, DFF, DM, ADense{H + (size_t)r0 * DM, DM, m}, BDense{p.fu + (size_t)j * DM * DFF, DFF, 0}, EMulInto{ACT, DFF, m});
                ngemm(st, m, DM, DFF, ADense{ACT, DFF, m}, BDense{p.fd + (size_t)j * DFF * DM, DM, 0}, EResid{p, i, 5, r0, m});
            }
        } else {
            int* cnt = (int*)(ws + WS_CTL) + 1024 + 64 * i;
            int* ltok = (int*)(ws + WS_ROUTE); float* lw = (float*)(ltok + NEXP * TT); int* lk = (int*)(lw + NEXP * TT);
            float* Y0 = (float*)(S2 + 120 * MiB); float* Y1 = Y0 + (size_t)TT * DM;
            hipLaunchKernelGGL(nk_router, dim3((nrows + 255) / 256), dim3(256), 0, st, p, H, p.mr + (size_t)j * DM * NEXP, nrows, cnt, ltok, lw, lk);
            for (int e = 0; e < NEXP; ++e) {
                const size_t we = ((size_t)j * NEXP + e) * DM * DFF;
                for (int r0 = 0; r0 < nrows; r0 += CH) {
                    ngemm(st, CH, DFF, DM, AGather{H, ltok + e * TT, cnt + e, r0, CH}, BDense{p.mg + we, DFF, 0}, ESiluCnt{ACT, cnt + e, DFF, r0, CH, 0});
                    ngemm(st, CH, DFF, DM, AGather{H, ltok + e * TT, cnt + e, r0, CH}, BDense{p.mu + we, DFF, 0}, EMulCnt{ACT, cnt + e, DFF, r0, CH, 0});
                    ngemm(st, CH, DM, DFF, ADenseCnt{ACT, cnt + e, DFF, r0, CH, 0}, BDense{p.md + we, DM, 0}, EScatterY{Y0, Y1, ltok + e * TT, lw + e * TT, lk + e * TT, cnt + e, r0, CH});
                }
            }
            hipLaunchKernelGGL(nk_moe_combine, dim3((unsigned)(((size_t)nrows * DM + 255) / 256)), dim3(256), 0, st, p, Y0, Y1, i, nrows);
        }
    }
    if (MEGA_MASK & 0x10) mega_launch(p, 33, 34, st); else hipLaunchKernelGGL(nk_final_norm, dim3(TL), dim3(256), 0, st, p);
}

extern "C" void kernel_launch(void* const* d_in, const int* in_sizes, int n_in, void* d_out, int out_size, void* d_ws, size_t ws_size, hipStream_t stream) {
    if (n_in != 20 || out_size != TL * DM || ws_size < WS_MEGA_END) { fprintf(stderr, "kernel_launch: unexpected shapes n_in %d out %d ws %zu\n", n_in, out_size, ws_size); return; }
    Prm p{};
    const float** f = (const float**)&p;
    for (int i = 0; i < 20; ++i) f[i] = (const float*)d_in[i];
    p.out = (float*)d_out; p.ws = (unsigned char*)d_ws;
    if (MEGA_MASK == 0xFF) {
        hipMemsetAsync(p.ws + WS_CTL, 0, 1 * MiB, stream);
        mega_launch(p, 0, 34, stream);
    } else naive_forward(p, stream);
}
```
